# Optimizing an MI355X kernel written in HIP

```python
import math
import jax
import jax.numpy as jnp
from jax import lax
import numpy as np

D_MODEL = 1024
BATCH = 8
SEQ = 4096
DEPTH = 2

CTX_LEN = 256
GRID_W = 64
EPS = 1e-6

MLA_HEADS = D_MODEL // 128
MLA_NOPE = 64
MLA_ROPE = 32
MLA_V = 64
MLA_Q_RANK = 3 * D_MODEL // 8
MLA_KV_RANK = D_MODEL // 4
MLA_WIDTH = MLA_HEADS * MLA_V
ROPE_THETA = 10000.0
Q_BLOCK = 128

ML_HEADS = 4
ML_HEAD_DIM = D_MODEL // (4 * ML_HEADS)
ML_WIDTH = ML_HEADS * ML_HEAD_DIM
ML_CHUNK = 64
ML_CONV = 3

HY_WIDTH = D_MODEL // 4
HY_CONV = 3
HY_BANDS = 16
HY_EMB = 1 + 2 * HY_BANDS
HY_HIDDEN = 64
HY_DECAY_TARGET = 1e-2
HY_FAST_PCT = 0.3
HY_SLOW_PCT = 1.5
HY_SHIFT = 0.05

MIX_WIDTH = MLA_WIDTH + ML_WIDTH + HY_WIDTH
N_MLA_IN = MLA_Q_RANK + MLA_KV_RANK + MLA_ROPE
N_ML_IN = 3 * ML_WIDTH + 4 * ML_HEADS
N_HY_IN = 3 * HY_WIDTH
N_IN = N_MLA_IN + N_ML_IN + N_HY_IN

D_FF = ((8 * D_MODEL // 3 + 255) // 256) * 256
FFN_CONV = 3

kernel_name = 'hybrid_mla_mlstm_hyena_dit_block'


def rmsnorm(x, g):
    xf = x.astype(jnp.float32)
    y = xf * lax.rsqrt(jnp.mean(xf * xf, axis=-1, keepdims=True) + EPS)
    return (y * g.astype(jnp.float32)).astype(x.dtype)


def dwconv(x, w, b):
    width = w.shape[0]
    pad = (width - 1) // 2
    seq = x.shape[1]
    xp = jnp.pad(x, ((0, 0), (pad, pad), (0, 0)))
    y = b
    for j in range(width):
        y = y + xp[:, j:j + seq] * w[j]
    return y


def grid_angles(rows):
    n_freq = MLA_ROPE // 4
    inv = ROPE_THETA ** (-jnp.arange(n_freq, dtype=jnp.float32) / n_freq)
    row = jnp.repeat(jnp.arange(rows, dtype=jnp.float32), GRID_W)
    col = jnp.tile(jnp.arange(GRID_W, dtype=jnp.float32), rows)
    return jnp.concatenate([row[:, None] * inv, col[:, None] * inv], axis=-1)


def axial_rope(x, ang):
    half = x.shape[-1] // 2
    shape = (ang.shape[0],) + (1,) * (x.ndim - 3) + (half,)
    cos = jnp.cos(ang).reshape(shape).astype(x.dtype)
    sin = jnp.sin(ang).reshape(shape).astype(x.dtype)
    x1, x2 = x[..., :half], x[..., half:]
    return jnp.concatenate([x1 * cos - x2 * sin, x1 * sin + x2 * cos], axis=-1)


def mla_kv(p_kv, kv_norm_g, w_ukv):
    b, seq = p_kv.shape[:2]
    kv = (rmsnorm(p_kv[..., :MLA_KV_RANK], kv_norm_g) @ w_ukv).reshape(b, seq, MLA_HEADS, MLA_NOPE + MLA_V)
    return kv[..., :MLA_NOPE], p_kv[..., MLA_KV_RANK:], kv[..., MLA_NOPE:]


def mla_q(p_q, q_norm_g, w_uq):
    b, seq = p_q.shape[:2]
    q = (rmsnorm(p_q, q_norm_g) @ w_uq).reshape(b, seq, MLA_HEADS, MLA_NOPE + MLA_ROPE)
    return q[..., :MLA_NOPE], q[..., MLA_NOPE:]


def block_attention(q_nope, q_rope, k_nope, k_rope, v):
    b, n_q, h, _ = q_nope.shape
    n_blk = n_q // Q_BLOCK
    scale = (MLA_NOPE + MLA_ROPE) ** -0.5

    def blocks(a):
        return jnp.moveaxis(a.reshape((b, n_blk, Q_BLOCK) + a.shape[2:]), 1, 0)

    def one_block(args):
        qn, qr = args
        s = jnp.einsum('bqhd,bkhd->bhqk', qn, k_nope) + jnp.einsum('bqhr,bkr->bhqk', qr, k_rope)
        p = jax.nn.softmax(s.astype(jnp.float32) * scale, axis=-1).astype(v.dtype)
        return jnp.einsum('bhqk,bkhd->bqhd', p, v)

    o = lax.map(one_block, (blocks(q_nope), blocks(q_rope)))
    return jnp.moveaxis(o, 0, 1).reshape(b, n_q, h * v.shape[-1])


def mlstm_features(p, conv_w, conv_b, wq, wk, gate_b):
    b, seq = p.shape[:2]
    w = ML_WIDTH
    u = jax.nn.silu(dwconv(p[..., :w], conv_w, conv_b)).reshape(b, seq, ML_HEADS, ML_HEAD_DIM)
    q = jnp.einsum('blhd,hde->blhe', u, wq)
    k = jnp.einsum('blhd,hde->blhe', u, wk) * (ML_HEAD_DIM ** -0.5)
    v = p[..., w:2 * w].reshape(b, seq, ML_HEADS, ML_HEAD_DIM)
    o = p[..., 2 * w:3 * w].reshape(b, seq, ML_HEADS, ML_HEAD_DIM)
    gates = p[..., 3 * w:].reshape(b, seq, 4, ML_HEADS).astype(jnp.float32) + gate_b.astype(jnp.float32)
    return q, k, v, o, gates


def mlstm_zero_state(b):
    f32 = jnp.float32
    return (jnp.zeros((b, ML_HEADS, ML_HEAD_DIM, ML_HEAD_DIM), f32),
            jnp.zeros((b, ML_HEADS, ML_HEAD_DIM), f32),
            jnp.zeros((b, ML_HEADS), f32))


def mlstm_chunk_scan(q, k, v, logi, logf, state):
    b, seq, h, dh = q.shape
    n_chunk = seq // ML_CHUNK
    f32 = jnp.float32
    causal = jnp.tril(jnp.ones((ML_CHUNK, ML_CHUNK), bool))

    def chunks(a):
        return jnp.moveaxis(a.astype(f32).reshape((b, n_chunk, ML_CHUNK) + a.shape[2:]), 1, 0)

    def step(carry, xs):
        c_mat, n_vec, m = carry
        qc, kc, vc, li, lf = xs
        cum = jnp.cumsum(lf, axis=1).transpose(0, 2, 1)
        li = li.transpose(0, 2, 1)
        dlog = jnp.where(causal, cum[..., :, None] - cum[..., None, :] + li[..., None, :], -jnp.inf)
        inter = cum + m[..., None]
        m_out = jnp.maximum(inter, jnp.max(dlog, axis=-1))
        s = jnp.einsum('bthd,bshd->bhts', qc, kc) * jnp.exp(dlog - m_out[..., None])
        a = jnp.exp(inter - m_out)
        num = jnp.einsum('bhts,bshd->bthd', s, vc) + jnp.einsum('bht,bthd,bhde->bthe', a, qc, c_mat)
        den = jnp.sum(s, axis=-1) + a * jnp.einsum('bthd,bhd->bht', qc, n_vec)
        out = num / jnp.maximum(jnp.abs(den), jnp.exp(-m_out)).transpose(0, 2, 1)[..., None]
        cum_last = cum[..., -1]
        g = cum_last[..., None] - cum + li
        m_new = jnp.maximum(cum_last + m, jnp.max(g, axis=-1))
        wts = jnp.exp(g - m_new[..., None])
        decay = jnp.exp(cum_last + m - m_new)
        c_mat = decay[..., None, None] * c_mat + jnp.einsum('bhs,bshd,bshe->bhde', wts, kc, vc)
        n_vec = decay[..., None] * n_vec + jnp.einsum('bhs,bshd->bhd', wts, kc)
        return (c_mat, n_vec, m_new), out

    state, out = lax.scan(step, state, tuple(chunks(a) for a in (q, k, v, logi, logf)))
    out = jnp.moveaxis(out, 0, 1).reshape(b, seq, h, dh)
    return out.astype(v.dtype), state


def mlstm_direction(feat, direction, state):
    q, k, v, _, gates = feat
    logi = gates[:, :, 2 * direction]
    logf = jax.nn.log_sigmoid(gates[:, :, 2 * direction + 1])
    seqs = (q, k, v, logi, logf)
    if direction == 1:
        seqs = tuple(jnp.flip(a, axis=1) for a in seqs)
    out, state = mlstm_chunk_scan(*seqs, state)
    if direction == 1:
        out = jnp.flip(out, axis=1)
    return out, state


def mlstm_output(h, o, norm_g):
    b, seq = h.shape[:2]
    h = rmsnorm(h * jax.nn.sigmoid(o), norm_g.reshape(ML_HEADS, ML_HEAD_DIM))
    return h.reshape(b, seq, ML_WIDTH)


def mlstm_mixer(px, pc, conv_w, conv_b, wq, wk, gate_b, norm_g, need_ctx):
    fx = mlstm_features(px, conv_w, conv_b, wq, wk, gate_b)
    fc = mlstm_features(pc, conv_w, conv_b, wq, wk, gate_b)
    zero = mlstm_zero_state(px.shape[0])
    hx, hc = [], []
    for direction in (0, 1):
        h_c, ctx_state = mlstm_direction(fc, direction, zero)
        h_x, _ = mlstm_direction(fx, direction, ctx_state)
        hx.append(h_x)
        hc.append(h_c)
    out_x = mlstm_output(hx[0] + hx[1], fx[3], norm_g)
    out_c = mlstm_output(hc[0] + hc[1], fc[3], norm_g) if need_ctx else None
    return out_x, out_c


def hyena_filter(seq, w1, b1, w2, b2, w3, sin_freq):
    f32 = jnp.float32
    t = jnp.linspace(0.0, 1.0, seq, dtype=f32)[:, None]
    omega = 2.0 * math.pi * jnp.arange(seq, dtype=f32) / seq
    bands = jnp.linspace(1e-4, HY_BANDS - 1, HY_BANDS, dtype=f32)
    ang = omega[:, None] * bands[None, :]
    z = jnp.concatenate([t, jnp.cos(ang), -jnp.sin(ang)], axis=-1)
    freq = sin_freq.astype(f32)
    hdn = jnp.sin(freq * (z @ w1.astype(f32) + b1.astype(f32)))
    hdn = jnp.sin(freq * (hdn @ w2.astype(f32) + b2.astype(f32)))
    filt = hdn @ w3.astype(f32)
    deltas = jnp.abs(jnp.linspace(math.log(HY_DECAY_TARGET) / HY_SLOW_PCT,
                                  math.log(HY_DECAY_TARGET) / HY_FAST_PCT, HY_WIDTH, dtype=f32))
    window = jnp.exp(-t * deltas) + HY_SHIFT
    h_fwd = filt[:, :HY_WIDTH] * window
    h_bwd = filt[:, HY_WIDTH:] * window
    l1 = jnp.sum(jnp.abs(h_fwd), axis=0) + jnp.sum(jnp.abs(h_bwd[1:]), axis=0)
    taps = jnp.concatenate([h_fwd, jnp.zeros((1, HY_WIDTH), f32), h_bwd[:0:-1]], axis=0)
    return taps / l1


def hyena_mixer(p, conv_w, conv_b, w1, b1, w2, b2, w3, sin_freq, bias_d):
    seq = p.shape[1]
    u = dwconv(p, conv_w, conv_b)
    x0, x1, v = u[..., :HY_WIDTH], u[..., HY_WIDTH:2 * HY_WIDTH], u[..., 2 * HY_WIDTH:]
    z = (x1 * v).astype(jnp.float32)
    taps = hyena_filter(seq, w1, b1, w2, b2, w3, sin_freq)
    n_fft = 2 * seq
    y = jnp.fft.irfft(jnp.fft.rfft(z, n=n_fft, axis=1) * jnp.fft.rfft(taps, n=n_fft, axis=0)[None],
                      n=n_fft, axis=1)[:, :seq]
    y = y + z * bias_d.astype(jnp.float32)
    return x0 * y.astype(p.dtype)


def conv_ffn(h, w_up, conv_w, conv_b, w_down):
    u = dwconv(h @ w_up, conv_w, conv_b)
    return (jax.nn.silu(u[..., :D_FF]) * u[..., D_FF:]) @ w_down


def setup_inputs(seed: int = 0) -> dict:
    key = jax.random.key(seed)
    ks = iter(jax.random.split(key, 48))

    def nrm(shape, scale):
        return jax.random.normal(next(ks), shape, jnp.float32) * scale

    def gain(shape):
        return 1.0 + nrm(shape, 0.05)

    d = D_MODEL
    lin = jnp.linspace(3.0, 6.0, ML_HEADS, dtype=jnp.float32)
    zer = jnp.zeros((ML_HEADS,), jnp.float32)
    gate_base = jnp.stack([zer, lin, zer, lin])
    return {
        'x': nrm((BATCH, SEQ, d), 1.0),
        'c': nrm((BATCH, d), 1.0),
        'ctx': nrm((BATCH, CTX_LEN, d), 1.0),
        'c_ctx': nrm((d,), 1.0),
        'ada_w': nrm((DEPTH, d, 6 * d), 0.5 * d ** -0.5),
        'ada_b': nrm((DEPTH, 6 * d), 0.02),
        'norm1_g': gain((DEPTH, d)),
        'norm2_g': gain((DEPTH, d)),
        'w_in': nrm((DEPTH, d, N_IN), d ** -0.5),
        'mla_q_norm_g': gain((DEPTH, MLA_Q_RANK)),
        'mla_kv_norm_g': gain((DEPTH, MLA_KV_RANK)),
        'mla_w_uq': nrm((DEPTH, MLA_Q_RANK, MLA_HEADS * (MLA_NOPE + MLA_ROPE)), MLA_Q_RANK ** -0.5),
        'mla_w_ukv': nrm((DEPTH, MLA_KV_RANK, MLA_HEADS * (MLA_NOPE + MLA_V)), MLA_KV_RANK ** -0.5),
        'ml_conv_w': nrm((DEPTH, ML_CONV, ML_WIDTH), ML_CONV ** -0.5),
        'ml_conv_b': nrm((DEPTH, ML_WIDTH), 0.02),
        'ml_wq': nrm((DEPTH, ML_HEADS, ML_HEAD_DIM, ML_HEAD_DIM), ML_HEAD_DIM ** -0.5),
        'ml_wk': nrm((DEPTH, ML_HEADS, ML_HEAD_DIM, ML_HEAD_DIM), ML_HEAD_DIM ** -0.5),
        'ml_gate_b': gate_base[None] + nrm((DEPTH, 4, ML_HEADS), 0.1),
        'ml_norm_g': gain((DEPTH, ML_WIDTH)),
        'hy_conv_w': nrm((DEPTH, HY_CONV, N_HY_IN), HY_CONV ** -0.5),
        'hy_conv_b': nrm((DEPTH, N_HY_IN), 0.02),
        'hy_w1': nrm((DEPTH, HY_EMB, HY_HIDDEN), HY_EMB ** -0.5),
        'hy_b1': nrm((DEPTH, HY_HIDDEN), 0.02),
        'hy_w2': nrm((DEPTH, HY_HIDDEN, HY_HIDDEN), HY_HIDDEN ** -0.5),
        'hy_b2': nrm((DEPTH, HY_HIDDEN), 0.02),
        'hy_w3': nrm((DEPTH, HY_HIDDEN, 2 * HY_WIDTH), HY_HIDDEN ** -0.5),
        'hy_sin_freq': gain((DEPTH, HY_HIDDEN)),
        'hy_bias_d': nrm((DEPTH, HY_WIDTH), 0.1),
        'w_out': nrm((DEPTH, MIX_WIDTH, d), MIX_WIDTH ** -0.5),
        'ffn_w_up': nrm((DEPTH, d, 2 * D_FF), d ** -0.5),
        'ffn_conv_w': nrm((DEPTH, FFN_CONV, 2 * D_FF), FFN_CONV ** -0.5),
        'ffn_conv_b': nrm((DEPTH, 2 * D_FF), 0.02),
        'ffn_w_down': nrm((DEPTH, D_FF, d), D_FF ** -0.5),
        'final_norm_g': gain((d,)),
    }


def reference(x, c, ctx, c_ctx, ada_w, ada_b, norm1_g, norm2_g, w_in, mla_q_norm_g, mla_kv_norm_g,
              mla_w_uq, mla_w_ukv, ml_conv_w, ml_conv_b, ml_wq, ml_wk, ml_gate_b, ml_norm_g,
              hy_conv_w, hy_conv_b, hy_w1, hy_b1, hy_w2, hy_b2, hy_w3, hy_sin_freq, hy_bias_d,
              w_out, ffn_w_up, ffn_conv_w, ffn_conv_b, ffn_w_down, final_norm_g):
    n_rows = x.shape[1] // GRID_W
    ang = grid_angles(n_rows)
    ml_lo = N_MLA_IN
    hy_lo = N_MLA_IN + N_ML_IN
    for i in range(DEPTH):
        last = i == DEPTH - 1
        mod_x = jax.nn.silu(c) @ ada_w[i] + ada_b[i]
        mod_c = jax.nn.silu(c_ctx) @ ada_w[i] + ada_b[i]
        sh1, sc1, g1, sh2, sc2, g2 = jnp.split(mod_x[:, None, :], 6, axis=-1)
        csh1, csc1, cg1, csh2, csc2, cg2 = jnp.split(mod_c, 6, axis=-1)

        hx = rmsnorm(x, norm1_g[i]) * (1.0 + sc1) + sh1
        hc = rmsnorm(ctx, norm1_g[i]) * (1.0 + csc1) + csh1
        px = hx @ w_in[i]
        pc = hc @ (w_in[i][:, :hy_lo] if last else w_in[i])

        kn_c, kr_c, v_c = mla_kv(pc[..., MLA_Q_RANK:N_MLA_IN], mla_kv_norm_g[i], mla_w_ukv[i])
        kn_x, kr_x, v_x = mla_kv(px[..., MLA_Q_RANK:N_MLA_IN], mla_kv_norm_g[i], mla_w_ukv[i])
        qn_x, qr_x = mla_q(px[..., :MLA_Q_RANK], mla_q_norm_g[i], mla_w_uq[i])
        att_x = block_attention(qn_x, axial_rope(qr_x, ang),
                                jnp.concatenate([kn_c, kn_x], axis=1),
                                jnp.concatenate([kr_c, axial_rope(kr_x, ang)], axis=1),
                                jnp.concatenate([v_c, v_x], axis=1))

        ml_x, ml_c = mlstm_mixer(px[..., ml_lo:hy_lo], pc[..., ml_lo:hy_lo], ml_conv_w[i], ml_conv_b[i],
                                 ml_wq[i], ml_wk[i], ml_gate_b[i], ml_norm_g[i], not last)

        hy_x = hyena_mixer(px[..., hy_lo:], hy_conv_w[i], hy_conv_b[i], hy_w1[i], hy_b1[i], hy_w2[i],
                           hy_b2[i], hy_w3[i], hy_sin_freq[i], hy_bias_d[i])

        x = x + g1 * (jnp.concatenate([att_x, ml_x, hy_x], axis=-1) @ w_out[i])
        x = x + g2 * conv_ffn(rmsnorm(x, norm2_g[i]) * (1.0 + sc2) + sh2,
                              ffn_w_up[i], ffn_conv_w[i], ffn_conv_b[i], ffn_w_down[i])

        if not last:
            qn_c, qr_c = mla_q(pc[..., :MLA_Q_RANK], mla_q_norm_g[i], mla_w_uq[i])
            att_c = block_attention(qn_c, qr_c, kn_c, kr_c, v_c)
            hy_c = hyena_mixer(pc[..., hy_lo:], hy_conv_w[i], hy_conv_b[i], hy_w1[i], hy_b1[i], hy_w2[i],
                               hy_b2[i], hy_w3[i], hy_sin_freq[i], hy_bias_d[i])
            ctx = ctx + cg1 * (jnp.concatenate([att_c, ml_c, hy_c], axis=-1) @ w_out[i])
            ctx = ctx + cg2 * conv_ffn(rmsnorm(ctx, norm2_g[i]) * (1.0 + csc2) + csh2,
                                       ffn_w_up[i], ffn_conv_w[i], ffn_conv_b[i], ffn_w_down[i])
    return rmsnorm(x, final_norm_g)
```

```cpp
#ifndef HOST_EMU
#include <hip/hip_runtime.h>
#endif
#include <stdint.h>
#include <math.h>

#ifndef CFG_D_MODEL
#define CFG_D_MODEL 1024
#define CFG_BATCH 8
#define CFG_SEQ 4096
#define CFG_CTX 256
#define CFG_SCS 256
#define CFG_NFC 4
#endif

#define DEV __device__ __forceinline__

namespace cfg {
constexpr int D = CFG_D_MODEL, B = CFG_BATCH, SEQ = CFG_SEQ, CTX = CFG_CTX, DEPTH = 2, GRID_W = 64;
constexpr int RPB = CTX + SEQ;
constexpr int R = B * RPB;
constexpr float EPS = 1e-6f;
constexpr int AH = D / 128, NOPE = 64, ROPE = 32, AV = 64, QR = 3 * D / 8, KVR = D / 4, AW = AH * AV;
constexpr int QW = AH * (NOPE + ROPE);
constexpr int KVW = AH * (NOPE + AV);
constexpr int MH = 4, MD = D / 16, MW = MH * MD;
constexpr int HW = D / 4, HB = 16, HE = 33, HH = 64;
constexpr int N_MLA = QR + KVR + ROPE, N_ML = 3 * MW + 4 * MH, N_HY = 3 * HW, N_IN = N_MLA + N_ML + N_HY;
constexpr int ML_LO = N_MLA, HY_LO = N_MLA + N_ML;
constexpr int NP = (N_IN + 255) / 256 * 256;
constexpr int FF = ((8 * D / 3 + 255) / 256) * 256, FF2 = 2 * FF;
constexpr int SCS = CFG_SCS;
constexpr int SCN = RPB / SCS, NCS = CTX / SCS;
constexpr int NFC = CFG_NFC;
constexpr int FCR = (B / NFC) * RPB;
static_assert(CTX % SCS == 0 && SEQ % SCS == 0, "super-chunk must divide ctx and seq");
static_assert(B % NFC == 0, "ffn chunks");
static_assert(MD == 64 || MD == 16, "mlstm head dim");
}
using namespace cfg;

typedef unsigned short bf16;
struct alignas(16) U4 { unsigned x, y, z, w; };

DEV float u2f(unsigned u) { union { unsigned u; float f; } c; c.u = u; return c.f; }
DEV unsigned f2u(float f) { union { unsigned u; float f; } c; c.f = f; return c.u; }
DEV float bf2f(bf16 v) { return u2f(((unsigned)v) << 16); }
DEV bf16 f2bf(float f) { unsigned u = f2u(f); u += 0x7FFFu + ((u >> 16) & 1u); return (bf16)(u >> 16); }
DEV float bflo(unsigned w) { return u2f(w << 16); }
DEV float bfhi(unsigned w) { return u2f(w & 0xFFFF0000u); }
DEV float silu_f(float x) { return x / (1.0f + expf(-x)); }
DEV float sigmoid_f(float x) { return 1.0f / (1.0f + expf(-x)); }
DEV float logsigmoid_f(float x) { return x >= 0.f ? -log1pf(expf(-x)) : x - log1pf(expf(x)); }
DEV float dot8(const U4& a, const U4& b) {
    return bflo(a.x) * bflo(b.x) + bfhi(a.x) * bfhi(b.x) + bflo(a.y) * bflo(b.y) + bfhi(a.y) * bfhi(b.y) +
           bflo(a.z) * bflo(b.z) + bfhi(a.z) * bfhi(b.z) + bflo(a.w) * bflo(b.w) + bfhi(a.w) * bfhi(b.w);
}

struct Params {
    const float *x, *c, *ctx, *c_ctx, *ada_w, *ada_b, *norm1_g, *norm2_g, *w_in, *q_norm_g, *kv_norm_g, *w_uq, *w_ukv;
    const float *ml_conv_w, *ml_conv_b, *ml_wq, *ml_wk, *ml_gate_b, *ml_norm_g;
    const float *hy_conv_w, *hy_conv_b, *hy_w1, *hy_b1, *hy_w2, *hy_b2, *hy_w3, *hy_freq, *hy_bias_d;
    const float *w_out, *w_up, *ffn_conv_w, *ffn_conv_b, *w_down, *final_g;
    float* out;
    float* X;
    bf16* H;
    bf16* P;
    bf16* Q;
    bf16* KV;
    bf16* KR;
    float* RS;
    float* MOD;
    float* ROPET;
    bf16 *WinT, *WuqT, *WukvT, *WoutT, *WupT, *WdownT;
    float *HD1, *HD2;
    float* FT;
    float* FL1;
    bf16* MU;
    bf16 *MQ, *MK;
    float* FG;
    float* MS;
    float* Z;
    bf16* UF;
    bf16* GF;
};

struct RowI { int b, o, t, bi; bool ctx; };
DEV RowI rowinfo(int r) { RowI i; i.b = r / RPB; i.o = r % RPB; i.ctx = i.o < CTX; i.t = i.ctx ? i.o : i.o - CTX; i.bi = i.ctx ? B : i.b; return i; }
DEV bool has_prev(const RowI& i) { return i.t > 0; }
DEV bool has_next(const RowI& i) { return i.t + 1 < (i.ctx ? CTX : SEQ); }

enum { PH_MOD, PH_ROPE, PH_WCVT, PH_FILT_A, PH_FILT_B, PH_FILT_C, PH_FILT_D, PH_NORM1, PH_GEMM1, PH_MLA_A, PH_MLA_Q, PH_MLA_KV, PH_ATT,
       PH_ML_U, PH_ML_QK, PH_ML_F, PH_ML_B, PH_ML_S, PH_ML_O, PH_HY_Z, PH_HY_O, PH_GEMM_OUT, PH_NORM2, PH_FFN_UP, PH_FFN_CG, PH_FFN_DOWN, PH_FINAL };

DEV float dot_bf16(const bf16* a, const bf16* b, int K) {
    float acc = 0.f;
    for (int k = 0; k < K; k += 8) { const U4 av = *(const U4*)(a + k), bv = *(const U4*)(b + k); acc += dot8(av, bv); }
    return acc;
}

template <int PH> DEV void phase(const Params& p, int l, int arg, long gtid, long gth);

template <> DEV void phase<PH_MOD>(const Params& p, int, int, long gtid, long gth) {
    for (long i = gtid; i < (long)DEPTH * (B + 1) * 6 * D; i += gth) {
        const int j = (int)(i % (6 * D)), bi = (int)((i / (6 * D)) % (B + 1)), l = (int)(i / ((long)6 * D * (B + 1)));
        const float* cv = bi < B ? p.c + (long)bi * D : p.c_ctx;
        const float* w = p.ada_w + (long)l * D * 6 * D + j;
        float acc = p.ada_b[(long)l * 6 * D + j];
        for (int k = 0; k < D; ++k) acc += silu_f(cv[k]) * w[(long)k * 6 * D];
        p.MOD[i] = acc;
    }
}
template <> DEV void phase<PH_ROPE>(const Params& p, int, int, long gtid, long gth) {
    for (long i = gtid; i < (long)SEQ * 16; i += gth) {
        const int j = (int)(i % 16), t = (int)(i / 16);
        const double inv = pow(10000.0, -(double)(j & 7) / 8.0);
        const double pos = j < 8 ? (double)(t / GRID_W) : (double)(t % GRID_W);
        const double a = pos * inv;
        p.ROPET[i * 2] = (float)cos(a); p.ROPET[i * 2 + 1] = (float)sin(a);
    }
}
template <> DEV void phase<PH_WCVT>(const Params& p, int l, int, long gtid, long gth) {
    for (long i = gtid; i < (long)NP * D; i += gth) { const int k = (int)(i % D), n = (int)(i / D);
        p.WinT[i] = n < N_IN ? f2bf(p.w_in[(long)l * D * N_IN + (long)k * N_IN + n]) : (bf16)0; }
    for (long i = gtid; i < (long)QW * QR; i += gth) { const int k = (int)(i % QR), n = (int)(i / QR);
        p.WuqT[i] = f2bf(p.q_norm_g[l * QR + k] * p.w_uq[(long)l * QR * QW + (long)k * QW + n]); }
    for (long i = gtid; i < (long)KVW * KVR; i += gth) { const int k = (int)(i % KVR), n = (int)(i / KVR);
        p.WukvT[i] = f2bf(p.kv_norm_g[l * KVR + k] * p.w_ukv[(long)l * KVR * KVW + (long)k * KVW + n]); }
    for (long i = gtid; i < (long)D * D; i += gth) { const int k = (int)(i % D), n = (int)(i / D);
        p.WoutT[i] = f2bf(p.w_out[(long)l * D * D + (long)k * D + n]); }
    for (long i = gtid; i < (long)FF2 * D; i += gth) { const int k = (int)(i % D), n = (int)(i / D);
        p.WupT[i] = f2bf(p.w_up[(long)l * D * FF2 + (long)k * FF2 + n]); }
    for (long i = gtid; i < (long)D * FF; i += gth) { const int k = (int)(i % FF), n = (int)(i / FF);
        p.WdownT[i] = f2bf(p.w_down[(long)l * FF * D + (long)k * D + n]); }
}
template <> DEV void phase<PH_FILT_A>(const Params& p, int l, int, long gtid, long gth) {
    for (long i = gtid; i < (long)2 * SEQ * HH; i += gth) {
        const int j = (int)(i % HH), pos = (int)((i / HH) % SEQ), set = (int)(i / ((long)HH * SEQ));
        const int L = set ? CTX : SEQ; if (pos >= L) continue;
        const float* w1 = p.hy_w1 + (long)l * HE * HH;
        const double tl = (double)pos / (double)(L - 1);
        const double om = 2.0 * 3.14159265358979323846 * (double)pos / (double)L;
        float acc = p.hy_b1[l * HH + j] + (float)tl * w1[j];
        for (int e = 0; e < HB; ++e) {
            const double band = 1e-4 + (double)e * ((double)(HB - 1) - 1e-4) / (double)(HB - 1);
            const double a = om * band;
            acc += (float)cos(a) * w1[(1 + e) * HH + j] - (float)sin(a) * w1[(1 + HB + e) * HH + j];
        }
        p.HD1[i] = sinf(p.hy_freq[l * HH + j] * acc);
    }
}
template <> DEV void phase<PH_FILT_B>(const Params& p, int l, int, long gtid, long gth) {
    for (long i = gtid; i < (long)2 * SEQ * HH; i += gth) {
        const int j = (int)(i % HH), pos = (int)((i / HH) % SEQ), set = (int)(i / ((long)HH * SEQ));
        const int L = set ? CTX : SEQ; if (pos >= L) continue;
        const float* w2 = p.hy_w2 + (long)l * HH * HH;
        const float* h1 = p.HD1 + (i - j);
        float acc = p.hy_b2[l * HH + j];
        for (int e = 0; e < HH; ++e) acc += h1[e] * w2[e * HH + j];
        p.HD2[i] = sinf(p.hy_freq[l * HH + j] * acc);
    }
}
template <> DEV void phase<PH_FILT_C>(const Params& p, int l, int, long gtid, long gth) {
    for (long i = gtid; i < (long)2 * SEQ * 2 * HW; i += gth) {
        const int c2 = (int)(i % (2 * HW)), pos = (int)((i / (2 * HW)) % SEQ), set = (int)(i / ((long)2 * HW * SEQ));
        const int L = set ? CTX : SEQ; if (pos >= L) continue;
        const float* w3 = p.hy_w3 + (long)l * HH * 2 * HW;
        const float* h2 = p.HD2 + ((long)set * SEQ + pos) * HH;
        float acc = 0.f;
        for (int e = 0; e < HH; ++e) acc += h2[e] * w3[e * 2 * HW + c2];
        const int c = c2 % HW;
        const double a0 = log(1e-2) / 1.5, a1 = log(1e-2) / 0.3;
        const double delta = fabs(a0 + (a1 - a0) * (double)c / (double)(HW - 1));
        const double tl = (double)pos / (double)(L - 1);
        p.FT[i] = acc * ((float)exp(-tl * delta) + 0.05f);
    }
}
template <> DEV void phase<PH_FILT_D>(const Params& p, int, int, long gtid, long gth) {
    for (long i = gtid; i < (long)2 * HW; i += gth) {
        const int c = (int)(i % HW), set = (int)(i / HW); const int L = set ? CTX : SEQ;
        const float* ft = p.FT + (long)set * SEQ * 2 * HW;
        float s = 0.f;
        for (int pos = 0; pos < L; ++pos) { s += fabsf(ft[(long)pos * 2 * HW + c]); if (pos >= 1) s += fabsf(ft[(long)pos * 2 * HW + HW + c]); }
        p.FL1[i] = s;
    }
}
template <> DEV void phase<PH_NORM1>(const Params& p, int l, int, long gtid, long gth) {
    for (long r = gtid; r < R; r += gth) {
        const RowI ri = rowinfo((int)r);
        float* xr = p.X + r * D;
        if (l == 0) { const float* src = ri.ctx ? p.ctx + ((long)ri.b * CTX + ri.t) * D : p.x + ((long)ri.b * SEQ + ri.t) * D;
            for (int k = 0; k < D; ++k) xr[k] = src[k]; }
        float ss = 0.f; for (int k = 0; k < D; ++k) ss += xr[k] * xr[k];
        const float rstd = 1.0f / sqrtf(ss / (float)D + EPS);
        const float* mod = p.MOD + ((long)l * (B + 1) + ri.bi) * 6 * D;
        const float* g = p.norm1_g + l * D;
        for (int k = 0; k < D; ++k) p.H[r * D + k] = f2bf(xr[k] * rstd * g[k] * (1.0f + mod[D + k]) + mod[k]);
    }
}
template <> DEV void phase<PH_GEMM1>(const Params& p, int, int, long gtid, long gth) {
    for (long i = gtid; i < (long)R * NP; i += gth) { const int n = (int)(i % NP); const long r = i / NP;
        p.P[i] = f2bf(dot_bf16(p.H + r * D, p.WinT + (long)n * D, D)); }
}
template <> DEV void phase<PH_MLA_A>(const Params& p, int, int, long gtid, long gth) {
    for (long r = gtid; r < R; r += gth) {
        const RowI ri = rowinfo((int)r); const bf16* pr = p.P + r * NP;
        float s = 0.f; for (int k = 0; k < QR; ++k) { const float v = bf2f(pr[k]); s += v * v; }
        p.RS[r * 2] = 1.0f / sqrtf(s / (float)QR + EPS);
        s = 0.f; for (int k = 0; k < KVR; ++k) { const float v = bf2f(pr[QR + k]); s += v * v; }
        p.RS[r * 2 + 1] = 1.0f / sqrtf(s / (float)KVR + EPS);
        for (int j = 0; j < 16; ++j) {
            const float x1 = bf2f(pr[QR + KVR + j]), x2 = bf2f(pr[QR + KVR + 16 + j]);
            float cs = 1.f, sn = 0.f; if (!ri.ctx) { cs = p.ROPET[((long)ri.t * 16 + j) * 2]; sn = p.ROPET[((long)ri.t * 16 + j) * 2 + 1]; }
            p.KR[r * ROPE + j] = f2bf(x1 * cs - x2 * sn); p.KR[r * ROPE + 16 + j] = f2bf(x1 * sn + x2 * cs);
        }
    }
}
template <> DEV void phase<PH_MLA_Q>(const Params& p, int, int, long gtid, long gth) {
    for (long i = gtid; i < (long)R * QW; i += gth) { const int n = (int)(i % QW); const long r = i / QW;
        const RowI ri = rowinfo((int)r);
        const float rs = p.RS[r * 2]; const bf16* a = p.P + r * NP;
        float v = rs * dot_bf16(a, p.WuqT + (long)n * QR, QR);
        const int d = n % (NOPE + ROPE);
        if (d >= NOPE && !ri.ctx) {
            const int j = d - NOPE, jj = j & 15; const int pn = j < 16 ? n + 16 : n - 16;
            const float w = rs * dot_bf16(a, p.WuqT + (long)pn * QR, QR);
            const float cs = p.ROPET[((long)ri.t * 16 + jj) * 2], sn = p.ROPET[((long)ri.t * 16 + jj) * 2 + 1];
            v = j < 16 ? v * cs - w * sn : w * sn + v * cs;
        }
        p.Q[i] = f2bf(v);
    }
}
template <> DEV void phase<PH_MLA_KV>(const Params& p, int, int, long gtid, long gth) {
    for (long i = gtid; i < (long)R * KVW; i += gth) { const int n = (int)(i % KVW); const long r = i / KVW;
        p.KV[i] = f2bf(p.RS[r * 2 + 1] * dot_bf16(p.P + r * NP + QR, p.WukvT + (long)n * KVR, KVR)); }
}
template <> DEV void phase<PH_ATT>(const Params& p, int l, int, long gtid, long gth) {
    const bool last = (l == DEPTH - 1);
    const float scale = 1.0f / sqrtf((float)(NOPE + ROPE));
    for (long i = gtid; i < (long)AH * R; i += gth) {
        const int h = (int)(i / R); const long r = i % R; const RowI ri = rowinfo((int)r);
        if (ri.ctx && last) continue;
        float q[NOPE + ROPE];
#pragma unroll
        for (int d = 0; d < NOPE + ROPE; ++d) q[d] = bf2f(p.Q[r * QW + h * (NOPE + ROPE) + d]) * scale;
        float o[AV];
#pragma unroll
        for (int d = 0; d < AV; ++d) o[d] = 0.f;
        float m = -1e30f, ssum = 0.f;
        const long k0 = (long)ri.b * RPB; const int nk = ri.ctx ? CTX : RPB;
        for (int kk = 0; kk < nk; ++kk) {
            const bf16* kv = p.KV + (k0 + kk) * KVW + h * (NOPE + AV); const bf16* kr = p.KR + (k0 + kk) * ROPE;
            float s = 0.f;
#pragma unroll
            for (int d = 0; d < NOPE; ++d) s += q[d] * bf2f(kv[d]);
#pragma unroll
            for (int d = 0; d < ROPE; ++d) s += q[NOPE + d] * bf2f(kr[d]);
            const float mn = fmaxf(m, s); const float corr = expf(m - mn), pw = expf(s - mn);
            ssum = ssum * corr + pw; m = mn;
#pragma unroll
            for (int d = 0; d < AV; ++d) o[d] = o[d] * corr + pw * bf2f(kv[NOPE + d]);
        }
        const float inv = 1.0f / ssum;
#pragma unroll
        for (int d = 0; d < AV; ++d) p.H[r * D + h * AV + d] = f2bf(o[d] * inv);
    }
}
template <> DEV void phase<PH_ML_U>(const Params& p, int l, int, long gtid, long gth) {
    for (long i = gtid; i < (long)R * MW; i += gth) { const int c = (int)(i % MW); const long r = i / MW; const RowI ri = rowinfo((int)r);
        const float* w = p.ml_conv_w + (long)l * 3 * MW; const bf16* pr = p.P + r * NP + ML_LO + c;
        float y = p.ml_conv_b[l * MW + c] + w[MW + c] * bf2f(pr[0]);
        if (has_prev(ri)) y += w[c] * bf2f(pr[-NP]);
        if (has_next(ri)) y += w[2 * MW + c] * bf2f(pr[NP]);
        p.MU[i] = f2bf(silu_f(y)); }
}
template <> DEV void phase<PH_ML_QK>(const Params& p, int l, int, long gtid, long gth) {
    const float ksc = 1.0f / sqrtf((float)MD);
    for (long i = gtid; i < (long)R * MW; i += gth) { const int c = (int)(i % MW); const long r = i / MW; const int h = c / MD, e = c % MD;
        const float* wq = p.ml_wq + ((long)l * MH + h) * MD * MD + e; const float* wk = p.ml_wk + ((long)l * MH + h) * MD * MD + e;
        float aq = 0.f, ak = 0.f;
        for (int d = 0; d < MD; ++d) { const float u = bf2f(p.MU[r * MW + h * MD + d]); aq += u * wq[d * MD]; ak += u * wk[d * MD]; }
        p.MQ[i] = f2bf(aq); p.MK[i] = f2bf(ak * ksc); }
}
DEV int ml_scan_o(int dir, int pos) { return dir == 0 ? pos : (pos < CTX ? CTX - 1 - pos : RPB - 1 - (pos - CTX)); }
DEV int ml_scan_sc(int dir, int k) { return dir == 0 ? k : (k < NCS ? NCS - 1 - k : SCN - 1 - (k - NCS)); }
DEV int ml_sc_rank(int dir, int sc) { return dir == 0 ? sc : (sc < NCS ? NCS - 1 - sc : NCS + (SCN - 1 - sc)); }
template <> DEV void phase<PH_ML_F>(const Params& p, int l, int, long gtid, long gth) {
    for (long i = gtid; i < (long)B * MH * 2; i += gth) { const int dir = (int)(i % 2), h = (int)((i / 2) % MH), b = (int)(i / (2 * MH));
        const float bi_ = p.ml_gate_b[(l * 4 + 2 * dir) * MH + h], bf_ = p.ml_gate_b[(l * 4 + 2 * dir + 1) * MH + h];
        float F = 0.f;
        for (int pos = 0; pos < RPB; ++pos) { const long r = (long)b * RPB + ml_scan_o(dir, pos);
            const bf16* g = p.P + r * NP + ML_LO + 3 * MW;
            const float li = bf2f(g[(2 * dir) * MH + h]) + bi_, lf = logsigmoid_f(bf2f(g[(2 * dir + 1) * MH + h]) + bf_);
            F += lf; float* fg = p.FG + ((r * 2 + dir) * MH + h) * 2; fg[0] = F; fg[1] = F - li; }
    }
}
template <> DEV void phase<PH_ML_B>(const Params& p, int, int, long gtid, long gth) {
    for (long i = gtid; i < (long)B * MH * 2 * SCN * (MD + 1) * MD; i += gth) {
        const int e = (int)(i % MD), jrow = (int)((i / MD) % (MD + 1)); long t = i / ((long)MD * (MD + 1));
        const int sc = (int)(t % SCN); t /= SCN; const int dir = (int)(t % 2); t /= 2; const int h = (int)(t % MH); const int b = (int)(t / MH);
        const long r0 = (long)b * RPB + (long)sc * SCS; const long rend = dir == 0 ? r0 + SCS - 1 : r0;
        const float Fend = p.FG[((rend * 2 + dir) * MH + h) * 2];
        float acc = 0.f;
        for (int s = 0; s < SCS; ++s) { const long r = r0 + s; const float w = expf(Fend - p.FG[((r * 2 + dir) * MH + h) * 2 + 1]);
            if (jrow < MD) acc += w * bf2f(p.MK[r * MW + h * MD + jrow]) * bf2f(p.P[r * NP + ML_LO + MW + h * MD + e]);
            else acc += w * bf2f(p.MK[r * MW + h * MD + e]); }
        p.MS[i] = acc;
    }
}
template <> DEV void phase<PH_ML_S>(const Params& p, int, int, long gtid, long gth) {
    for (long i = gtid; i < (long)B * MH * 2 * (MD + 1) * MD; i += gth) {
        const int el = (int)(i % ((MD + 1) * MD)); long t = i / ((MD + 1) * MD); const int dir = (int)(t % 2); t /= 2; const int h = (int)(t % MH); const int b = (int)(t / MH);
        float* base = p.MS + ((((long)b * MH + h) * 2 + dir) * SCN) * (MD + 1) * MD + el;
        float C = 0.f, Fprev = 0.f;
        for (int k = 0; k < SCN; ++k) { const int sc = ml_scan_sc(dir, k);
            const long r0 = (long)b * RPB + (long)sc * SCS; const long rend = dir == 0 ? r0 + SCS - 1 : r0;
            const float Fend = p.FG[((rend * 2 + dir) * MH + h) * 2];
            float* slot = base + (long)sc * (MD + 1) * MD; const float Bk = *slot; *slot = C;
            C = expf(Fend - Fprev) * C + Bk; Fprev = Fend; }
    }
}
template <> DEV void phase<PH_ML_O>(const Params& p, int l, int, long gtid, long gth) {
    const bool last = (l == DEPTH - 1);
    for (long i = gtid; i < (long)MH * R; i += gth) {
        const int h = (int)(i / R); const long r = i % R; const RowI ri = rowinfo((int)r);
        if (ri.ctx && last) continue;
        float q[MD], hs[MD], num[MD];
#pragma unroll
        for (int d = 0; d < MD; ++d) { q[d] = bf2f(p.MQ[r * MW + h * MD + d]); hs[d] = 0.f; }
        const int sc = ri.o / SCS; const long r0 = (long)ri.b * RPB + (long)sc * SCS;
        for (int dir = 0; dir < 2; ++dir) {
#pragma unroll
            for (int d = 0; d < MD; ++d) num[d] = 0.f;
            float den = 0.f;
            const float Ft = p.FG[((r * 2 + dir) * MH + h) * 2];
            const long sa = dir == 0 ? r0 : r, sb = dir == 0 ? r : r0 + SCS - 1;
            for (long s = sa; s <= sb; ++s) {
                const float w = expf(Ft - p.FG[((s * 2 + dir) * MH + h) * 2 + 1]);
                float dt = 0.f;
#pragma unroll
                for (int d = 0; d < MD; ++d) dt += q[d] * bf2f(p.MK[s * MW + h * MD + d]);
                dt *= w; den += dt;
#pragma unroll
                for (int d = 0; d < MD; ++d) num[d] += dt * bf2f(p.P[s * NP + ML_LO + MW + h * MD + d]);
            }
            const int k = ml_sc_rank(dir, sc);
            if (k > 0) {
                const int scp = ml_scan_sc(dir, k - 1); const long rp0 = (long)ri.b * RPB + (long)scp * SCS; const long rpe = dir == 0 ? rp0 + SCS - 1 : rp0;
                const float a = expf(Ft - p.FG[((rpe * 2 + dir) * MH + h) * 2]);
                const float* Cin = p.MS + (((((long)ri.b * MH + h) * 2 + dir) * SCN) + sc) * (MD + 1) * MD;
#pragma unroll 1
                for (int d = 0; d < MD; ++d) { const float qa = bf2f(p.MQ[r * MW + h * MD + d]) * a; den += qa * Cin[MD * MD + d];
#pragma unroll
                    for (int e = 0; e < MD; ++e) num[e] += qa * Cin[d * MD + e]; }
            }
            const float dn = 1.0f / fmaxf(fabsf(den), 1.0f);
#pragma unroll
            for (int d = 0; d < MD; ++d) hs[d] += num[d] * dn;
        }
        float ss = 0.f;
#pragma unroll
        for (int d = 0; d < MD; ++d) { hs[d] *= sigmoid_f(bf2f(p.P[r * NP + ML_LO + 2 * MW + h * MD + d])); ss += hs[d] * hs[d]; }
        const float rstd = 1.0f / sqrtf(ss / (float)MD + EPS);
#pragma unroll
        for (int d = 0; d < MD; ++d) p.H[r * D + AW + h * MD + d] = f2bf(hs[d] * rstd * p.ml_norm_g[l * MW + h * MD + d]);
    }
}
DEV float hy_conv(const Params& p, int l, long r, const RowI& ri, int ch) {
    const float* w = p.hy_conv_w + (long)l * 3 * N_HY; const bf16* pr = p.P + r * NP + HY_LO + ch;
    float y = p.hy_conv_b[l * N_HY + ch] + w[N_HY + ch] * bf2f(pr[0]);
    if (has_prev(ri)) y += w[ch] * bf2f(pr[-NP]);
    if (has_next(ri)) y += w[2 * N_HY + ch] * bf2f(pr[NP]);
    return y;
}
template <> DEV void phase<PH_HY_Z>(const Params& p, int l, int, long gtid, long gth) {
    for (long i = gtid; i < (long)R * HW; i += gth) { const int c = (int)(i % HW); const long r = i / HW; const RowI ri = rowinfo((int)r);
        p.Z[i] = hy_conv(p, l, r, ri, HW + c) * hy_conv(p, l, r, ri, 2 * HW + c); }
}
template <> DEV void phase<PH_HY_O>(const Params& p, int l, int, long gtid, long gth) {
    const bool last = (l == DEPTH - 1);
    for (long i = gtid; i < (long)R * HW; i += gth) { const int c = (int)(i % HW); const long r = i / HW; const RowI ri = rowinfo((int)r);
        if (ri.ctx && last) continue;
        const int set = ri.ctx ? 1 : 0, L = ri.ctx ? CTX : SEQ;
        const float* ft = p.FT + (long)set * SEQ * 2 * HW; const float* z = p.Z + (r - ri.t) * HW + c;
        float y = 0.f;
        for (int s = 0; s <= ri.t; ++s) y += ft[(long)(ri.t - s) * 2 * HW + c] * z[(long)s * HW];
        for (int s = ri.t + 1; s < L; ++s) y += ft[(long)(s - ri.t) * 2 * HW + HW + c] * z[(long)s * HW];
        y = y / p.FL1[set * HW + c] + z[(long)ri.t * HW] * p.hy_bias_d[l * HW + c];
        p.H[r * D + AW + MW + c] = f2bf(hy_conv(p, l, r, ri, c) * y); }
}
template <> DEV void phase<PH_GEMM_OUT>(const Params& p, int l, int, long gtid, long gth) {
    for (long i = gtid; i < (long)R * D; i += gth) { const int n = (int)(i % D); const long r = i / D; const RowI ri = rowinfo((int)r);
        const float g1 = p.MOD[((long)l * (B + 1) + ri.bi) * 6 * D + 2 * D + n];
        p.X[i] += g1 * dot_bf16(p.H + r * D, p.WoutT + (long)n * D, D); }
}
template <> DEV void phase<PH_NORM2>(const Params& p, int l, int, long gtid, long gth) {
    for (long r = gtid; r < R; r += gth) { const RowI ri = rowinfo((int)r); const float* xr = p.X + r * D;
        float ss = 0.f; for (int k = 0; k < D; ++k) ss += xr[k] * xr[k];
        const float rstd = 1.0f / sqrtf(ss / (float)D + EPS);
        const float* mod = p.MOD + ((long)l * (B + 1) + ri.bi) * 6 * D; const float* g = p.norm2_g + l * D;
        for (int k = 0; k < D; ++k) p.H[r * D + k] = f2bf(xr[k] * rstd * g[k] * (1.0f + mod[4 * D + k]) + mod[3 * D + k]); }
}
template <> DEV void phase<PH_FFN_UP>(const Params& p, int, int fc, long gtid, long gth) {
    for (long i = gtid; i < (long)FCR * FF2; i += gth) { const int n = (int)(i % FF2); const long rr = i / FF2; const long r = (long)fc * FCR + rr;
        p.UF[i] = f2bf(dot_bf16(p.H + r * D, p.WupT + (long)n * D, D)); }
}
template <> DEV void phase<PH_FFN_CG>(const Params& p, int l, int fc, long gtid, long gth) {
    for (long i = gtid; i < (long)FCR * FF; i += gth) { const int j = (int)(i % FF); const long rr = i / FF; const long r = (long)fc * FCR + rr; const RowI ri = rowinfo((int)r);
        const float* w = p.ffn_conv_w + (long)l * 3 * FF2; const float* cb = p.ffn_conv_b + (long)l * FF2; const bf16* u = p.UF + rr * FF2;
        float a = cb[j] + w[FF2 + j] * bf2f(u[j]), g = cb[FF + j] + w[FF2 + FF + j] * bf2f(u[FF + j]);
        if (has_prev(ri)) { a += w[j] * bf2f(u[j - FF2]); g += w[FF + j] * bf2f(u[FF + j - FF2]); }
        if (has_next(ri)) { a += w[2 * FF2 + j] * bf2f(u[j + FF2]); g += w[2 * FF2 + FF + j] * bf2f(u[FF + j + FF2]); }
        p.GF[i] = f2bf(silu_f(a) * g); }
}
template <> DEV void phase<PH_FFN_DOWN>(const Params& p, int l, int fc, long gtid, long gth) {
    for (long i = gtid; i < (long)FCR * D; i += gth) { const int n = (int)(i % D); const long rr = i / D; const long r = (long)fc * FCR + rr; const RowI ri = rowinfo((int)r);
        const float g2 = p.MOD[((long)l * (B + 1) + ri.bi) * 6 * D + 5 * D + n];
        p.X[r * D + n] += g2 * dot_bf16(p.GF + rr * FF, p.WdownT + (long)n * FF, FF); }
}
template <> DEV void phase<PH_FINAL>(const Params& p, int, int, long gtid, long gth) {
    for (long q = gtid; q < (long)B * SEQ; q += gth) { const int b = (int)(q / SEQ), t = (int)(q % SEQ); const float* xr = p.X + ((long)b * RPB + CTX + t) * D;
        float ss = 0.f; for (int k = 0; k < D; ++k) ss += xr[k] * xr[k];
        const float rstd = 1.0f / sqrtf(ss / (float)D + EPS);
        for (int k = 0; k < D; ++k) p.out[q * D + k] = xr[k] * rstd * p.final_g[k]; }
}

template <int PH> __global__ void __launch_bounds__(256) k_phase(Params p, int l, int arg) {
    phase<PH>(p, l, arg, (long)blockIdx.x * blockDim.x + threadIdx.x, (long)gridDim.x * blockDim.x);
}

#ifdef HOST_EMU
#define LAUNCH(PH, l, arg) emu_launch([&](long gtid, long gth) { phase<PH>(p, l, arg, gtid, gth); })
#else
#define LAUNCH(PH, l, arg) hipLaunchKernelGGL((k_phase<PH>), dim3(GRID), dim3(256), 0, stream, p, l, arg)
#endif

static inline char* carve(char*& cur, size_t bytes) { char* r = cur; cur += (bytes + 255) & ~(size_t)255; return r; }

extern "C" void kernel_launch(void* const* d_in, const int* in_sizes, int n_in, void* d_out, int out_size, void* d_ws, size_t ws_size, hipStream_t stream) {
    (void)in_sizes; (void)n_in; (void)out_size; (void)ws_size;
    Params p{};
    const float* const* in = (const float* const*)d_in;
    p.x = in[0]; p.c = in[1]; p.ctx = in[2]; p.c_ctx = in[3]; p.ada_w = in[4]; p.ada_b = in[5]; p.norm1_g = in[6]; p.norm2_g = in[7]; p.w_in = in[8];
    p.q_norm_g = in[9]; p.kv_norm_g = in[10]; p.w_uq = in[11]; p.w_ukv = in[12]; p.ml_conv_w = in[13]; p.ml_conv_b = in[14]; p.ml_wq = in[15]; p.ml_wk = in[16];
    p.ml_gate_b = in[17]; p.ml_norm_g = in[18]; p.hy_conv_w = in[19]; p.hy_conv_b = in[20]; p.hy_w1 = in[21]; p.hy_b1 = in[22]; p.hy_w2 = in[23]; p.hy_b2 = in[24];
    p.hy_w3 = in[25]; p.hy_freq = in[26]; p.hy_bias_d = in[27]; p.w_out = in[28]; p.w_up = in[29]; p.ffn_conv_w = in[30]; p.ffn_conv_b = in[31]; p.w_down = in[32]; p.final_g = in[33];
    p.out = (float*)d_out;
    char* cur = (char*)d_ws;
    p.X = (float*)carve(cur, (size_t)R * D * 4);
    p.H = (bf16*)carve(cur, (size_t)R * D * 2);
    p.MOD = (float*)carve(cur, (size_t)DEPTH * (B + 1) * 6 * D * 4);
    p.ROPET = (float*)carve(cur, (size_t)SEQ * 16 * 2 * 4);
    p.WinT = (bf16*)carve(cur, (size_t)NP * D * 2); p.WuqT = (bf16*)carve(cur, (size_t)QW * QR * 2); p.WukvT = (bf16*)carve(cur, (size_t)KVW * KVR * 2);
    p.WoutT = (bf16*)carve(cur, (size_t)D * D * 2); p.WupT = (bf16*)carve(cur, (size_t)FF2 * D * 2); p.WdownT = (bf16*)carve(cur, (size_t)D * FF * 2);
    p.HD1 = (float*)carve(cur, (size_t)2 * SEQ * HH * 4); p.HD2 = (float*)carve(cur, (size_t)2 * SEQ * HH * 4);
    p.FT = (float*)carve(cur, (size_t)2 * SEQ * 2 * HW * 4); p.FL1 = (float*)carve(cur, (size_t)2 * HW * 4);
    char* mix0 = cur;
    p.P = (bf16*)carve(cur, (size_t)R * NP * 2);
    p.KR = (bf16*)carve(cur, (size_t)R * ROPE * 2); p.RS = (float*)carve(cur, (size_t)R * 2 * 4);
    p.MQ = (bf16*)carve(cur, (size_t)R * MW * 2); p.MK = (bf16*)carve(cur, (size_t)R * MW * 2);
    p.FG = (float*)carve(cur, (size_t)R * 2 * MH * 2 * 4);
    p.MS = (float*)carve(cur, (size_t)B * MH * 2 * SCN * (MD + 1) * MD * 4);
    p.Z = (float*)carve(cur, (size_t)R * HW * 4); p.MU = (bf16*)p.Z;
    char* fc = mix0;
    p.UF = (bf16*)carve(fc, (size_t)FCR * FF2 * 2); p.GF = (bf16*)carve(fc, (size_t)FCR * FF * 2);
    p.Q = (bf16*)d_out; p.KV = (bf16*)((char*)d_out + (((size_t)R * QW * 2 + 255) & ~(size_t)255));
    const int GRID = 2048;
    LAUNCH(PH_MOD, 0, 0); LAUNCH(PH_ROPE, 0, 0);
    for (int l = 0; l < DEPTH; ++l) {
        LAUNCH(PH_WCVT, l, 0);
        LAUNCH(PH_FILT_A, l, 0); LAUNCH(PH_FILT_B, l, 0); LAUNCH(PH_FILT_C, l, 0); LAUNCH(PH_FILT_D, l, 0);
        LAUNCH(PH_NORM1, l, 0); LAUNCH(PH_GEMM1, l, 0);
        LAUNCH(PH_MLA_A, l, 0); LAUNCH(PH_MLA_Q, l, 0); LAUNCH(PH_MLA_KV, l, 0); LAUNCH(PH_ATT, l, 0);
        LAUNCH(PH_ML_U, l, 0); LAUNCH(PH_ML_QK, l, 0); LAUNCH(PH_ML_F, l, 0); LAUNCH(PH_ML_B, l, 0); LAUNCH(PH_ML_S, l, 0); LAUNCH(PH_ML_O, l, 0);
        LAUNCH(PH_HY_Z, l, 0); LAUNCH(PH_HY_O, l, 0);
        LAUNCH(PH_GEMM_OUT, l, 0); LAUNCH(PH_NORM2, l, 0);
        for (int fcI = 0; fcI < NFC; ++fcI) { LAUNCH(PH_FFN_UP, l, fcI); LAUNCH(PH_FFN_CG, l, fcI); LAUNCH(PH_FFN_DOWN, l, fcI); }
    }
    LAUNCH(PH_FINAL, 0, 0);
}
```

```cpp
#ifndef HOST_EMU
#include <hip/hip_runtime.h>
#endif
#include <stdint.h>
#include <math.h>

#ifndef CFG_D_MODEL
#define CFG_D_MODEL 1024
#define CFG_BATCH 8
#define CFG_SEQ 4096
#define CFG_CTX 256
#define CFG_SCS 256
#define CFG_NFC 4
#endif

#define DEV __device__ __forceinline__

namespace cfg {
constexpr int D = CFG_D_MODEL, B = CFG_BATCH, SEQ = CFG_SEQ, CTX = CFG_CTX, DEPTH = 2, GRID_W = 64;
constexpr int RPB = CTX + SEQ;
constexpr int R = B * RPB;
constexpr float EPS = 1e-6f;
constexpr int AH = D / 128, NOPE = 64, ROPE = 32, AV = 64, QR = 3 * D / 8, KVR = D / 4, AW = AH * AV;
constexpr int QW = AH * (NOPE + ROPE);
constexpr int KVW = AH * (NOPE + AV);
constexpr int MH = 4, MD = D / 16, MW = MH * MD;
constexpr int HW = D / 4, HB = 16, HE = 33, HH = 64;
constexpr int N_MLA = QR + KVR + ROPE, N_ML = 3 * MW + 4 * MH, N_HY = 3 * HW, N_IN = N_MLA + N_ML + N_HY;
constexpr int ML_LO = N_MLA, HY_LO = N_MLA + N_ML;
constexpr int NP = (N_IN + 255) / 256 * 256;
constexpr int FF = ((8 * D / 3 + 255) / 256) * 256, FF2 = 2 * FF;
constexpr int SCS = CFG_SCS;
constexpr int SCN = RPB / SCS, NCS = CTX / SCS;
constexpr int NFC = CFG_NFC;
constexpr int FCR = (B / NFC) * RPB;
static_assert(CTX % SCS == 0 && SEQ % SCS == 0, "super-chunk must divide ctx and seq");
static_assert(B % NFC == 0, "ffn chunks");
static_assert(MD == 64 || MD == 16, "mlstm head dim");
}
using namespace cfg;
constexpr int NTHREADS = 512, NBLOCKS = 256;

typedef unsigned short bf16;
struct alignas(16) U4 { unsigned x, y, z, w; };

DEV float u2f(unsigned u) { union { unsigned u; float f; } c; c.u = u; return c.f; }
DEV unsigned f2u(float f) { union { unsigned u; float f; } c; c.f = f; return c.u; }
DEV float bf2f(bf16 v) { return u2f(((unsigned)v) << 16); }
DEV bf16 f2bf(float f) { unsigned u = f2u(f); u += 0x7FFFu + ((u >> 16) & 1u); return (bf16)(u >> 16); }
DEV float bflo(unsigned w) { return u2f(w << 16); }
DEV float bfhi(unsigned w) { return u2f(w & 0xFFFF0000u); }
#ifdef HOST_EMU
DEV float sin_f(float x) { return sinf(x); }
DEV float cos_t(float turns) { return cosf(6.283185307179586f * turns); }
DEV float sin_t(float turns) { return sinf(6.283185307179586f * turns); }
#else
DEV float sin_f(float x) { return __builtin_amdgcn_sinf(__builtin_amdgcn_fractf(x * 0.15915494309189535f)); }
DEV float cos_t(float turns) { return __builtin_amdgcn_cosf(turns); }
DEV float sin_t(float turns) { return __builtin_amdgcn_sinf(turns); }
#endif
#ifdef HOST_EMU
DEV float exp_f(float x) { return expf(x); }
DEV float log1p_f(float y) { return log1pf(y); }
#else
DEV float exp_f(float x) { return __builtin_amdgcn_exp2f(x * 1.4426950408889634f); }
DEV float log1p_f(float y) { return __builtin_amdgcn_logf(1.0f + y) * 0.6931471805599453f; }
#endif
#ifdef HOST_EMU
DEV float rcp_f(float x) { return 1.0f / x; }
#else
DEV float rcp_f(float x) { return __builtin_amdgcn_rcpf(x); }
#endif
DEV float silu_f(float x) { return x * rcp_f(1.0f + exp_f(-x)); }
DEV float sigmoid_f(float x) { return rcp_f(1.0f + exp_f(-x)); }
DEV float logsigmoid_f(float x) { return x >= 0.f ? -log1p_f(exp_f(-x)) : x - log1p_f(exp_f(x)); }
DEV float dot8(const U4& a, const U4& b) {
    return bflo(a.x) * bflo(b.x) + bfhi(a.x) * bfhi(b.x) + bflo(a.y) * bflo(b.y) + bfhi(a.y) * bfhi(b.y) +
           bflo(a.z) * bflo(b.z) + bfhi(a.z) * bfhi(b.z) + bflo(a.w) * bflo(b.w) + bfhi(a.w) * bfhi(b.w);
}

constexpr size_t CTL_BYTES = 65536;
constexpr size_t al256(size_t x) { return (x + 255) & ~(size_t)255; }
constexpr size_t OFF_ctl = 0, SZ_ctl = al256(CTL_BYTES);
constexpr size_t OFF_X = OFF_ctl + SZ_ctl, SZ_X = al256((size_t)R * D * 2);
constexpr size_t OFF_H = OFF_X + SZ_X, SZ_H = al256((size_t)R * D * 2);
constexpr size_t OFF_MOD = OFF_H + SZ_H, SZ_MOD = al256((size_t)DEPTH * (B + 1) * 6 * D * 4);
constexpr size_t OFF_MODP = OFF_MOD + SZ_MOD, SZ_MODP = al256((size_t)8 * DEPTH * (B + 1) * 6 * D * 4);
constexpr size_t OFF_ROPET = OFF_MODP + SZ_MODP, SZ_ROPET = al256((size_t)SEQ * 16 * 2 * 4);
constexpr size_t OFF_WinT = OFF_ROPET + SZ_ROPET, SZ_WinT = al256((size_t)NP * D * 2);
constexpr size_t OFF_WuqT = OFF_WinT + SZ_WinT, SZ_WuqT = al256((size_t)QW * QR * 2);
constexpr size_t OFF_WukvT = OFF_WuqT + SZ_WuqT, SZ_WukvT = al256((size_t)KVW * KVR * 2);
constexpr size_t OFF_WoutT = OFF_WukvT + SZ_WukvT, SZ_WoutT = al256((size_t)D * D * 2);
constexpr size_t OFF_WupT = OFF_WoutT + SZ_WoutT, SZ_WupT = al256((size_t)FF2 * D * 2);
constexpr size_t OFF_WdownT = OFF_WupT + SZ_WupT, SZ_WdownT = al256((size_t)D * FF * 2);
constexpr size_t OFF_HD1 = OFF_WdownT + SZ_WdownT, SZ_HD1 = al256((size_t)2 * SEQ * HH * 4);
constexpr size_t OFF_HD2 = OFF_HD1 + SZ_HD1, SZ_HD2 = al256((size_t)2 * SEQ * HH * 4);
constexpr size_t OFF_FT = OFF_HD2 + SZ_HD2, SZ_FT = al256((size_t)2 * HW * SEQ * 4);
constexpr size_t OFF_FT1 = OFF_FT + SZ_FT, SZ_FT1 = al256((size_t)CTX * 2 * HW * 4);
constexpr size_t OFF_FL1 = OFF_FT1 + SZ_FT1, SZ_FL1 = al256((size_t)2 * HW * 64 * 4);
constexpr size_t OFF_HSPEC = OFF_FL1 + SZ_FL1, SZ_HSPEC = al256((size_t)HW * 2 * SEQ * 8);
constexpr size_t OFF_P = OFF_HSPEC + SZ_HSPEC, SZ_P = al256((size_t)R * NP * 2);
constexpr size_t OFF_KR = OFF_P + SZ_P, SZ_KR = al256((size_t)R * ROPE * 2);
constexpr size_t OFF_RS = OFF_KR + SZ_KR, SZ_RS = al256((size_t)R * 2 * 4);
constexpr size_t OFF_MQK = OFF_RS + SZ_RS, SZ_MQK = al256((size_t)R * 2 * MW * 2);
constexpr size_t OFF_WML = OFF_MQK + SZ_MQK, SZ_WML = al256((size_t)2 * MW * MW * 2);
constexpr size_t OFF_FG = OFF_WML + SZ_WML, SZ_FG = al256((size_t)R * 2 * MH * 2 * 4);
constexpr size_t OFF_MS = OFF_FG + SZ_FG, SZ_MS = al256((size_t)B * MH * 2 * SCN * (MD + 1) * MD * 4);
constexpr size_t OFF_Z = OFF_MS + SZ_MS, SZ_Z = al256((size_t)B * CTX * HW * 4);
constexpr size_t OFF_ZT = OFF_Z + SZ_Z, SZ_ZT = al256((size_t)B * HW * SEQ * 2);
#ifdef HOST_EMU
constexpr size_t OFF_UF = OFF_P, SZ_UF = al256((size_t)FCR * FF2 * 2), OFF_GF = OFF_UF + SZ_UF, SZ_GF = al256((size_t)FCR * FF * 2);
#else
constexpr size_t OFF_UF = OFF_P, SZ_UF = 0, OFF_GF = OFF_P, SZ_GF = al256((size_t)R * FF * 2);
#endif
constexpr size_t WS_BASE = (OFF_ZT + SZ_ZT) > (OFF_GF + SZ_GF) ? (OFF_ZT + SZ_ZT) : (OFF_GF + SZ_GF);
constexpr size_t OFF_WSET1 = WS_BASE, SZ_WSET = OFF_HD1 - OFF_WinT, WSET_STRIDE = OFF_WSET1 - OFF_WinT;
constexpr size_t WS_NEED = OFF_WSET1 + SZ_WSET;
static_assert(WS_NEED <= (size_t)536870912 || D != 1024, "workspace");
constexpr size_t OFF_Q = 0, OFF_KN = al256((size_t)R * QW * 2), OFF_VT = OFF_KN + al256((size_t)R * AW * 2);
static_assert(OFF_VT + (size_t)R * AW * 2 <= (size_t)B * SEQ * D * 4 || D != 1024, "d_out scratch");
struct Params {
    const float *x, *c, *ctx, *c_ctx, *ada_w, *ada_b, *norm1_g, *norm2_g, *w_in, *q_norm_g, *kv_norm_g, *w_uq, *w_ukv;
    const float *ml_conv_w, *ml_conv_b, *ml_wq, *ml_wk, *ml_gate_b, *ml_norm_g;
    const float *hy_conv_w, *hy_conv_b, *hy_w1, *hy_b1, *hy_w2, *hy_b2, *hy_w3, *hy_freq, *hy_bias_d;
    const float *w_out, *w_up, *ffn_conv_w, *ffn_conv_b, *w_down, *final_g;
    float* out;
    char* ws;
};

DEV unsigned* wctl(char* ws) { return (unsigned*)(ws + OFF_ctl); }
DEV bf16* wX(char* ws) { return (bf16*)(ws + OFF_X); }
DEV bf16* wH(char* ws) { return (bf16*)(ws + OFF_H); }
DEV float* wMOD(char* ws) { return (float*)(ws + OFF_MOD); }
DEV float* wROPET(char* ws) { return (float*)(ws + OFF_ROPET); }
DEV bf16* wWinT(char* ws, int l) { return (bf16*)(ws + OFF_WinT + (size_t)(l & 1) * WSET_STRIDE); }
DEV bf16* wWuqT(char* ws, int l) { return (bf16*)(ws + OFF_WuqT + (size_t)(l & 1) * WSET_STRIDE); }
DEV bf16* wWukvT(char* ws, int l) { return (bf16*)(ws + OFF_WukvT + (size_t)(l & 1) * WSET_STRIDE); }
DEV bf16* wWoutT(char* ws, int l) { return (bf16*)(ws + OFF_WoutT + (size_t)(l & 1) * WSET_STRIDE); }
DEV bf16* wWupT(char* ws, int l) { return (bf16*)(ws + OFF_WupT + (size_t)(l & 1) * WSET_STRIDE); }
DEV bf16* wWdownT(char* ws, int l) { return (bf16*)(ws + OFF_WdownT + (size_t)(l & 1) * WSET_STRIDE); }
DEV float* wHD1(char* ws) { return (float*)(ws + OFF_HD1); }
DEV float* wHD2(char* ws) { return (float*)(ws + OFF_HD2); }
DEV float* wFT(char* ws) { return (float*)(ws + OFF_FT); }
DEV float* wFL1(char* ws) { return (float*)(ws + OFF_FL1); }
DEV float* wMODP(char* ws) { return (float*)(ws + OFF_MODP); }
DEV float* wFT1(char* ws) { return (float*)(ws + OFF_FT1); }
DEV bf16* wZT(char* ws) { return (bf16*)(ws + OFF_ZT); }
struct alignas(8) C2 { float x, y; };
DEV C2* wHSPEC(char* ws) { return (C2*)(ws + OFF_HSPEC); }
DEV bf16* wP(char* ws) { return (bf16*)(ws + OFF_P); }
DEV bf16* wKR(char* ws) { return (bf16*)(ws + OFF_KR); }
DEV float* wRS(char* ws) { return (float*)(ws + OFF_RS); }
DEV bf16* wMQK(char* ws) { return (bf16*)(ws + OFF_MQK); }
DEV bf16* wWML(char* ws) { return (bf16*)(ws + OFF_WML); }
DEV bf16* wMU(char* ws) { return (bf16*)(ws + OFF_MS); }
static_assert((size_t)R * MW * 2 <= SZ_MS, "MU aliases MS");
DEV float* wFG(char* ws) { return (float*)(ws + OFF_FG); }
DEV float* wMS(char* ws) { return (float*)(ws + OFF_MS); }
DEV float* wZ(char* ws) { return (float*)(ws + OFF_Z); }
DEV bf16* wUF(char* ws) { return (bf16*)(ws + OFF_UF); }
DEV bf16* wGF(char* ws) { return (bf16*)(ws + OFF_GF); }
DEV bf16* wQ(float* out) { return (bf16*)((char*)out + OFF_Q); }
DEV bf16* wKN(float* out) { return (bf16*)((char*)out + OFF_KN); }
DEV bf16* wVT(float* out) { return (bf16*)((char*)out + OFF_VT); }

#ifdef HOST_EMU
typedef const Params& PRef;
#else
typedef const Params __attribute__((address_space(4)))& PRef;
#endif

struct RowI { int b, o, t, bi; bool ctx; };
DEV RowI rowinfo(int r) { RowI i; i.b = r / RPB; i.o = r % RPB; i.ctx = i.o < CTX; i.t = i.ctx ? i.o : i.o - CTX; i.bi = i.ctx ? B : i.b; return i; }
DEV int swap23(int o) { return (o & 3) | ((o & 4) << 1) | ((o & 8) >> 1); }
DEV int vperm32(int o) { return (o & 3) | (((o >> 4) & 1) << 2) | (((o >> 2) & 3) << 3); }
DEV bool has_prev(const RowI& i) { return i.t > 0; }
DEV bool has_next(const RowI& i) { return i.t + 1 < (i.ctx ? CTX : SEQ); }

enum { PH_MOD, PH_MOD2, PH_ROPE, PH_FILT_A, PH_FILT_B, PH_FILT_C, PH_FILT_D, PH_NORM1, PH_GEMM1, PH_MLA_A, PH_MLA_Q, PH_MLA_KV, PH_ATT,
       PH_ML_U, PH_ML_QK, PH_ML_F, PH_ML_B, PH_ML_S, PH_ML_O, PH_HY_Z, PH_HY_O, PH_GEMM_OUT, PH_NORM2, PH_FFN_UP, PH_FFN_CG, PH_FFN_DOWN, PH_FINAL };

DEV float dot_bf16(const bf16* a, const bf16* b, int K) {
    float acc = 0.f;
    for (int k = 0; k < K; k += 8) { const U4 av = *(const U4*)(a + k), bv = *(const U4*)(b + k); acc += dot8(av, bv); }
    return acc;
}


#ifndef HOST_EMU
namespace pg8 {
#define PG8_LAS __attribute__((address_space(3)))
typedef unsigned short bf16_t;
typedef short bf16x8 __attribute__((ext_vector_type(8)));
typedef float f32x4 __attribute__((ext_vector_type(4)));
typedef unsigned u32x4 __attribute__((ext_vector_type(4)));
constexpr int BM = 256, BK = 64, HALF = 128, HTB = HALF * BK * 2  , STAGE_BYTES = 8 * HTB, NXCD = 8, WGM = 8;

__host__ __device__ __forceinline__ int lds_byte(int r, int c) { const int st = (r >> 4) * 2 + (c >> 5), rr = r & 15, cc = c & 31, ob = rr * 64 + cc * 2; return st * 1024 + (ob ^ (((ob >> 9) & 1) << 5)); }
__host__ __device__ __forceinline__ void stage_rc(int b, int& R, int& C) { const int st = b / 1024, sb = b % 1024, swz = sb ^ (((sb >> 9) & 1) << 5); R = (st >> 1) * 16 + swz / 64; C = (st & 1) * 32 + (swz % 64) / 2; }
__host__ __device__ __forceinline__ int perm32(int rho) { const int n = rho >> 4, i = rho & 15; return 8 * (i >> 2) + 4 * n + (i & 3); }

struct Unit { int pm, pn; };
struct Gemm { const bf16_t* A; const bf16_t* Bt; int lda, ldb, M, N, K, mstep; };

struct StaticOrder {
    int nM, nN, nwg, G, c, lat;
    __host__ __device__ void init(int M, int N, int G_, int c_, int lat_ = 0) { nM = M / BM; nN = N / BM; nwg = nM * nN; G = G_; c = c_; lat = lat_; }
    __host__ __device__ bool next(int i, Unit& u) const {
        const long L = (long)i * G + c; if (L >= nwg) return false;
        int wgid = (int)L; { const int q = nwg / NXCD, r = nwg % NXCD, xcd = wgid % NXCD, off = wgid / NXCD; wgid = (xcd < r ? xcd * (q + 1) : r * (q + 1) + (xcd - r) * q) + off; }
        const int nig = WGM * nN, gid = wgid / nig, fm = gid * WGM, gsz = (nM - fm) < WGM ? (nM - fm) : WGM;
        u.pm = fm + ((wgid % nig) % gsz); u.pn = (wgid % nig) / gsz;
        if (lat) u.pm = u.pm + (u.pm / (SEQ / BM) + 1) * (CTX / BM);
        return true;
    }
    __device__ __forceinline__ void a_ready(const Unit&) const {}
    __device__ __forceinline__ void done(const Unit&) const {}
};
__device__ __forceinline__ unsigned cvt_pk_bf16(float lo, float hi) { unsigned r; asm volatile("v_cvt_pk_bf16_f32 %0, %1, %2" : "=v"(r) : "v"(lo), "v"(hi)); return r; }

template <class Epi, class Sched, bool ALIGN_EPI = false, bool SP2 = false>
__device__ __forceinline__ void gemm_phase(PG8_LAS unsigned char* lds, const Gemm g, const Sched& S, const Epi& E) {
    int tid_ = threadIdx.x; asm volatile("" : "+v"(tid_));
    const int tid = tid_, wid = __builtin_amdgcn_readfirstlane(tid >> 6), lane = tid & 63, wr = wid >> 2, wc = wid & 3, fr = lane & 15, fq = lane >> 4;
    const int K = g.K, nt = K / BK;
    unsigned vvoffA, vvoffB;
    { int R_, C_; stage_rc(tid * 16, R_, C_); const int Rb = Epi::PERM ? ((R_ & ~31) + perm32(R_ & 31)) : R_;
      vvoffA = (unsigned)(R_ * g.lda + C_) * 2u; vvoffB = (unsigned)(Rb * g.ldb + C_) * 2u; }
    const size_t pvoffA = (size_t)64 * g.lda * 2, pvoffB = (size_t)64 * g.ldb * 2;
    const size_t kstep = (size_t)(BK * 2);
    const size_t hstepA = (size_t)HALF * g.lda * 2, hstepB = (size_t)HALF * g.ldb * 2;
    const size_t tstepA = (size_t)g.mstep * g.lda * 2, tstepB = 2 * hstepB;
    const unsigned ldsw = (unsigned)wid * 1024u;
    const int aoff = lds_byte(wr * 64 + fr, fq * 8), boff = lds_byte(wc * 32 + fr, fq * 8);
#define PG8_SA(b, h) (((b) * 2 + (h)) * HTB)
#define PG8_SB(b, h) ((4 + (b) * 2 + (h)) * HTB)
#define PG8_STAGE(bufoff, gbase, voff) do { _Pragma("unroll") for (int _i = 0; _i < 2; ++_i) \
        __builtin_amdgcn_global_load_lds((const unsigned*)((const char*)(gbase) + (size_t)_i * p##voff + (v##voff)), (PG8_LAS unsigned*)(lds + (bufoff) + ldsw + _i * 8192), 16, 0, 0); } while (0)
#define PG8_LDA(dst, b, h) do { _Pragma("unroll") for (int m = 0; m < 4; ++m) _Pragma("unroll") for (int k = 0; k < 2; ++k) dst[m][k] = *(const PG8_LAS bf16x8*)(lds + PG8_SA(b, h) + aoff + m * 2048 + k * 1024); } while (0)
#define PG8_LDB(dst, b, h) do { _Pragma("unroll") for (int n = 0; n < 2; ++n) _Pragma("unroll") for (int k = 0; k < 2; ++k) dst[n][k] = *(const PG8_LAS bf16x8*)(lds + PG8_SB(b, h) + boff + n * 2048 + k * 1024); } while (0)
#define PG8_MMA(ai, bj, At, Bt) do { __builtin_amdgcn_s_setprio(1); _Pragma("unroll") for (int m = 0; m < 4; ++m) _Pragma("unroll") for (int n = 0; n < 2; ++n) _Pragma("unroll") for (int k = 0; k < 2; ++k) \
        acc[ai][bj][m][n] = __builtin_amdgcn_mfma_f32_16x16x32_bf16(Bt[n][k], At[m][k], acc[ai][bj][m][n], 0, 0, 0); __builtin_amdgcn_s_setprio(0); } while (0)
#define PG8_WAIT_V(n) asm volatile("s_waitcnt vmcnt(" #n ")" ::: "memory")
#define PG8_WAIT_L(n) asm volatile("s_waitcnt lgkmcnt(" #n ")" ::: "memory")
#define PG8_BAR __builtin_amdgcn_s_barrier()
#define PG8_SCHED __builtin_amdgcn_sched_barrier(0)
    Unit cur, nxt; int ui = 0;
    if (!S.next(0, cur)) return;
    f32x4 acc[2][2][4][2];
#pragma unroll
    for (int a = 0; a < 2; ++a)
#pragma unroll
        for (int b = 0; b < 2; ++b)
#pragma unroll
            for (int m = 0; m < 4; ++m)
#pragma unroll
                for (int n = 0; n < 2; ++n) acc[a][b][m][n] = (f32x4){0.f, 0.f, 0.f, 0.f};
    bf16x8 At[4][2], B0[2][2], B1[2][2];
    const char* cA = (const char*)g.A + (size_t)cur.pm * tstepA; const char* cB = (const char*)g.Bt + (size_t)cur.pn * tstepB;
    S.a_ready(cur);
    if constexpr (SP2) {
        PG8_STAGE(PG8_SB(0, 0), cB, voffB); PG8_STAGE(PG8_SB(0, 1), cB + hstepB, voffB); PG8_STAGE(PG8_SA(0, 0), cA, voffA); PG8_STAGE(PG8_SA(0, 1), cA + hstepA, voffA);
        if (wr == 1) PG8_BAR;
        PG8_WAIT_V(2); PG8_BAR;
        PG8_STAGE(PG8_SB(1, 0), cB + kstep, voffB); PG8_STAGE(PG8_SA(1, 0), cA + kstep, voffA); PG8_STAGE(PG8_SB(1, 1), cB + hstepB + kstep, voffB);
        PG8_WAIT_V(6); PG8_BAR;
    } else {
        PG8_STAGE(PG8_SB(0, 0), cB, voffB); PG8_STAGE(PG8_SA(0, 0), cA, voffA); PG8_STAGE(PG8_SB(0, 1), cB + hstepB, voffB); PG8_STAGE(PG8_SA(0, 1), cA + hstepA, voffA);
        if (wr == 1) PG8_BAR;
        PG8_WAIT_V(4); PG8_BAR;
        PG8_STAGE(PG8_SB(1, 0), cB + kstep, voffB); PG8_STAGE(PG8_SA(1, 0), cA + kstep, voffA); PG8_STAGE(PG8_SB(1, 1), cB + hstepB + kstep, voffB);
        PG8_WAIT_V(6); PG8_BAR;
    }
    for (;;) {
        const bool has_next = S.next(ui + 1, nxt);
        const char* nA = has_next ? (const char*)g.A + (size_t)nxt.pm * tstepA : cA; const char* nB = has_next ? (const char*)g.Bt + (size_t)nxt.pn * tstepB : cB;
        for (int t = 0; t < nt; t += 2) {
            const bool last = (t == nt - 2);
            const char* a1 = cA + (size_t)(t + 1) * kstep;
            const char* a2 = last ? nA : cA + (size_t)(t + 2) * kstep; const char* b2 = last ? nB : cB + (size_t)(t + 2) * kstep;
            const char* a3 = a2 + kstep; const char* b3 = b2 + kstep;
            if (last && has_next) S.a_ready(nxt);
            if constexpr (SP2) {
            PG8_LDB(B0, 0, 0); PG8_LDB(B1, 0, 1); PG8_SCHED; PG8_LDA(At, 0, 0); PG8_STAGE(PG8_SA(1, 1), a1 + hstepA, voffA);
            PG8_WAIT_V(8); PG8_WAIT_L(0); PG8_BAR; PG8_MMA(0, 0, At, B0); PG8_MMA(0, 1, At, B1); PG8_BAR; PG8_SCHED;
            PG8_LDA(At, 0, 1); PG8_STAGE(PG8_SB(0, 0), b2, voffB); PG8_STAGE(PG8_SB(0, 1), b2 + hstepB, voffB); PG8_STAGE(PG8_SA(0, 0), a2, voffA);
            PG8_WAIT_V(8); PG8_WAIT_L(0); PG8_BAR; PG8_MMA(1, 0, At, B0); PG8_MMA(1, 1, At, B1); PG8_BAR; PG8_SCHED;
            PG8_LDB(B0, 1, 0); PG8_LDB(B1, 1, 1); PG8_SCHED; PG8_LDA(At, 1, 0); PG8_STAGE(PG8_SA(0, 1), a2 + hstepA, voffA);
            PG8_WAIT_V(8); PG8_WAIT_L(0); PG8_BAR; PG8_MMA(0, 0, At, B0); PG8_MMA(0, 1, At, B1); PG8_BAR; PG8_SCHED;
            PG8_LDA(At, 1, 1); PG8_STAGE(PG8_SB(1, 0), b3, voffB); PG8_STAGE(PG8_SB(1, 1), b3 + hstepB, voffB); PG8_STAGE(PG8_SA(1, 0), a3, voffA);
            PG8_WAIT_V(8); PG8_WAIT_L(0); PG8_BAR; PG8_MMA(1, 0, At, B0); PG8_MMA(1, 1, At, B1); PG8_BAR; PG8_SCHED;
            } else {
            PG8_LDB(B0, 0, 0); PG8_SCHED; PG8_LDA(At, 0, 0); PG8_STAGE(PG8_SA(1, 1), a1 + hstepA, voffA);
            PG8_WAIT_L(8); PG8_BAR; PG8_WAIT_L(0); PG8_MMA(0, 0, At, B0); PG8_BAR; PG8_SCHED;
            PG8_LDB(B1, 0, 1); PG8_STAGE(PG8_SB(0, 0), b2, voffB);
            PG8_BAR; PG8_WAIT_L(0); PG8_MMA(0, 1, At, B1); PG8_BAR;
            PG8_LDA(At, 0, 1); PG8_STAGE(PG8_SA(0, 0), a2, voffA);
            PG8_BAR; PG8_WAIT_L(0); PG8_MMA(1, 0, At, B0); PG8_BAR; PG8_SCHED;
            PG8_STAGE(PG8_SB(0, 1), b2 + hstepB, voffB);
            PG8_WAIT_V(6); PG8_BAR; PG8_MMA(1, 1, At, B1); PG8_BAR;
            PG8_LDB(B0, 1, 0); PG8_SCHED; PG8_LDA(At, 1, 0); PG8_STAGE(PG8_SA(0, 1), a2 + hstepA, voffA);
            PG8_WAIT_L(8); PG8_BAR; PG8_WAIT_L(0); PG8_MMA(0, 0, At, B0); PG8_BAR; PG8_SCHED;
            PG8_LDB(B1, 1, 1); PG8_STAGE(PG8_SB(1, 0), b3, voffB);
            PG8_BAR; PG8_WAIT_L(0); PG8_MMA(0, 1, At, B1); PG8_BAR;
            PG8_LDA(At, 1, 1); PG8_STAGE(PG8_SA(1, 0), a3, voffA);
            PG8_BAR; PG8_WAIT_L(0); PG8_MMA(1, 0, At, B0); PG8_BAR; PG8_SCHED;
            PG8_STAGE(PG8_SB(1, 1), b3 + hstepB, voffB);
            PG8_WAIT_V(6); PG8_BAR; PG8_MMA(1, 1, At, B1); PG8_BAR;
            }
        }
        if constexpr (ALIGN_EPI) { if (wr == 0) PG8_BAR; }
        E(acc, cur, wr, wc, fr, fq); S.done(cur);
        if (!has_next) break;
#pragma unroll
        for (int a = 0; a < 2; ++a)
#pragma unroll
            for (int b = 0; b < 2; ++b)
#pragma unroll
                for (int m = 0; m < 4; ++m)
#pragma unroll
                    for (int n = 0; n < 2; ++n) acc[a][b][m][n] = (f32x4){0.f, 0.f, 0.f, 0.f};
        cur = nxt; cA = nA; cB = nB; ++ui;
        if constexpr (ALIGN_EPI) { if (wr == 1) PG8_BAR; }
    }
    PG8_WAIT_V(0);
    if constexpr (!ALIGN_EPI) { if (wr == 0) PG8_BAR; }
    PG8_BAR;
#undef PG8_SA
#undef PG8_SB
#undef PG8_STAGE
#undef PG8_LDA
#undef PG8_LDB
#undef PG8_MMA
#undef PG8_WAIT_V
#undef PG8_WAIT_L
#undef PG8_BAR
#undef PG8_SCHED
}

struct EpiBf16 {
    static constexpr bool PERM = true;
    bf16_t* O; int ldc; const float* rs; int rs_stride;
    __device__ __forceinline__ void operator()(const f32x4 (&acc)[2][2][4][2], const Unit& u, int wr, int wc, int, int) const {
        __builtin_amdgcn_sched_barrier(0);
        int t_ = threadIdx.x; asm volatile("" : "+v"(t_)); const int fr = t_ & 15, fq = (t_ >> 4) & 3;
        const int row0 = u.pm * BM + wr * 64 + fr, col0 = u.pn * BM + wc * 32 + 8 * fq;
#pragma unroll
        for (int ai = 0; ai < 2; ++ai)
#pragma unroll
            for (int m = 0; m < 4; ++m) { const int row = row0 + ai * HALF + m * 16; bf16_t* rowp = O + (size_t)row * ldc + col0;
                const float sc = rs ? rs[(size_t)row * rs_stride] : 1.0f;
#pragma unroll
                for (int bj = 0; bj < 2; ++bj) { const f32x4 v0 = acc[ai][bj][m][0] * sc, v1 = acc[ai][bj][m][1] * sc;
                    u32x4 w; w.x = cvt_pk_bf16(v0[0], v0[1]); w.y = cvt_pk_bf16(v0[2], v0[3]); w.z = cvt_pk_bf16(v1[0], v1[1]); w.w = cvt_pk_bf16(v1[2], v1[3]);
                    *(u32x4*)(rowp + bj * HALF) = w; } }
    }
};
struct EpiVT {
    static constexpr bool PERM = true;
    bf16_t* O; const float* rs;
    __device__ __forceinline__ void operator()(const f32x4 (&acc)[2][2][4][2], const Unit& u, int wr, int wc, int, int) const {
        __builtin_amdgcn_sched_barrier(0);
        int t_ = threadIdx.x; asm volatile("" : "+v"(t_)); const int fr = t_ & 15, fq = (t_ >> 4) & 3;
        const int row0 = u.pm * BM + wr * 64 + fr, col0 = u.pn * BM + wc * 32;
        typedef unsigned u32x2 __attribute__((ext_vector_type(2)));
#pragma unroll
        for (int bj = 0; bj < 2; ++bj) { const int cb = col0 + bj * HALF;
            const float* rsp = rs + cb + 8 * fq;
            typedef bf16_t __attribute__((address_space(1))) gbf16;
            gbf16* rowp = (gbf16*)(O + (size_t)row0 * R + cb + 4 * (fq >> 1) + 16 * (fq & 1));
#pragma unroll
            for (int ai = 0; ai < 2; ++ai)
#pragma unroll
                for (int m = 0; m < 4; ++m) {
                    const f32x4 v0 = acc[ai][bj][m][0] * *(const f32x4*)(rsp), v1 = acc[ai][bj][m][1] * *(const f32x4*)(rsp + 4);
                    u32x2 w0, w1; w0.x = cvt_pk_bf16(v0[0], v0[1]); w0.y = cvt_pk_bf16(v0[2], v0[3]); w1.x = cvt_pk_bf16(v1[0], v1[1]); w1.y = cvt_pk_bf16(v1[2], v1[3]);
                    *(__attribute__((address_space(1))) u32x2*)(rowp) = w0; *(__attribute__((address_space(1))) u32x2*)(rowp + 8) = w1;
                    rowp += (size_t)(m == 3 ? HALF - 48 : 16) * R; asm volatile("" : "+v"(rowp)); } }
    }
};
struct EpiConvGate {
    static constexpr bool PERM = true;
    bf16_t* O; const float* cw; const float* cb; PG8_LAS unsigned char* xl;
    __device__ __forceinline__ void operator()(f32x4 (&acc)[2][2][4][2], const Unit& u, int wr, int wc, int, int) const {
        __builtin_amdgcn_sched_barrier(0);
        int t_ = threadIdx.x; asm volatile("" : "+v"(t_)); const int lane = t_ & 63, fr = t_ & 15, fq = (t_ >> 4) & 3, wave = wr * 4 + wc;
        PG8_LAS f32x4* myx = (PG8_LAS f32x4*)(xl + wave * 1024);
#pragma unroll
        for (int ai = 0; ai < 2; ++ai)
#pragma unroll
            for (int bj = 0; bj < 2; ++bj)
#pragma unroll
                for (int n = 0; n < 2; ++n) { if (fr == 0) myx[(((ai * 2 + 0) * 2 + bj) * 2 + n) * 4 + fq] = acc[ai][bj][0][n]; if (fr == 15) myx[(((ai * 2 + 1) * 2 + bj) * 2 + n) * 4 + fq] = acc[ai][bj][3][n]; }
        asm volatile("s_waitcnt lgkmcnt(0)" ::: "memory"); __builtin_amdgcn_s_barrier(); asm volatile("" ::: "memory");
        const int rg0 = u.pm * 254 - 1 + wr * 64 + fr;
        unsigned hpm = 0u, hnm = 0u;
#pragma unroll
        for (int ai = 0; ai < 2; ++ai)
#pragma unroll
            for (int m = 0; m < 4; ++m) { const int rg = rg0 + ai * HALF + m * 16; const int o = ((rg % RPB) + RPB) % RPB;
                if (o != 0 && o != CTX) hpm |= 1u << (ai * 4 + m); if (o != CTX - 1 && o != RPB - 1) hnm |= 1u << (ai * 4 + m); }
        typedef float f32x2 __attribute__((ext_vector_type(2)));
        {
#pragma unroll
            for (int bj = 0; bj < 2; ++bj)
#pragma unroll
                for (int n = 0; n < 2; ++n) {
                    const int jj = bj * FF + u.pn * HALF + wc * 32 + 8 * fq + 4 * n;
                    const f32x4 w0 = *(const f32x4*)(cw + jj), w1 = *(const f32x4*)(cw + FF2 + jj), w2 = *(const f32x4*)(cw + 2 * FF2 + jj), bb = *(const f32x4*)(cb + jj);
#pragma unroll
                    for (int ai = 0; ai < 2; ++ai) {
                        const int blk = 2 * ai + wr;
                        f32x4 prow = (f32x4){0.f, 0.f, 0.f, 0.f}, nrow = prow;
                        if (blk > 0) prow = *(const PG8_LAS f32x4*)(xl + (((blk - 1) & 1) * 4 + wc) * 1024 + ((((((blk - 1) >> 1) * 2 + 1) * 2 + bj) * 2 + n) * 4 + fq) * 16);
                        if (blk < 3) nrow = *(const PG8_LAS f32x4*)(xl + (((blk + 1) & 1) * 4 + wc) * 1024 + ((((((blk + 1) >> 1) * 2 + 0) * 2 + bj) * 2 + n) * 4 + fq) * 16);
#pragma unroll
                        for (int ep = 0; ep < 2; ++ep) {
                            f32x2 ru[4], rd[4], res[4];
#pragma unroll
                            for (int m = 0; m < 4; ++m)
#pragma unroll
                                for (int k = 0; k < 2; ++k) { int vi = __float_as_int(acc[ai][bj][m][n][2 * ep + k]); asm volatile("" : "+v"(vi));
                                    ru[m][k] = __int_as_float(__builtin_amdgcn_update_dpp(0, vi, 0x121, 0xf, 0xf, false));
                                    rd[m][k] = __int_as_float(__builtin_amdgcn_update_dpp(0, vi, 0x12F, 0xf, 0xf, false)); }
                            const f32x2 w0p = {w0[2 * ep], w0[2 * ep + 1]}, w1p = {w1[2 * ep], w1[2 * ep + 1]}, w2p = {w2[2 * ep], w2[2 * ep + 1]}, bbp = {bb[2 * ep], bb[2 * ep + 1]};
                            const f32x2 pr2 = {prow[2 * ep], prow[2 * ep + 1]}, nr2 = {nrow[2 * ep], nrow[2 * ep + 1]};
#pragma unroll
                            for (int m = 0; m < 4; ++m) {
                                const f32x2 xv = {acc[ai][bj][m][n][2 * ep], acc[ai][bj][m][n][2 * ep + 1]};
                                const f32x2 upv = fr == 0 ? (m == 0 ? pr2 : ru[m == 0 ? 0 : m - 1]) : ru[m];
                                const f32x2 dnv = fr == 15 ? (m == 3 ? nr2 : rd[m == 3 ? 3 : m + 1]) : rd[m];
                                const bool hp = (hpm >> (ai * 4 + m)) & 1u, hn = (hnm >> (ai * 4 + m)) & 1u;
                                const f32x2 z = {0.f, 0.f};
                                res[m] = bbp + w1p * xv + (hp ? w0p * upv : z) + (hn ? w2p * dnv : z); }
                            asm volatile("" : "+v"(res[0]), "+v"(res[1]), "+v"(res[2]), "+v"(res[3]));
#pragma unroll
                            for (int m = 0; m < 4; ++m) { acc[ai][bj][m][n][2 * ep] = res[m][0]; acc[ai][bj][m][n][2 * ep + 1] = res[m][1]; }
                        }
                    }
                }
        }
#pragma unroll
        for (int ai = 0; ai < 2; ++ai)
#pragma unroll
            for (int m = 0; m < 4; ++m) { const int tr = ai * HALF + wr * 64 + m * 16 + fr, rg = u.pm * 254 - 1 + tr;
                if (tr == 0 || tr == 255 || rg >= R) continue;
                const f32x4 a0 = acc[ai][0][m][0], a1 = acc[ai][0][m][1], g0 = acc[ai][1][m][0], g1 = acc[ai][1][m][1];
                float o[8];
#pragma unroll
                for (int e = 0; e < 4; ++e) { o[e] = a0[e] * __builtin_amdgcn_rcpf(1.0f + __builtin_amdgcn_exp2f(-1.4426950408889634f * a0[e])) * g0[e]; o[4 + e] = a1[e] * __builtin_amdgcn_rcpf(1.0f + __builtin_amdgcn_exp2f(-1.4426950408889634f * a1[e])) * g1[e]; }
                u32x4 w; w.x = cvt_pk_bf16(o[0], o[1]); w.y = cvt_pk_bf16(o[2], o[3]); w.z = cvt_pk_bf16(o[4], o[5]); w.w = cvt_pk_bf16(o[6], o[7]);
                *(u32x4*)(O + (size_t)rg * FF + u.pn * HALF + wc * 32 + 8 * fq) = w; }
    }
};
struct EpiResid {
    static constexpr bool PERM = true;
    bf16_t* X; const float* gate; float* outf; int dry;
    __device__ __forceinline__ void operator()(const f32x4 (&acc)[2][2][4][2], const Unit& u, int wr, int wc, int, int) const {
        __builtin_amdgcn_sched_barrier(0);
        int t_ = threadIdx.x; asm volatile("" : "+v"(t_)); const int fr = t_ & 15, fq = (t_ >> 4) & 3;
        const int row0 = u.pm * BM + wr * 64 + fr, col0 = u.pn * BM + wc * 32 + 8 * fq;
#pragma unroll
        for (int ai = 0; ai < 2; ++ai)
#pragma unroll
            for (int m = 0; m < 4; ++m) { const int row = row0 + ai * HALF + m * 16; const RowI ri = rowinfo(row);
                bf16_t* rowp = X + (size_t)row * D + col0; const float* gp = gate + (size_t)ri.bi * 6 * D + col0;
                float* op = outf ? outf + ((size_t)ri.b * SEQ + ri.t) * D + col0 : nullptr;
#pragma unroll
                for (int bj = 0; bj < 2; ++bj) { const int co = bj * HALF;
                    const u32x4 xw = *(const u32x4*)(rowp + co); const f32x4 g0 = *(const f32x4*)(gp + co), g1 = *(const f32x4*)(gp + co + 4);
                    f32x4 n0, n1;
                    n0[0] = __uint_as_float(xw.x << 16); n0[1] = __uint_as_float(xw.x & 0xFFFF0000u); n0[2] = __uint_as_float(xw.y << 16); n0[3] = __uint_as_float(xw.y & 0xFFFF0000u);
                    n1[0] = __uint_as_float(xw.z << 16); n1[1] = __uint_as_float(xw.z & 0xFFFF0000u); n1[2] = __uint_as_float(xw.w << 16); n1[3] = __uint_as_float(xw.w & 0xFFFF0000u);
                    n0 = n0 + g0 * acc[ai][bj][m][0]; n1 = n1 + g1 * acc[ai][bj][m][1];
                    if (dry) continue;
                    if (outf) { *(f32x4*)(op + co) = n0; *(f32x4*)(op + co + 4) = n1; }
                    else { u32x4 w; w.x = cvt_pk_bf16(n0[0], n0[1]); w.y = cvt_pk_bf16(n0[2], n0[3]); w.z = cvt_pk_bf16(n1[0], n1[1]); w.w = cvt_pk_bf16(n1[2], n1[3]); *(u32x4*)(rowp + co) = w; } } }
    }
};
}
#endif


DEV void ld8(const bf16* q, float (&f)[8]) { const U4 u = *(const U4*)q; f[0] = bflo(u.x); f[1] = bfhi(u.x); f[2] = bflo(u.y); f[3] = bfhi(u.y); f[4] = bflo(u.z); f[5] = bfhi(u.z); f[6] = bflo(u.w); f[7] = bfhi(u.w); }
DEV void ldf8(const float* q, float (&f)[8]) {
#pragma unroll
    for (int e = 0; e < 8; ++e) f[e] = q[e]; }
DEV U4 pack8(const float (&f)[8]) { U4 u; u.x = f2bf(f[0]) | ((unsigned)f2bf(f[1]) << 16); u.y = f2bf(f[2]) | ((unsigned)f2bf(f[3]) << 16); u.z = f2bf(f[4]) | ((unsigned)f2bf(f[5]) << 16); u.w = f2bf(f[6]) | ((unsigned)f2bf(f[7]) << 16); return u; }
DEV void conv4x8(const bf16* src, int ld, const float* w  , int wn, const float* bias, bool hp0, bool hn3, float (&out)[4][8]) {
    float w0[8], w1[8], w2[8], bb[8], x[6][8];
    ldf8(w, w0); ldf8(w + wn, w1); ldf8(w + 2 * wn, w2); ldf8(bias, bb);
#pragma unroll
    for (int i = 0; i < 6; ++i) { if ((i == 0 && !hp0) || (i == 5 && !hn3)) {
#pragma unroll
            for (int e = 0; e < 8; ++e) x[i][e] = 0.f; } else ld8(src + (long)(i - 1) * ld, x[i]); }
#pragma unroll
    for (int i = 0; i < 4; ++i)
#pragma unroll
        for (int e = 0; e < 8; ++e) out[i][e] = bb[e] + w0[e] * x[i][e] + w1[e] * x[i + 1][e] + w2[e] * x[i + 2][e];
}

template <int PH> DEV void phase(PRef p, int l, int arg, long gtid, long gth);


template <> DEV void phase<PH_MOD>(PRef p, int, int, long gtid, long gth) {
    constexpr int KC = D / 8;
    for (long i = gtid; i < (long)8 * DEPTH * 6 * D; i += gth) {
        const int j = (int)(i % (6 * D)), l = (int)((i / (6 * D)) % DEPTH), kc = (int)(i / ((long)6 * D * DEPTH));
        const float* w = p.ada_w + (long)l * D * 6 * D + j;
        float acc[B + 1];
#pragma unroll
        for (int bi = 0; bi <= B; ++bi) acc[bi] = 0.f;
        for (int k = kc * KC; k < (kc + 1) * KC; ++k) { const float wv = w[(long)k * 6 * D];
#pragma unroll
            for (int bi = 0; bi <= B; ++bi) acc[bi] += silu_f(bi < B ? p.c[(long)bi * D + k] : p.c_ctx[k]) * wv; }
#pragma unroll
        for (int bi = 0; bi <= B; ++bi) wMODP(p.ws)[(((long)kc * DEPTH + l) * (B + 1) + bi) * 6 * D + j] = acc[bi];
    }
}
template <> DEV void phase<PH_MOD2>(PRef p, int, int, long gtid, long gth) {
    for (long i = gtid; i < (long)DEPTH * (B + 1) * 6 * D; i += gth) {
        const int j = (int)(i % (6 * D)), l = (int)(i / ((long)6 * D * (B + 1)));
        float acc = p.ada_b[(long)l * 6 * D + j];
        for (int kc = 0; kc < 8; ++kc) acc += wMODP(p.ws)[(long)kc * DEPTH * (B + 1) * 6 * D + i];
        wMOD(p.ws)[i] = acc;
    }
}
template <> DEV void phase<PH_ROPE>(PRef p, int, int, long gtid, long gth) {
    for (long i = gtid; i < (long)SEQ * 16; i += gth) {
        const int j = (int)(i % 16), t = (int)(i / 16);
        const int jj = j & 7;
        const float inv = (jj & 1 ? 0.31622776601683794f : 1.0f) * (jj >> 1 == 0 ? 1.0f : jj >> 1 == 1 ? 0.1f : jj >> 1 == 2 ? 0.01f : 0.001f);
        const float pos = j < 8 ? (float)(t / GRID_W) : (float)(t % GRID_W);
        const float a = pos * inv;
        wROPET(p.ws)[i * 2] = cosf(a); wROPET(p.ws)[i * 2 + 1] = sinf(a);
    }
}
template <> DEV void phase<PH_FILT_A>(PRef p, int l, int, long gtid, long gth) {
    for (long i = gtid; i < (long)2 * SEQ * HH; i += gth) {
        const int j = (int)(i % HH), pos = (int)((i / HH) % SEQ), set = (int)(i / ((long)HH * SEQ));
        const int L = set ? CTX : SEQ; if (pos >= L) continue;
        const float* w1 = p.hy_w1 + (long)l * HE * HH;
        const float tl = (float)pos / (float)(L - 1);
        float acc = p.hy_b1[l * HH + j] + tl * w1[j];
        for (int e = 0; e < HB; ++e) {
            const float band = 1e-4f + (float)e * (((float)(HB - 1) - 1e-4f) / (float)(HB - 1));
            float turns = (float)pos * band / (float)L; turns -= floorf(turns);
            acc += cos_t(turns) * w1[(1 + e) * HH + j] - sin_t(turns) * w1[(1 + HB + e) * HH + j];
        }
        wHD1(p.ws)[i] = sin_f(p.hy_freq[l * HH + j] * acc);
    }
}
template <> DEV void phase<PH_FILT_B>(PRef p, int l, int, long gtid, long gth) {
    for (long i = gtid; i < (long)2 * SEQ * HH; i += gth) {
        const int j = (int)(i % HH), pos = (int)((i / HH) % SEQ), set = (int)(i / ((long)HH * SEQ));
        const int L = set ? CTX : SEQ; if (pos >= L) continue;
        const float* w2 = p.hy_w2 + (long)l * HH * HH;
        const float* h1 = wHD1(p.ws) + (i - j);
        float acc = p.hy_b2[l * HH + j];
        for (int e = 0; e < HH; ++e) acc += h1[e] * w2[e * HH + j];
        wHD2(p.ws)[i] = sin_f(p.hy_freq[l * HH + j] * acc);
    }
}
template <> DEV void phase<PH_FILT_C>(PRef p, int l, int, long gtid, long gth) {
    const float* w3 = p.hy_w3 + (long)l * HH * 2 * HW;
    for (long i = gtid; i < (long)2 * (SEQ / 4) * 2 * HW; i += gth) {
        const int c2 = (int)(i % (2 * HW)), pq = (int)((i / (2 * HW)) % (SEQ / 4)), set = (int)(i / ((long)2 * HW * (SEQ / 4)));
        const int L = set ? CTX : SEQ, pos0 = pq * 4; if (pos0 >= L) continue;
        const float* h2 = wHD2(p.ws) + ((long)set * SEQ + pos0) * HH;
        float acc[4] = {0.f, 0.f, 0.f, 0.f};
        for (int e = 0; e < HH; ++e) { const float w = w3[e * 2 * HW + c2];
#pragma unroll
            for (int k = 0; k < 4; ++k) acc[k] += h2[k * HH + e] * w; }
        const int c = c2 % HW;
        const float a0 = -4.605170185988091f / 1.5f, a1 = -4.605170185988091f / 0.3f;
        const float delta = fabsf(a0 + (a1 - a0) * (float)c / (float)(HW - 1));
#pragma unroll
        for (int k = 0; k < 4; ++k) { const int pos = pos0 + k; const float tl = (float)pos / (float)(L - 1); const float v = acc[k] * (exp_f(-tl * delta) + 0.05f);
            if (set == 0) wFT(p.ws)[(long)c2 * SEQ + pos] = v; else wFT1(p.ws)[(long)pos * 2 * HW + c2] = v; }
    }
}
DEV float filt_tap(PRef p, int set, int c2, int pos) { return set == 0 ? wFT(p.ws)[(long)c2 * SEQ + pos] : wFT1(p.ws)[(long)pos * 2 * HW + c2]; }
template <> DEV void phase<PH_FILT_D>(PRef p, int, int, long gtid, long gth) {
    for (long i = gtid; i < (long)2 * HW * 64; i += gth) {
        const int part = (int)(i % 64), c = (int)((i / 64) % HW), set = (int)(i / (64 * HW)); const int L = set ? CTX : SEQ, per = L / 64;
        float s = 0.f;
        for (int pos = part * per; pos < (part + 1) * per; ++pos) { s += fabsf(filt_tap(p, set, c, pos)); if (pos >= 1) s += fabsf(filt_tap(p, set, HW + c, pos)); }
        wFL1(p.ws)[i] = s;
    }
}
DEV float filt_l1(PRef p, int set, int c) { const float* q = wFL1(p.ws) + ((long)set * HW + c) * 64; float s = 0.f; for (int i = 0; i < 64; ++i) s += q[i]; return s; }
template <> DEV void phase<PH_NORM1>(PRef p, int l, int, long gtid, long gth) {
    for (long r = gtid; r < R; r += gth) {
        const RowI ri = rowinfo((int)r);
        bf16* xr = wX(p.ws) + r * D; const float* src = ri.ctx ? p.ctx + ((long)ri.b * CTX + ri.t) * D : p.x + ((long)ri.b * SEQ + ri.t) * D;
        if (l == 0) for (int k = 0; k < D; ++k) xr[k] = f2bf(src[k]);
        float ss = 0.f; for (int k = 0; k < D; ++k) { const float v = l == 0 ? src[k] : bf2f(xr[k]); ss += v * v; }
        const float rstd = 1.0f / sqrtf(ss / (float)D + EPS);
        const float* mod = wMOD(p.ws) + ((long)l * (B + 1) + ri.bi) * 6 * D;
        const float* g = p.norm1_g + l * D;
        for (int k = 0; k < D; ++k) { const float v = l == 0 ? src[k] : bf2f(xr[k]); wH(p.ws)[r * D + k] = f2bf(v * rstd * g[k] * (1.0f + mod[D + k]) + mod[k]); }
    }
}
template <> DEV void phase<PH_GEMM1>(PRef p, int l, int, long gtid, long gth) {
    for (long i = gtid; i < (long)R * NP; i += gth) { const int n = (int)(i % NP); const long r = i / NP;
        wP(p.ws)[i] = f2bf(dot_bf16(wH(p.ws) + r * D, wWinT(p.ws, l) + (long)n * D, D)); }
}
template <> DEV void phase<PH_MLA_A>(PRef p, int, int, long gtid, long gth) {
    for (long r = gtid; r < R; r += gth) {
        const RowI ri = rowinfo((int)r); const bf16* pr = wP(p.ws) + r * NP;
        float s = 0.f; for (int k = 0; k < QR; ++k) { const float v = bf2f(pr[k]); s += v * v; }
        wRS(p.ws)[r] = 1.0f / sqrtf(s / (float)QR + EPS);
        s = 0.f; for (int k = 0; k < KVR; ++k) { const float v = bf2f(pr[QR + k]); s += v * v; }
        wRS(p.ws)[R + r] = 1.0f / sqrtf(s / (float)KVR + EPS);
        for (int j = 0; j < 16; ++j) {
            const float x1 = bf2f(pr[QR + KVR + j]), x2 = bf2f(pr[QR + KVR + 16 + j]);
            float cs = 1.f, sn = 0.f; if (!ri.ctx) { cs = wROPET(p.ws)[((long)ri.t * 16 + j) * 2]; sn = wROPET(p.ws)[((long)ri.t * 16 + j) * 2 + 1]; }
            wKR(p.ws)[r * ROPE + j] = f2bf(x1 * cs - x2 * sn); wKR(p.ws)[r * ROPE + 16 + j] = f2bf(x1 * sn + x2 * cs);
        }
    }
}
template <> DEV void phase<PH_MLA_Q>(PRef p, int l, int, long gtid, long gth) {
    for (long i = gtid; i < (long)R * QW; i += gth) { const int n = (int)(i % QW); const long r = i / QW;
        const RowI ri = rowinfo((int)r);
        const float rs = wRS(p.ws)[r]; const bf16* a = wP(p.ws) + r * NP;
        float v = rs * dot_bf16(a, wWuqT(p.ws, l) + (long)n * QR, QR);
        wQ(p.out)[i] = f2bf(v);
    }
}
template <> DEV void phase<PH_MLA_KV>(PRef p, int l, int, long gtid, long gth) {
    for (long i = gtid; i < (long)R * KVW; i += gth) { const int n = (int)(i % KVW); const long r = i / KVW;
        const bf16 v = f2bf(wRS(p.ws)[R + r] * dot_bf16(wP(p.ws) + r * NP + QR, wWukvT(p.ws, l) + (long)n * KVR, KVR));
        if (n < AW) wKN(p.out)[r * AW + n] = v; else wVT(p.out)[(long)(n - AW) * R + (r & ~31L) + vperm32((int)(r & 31))] = v; }
}
template <> DEV void phase<PH_ATT>(PRef p, int l, int, long gtid, long gth) {
    const bool last = (l == DEPTH - 1);
    const float scale = 1.0f / sqrtf((float)(NOPE + ROPE));
    for (long i = gtid; i < (long)AH * R; i += gth) {
        const int h = (int)(i / R); const long r = i % R; const RowI ri = rowinfo((int)r);
        if (ri.ctx && last) continue;
        const bf16* qp = wQ(p.out) + r * QW + h * (NOPE + ROPE);
        float qr[ROPE];
#pragma unroll
        for (int j = 0; j < 16; ++j) { const float x1 = bf2f(qp[NOPE + j]), x2 = bf2f(qp[NOPE + 16 + j]);
            float cs = 1.f, sn = 0.f; if (!ri.ctx) { cs = wROPET(p.ws)[((long)ri.t * 16 + j) * 2]; sn = wROPET(p.ws)[((long)ri.t * 16 + j) * 2 + 1]; }
            qr[j] = x1 * cs - x2 * sn; qr[16 + j] = x1 * sn + x2 * cs; }
        float o[AV];
#pragma unroll
        for (int d = 0; d < AV; ++d) o[d] = 0.f;
        float m = -1e30f, ssum = 0.f;
        const long k0 = (long)ri.b * RPB; const int nk = ri.ctx ? CTX : RPB;
        for (int kk = 0; kk < nk; ++kk) {
            const bf16* kv = wKN(p.out) + (k0 + kk) * AW + h * NOPE; const bf16* kr = wKR(p.ws) + (k0 + kk) * ROPE;
            const bf16* vt = wVT(p.out) + (long)h * AV * R + ((k0 + kk) & ~31L) + vperm32((int)((k0 + kk) & 31));
            float s = 0.f;
#pragma unroll
            for (int d = 0; d < NOPE; d += 8) s += dot8(*(const U4*)(qp + d), *(const U4*)(kv + d));
#pragma unroll
            for (int d = 0; d < ROPE; ++d) s += qr[d] * bf2f(kr[d]);
            s *= scale;
            const float mn = fmaxf(m, s); const float corr = exp_f(m - mn), pw = exp_f(s - mn);
            ssum = ssum * corr + pw; m = mn;
#pragma unroll
            for (int d = 0; d < AV; ++d) o[d] = o[d] * corr + pw * bf2f(vt[(long)d * R]);
        }
        const float inv = 1.0f / ssum;
#pragma unroll
        for (int d = 0; d < AV; ++d) wH(p.ws)[r * D + h * AV + d] = f2bf(o[d] * inv);
    }
}
template <> DEV void phase<PH_ML_U>(PRef p, int l, int, long gtid, long gth) {
    for (long i = gtid; i < (long)(R / 4) * (MW / 8); i += gth) { const int cg = (int)(i % (MW / 8)); const long r = (i / (MW / 8)) * 4; const RowI ri = rowinfo((int)r);
        const int L = ri.ctx ? CTX : SEQ; float o[4][8];
        conv4x8(wP(p.ws) + r * NP + ML_LO + cg * 8, NP, p.ml_conv_w + (long)l * 3 * MW + cg * 8, MW, p.ml_conv_b + l * MW + cg * 8, ri.t > 0, ri.t + 4 < L, o);
#pragma unroll
        for (int k = 0; k < 4; ++k) {
#pragma unroll
            for (int e = 0; e < 8; ++e) o[k][e] = silu_f(o[k][e]);
            *(U4*)(wMU(p.ws) + (r + k) * MW + cg * 8) = pack8(o[k]); } }
    const float ksc = 1.0f / sqrtf((float)MD);
    for (long i = gtid; i < (long)2 * MW * MW; i += gth) { const int k = (int)(i % MW), n = (int)(i / MW); const int isk = n >= MW, nn = n % MW, h = nn / MD, e = nn % MD;
        float v = 0.f; if (k / MD == h) v = isk ? p.ml_wk[(((long)l * MH + h) * MD + k % MD) * MD + e] * ksc : p.ml_wq[(((long)l * MH + h) * MD + k % MD) * MD + e];
        wWML(p.ws)[i] = f2bf(v); }
}
template <> DEV void phase<PH_ML_QK>(PRef p, int, int, long gtid, long gth) {
    for (long i = gtid; i < (long)R * 2 * MW; i += gth) { const int n = (int)(i % (2 * MW)); const long r = i / (2 * MW);
        wMQK(p.ws)[i] = f2bf(dot_bf16(wMU(p.ws) + r * MW, wWML(p.ws) + (long)n * MW, MW)); }
}
DEV int ml_scan_sc(int dir, int k) { return dir == 0 ? k : (k < NCS ? NCS - 1 - k : SCN - 1 - (k - NCS)); }
DEV int ml_sc_rank(int dir, int sc) { return dir == 0 ? sc : (sc < NCS ? NCS - 1 - sc : NCS + (SCN - 1 - sc)); }
template <> DEV void phase<PH_ML_F>(PRef p, int l, int, long gtid, long gth) {
    for (long i = gtid; i < (long)B * SCN * MH * 2; i += gth) { const int dir = (int)(i % 2), h = (int)((i / 2) % MH), sc = (int)((i / (2 * MH)) % SCN), b = (int)(i / (2 * MH * SCN));
        const float bi_ = p.ml_gate_b[(l * 4 + 2 * dir) * MH + h], bf_ = p.ml_gate_b[(l * 4 + 2 * dir + 1) * MH + h];
        float F = 0.f;
        for (int pos = 0; pos < SCS; ++pos) { const long r = (long)b * RPB + (long)sc * SCS + (dir == 0 ? pos : SCS - 1 - pos);
            const bf16* g = wP(p.ws) + r * NP + ML_LO + 3 * MW;
            const float li = bf2f(g[(2 * dir) * MH + h]) + bi_, lf = logsigmoid_f(bf2f(g[(2 * dir + 1) * MH + h]) + bf_);
            F += lf; float* fg = wFG(p.ws) + ((r * 2 + dir) * MH + h) * 2; fg[0] = F; fg[1] = F - li; }
    }
}
template <> DEV void phase<PH_ML_B>(PRef p, int, int, long gtid, long gth) {
    for (long i = gtid; i < (long)B * MH * 2 * SCN * (MD + 1) * MD; i += gth) {
        const int e = (int)(i % MD), jrow = (int)((i / MD) % (MD + 1)); long t = i / ((long)MD * (MD + 1));
        const int sc = (int)(t % SCN); t /= SCN; const int dir = (int)(t % 2); t /= 2; const int h = (int)(t % MH); const int b = (int)(t / MH);
        const long r0 = (long)b * RPB + (long)sc * SCS; const long rend = dir == 0 ? r0 + SCS - 1 : r0;
        const float Fend = wFG(p.ws)[((rend * 2 + dir) * MH + h) * 2];
        float acc = 0.f;
        for (int s = 0; s < SCS; ++s) { const long r = r0 + s; const float w = exp_f(Fend - wFG(p.ws)[((r * 2 + dir) * MH + h) * 2 + 1]);
            if (jrow < MD) acc += w * bf2f(wMQK(p.ws)[r * 2 * MW + MW + h * MD + jrow]) * bf2f(wP(p.ws)[r * NP + ML_LO + MW + h * MD + e]);
            else acc += w * bf2f(wMQK(p.ws)[r * 2 * MW + MW + h * MD + e]); }
        wMS(p.ws)[i] = acc;
    }
}
template <> DEV void phase<PH_ML_S>(PRef p, int, int dry, long gtid, long gth) {
    for (long i = gtid; i < (long)B * MH * 2 * (MD + 1) * MD; i += gth) {
        const int el = (int)(i % ((MD + 1) * MD)); long t = i / ((MD + 1) * MD); const int dir = (int)(t % 2); t /= 2; const int h = (int)(t % MH); const int b = (int)(t / MH);
        float* base = wMS(p.ws) + ((((long)b * MH + h) * 2 + dir) * SCN) * (MD + 1) * MD + el;
        float C = 0.f;
        for (int k = 0; k < SCN; ++k) { const int sc = ml_scan_sc(dir, k);
            const long r0 = (long)b * RPB + (long)sc * SCS; const long rend = dir == 0 ? r0 + SCS - 1 : r0;
            const float Ftot = wFG(p.ws)[((rend * 2 + dir) * MH + h) * 2];
            float* slot = base + (long)sc * (MD + 1) * MD; const float Bk = *slot; if (!dry) *slot = C;
            C = exp_f(Ftot) * C + Bk; }
    }
}
template <> DEV void phase<PH_ML_O>(PRef p, int l, int, long gtid, long gth) {
    const bool last = (l == DEPTH - 1);
    constexpr int HV = MD / 2;
    for (long i = gtid; i < (long)MH * R; i += gth) {
        const int h = (int)(i / R); const long r = i % R; const RowI ri = rowinfo((int)r);
        if (ri.ctx && last) continue;
        const bf16* qp = wMQK(p.ws) + r * 2 * MW + h * MD;
        const int sc = ri.o / SCS; const long r0 = (long)ri.b * RPB + (long)sc * SCS;
        float ss = 0.f;
        for (int half = 0; half < 2; ++half) {
            float hs[HV], num[HV];
#pragma unroll
            for (int d = 0; d < HV; ++d) hs[d] = 0.f;
            for (int dir = 0; dir < 2; ++dir) {
#pragma unroll
                for (int d = 0; d < HV; ++d) num[d] = 0.f;
                float den = 0.f;
                const float Ft = wFG(p.ws)[((r * 2 + dir) * MH + h) * 2];
                const long sa = dir == 0 ? r0 : r, sb = dir == 0 ? r : r0 + SCS - 1;
                for (long s = sa; s <= sb; ++s) {
                    const float w = exp_f(Ft - wFG(p.ws)[((s * 2 + dir) * MH + h) * 2 + 1]);
                    float dt = 0.f;
#pragma unroll
                    for (int d = 0; d < MD; d += 8) dt += dot8(*(const U4*)(qp + d), *(const U4*)(wMQK(p.ws) + s * 2 * MW + MW + h * MD + d));
                    dt *= w; den += dt;
#pragma unroll
                    for (int d = 0; d < HV; ++d) num[d] += dt * bf2f(wP(p.ws)[s * NP + ML_LO + MW + h * MD + half * HV + d]);
                }
                if (ml_sc_rank(dir, sc) > 0) {
                    const float a = exp_f(Ft);
                    const float* Cin = wMS(p.ws) + (((((long)ri.b * MH + h) * 2 + dir) * SCN) + sc) * (MD + 1) * MD;
#pragma unroll 1
                    for (int d = 0; d < MD; ++d) { const float qa = bf2f(qp[d]) * a; den += qa * Cin[MD * MD + d];
#pragma unroll
                        for (int e = 0; e < HV; ++e) num[e] += qa * Cin[d * MD + half * HV + e]; }
                }
                const float dn = 1.0f / fmaxf(fabsf(den), 1.0f);
#pragma unroll
                for (int d = 0; d < HV; ++d) hs[d] += num[d] * dn;
            }
#pragma unroll
            for (int d = 0; d < HV; ++d) { const float v = hs[d] * sigmoid_f(bf2f(wP(p.ws)[r * NP + ML_LO + 2 * MW + h * MD + half * HV + d])); ss += v * v;
                wH(p.ws)[r * D + AW + h * MD + half * HV + d] = f2bf(v); }
        }
        const float rstd = 1.0f / sqrtf(ss / (float)MD + EPS);
        for (int d = 0; d < MD; ++d) { bf16* o = wH(p.ws) + r * D + AW + h * MD + d; *o = f2bf(bf2f(*o) * rstd * p.ml_norm_g[l * MW + h * MD + d]); }
    }
}

DEV float hy_conv(PRef p, int l, long r, const RowI& ri, int ch) {
    const float* w = p.hy_conv_w + (long)l * 3 * N_HY; const bf16* pr = wP(p.ws) + r * NP + HY_LO + ch;
    float y = p.hy_conv_b[l * N_HY + ch] + w[N_HY + ch] * bf2f(pr[0]);
    if (has_prev(ri)) y += w[ch] * bf2f(pr[-NP]);
    if (has_next(ri)) y += w[2 * N_HY + ch] * bf2f(pr[NP]);
    return y;
}
template <> DEV void phase<PH_HY_Z>(PRef p, int l, int, long gtid, long gth) {
    for (long i = gtid; i < (long)B * CTX * HW; i += gth) { const int c = (int)(i % HW); const long q = i / HW; const long r = (q / CTX) * RPB + (q % CTX); const RowI ri = rowinfo((int)r);
        wZ(p.ws)[i] = hy_conv(p, l, r, ri, HW + c) * hy_conv(p, l, r, ri, 2 * HW + c); }
}
template <> DEV void phase<PH_HY_O>(PRef p, int l, int, long gtid, long gth) {
    if (l == DEPTH - 1) return;
    for (long i = gtid; i < (long)B * CTX * HW; i += gth) { const int c = (int)(i % HW); const long q = i / HW; const int b = (int)(q / CTX), t = (int)(q % CTX); const long r = (long)b * RPB + t; const RowI ri = rowinfo((int)r);
        const float* z = wZ(p.ws) + (long)b * CTX * HW + c;
        float y = 0.f;
        for (int s2 = 0; s2 <= t; ++s2) y += filt_tap(p, 1, c, t - s2) * z[(long)s2 * HW];
        for (int s2 = t + 1; s2 < CTX; ++s2) y += filt_tap(p, 1, HW + c, s2 - t) * z[(long)s2 * HW];
        y = y / filt_l1(p, 1, c) + z[(long)t * HW] * p.hy_bias_d[l * HW + c];
        wH(p.ws)[r * D + AW + MW + c] = f2bf(hy_conv(p, l, r, ri, c) * y); }
}
#ifdef HOST_EMU
#define BLOCK_FOR(tid) for (int tid = 0; tid < NTHREADS; ++tid)
#define BLOCK_SYNC() do {} while (0)
typedef unsigned char* LdsPtr;
DEV C2 twid(float turns) { C2 w; w.x = cosf(6.283185307179586f * turns); w.y = -sinf(6.283185307179586f * turns); return w; }
#else
DEV int opaque_tid() { int t = threadIdx.x; asm volatile("" : "+v"(t)); return t; }
#define BLOCK_FOR(tid) for (int tid = opaque_tid(), once_ = 1; once_; once_ = 0)
#define BLOCK_SYNC() __syncthreads()
typedef __attribute__((address_space(3))) unsigned char* LdsPtr;
DEV C2 twid(float turns) { C2 w; w.x = __builtin_amdgcn_cosf(turns); w.y = -__builtin_amdgcn_sinf(turns); return w; }
#endif
#ifdef HOST_EMU
typedef float* LdsC2; typedef bf16* LdsBf;
#else
typedef __attribute__((address_space(3))) float* LdsC2; typedef __attribute__((address_space(3))) bf16* LdsBf;
#endif
constexpr int NF = 2 * SEQ, NBF = NF / 8;
static_assert(SEQ == 4096 || SEQ == 512, "FFT passes: one radix-2 step then radix-8 steps (SEQ a power of 8)");
DEV int PI(int i) { return i + (i >> 3); }
DEV C2 ldc(LdsC2 buf, int i) { C2 r; r.x = buf[2 * i]; r.y = buf[2 * i + 1]; return r; }
DEV void stc(LdsC2 buf, int i, C2 v) { buf[2 * i] = v.x; buf[2 * i + 1] = v.y; }
DEV C2 cmul(C2 a, C2 b) { C2 r; r.x = a.x * b.x - a.y * b.y; r.y = a.x * b.y + a.y * b.x; return r; }
DEV C2 cmulc(C2 a, C2 b) { C2 r; r.x = a.x * b.x + a.y * b.y; r.y = a.y * b.x - a.x * b.y; return r; }
DEV void dft4(C2& u0, C2& u1, C2& u2, C2& u3) {
    const C2 t0 = {u0.x + u2.x, u0.y + u2.y}, t1 = {u0.x - u2.x, u0.y - u2.y}, t2 = {u1.x + u3.x, u1.y + u3.y}, d = {u1.x - u3.x, u1.y - u3.y};
    const C2 t3 = {d.y, -d.x};
    u0.x = t0.x + t2.x; u0.y = t0.y + t2.y; u2.x = t0.x - t2.x; u2.y = t0.y - t2.y; u1.x = t1.x + t3.x; u1.y = t1.y + t3.y; u3.x = t1.x - t3.x; u3.y = t1.y - t3.y;
}
DEV void dft8(C2 (&a)[8]) {
    const float c = 0.70710678118654752f;
    C2 b0 = {a[0].x + a[4].x, a[0].y + a[4].y}, b4 = {a[0].x - a[4].x, a[0].y - a[4].y};
    C2 b1 = {a[1].x + a[5].x, a[1].y + a[5].y}, d5 = {a[1].x - a[5].x, a[1].y - a[5].y};
    C2 b2 = {a[2].x + a[6].x, a[2].y + a[6].y}, d6 = {a[2].x - a[6].x, a[2].y - a[6].y};
    C2 b3 = {a[3].x + a[7].x, a[3].y + a[7].y}, d7 = {a[3].x - a[7].x, a[3].y - a[7].y};
    C2 b5 = {c * (d5.x + d5.y), c * (d5.y - d5.x)};
    C2 b6 = {d6.y, -d6.x};
    C2 b7 = {c * (d7.y - d7.x), -c * (d7.x + d7.y)};
    dft4(b0, b1, b2, b3); dft4(b4, b5, b6, b7);
    a[0] = b0; a[2] = b1; a[4] = b2; a[6] = b3; a[1] = b4; a[3] = b5; a[5] = b6; a[7] = b7;
}
DEV void idft8(C2 (&a)[8]) {
#pragma unroll
    for (int k = 0; k < 8; ++k) a[k].y = -a[k].y;
    dft8(a);
#pragma unroll
    for (int k = 0; k < 8; ++k) a[k].y = -a[k].y;
}
DEV void twpow(C2 w1, C2 (&w)[8]) { w[0].x = 1.f; w[0].y = 0.f; w[1] = w1; w[2] = cmul(w1, w1); w[3] = cmul(w[2], w1); w[4] = cmul(w[2], w[2]); w[5] = cmul(w[4], w1); w[6] = cmul(w[3], w[3]); w[7] = cmul(w[4], w[3]); }
template <bool INV> DEV void fft_pass8(LdsC2 buf, int s, int ls, int tid) {
    for (int q = tid; q < NBF; q += NTHREADS) {
        const int blk = q >> ls, j = q & (s - 1), base = (blk << (ls + 3)) + j;
        C2 a[8], w[8];
#pragma unroll
        for (int k = 0; k < 8; ++k) a[k] = ldc(buf, PI(base + (k << ls)));
        twpow(twid((float)j / (float)(8 * s)), w);
        if (!INV) { dft8(a);
#pragma unroll
            for (int m = 1; m < 8; ++m) a[m] = cmul(a[m], w[m]);
        } else {
#pragma unroll
            for (int m = 1; m < 8; ++m) a[m] = cmulc(a[m], w[m]);
            idft8(a); }
#pragma unroll
        for (int k = 0; k < 8; ++k) stc(buf, PI(base + (k << ls)), a[k]);
    }
}
DEV void fft_fwd_passes(LdsC2 buf, LdsC2 buf2 = nullptr) {
    int ls = (SEQ == 4096 ? 9 : 6);
    for (int s = SEQ / 8; s >= 8; s >>= 3, ls -= 3) { BLOCK_FOR(tid) { fft_pass8<false>(buf, s, ls, tid); if (buf2) fft_pass8<false>(buf2, s, ls, tid); } BLOCK_SYNC(); }
}
DEV void fft_inv_passes(LdsC2 buf, LdsC2 buf2 = nullptr) {
    int ls = 3;
    for (int s = 8; s <= SEQ / 8; s <<= 3, ls += 3) { BLOCK_FOR(tid) { fft_pass8<true>(buf, s, ls, tid); if (buf2) fft_pass8<true>(buf2, s, ls, tid); } BLOCK_SYNC(); }
}
enum { BPH_HFFT, BPH_HYFFT, BPH_HYZ, BPH_HYOUT, BPH_WCVT, BPH_HYCTX };
template <int BPH> DEV void bphase(PRef p, int l, int blk, LdsPtr lds);
constexpr int WT_UP = (D / 32) * (FF2 / 64), WT_DOWN = (FF / 32) * (D / 64), WT_IN = (D / 32) * (NP / 64), WT_UQ = (QR / 32) * (QW / 64), WT_UKV = (KVR / 32) * (KVW / 64), WT_OUT = (D / 32) * (D / 64);
constexpr int WT_ALL = WT_IN + WT_UQ + WT_UKV + WT_OUT + WT_UP + WT_DOWN;
static_assert(QR % 32 == 0 && KVR % 32 == 0 && QW % 64 == 0 && FF % 64 == 0 && NP % 64 == 0, "weight tiles");
struct WTile { const float* W; const float* gain; bf16* WT; int K, N, k0, n0, s0; };
DEV WTile wtile_decode(PRef p, int l, int t) {
    WTile w; w.gain = nullptr; int NT, which;
    if (t < WT_IN) { which = 0; w.W = p.w_in + (long)l * D * N_IN; w.WT = wWinT(p.ws, l); w.K = D; w.N = N_IN; NT = NP; }
    else if ((t -= WT_IN) < WT_UQ) { which = 1; w.W = p.w_uq + (long)l * QR * QW; w.gain = p.q_norm_g + l * QR; w.WT = wWuqT(p.ws, l); w.K = QR; w.N = QW; NT = QW; }
    else if ((t -= WT_UQ) < WT_UKV) { which = 2; w.W = p.w_ukv + (long)l * KVR * KVW; w.gain = p.kv_norm_g + l * KVR; w.WT = wWukvT(p.ws, l); w.K = KVR; w.N = KVW; NT = KVW; }
    else if ((t -= WT_UKV) < WT_OUT) { which = 3; w.W = p.w_out + (long)l * D * D; w.WT = wWoutT(p.ws, l); w.K = D; w.N = D; NT = D; }
    else if ((t -= WT_OUT) < WT_UP) { which = 4; w.W = p.w_up + (long)l * D * FF2; w.WT = wWupT(p.ws, l); w.K = D; w.N = FF2; NT = FF2; }
    else { t -= WT_UP; which = 5; w.W = p.w_down + (long)l * FF * D; w.WT = wWdownT(p.ws, l); w.K = FF; w.N = D; NT = D; }
    const int ntn = NT / 64, kb = t / ntn, nb = t % ntn; w.k0 = kb * 32; w.n0 = nb * 64;
    w.s0 = w.n0;
    if (which == 2) { const int hd = (w.n0 % AW) / 64; w.s0 = hd * (NOPE + AV) + (w.n0 < AW ? 0 : NOPE); }
#ifndef HOST_EMU
    if (which == 4) { const int tile = w.n0 / 256, within = w.n0 % 256; w.s0 = within < 128 ? tile * 128 + within : FF + tile * 128 + (within - 128); }
#endif
    return w;
}
constexpr int DOWN_BUSY = (R / 256 * (D / 256)) % NBLOCKS, NFILL = NBLOCKS - DOWN_BUSY;
constexpr int WT_PER = 4, WT_ITEMS = (WT_ALL + WT_PER - 1) / WT_PER, WT_SPLIT = (WT_IN + WT_UQ + WT_UKV + WT_OUT + WT_PER - 1) / WT_PER;
template <> DEV void bphase<BPH_WCVT>(PRef p, int l, int blk, LdsPtr lds) {
#ifdef HOST_EMU
    float* sm = (float*)lds;
#else
    __attribute__((address_space(3))) float* sm = (__attribute__((address_space(3))) float*)lds;
#endif
    BLOCK_FOR(tid) {
        for (int sub = 0; sub < WT_PER; ++sub) { const int t = blk * WT_PER + sub; if (t >= WT_ALL) break; const WTile w = wtile_decode(p, l, t);
            for (int idx = tid; idx < 32 * 64; idx += NTHREADS) { const int kk = idx >> 6, nn = idx & 63;
                float v = 0.f; if (w.s0 + nn < w.N) v = w.W[(long)(w.k0 + kk) * w.N + w.s0 + nn];
                if (w.gain) v *= w.gain[w.k0 + kk];
                sm[sub * 64 * 33 + nn * 33 + kk] = v; } }
    }
    BLOCK_SYNC();
    BLOCK_FOR(tid) {
        for (int sub = 0; sub < WT_PER; ++sub) { const int t = blk * WT_PER + sub; if (t >= WT_ALL) break; const WTile w = wtile_decode(p, l, t);
            for (int idx = tid; idx < 64 * 4; idx += NTHREADS) { const int nn = idx >> 2, ch = idx & 3; const int so = sub * 64 * 33 + nn * 33 + ch * 8;
                U4 o;
                o.x = f2bf(sm[so + 0]) | ((unsigned)f2bf(sm[so + 1]) << 16); o.y = f2bf(sm[so + 2]) | ((unsigned)f2bf(sm[so + 3]) << 16);
                o.z = f2bf(sm[so + 4]) | ((unsigned)f2bf(sm[so + 5]) << 16); o.w = f2bf(sm[so + 6]) | ((unsigned)f2bf(sm[so + 7]) << 16);
                *(U4*)(w.WT + (long)(w.n0 + nn) * w.K + w.k0 + ch * 8) = o; } }
    }
    BLOCK_SYNC();
}
template <> DEV void bphase<BPH_HFFT>(PRef p, int l, int blk, LdsPtr lds) {
    LdsC2 buf = (LdsC2)lds; const int c = blk;
    BLOCK_FOR(tid) {
        const float inv = 1.0f / filt_l1(p, 0, c), bias = p.hy_bias_d[l * HW + c];
        const float* fw = wFT(p.ws) + (long)c * SEQ; const float* bw = wFT(p.ws) + (long)(HW + c) * SEQ;
        for (int i = tid; i < SEQ; i += NTHREADS) {
            const float t0 = fw[i] * inv + (i == 0 ? bias : 0.f), t1 = (i == 0) ? 0.f : bw[SEQ - i] * inv;
            C2 e; e.x = t0 + t1; e.y = 0.f; stc(buf, PI(i), e);
            const C2 w = twid((float)i / (float)NF); const float d = t0 - t1; C2 o; o.x = d * w.x; o.y = d * w.y; stc(buf, PI(i + SEQ), o); }
    }
    BLOCK_SYNC();
    fft_fwd_passes(buf);
    BLOCK_FOR(tid) {
        C2* hs = wHSPEC(p.ws) + (long)c * NF; const float sc = 1.0f / (float)NF;
        for (int q = tid; q < NBF; q += NTHREADS) { C2 a[8];
#pragma unroll
            for (int k = 0; k < 8; ++k) a[k] = ldc(buf, 9 * q + k);
            dft8(a);
#pragma unroll
            for (int k = 0; k < 8; ++k) { C2 o; o.x = a[k].x * sc; o.y = a[k].y * sc; hs[8 * q + k] = o; } }
    }
    BLOCK_SYNC();
}
template <> DEV void bphase<BPH_HYFFT>(PRef p, int lflag, int blk, LdsPtr lds) {
    const int c = blk;
    constexpr int NPB = (B >= 4 && B % 4 == 0) ? 2 : 1;
    LdsC2 bufs[2] = {(LdsC2)lds, (LdsC2)(lds + (NPB == 2 ? (NF + NF / 8) * 8 : 0))};
    for (int pr = 0; pr < B / 2; pr += NPB) {
        BLOCK_FOR(tid) {
#pragma unroll
            for (int k = 0; k < NPB; ++k) { LdsC2 buf = bufs[k]; const bf16* z1 = wZT(p.ws) + ((long)(2 * (pr + k)) * HW + c) * SEQ; const bf16* z2 = z1 + (long)HW * SEQ;
                for (int i = tid; i < SEQ; i += NTHREADS) { C2 e; e.x = bf2f(z1[i]); e.y = bf2f(z2[i]); stc(buf, PI(i), e); stc(buf, PI(i + SEQ), cmul(e, twid((float)i / (float)NF))); } }
        }
        BLOCK_SYNC();
        fft_fwd_passes(bufs[0], NPB == 2 ? bufs[1] : nullptr);
        BLOCK_FOR(tid) {
            const C2* hs = wHSPEC(p.ws) + (long)c * NF;
            for (int q = tid; q < NBF; q += NTHREADS) { C2 hv[8];
#pragma unroll
                for (int k = 0; k < 8; ++k) hv[k] = hs[8 * q + k];
#pragma unroll
                for (int kb = 0; kb < NPB; ++kb) { LdsC2 buf = bufs[kb]; C2 a[8];
#pragma unroll
                    for (int k = 0; k < 8; ++k) a[k] = ldc(buf, 9 * q + k);
                    dft8(a);
#pragma unroll
                    for (int k = 0; k < 8; ++k) a[k] = cmul(a[k], hv[k]);
                    idft8(a);
#pragma unroll
                    for (int k = 0; k < 8; ++k) stc(buf, 9 * q + k, a[k]); } }
        }
        BLOCK_SYNC();
        fft_inv_passes(bufs[0], NPB == 2 ? bufs[1] : nullptr);
        BLOCK_FOR(tid) {
#pragma unroll
            for (int k = 0; k < NPB; ++k) { LdsC2 buf = bufs[k]; bf16* z1 = wZT(p.ws) + ((long)(2 * (pr + k)) * HW + c) * SEQ; bf16* z2 = z1 + (long)HW * SEQ;
                for (int i = tid; i < SEQ; i += NTHREADS) { const C2 a = ldc(buf, PI(i)), bb = ldc(buf, PI(i + SEQ)); const C2 y = cmulc(bb, twid((float)i / (float)NF));
                    if (!(lflag & 256)) { z1[i] = f2bf(a.x + y.x); z2[i] = f2bf(a.y + y.y); } } }
        }
        BLOCK_SYNC();
    }
}
template <> DEV void bphase<BPH_HYCTX>(PRef p, int l, int blk, LdsPtr lds) {
#ifdef HOST_EMU
    float* sm = (float*)lds;
#else
    __attribute__((address_space(3))) float* sm = (__attribute__((address_space(3))) float*)lds;
#endif
    const int b = blk / (HW / 8), c0 = (blk % (HW / 8)) * 8;
    BLOCK_FOR(tid) {
        for (int idx = tid; idx < CTX * 8; idx += NTHREADS) { const int t = idx >> 3, c = idx & 7;
            sm[idx] = wZ(p.ws)[((long)b * CTX + t) * HW + c0 + c];
            sm[CTX * 8 + idx] = wFT1(p.ws)[(long)t * 2 * HW + c0 + c]; sm[2 * CTX * 8 + idx] = wFT1(p.ws)[(long)t * 2 * HW + HW + c0 + c]; }
    }
    BLOCK_SYNC();
    BLOCK_FOR(tid) {
        for (int idx = tid; idx < CTX * 8; idx += NTHREADS) { const int t = idx >> 3, c = idx & 7;
            float y = 0.f;
            for (int s2 = 0; s2 <= t; ++s2) y += sm[CTX * 8 + (t - s2) * 8 + c] * sm[s2 * 8 + c];
            for (int s2 = t + 1; s2 < CTX; ++s2) y += sm[2 * CTX * 8 + (s2 - t) * 8 + c] * sm[s2 * 8 + c];
            const long r = (long)b * RPB + t; const RowI ri = rowinfo((int)r);
            y = y / filt_l1(p, 1, c0 + c) + sm[t * 8 + c] * p.hy_bias_d[l * HW + c0 + c];
            wH(p.ws)[r * D + AW + MW + c0 + c] = f2bf(hy_conv(p, l, r, ri, c0 + c) * y); }
    }
    BLOCK_SYNC();
}
constexpr int HZP = 72;
template <> DEV void bphase<BPH_HYZ>(PRef p, int l, int blk, LdsPtr lds) {
    LdsBf sm = (LdsBf)lds; const int b = blk / (SEQ / 64), tt = blk % (SEQ / 64); const long r0 = (long)b * RPB + CTX + (long)tt * 64;
    BLOCK_FOR(tid) { for (int it = tid; it < (HW / 8) * 16; it += NTHREADS) {
        const int cg = it % (HW / 8), rs = it / (HW / 8); const int t0 = tt * 64 + rs * 4; const long r = r0 + rs * 4;
        float a[4][8], v[4][8];
        conv4x8(wP(p.ws) + r * NP + HY_LO + HW + cg * 8, NP, p.hy_conv_w + (long)l * 3 * N_HY + HW + cg * 8, N_HY, p.hy_conv_b + l * N_HY + HW + cg * 8, t0 > 0, t0 + 4 < SEQ, a);
        conv4x8(wP(p.ws) + r * NP + HY_LO + 2 * HW + cg * 8, NP, p.hy_conv_w + (long)l * 3 * N_HY + 2 * HW + cg * 8, N_HY, p.hy_conv_b + l * N_HY + 2 * HW + cg * 8, t0 > 0, t0 + 4 < SEQ, v);
#pragma unroll
        for (int e = 0; e < 8; ++e)
#pragma unroll
            for (int k = 0; k < 4; ++k) sm[(cg * 8 + e) * HZP + rs * 4 + k] = f2bf(a[k][e] * v[k][e]);
    } }
    BLOCK_SYNC();
    BLOCK_FOR(tid) {
        for (int idx = tid; idx < HW * 8; idx += NTHREADS) { const int c = idx >> 3, ch = idx & 7;
            U4 v; const LdsBf q = sm + c * HZP + ch * 8;
            v.x = q[0] | ((unsigned)q[1] << 16); v.y = q[2] | ((unsigned)q[3] << 16); v.z = q[4] | ((unsigned)q[5] << 16); v.w = q[6] | ((unsigned)q[7] << 16);
            *(U4*)(wZT(p.ws) + ((long)b * HW + c) * SEQ + tt * 64 + ch * 8) = v; }
    }
    BLOCK_SYNC();
}
template <> DEV void bphase<BPH_HYOUT>(PRef p, int l, int blk, LdsPtr lds) {
    LdsBf sm = (LdsBf)lds; const int b = blk / (SEQ / 64), tt = blk % (SEQ / 64); const long r0 = (long)b * RPB + CTX + (long)tt * 64;
    BLOCK_FOR(tid) {
        for (int idx = tid; idx < HW * 8; idx += NTHREADS) { const int c = idx >> 3, ch = idx & 7;
            const U4 v = *(const U4*)(wZT(p.ws) + ((long)b * HW + c) * SEQ + tt * 64 + ch * 8); LdsBf q = sm + c * HZP + ch * 8;
            q[0] = (bf16)v.x; q[1] = (bf16)(v.x >> 16); q[2] = (bf16)v.y; q[3] = (bf16)(v.y >> 16); q[4] = (bf16)v.z; q[5] = (bf16)(v.z >> 16); q[6] = (bf16)v.w; q[7] = (bf16)(v.w >> 16); }
    }
    BLOCK_SYNC();
    BLOCK_FOR(tid) { for (int it = tid; it < (HW / 8) * 16; it += NTHREADS) {
        const int cg = it % (HW / 8), rs = it / (HW / 8); const int t0 = tt * 64 + rs * 4; const long r = r0 + rs * 4;
        float x0[4][8];
        conv4x8(wP(p.ws) + r * NP + HY_LO + cg * 8, NP, p.hy_conv_w + (long)l * 3 * N_HY + cg * 8, N_HY, p.hy_conv_b + l * N_HY + cg * 8, t0 > 0, t0 + 4 < SEQ, x0);
#pragma unroll
        for (int k = 0; k < 4; ++k) {
#pragma unroll
            for (int e = 0; e < 8; ++e) x0[k][e] *= bf2f(sm[(cg * 8 + e) * HZP + rs * 4 + k]);
            *(U4*)(wH(p.ws) + (r + k) * D + AW + MW + cg * 8) = pack8(x0[k]); }
    } }
    BLOCK_SYNC();
}
template <> DEV void phase<PH_GEMM_OUT>(PRef p, int l, int, long gtid, long gth) {
    for (long i = gtid; i < (long)R * D; i += gth) { const int n = (int)(i % D); const long r = i / D; const RowI ri = rowinfo((int)r);
        const float g1 = wMOD(p.ws)[((long)l * (B + 1) + ri.bi) * 6 * D + 2 * D + n];
        wX(p.ws)[i] = f2bf(bf2f(wX(p.ws)[i]) + g1 * dot_bf16(wH(p.ws) + r * D, wWoutT(p.ws, l) + (long)n * D, D)); }
}
template <> DEV void phase<PH_NORM2>(PRef p, int l, int, long gtid, long gth) {
    for (long r = gtid; r < R; r += gth) { const RowI ri = rowinfo((int)r); const bf16* xr = wX(p.ws) + r * D;
        float ss = 0.f; for (int k = 0; k < D; ++k) ss += bf2f(xr[k]) * bf2f(xr[k]);
        const float rstd = 1.0f / sqrtf(ss / (float)D + EPS);
        const float* mod = wMOD(p.ws) + ((long)l * (B + 1) + ri.bi) * 6 * D; const float* g = p.norm2_g + l * D;
        for (int k = 0; k < D; ++k) wH(p.ws)[r * D + k] = f2bf(bf2f(xr[k]) * rstd * g[k] * (1.0f + mod[4 * D + k]) + mod[3 * D + k]); }
}
template <> DEV void phase<PH_FFN_UP>(PRef p, int l, int fc, long gtid, long gth) {
    for (long i = gtid; i < (long)FCR * FF2; i += gth) { const int n = (int)(i % FF2); const long rr = i / FF2; const long r = (long)fc * FCR + rr;
        wUF(p.ws)[i] = f2bf(dot_bf16(wH(p.ws) + r * D, wWupT(p.ws, l) + (long)n * D, D)); }
}
template <> DEV void phase<PH_FFN_CG>(PRef p, int l, int fc, long gtid, long gth) {
    for (long i = gtid; i < (long)FCR * FF; i += gth) { const int j = (int)(i % FF); const long rr = i / FF; const long r = (long)fc * FCR + rr; const RowI ri = rowinfo((int)r);
        const float* w = p.ffn_conv_w + (long)l * 3 * FF2; const float* cb = p.ffn_conv_b + (long)l * FF2; const bf16* u = wUF(p.ws) + rr * FF2;
        float a = cb[j] + w[FF2 + j] * bf2f(u[j]), g = cb[FF + j] + w[FF2 + FF + j] * bf2f(u[FF + j]);
        if (has_prev(ri)) { a += w[j] * bf2f(u[j - FF2]); g += w[FF + j] * bf2f(u[FF + j - FF2]); }
        if (has_next(ri)) { a += w[2 * FF2 + j] * bf2f(u[j + FF2]); g += w[2 * FF2 + FF + j] * bf2f(u[FF + j + FF2]); }
        wGF(p.ws)[i] = f2bf(silu_f(a) * g); }
}
template <> DEV void phase<PH_FFN_DOWN>(PRef p, int l, int fc, long gtid, long gth) {
    for (long i = gtid; i < (long)FCR * D; i += gth) { const int n = (int)(i % D); const long rr = i / D; const long r = (long)fc * FCR + rr; const RowI ri = rowinfo((int)r);
        const float g2 = wMOD(p.ws)[((long)l * (B + 1) + ri.bi) * 6 * D + 5 * D + n];
        const float xn = bf2f(wX(p.ws)[r * D + n]) + g2 * dot_bf16(wGF(p.ws) + rr * FF, wWdownT(p.ws, l) + (long)n * FF, FF);
        wX(p.ws)[r * D + n] = f2bf(xn); }
}
template <> DEV void phase<PH_FINAL>(PRef p, int, int, long gtid, long gth) {
    for (long q = gtid; q < (long)B * SEQ; q += gth) { const bf16* xr = wX(p.ws) + ((q / SEQ) * RPB + CTX + q % SEQ) * D;
        float ss = 0.f; for (int k = 0; k < D; ++k) ss += bf2f(xr[k]) * bf2f(xr[k]);
        const float rstd = 1.0f / sqrtf(ss / (float)D + EPS);
        for (int k = 0; k < D; ++k) p.out[q * D + k] = bf2f(xr[k]) * rstd * p.final_g[k]; }
}


#ifndef HOST_EMU
namespace wv {
typedef float f32x4 __attribute__((ext_vector_type(4)));
typedef unsigned u32x2 __attribute__((ext_vector_type(2)));
__device__ __forceinline__ float wsum(float v, int lane) {
#pragma unroll
    for (int o = 32; o; o >>= 1) v += __int_as_float(__builtin_amdgcn_ds_bpermute((lane ^ o) << 2, __float_as_int(v)));
    return v;
}
typedef __bf16 bf2_t __attribute__((ext_vector_type(2)));
typedef float f32x2_t __attribute__((ext_vector_type(2)));
__device__ __forceinline__ unsigned pk(float lo, float hi) { f32x2_t v = {lo, hi}; return __builtin_bit_cast(unsigned, __builtin_convertvector(v, bf2_t)); }
constexpr int NW = NBLOCKS * (NTHREADS / 64), NV = D / 256;
template <int MODE> __device__ __forceinline__ void norm_rows(PRef p, int l) {
    int t_ = threadIdx.x; asm volatile("" : "+v"(t_)); const int lane = t_ & 63, gw = (int)blockIdx.x * (NTHREADS / 64) + (t_ >> 6);
    const int nrows = MODE == 2 ? B * SEQ : R;
    for (int q0 = gw; q0 < nrows; q0 += 2 * NW) {
        const bool two = q0 + NW < nrows;
        long r[2]; int bi[2]; const float* src[2] = {nullptr, nullptr}; bf16* xdst[2] = {nullptr, nullptr};
        f32x4 v[2][NV];
#pragma unroll
        for (int u = 0; u < 2; ++u) if (u == 0 || two) {
            const int q = q0 + u * NW;
            if (MODE == 2) { r[u] = (long)(q / SEQ) * RPB + CTX + (q % SEQ); bi[u] = 0; }
            else { r[u] = q; const RowI ri = rowinfo(q); bi[u] = ri.bi;
                if (MODE == 0 && l == 0) { src[u] = ri.ctx ? p.ctx + ((long)ri.b * CTX + ri.t) * D : p.x + ((long)ri.b * SEQ + ri.t) * D; xdst[u] = wX(p.ws) + r[u] * D; } }
#pragma unroll
            for (int j = 0; j < NV; ++j) {
                if (src[u]) v[u][j] = *(const f32x4*)(src[u] + 4 * lane + 256 * j);
                else { const u32x2 xw = *(const u32x2*)(wX(p.ws) + r[u] * D + 4 * lane + 256 * j); v[u][j][0] = __uint_as_float(xw.x << 16); v[u][j][1] = __uint_as_float(xw.x & 0xFFFF0000u); v[u][j][2] = __uint_as_float(xw.y << 16); v[u][j][3] = __uint_as_float(xw.y & 0xFFFF0000u); } }
        }
#pragma unroll
        for (int u = 0; u < 2; ++u) if (u == 0 || two) {
            const int q = q0 + u * NW;
            float ss = 0.f;
#pragma unroll
            for (int j = 0; j < NV; ++j) ss += (v[u][j][0] * v[u][j][0] + v[u][j][1] * v[u][j][1]) + (v[u][j][2] * v[u][j][2] + v[u][j][3] * v[u][j][3]);
            if (xdst[u]) {
#pragma unroll
                for (int j = 0; j < NV; ++j) { u32x2 w; w.x = pk(v[u][j][0], v[u][j][1]); w.y = pk(v[u][j][2], v[u][j][3]); *(u32x2*)(xdst[u] + 4 * lane + 256 * j) = w; } }
            const float rstd = 1.0f / sqrtf(wsum(ss, lane) / (float)D + EPS);
            if (MODE == 2) {
#pragma unroll
                for (int j = 0; j < NV; ++j) { const f32x4 g = *(const f32x4*)(p.final_g + 4 * lane + 256 * j); *(f32x4*)(p.out + (long)q * D + 4 * lane + 256 * j) = v[u][j] * rstd * g; }
            } else {
                const float* mod = wMOD(p.ws) + ((long)l * (B + 1) + bi[u]) * 6 * D + (MODE == 0 ? 0 : 3 * D); const float* g = (MODE == 0 ? p.norm1_g : p.norm2_g) + l * D;
#pragma unroll
                for (int j = 0; j < NV; ++j) { const int k = 4 * lane + 256 * j; const f32x4 gg = *(const f32x4*)(g + k), sh = *(const f32x4*)(mod + k), sc = *(const f32x4*)(mod + D + k);
                    const f32x4 o = v[u][j] * rstd * gg * (sc + 1.0f) + sh; u32x2 w; w.x = pk(o[0], o[1]); w.y = pk(o[2], o[3]); *(u32x2*)(wH(p.ws) + r[u] * D + k) = w; }
            }
        }
    }
}
__device__ __forceinline__ float rsum16(float v) {
    v += __int_as_float(__builtin_amdgcn_update_dpp(0, __float_as_int(v), 0x128, 0xf, 0xf, false));
    v += __int_as_float(__builtin_amdgcn_update_dpp(0, __float_as_int(v), 0x124, 0xf, 0xf, false));
    v += __int_as_float(__builtin_amdgcn_update_dpp(0, __float_as_int(v), 0x122, 0xf, 0xf, false));
    v += __int_as_float(__builtin_amdgcn_update_dpp(0, __float_as_int(v), 0x121, 0xf, 0xf, false));
    return v;
}
__device__ __forceinline__ void mla_a_rows(PRef p) {
    int t_ = threadIdx.x; asm volatile("" : "+v"(t_)); const int lane = t_ & 63, i = lane & 15, g = lane >> 4, gw = (int)blockIdx.x * (NTHREADS / 64) + (t_ >> 6);
    static_assert(QR == 3 * 128 && KVR == 2 * 128 && ROPE == 32 && R % 4 == 0, "mla_a lane map");
    for (int q0 = gw * 4; q0 < R; q0 += 8 * NW) {
        U4 uq[2][3], uk[2][2]; float x1[2], x2[2], cs[2], sn[2]; bool ok[2], cx[2] = {false, false};
#pragma unroll
        for (int u = 0; u < 2; ++u) {
            const int r = q0 + u * 4 * NW + g; ok[u] = r < R;
            if (ok[u]) { const RowI ri = rowinfo(r); const bf16* pr = wP(p.ws) + (long)r * NP;
#pragma unroll
                for (int c = 0; c < 3; ++c) uq[u][c] = *(const U4*)(pr + (i + 16 * c) * 8);
#pragma unroll
                for (int c = 0; c < 2; ++c) uk[u][c] = *(const U4*)(pr + QR + (i + 16 * c) * 8);
                x1[u] = bf2f(pr[QR + KVR + i]); x2[u] = bf2f(pr[QR + KVR + 16 + i]);
                const int tt = ri.ctx ? 0 : ri.t; cx[u] = ri.ctx; cs[u] = wROPET(p.ws)[((long)tt * 16 + i) * 2]; sn[u] = wROPET(p.ws)[((long)tt * 16 + i) * 2 + 1]; }
        }
#pragma unroll
        for (int u = 0; u < 2; ++u) {
            const int r = q0 + u * 4 * NW + g;
            float sq = 0.f, sk = 0.f;
            if (ok[u]) { sq = dot8(uq[u][0], uq[u][0]) + dot8(uq[u][1], uq[u][1]) + dot8(uq[u][2], uq[u][2]); sk = dot8(uk[u][0], uk[u][0]) + dot8(uk[u][1], uk[u][1]); }
            sq = rsum16(sq); sk = rsum16(sk);
            if (ok[u]) {
                if (i == 0) { wRS(p.ws)[r] = 1.0f / sqrtf(sq / (float)QR + EPS); wRS(p.ws)[R + r] = 1.0f / sqrtf(sk / (float)KVR + EPS); }
                const float c_ = cx[u] ? 1.0f : cs[u], s_ = cx[u] ? 0.0f : sn[u];
                wKR(p.ws)[(long)r * ROPE + i] = f2bf(x1[u] * c_ - x2[u] * s_); wKR(p.ws)[(long)r * ROPE + 16 + i] = f2bf(x1[u] * s_ + x2[u] * c_); }
        }
    }
}
__device__ __forceinline__ void ml_f_rows(PRef p, int l) {
    int t_ = threadIdx.x; asm volatile("" : "+v"(t_)); const int lane = t_ & 63, gw = (int)blockIdx.x * (NTHREADS / 64) + (t_ >> 6);
    static_assert(SCS == 256, "ml_f_rows: 64 lanes x 4 positions");
    for (int u = NW - 1 - gw; u < B * SCN * MH * 2; u += NW) {
        const int dir = u % 2, h = (u / 2) % MH, sc = (u / (2 * MH)) % SCN, b = u / (2 * MH * SCN);
        const float bi_ = p.ml_gate_b[(l * 4 + 2 * dir) * MH + h], bf_ = p.ml_gate_b[(l * 4 + 2 * dir + 1) * MH + h];
        const long rb = (long)b * RPB + (long)sc * SCS;
        float li[4], c[4]; float run = 0.f;
#pragma unroll
        for (int i = 0; i < 4; ++i) { const int pos = 4 * lane + i; const long r = rb + (dir == 0 ? pos : SCS - 1 - pos);
            const bf16* g = wP(p.ws) + r * NP + ML_LO + 3 * MW;
            li[i] = bf2f(g[(2 * dir) * MH + h]) + bi_; run += logsigmoid_f(bf2f(g[(2 * dir + 1) * MH + h]) + bf_); c[i] = run; }
        float inc = run;
#pragma unroll
        for (int o = 1; o < 64; o <<= 1) { const float t = __int_as_float(__builtin_amdgcn_ds_bpermute(((lane - o) & 63) << 2, __float_as_int(inc))); if (lane >= o) inc += t; }
        const float excl = inc - run;
#pragma unroll
        for (int i = 0; i < 4; ++i) { const int pos = 4 * lane + i; const long r = rb + (dir == 0 ? pos : SCS - 1 - pos); const float F = excl + c[i];
            float* fg = wFG(p.ws) + ((r * 2 + dir) * MH + h) * 2; fg[0] = F; fg[1] = F - li[i]; }
    }
}
}
#endif
#ifndef HOST_EMU
#define LAS __attribute__((address_space(3)))
#endif

#ifndef HOST_EMU
namespace att {
typedef short bf16x8 __attribute__((ext_vector_type(8)));
typedef float f32x4 __attribute__((ext_vector_type(4)));
typedef unsigned u32x4 __attribute__((ext_vector_type(4)));
typedef unsigned u32x2 __attribute__((ext_vector_type(2)));
constexpr int TK = 128;
constexpr int KROW = 224, VROW = TK * 2 + 32, KT_BYTES = TK * KROW, VT_BYTES = 64 * VROW;
constexpr int QBLK = 256, NQB = SEQ / QBLK, NLAT = B * AH * NQB, NCQ = CTX / QBLK;
static_assert(SEQ % QBLK == 0 && RPB % TK == 0 && CTX % TK == 0 && CTX % QBLK == 0, "attention tiling");
__device__ __forceinline__ float bfl(unsigned w) { return __uint_as_float(w << 16); }
__device__ __forceinline__ float bfh(unsigned w) { return __uint_as_float(w & 0xFFFF0000u); }
typedef __bf16 bf2_t __attribute__((ext_vector_type(2)));
typedef float f32x2_t __attribute__((ext_vector_type(2)));
__device__ __forceinline__ unsigned pk(float lo, float hi) { f32x2_t v = {lo, hi}; return __builtin_bit_cast(unsigned, __builtin_convertvector(v, bf2_t)); }
__device__ __forceinline__ float xl(float v, int lane, int m) { return __int_as_float(__builtin_amdgcn_ds_bpermute((lane ^ m) << 2, __float_as_int(v))); }
__device__ __forceinline__ void attn_phase(PRef p, int l, LAS unsigned char* lds) {
    const int wave = __builtin_amdgcn_readfirstlane((int)threadIdx.x >> 6);
    const bool last = (l == DEPTH - 1);
    const int vcu = ((int)blockIdx.x % 8) * (NBLOCKS / 8) + (int)blockIdx.x / 8;
    const int nunits = NLAT + (last ? 0 : B * AH * NCQ);
    const float qscale = 0.14724420716f;
    const bf16* Qg = wQ(p.out); const bf16* KNg = wKN(p.out); const bf16* KRg = wKR(p.ws); const bf16* VTg = wVT(p.out); const float* ROPEg = wROPET(p.ws); bf16* Og = wH(p.ws);
    for (int u = vcu; u < nunits; u += NBLOCKS) {
        int tid_ = threadIdx.x; asm volatile("" : "+v"(tid_));
        const int tid = tid_, lane = tid & 63, i16 = lane & 15, g = lane >> 4;
        const bool isctx = u >= NLAT;
        int b, hd, nkeys; long q0;
        if (!isctx) { b = u / (AH * NQB); hd = (u / NQB) % AH; q0 = (long)b * RPB + CTX + (long)(u % NQB) * QBLK; nkeys = RPB; }
        else { const int uu = u - NLAT; b = uu / (AH * NCQ); hd = (uu / NCQ) % AH; q0 = (long)b * RPB + (long)(uu % NCQ) * QBLK; nkeys = CTX; }
        const long k0 = (long)b * RPB;
        const long qw = q0 + wave * 32;
        bf16x8 qf[2][3];
#pragma unroll
        for (int qb = 0; qb < 2; ++qb) {
            const bf16* qp = (Qg + qw * QW + hd * (NOPE + ROPE)) + (unsigned)((qb * 16 + i16) * QW + g * 8);
            u32x4 raw[3];
#pragma unroll
            for (int ks = 0; ks < 3; ++ks) raw[ks] = *(const u32x4*)(qp + ks * 32);
#pragma unroll
            for (int ks = 0; ks < 2; ++ks) { u32x4 w;
#pragma unroll
                for (int e = 0; e < 4; ++e) w[e] = pk(bfl(raw[ks][e]) * qscale, bfh(raw[ks][e]) * qscale);
                qf[qb][ks] = __builtin_bit_cast(bf16x8, w); }
            u32x4 w2;
            if (!isctx) {
                u32x4 pr;
#pragma unroll
                for (int e = 0; e < 4; ++e) pr[e] = (unsigned)__builtin_amdgcn_ds_bpermute((lane ^ 32) << 2, (int)raw[2][e]);
                const float* tb = (ROPEg + (qw - k0 - CTX) * 32) + (unsigned)((qb * 16 + i16) * 32 + 16 * (g & 1));
                const float sg = g < 2 ? -1.0f : 1.0f;
#pragma unroll
                for (int e = 0; e < 4; ++e) { const f32x4 cs = *(const f32x4*)(tb + 4 * e);
                    const float m0 = bfl(raw[2][e]), m1 = bfh(raw[2][e]), o0 = bfl(pr[e]), o1 = bfh(pr[e]);
                    w2[e] = pk((m0 * cs[0] + sg * o0 * cs[1]) * qscale, (m1 * cs[2] + sg * o1 * cs[3]) * qscale); }
            } else {
#pragma unroll
                for (int e = 0; e < 4; ++e) w2[e] = pk(bfl(raw[2][e]) * qscale, bfh(raw[2][e]) * qscale);
            }
            qf[qb][2] = __builtin_bit_cast(bf16x8, w2);
        }
        const bf16* knb = KNg + k0 * AW + hd * NOPE; const bf16* krb = KRg + k0 * ROPE; const bf16* vb = VTg + (long)hd * AV * R + k0;
        const unsigned kn_off0 = (unsigned)((tid >> 3) * AW + (tid & 7) * 8), kn_off1 = kn_off0 + 64u * AW, kr_off = (unsigned)((tid >> 2) * ROPE + (tid & 3) * 8);
        const unsigned v_off0 = (unsigned)((tid >> 4) * R + (tid & 15) * 8), v_off1 = v_off0 + 32u * R;
        const int kn_dst0 = (tid >> 3) * KROW + (tid & 7) * 16, kn_dst1 = kn_dst0 + 64 * KROW, kr_dst = (tid >> 2) * KROW + 128 + (tid & 3) * 16;
        const int v_dst0 = 2 * KT_BYTES + (tid >> 4) * VROW + (tid & 15) * 16, v_dst1 = v_dst0 + 32 * VROW;
        const int nt = nkeys / TK;
        f32x4 O[2][4];
#pragma unroll
        for (int qb = 0; qb < 2; ++qb)
#pragma unroll
            for (int dvt = 0; dvt < 4; ++dvt) O[qb][dvt] = (f32x4){0.f, 0.f, 0.f, 0.f};
        float mrun[2] = {0.f, 0.f}, lsum[2] = {0.f, 0.f};
        f32x4 negm[2] = {(f32x4){0.f, 0.f, 0.f, 0.f}, (f32x4){0.f, 0.f, 0.f, 0.f}};
        const int kfo = i16 * KROW + g * 16, vfo = 2 * KT_BYTES + i16 * VROW + g * 16;
        u32x4 s1, s2, s3, s4, s5;
        auto load_stage = [&](int tt) { s1 = *(const u32x4*)(knb + (long)tt * TK * AW + kn_off0); s2 = *(const u32x4*)(knb + (long)tt * TK * AW + kn_off1); s3 = *(const u32x4*)(krb + (long)tt * TK * ROPE + kr_off);
            s4 = *(const u32x4*)(vb + (long)tt * TK + v_off0); s5 = *(const u32x4*)(vb + (long)tt * TK + v_off1); };
        auto store_stage = [&](int buf) { const int nk = buf * KT_BYTES, nv = buf * VT_BYTES;
            *(LAS u32x4*)(lds + nk + kn_dst0) = s1; *(LAS u32x4*)(lds + nk + kn_dst1) = s2; *(LAS u32x4*)(lds + nk + kr_dst) = s3; *(LAS u32x4*)(lds + nv + v_dst0) = s4; *(LAS u32x4*)(lds + nv + v_dst1) = s5; };
        auto subtile = [&](int kb_off, int vb_off, bool first) {
            bf16x8 kf[12];
#pragma unroll
            for (int kb = 0; kb < 4; ++kb)
#pragma unroll
                for (int ks = 0; ks < 3; ++ks) kf[kb * 3 + ks] = *(const LAS bf16x8*)(lds + kb_off + kb * 16 * KROW + ks * 64);
            asm volatile("s_waitcnt lgkmcnt(0)" : "+v"(kf[0]), "+v"(kf[1]), "+v"(kf[2]), "+v"(kf[3]), "+v"(kf[4]), "+v"(kf[5]), "+v"(kf[6]), "+v"(kf[7]), "+v"(kf[8]), "+v"(kf[9]), "+v"(kf[10]), "+v"(kf[11]) :: "memory");
            f32x4 S[2][4];
#pragma unroll
            for (int kb = 0; kb < 4; ++kb)
#pragma unroll
                for (int ks = 0; ks < 3; ++ks) {
                    S[0][kb] = __builtin_amdgcn_mfma_f32_16x16x32_bf16(kf[kb * 3 + ks], qf[0][ks], ks == 0 ? negm[0] : S[0][kb], 0, 0, 0);
                    S[1][kb] = __builtin_amdgcn_mfma_f32_16x16x32_bf16(kf[kb * 3 + ks], qf[1][ks], ks == 0 ? negm[1] : S[1][kb], 0, 0, 0); }
            bf16x8 vf[8];
#pragma unroll
            for (int dvt = 0; dvt < 4; ++dvt)
#pragma unroll
                for (int kp = 0; kp < 2; ++kp) vf[dvt * 2 + kp] = *(const LAS bf16x8*)(lds + vb_off + dvt * 16 * VROW + kp * 64);
            asm volatile("" ::: "memory");
            bf16x8 pf[2][2];
#pragma unroll
            for (int qb = 0; qb < 2; ++qb) {
                float mx = S[qb][0][0];
#pragma unroll
                for (int kb = 0; kb < 4; ++kb)
#pragma unroll
                    for (int e = 0; e < 4; ++e) mx = fmaxf(mx, S[qb][kb][e]);
                if (first || __builtin_amdgcn_ballot_w64(mx > 8.0f) != 0ull) {
                    mx = fmaxf(mx, xl(mx, lane, 16)); mx = fmaxf(mx, xl(mx, lane, 32));
                    const float d = first ? mx : fmaxf(mx, 0.0f), corr = first ? 1.0f : __builtin_amdgcn_exp2f(-d);
                    mrun[qb] += d; lsum[qb] *= corr; negm[qb] = (f32x4){-mrun[qb], -mrun[qb], -mrun[qb], -mrun[qb]};
#pragma unroll
                    for (int dvt = 0; dvt < 4; ++dvt) O[qb][dvt] = O[qb][dvt] * corr;
#pragma unroll
                    for (int kb = 0; kb < 4; ++kb) S[qb][kb] = S[qb][kb] - d;
                }
                float ps = 0.f;
#pragma unroll
                for (int kb = 0; kb < 4; ++kb)
#pragma unroll
                    for (int e = 0; e < 4; ++e) { const float ex = __builtin_amdgcn_exp2f(S[qb][kb][e]); S[qb][kb][e] = ex; ps += ex; }
                lsum[qb] += ps;
#pragma unroll
                for (int kp = 0; kp < 2; ++kp) { u32x4 w; w[0] = pk(S[qb][2 * kp][0], S[qb][2 * kp][1]); w[1] = pk(S[qb][2 * kp][2], S[qb][2 * kp][3]); w[2] = pk(S[qb][2 * kp + 1][0], S[qb][2 * kp + 1][1]); w[3] = pk(S[qb][2 * kp + 1][2], S[qb][2 * kp + 1][3]);
                    pf[qb][kp] = __builtin_bit_cast(bf16x8, w); }
            }
            asm volatile("s_waitcnt lgkmcnt(0)" : "+v"(vf[0]), "+v"(vf[1]), "+v"(vf[2]), "+v"(vf[3]), "+v"(vf[4]), "+v"(vf[5]), "+v"(vf[6]), "+v"(vf[7]) :: "memory");
#pragma unroll
            for (int dvt = 0; dvt < 4; ++dvt)
#pragma unroll
                for (int kp = 0; kp < 2; ++kp) {
                    O[0][dvt] = __builtin_amdgcn_mfma_f32_16x16x32_bf16(vf[dvt * 2 + kp], pf[0][kp], O[0][dvt], 0, 0, 0);
                    O[1][dvt] = __builtin_amdgcn_mfma_f32_16x16x32_bf16(vf[dvt * 2 + kp], pf[1][kp], O[1][dvt], 0, 0, 0); }
        };
        load_stage(0); store_stage(0);
        __syncthreads();
        for (int t = 0; t < nt; ++t) {
            const int buf = t & 1;
            if (t + 1 < nt) load_stage(t + 1);
#pragma unroll
            for (int sub = 0; sub < TK / 64; ++sub) subtile(buf * KT_BYTES + sub * 64 * KROW + kfo, buf * VT_BYTES + sub * 128 + vfo, sub == 0 && t == 0);
            if (t + 1 < nt) store_stage(buf ^ 1);
            __syncthreads();
        }
#pragma unroll
        for (int qb = 0; qb < 2; ++qb) {
            float lt = lsum[qb]; lt += xl(lt, lane, 16); lt += xl(lt, lane, 32); const float inv = 1.0f / lt;
            bf16* op = (Og + qw * D + hd * AV) + (unsigned)((qb * 16 + i16) * D + 4 * g);
#pragma unroll
            for (int dvt = 0; dvt < 4; ++dvt) { u32x2 w; w.x = pk(O[qb][dvt][0] * inv, O[qb][dvt][1] * inv); w.y = pk(O[qb][dvt][2] * inv, O[qb][dvt][3] * inv); *(u32x2*)(op + dvt * 16) = w; }
        }
    }
}
}
#endif

#ifndef HOST_EMU
namespace mlk {
typedef short bf16x8 __attribute__((ext_vector_type(8)));
typedef float f32x16 __attribute__((ext_vector_type(16)));
typedef float f32x4 __attribute__((ext_vector_type(4)));
typedef unsigned u32x4 __attribute__((ext_vector_type(4)));
typedef unsigned u32x2 __attribute__((ext_vector_type(2)));
static_assert(SCS == 256 && MD == 64, "mlstm MFMA phases: 256-row super-chunks, head dim 64");
constexpr int KP = 144, TP = 528;
constexpr int O_KL = 0, O_VT = 256 * KP, O_CT = O_VT + 64 * TP, O_FG = O_CT + 2 * 64 * KP, O_NL = O_FG + 2 * 2 * 256 * 4, O_END = O_NL + 2 * 64 * 4;
constexpr int B_KT = 0, B_VT = 64 * TP, B_WL = 2 * 64 * TP, B_END = B_WL + 2 * 256 * 4;
constexpr float LOG2E = 1.4426950408889634f;
__device__ __forceinline__ float bfl(unsigned w) { return __uint_as_float(w << 16); }
__device__ __forceinline__ float bfh(unsigned w) { return __uint_as_float(w & 0xFFFF0000u); }
__device__ __forceinline__ unsigned pk(float lo, float hi) { unsigned r; asm volatile("v_cvt_pk_bf16_f32 %0, %1, %2" : "=v"(r) : "v"(lo), "v"(hi)); return r; }
__device__ __forceinline__ float xl32(float v, int lane) { return __int_as_float(__builtin_amdgcn_ds_bpermute((lane ^ 32) << 2, __float_as_int(v))); }
__device__ __forceinline__ int kpos(int key) { return (key & ~15) | swap23(key & 15); }
__device__ __forceinline__ void stage_t(LAS unsigned char* img, const u32x4 v, int dim0, int key) {
    const int kb = kpos(key) * 2;
#pragma unroll
    for (int e = 0; e < 4; ++e) { *(LAS unsigned short*)(img + (dim0 + 2 * e) * TP + kb) = (unsigned short)(v[e] & 0xFFFFu); *(LAS unsigned short*)(img + (dim0 + 2 * e + 1) * TP + kb) = (unsigned short)(v[e] >> 16); }
}
__device__ __forceinline__ void ml_b_phase(PRef p, LAS unsigned char* lds) {
    const int wave = __builtin_amdgcn_readfirstlane((int)threadIdx.x >> 6);
    for (int u = ((((int)blockIdx.x % 8) + 6) % 8) * (NBLOCKS / 8) + (int)blockIdx.x / 8; u < B * MH * SCN; u += NBLOCKS) {
        int tid_ = threadIdx.x; asm volatile("" : "+v"(tid_)); const int tid = tid_, lane = tid & 63, r = lane & 31, hh = lane >> 5;
        const int sc = u % SCN, h = (u / SCN) % MH, b = u / (SCN * MH); const long r0 = (long)b * RPB + (long)sc * SCS;
        const bf16* kg = wMQK(p.ws) + r0 * 2 * MW + MW + h * MD; const bf16* vg = wP(p.ws) + r0 * NP + ML_LO + MW + h * MD; const float* fg = wFG(p.ws);
#pragma unroll
        for (int i = 0; i < 4; ++i) { const int ci = tid + 512 * i, key = ci >> 3, part = ci & 7;
            stage_t(lds + B_KT, *(const u32x4*)(kg + (unsigned)(key * 2 * MW + part * 8)), part * 8, key);
            stage_t(lds + B_VT, *(const u32x4*)(vg + (unsigned)(key * NP + part * 8)), part * 8, key); }
        { const int dir = tid >> 8, key = tid & 255; const long rend = dir == 0 ? r0 + SCS - 1 : r0;
          const float Fend = fg[((rend * 2 + dir) * MH + h) * 2], G = fg[(((r0 + key) * 2 + dir) * MH + h) * 2 + 1];
          *(LAS float*)(lds + B_WL + (dir * 256 + kpos(key)) * 4) = __builtin_amdgcn_exp2f((Fend - G) * LOG2E); }
        __syncthreads();
        const int dir = wave >> 2, dvb = (wave >> 1) & 1, kb = wave & 1;
        f32x16 acc;
#pragma unroll
        for (int i = 0; i < 16; ++i) acc[i] = 0.f;
        float nacc = 0.f;
#pragma unroll 4
        for (int ks = 0; ks < 16; ++ks) {
            const bf16x8 vf = *(const LAS bf16x8*)(lds + B_VT + (dvb * 32 + r) * TP + ks * 32 + hh * 16);
            const u32x4 kr = *(const LAS u32x4*)(lds + B_KT + (kb * 32 + r) * TP + ks * 32 + hh * 16);
            const f32x4 w0 = *(const LAS f32x4*)(lds + B_WL + (dir * 256 + ks * 16 + hh * 8) * 4), w1 = *(const LAS f32x4*)(lds + B_WL + (dir * 256 + ks * 16 + hh * 8 + 4) * 4);
            const float k0 = bfl(kr[0]) * w0[0], k1 = bfh(kr[0]) * w0[1], k2 = bfl(kr[1]) * w0[2], k3 = bfh(kr[1]) * w0[3], k4 = bfl(kr[2]) * w1[0], k5 = bfh(kr[2]) * w1[1], k6 = bfl(kr[3]) * w1[2], k7 = bfh(kr[3]) * w1[3];
            nacc += ((k0 + k1) + (k2 + k3)) + ((k4 + k5) + (k6 + k7));
            u32x4 kw; kw[0] = pk(k0, k1); kw[1] = pk(k2, k3); kw[2] = pk(k4, k5); kw[3] = pk(k6, k7);
            acc = __builtin_amdgcn_mfma_f32_32x32x16_bf16(vf, __builtin_bit_cast(bf16x8, kw), acc, 0, 0, 0);
        }
        float* ms = wMS(p.ws) + ((((long)b * MH + h) * 2 + dir) * SCN + sc) * (MD + 1) * MD;
#pragma unroll
        for (int g = 0; g < 4; ++g) { f32x4 o; o[0] = acc[4 * g]; o[1] = acc[4 * g + 1]; o[2] = acc[4 * g + 2]; o[3] = acc[4 * g + 3];
            *(f32x4*)(ms + (unsigned)((kb * 32 + r) * MD + dvb * 32 + 8 * g + 4 * hh)) = o; }
        const float nt = nacc + xl32(nacc, lane);
        if (dvb == 0 && hh == 0) ms[MD * MD + kb * 32 + r] = nt;
        __syncthreads();
    }
}
__device__ __forceinline__ void ml_o_phase(PRef p, int l, LAS unsigned char* lds) {
    const int wave = __builtin_amdgcn_readfirstlane((int)threadIdx.x >> 6);
    const bool last = (l == DEPTH - 1);
    for (int u = blockIdx.x; u < B * MH * SCN; u += NBLOCKS) {
        const int sc = u % SCN, h = (u / SCN) % MH, b = u / (SCN * MH);
        if (last && sc < NCS) continue;
        int tid_ = threadIdx.x; asm volatile("" : "+v"(tid_)); const int tid = tid_, lane = tid & 63, r = lane & 31, hh = lane >> 5;
        const long r0 = (long)b * RPB + (long)sc * SCS;
        const bf16* qg = wMQK(p.ws) + r0 * 2 * MW + h * MD; const bf16* kg = qg + MW; const bf16* pg = wP(p.ws) + r0 * NP + ML_LO + h * MD; const float* fg = wFG(p.ws);
        const float* msb = wMS(p.ws) + (((long)b * MH + h) * 2 * SCN + sc) * (MD + 1) * MD;
#pragma unroll
        for (int i = 0; i < 4; ++i) { const int ci = tid + 512 * i, key = ci >> 3, part = ci & 7;
            *(LAS u32x4*)(lds + O_KL + key * KP + part * 16) = *(const u32x4*)(kg + (unsigned)(key * 2 * MW + part * 8));
            stage_t(lds + O_VT, *(const u32x4*)(pg + (unsigned)(key * NP + MW + part * 8)), part * 8, key); }
#pragma unroll
        for (int i = 0; i < 4; ++i) { const int ci = tid + 512 * i, dir = ci >> 10, kdim = (ci >> 4) & 63, d4 = ci & 15;
            const f32x4 c = *(const f32x4*)(msb + (unsigned)(dir * SCN * (MD + 1) * MD + kdim * MD + d4 * 4));
#pragma unroll
            for (int e = 0; e < 4; ++e) *(LAS unsigned short*)(lds + O_CT + (dir * 64 + d4 * 4 + e) * KP + kdim * 2) = (unsigned short)f2bf(c[e]); }
        if (tid < 128) { const int dir = tid >> 6, kdim = tid & 63; *(LAS float*)(lds + O_NL + tid * 4) = msb[(unsigned)(dir * SCN * (MD + 1) * MD + MD * MD + kdim)]; }
        { const int dir = tid >> 8, key = tid & 255; const float F = fg[(((r0 + key) * 2 + dir) * MH + h) * 2], G = fg[(((r0 + key) * 2 + dir) * MH + h) * 2 + 1];
          *(LAS float*)(lds + O_FG + ((dir * 2 + 0) * 256 + key) * 4) = F * LOG2E; *(LAS float*)(lds + O_FG + ((dir * 2 + 1) * 256 + key) * 4) = G * LOG2E; }
        bf16x8 qf[4];
#pragma unroll
        for (int ks = 0; ks < 4; ++ks) qf[ks] = *(const bf16x8*)(qg + (unsigned)((wave * 32 + r) * 2 * MW + ks * 16 + hh * 8));
        __syncthreads();
        f32x16 hs[2];
#pragma unroll
        for (int dvb = 0; dvb < 2; ++dvb)
#pragma unroll
            for (int i = 0; i < 16; ++i) hs[dvb][i] = 0.f;
#pragma unroll 1
        for (int dir = 0; dir < 2; ++dir) {
            const float Ft = *(const LAS float*)(lds + O_FG + ((dir * 2 + 0) * 256 + wave * 32 + r) * 4);
            f32x16 O[2];
#pragma unroll
            for (int dvb = 0; dvb < 2; ++dvb)
#pragma unroll
                for (int i = 0; i < 16; ++i) O[dvb][i] = 0.f;
            float den = 0.f;
            const int kt0 = dir == 0 ? 0 : wave, kt1 = dir == 0 ? wave : 7;
            for (int kt = kt0; kt <= kt1; ++kt) {
                f32x16 S;
#pragma unroll
                for (int i = 0; i < 16; ++i) S[i] = 0.f;
#pragma unroll
                for (int ks = 0; ks < 4; ++ks) {
                    const bf16x8 kf = *(const LAS bf16x8*)(lds + O_KL + (kt * 32 + r) * KP + ks * 32 + hh * 16);
                    S = __builtin_amdgcn_mfma_f32_32x32x16_bf16(kf, qf[ks], S, 0, 0, 0); }
                const bool diag = (kt == wave);
#pragma unroll
                for (int g = 0; g < 4; ++g) { const f32x4 gv = *(const LAS f32x4*)(lds + O_FG + ((dir * 2 + 1) * 256 + kt * 32 + 8 * g + 4 * hh) * 4);
#pragma unroll
                    for (int e = 0; e < 4; ++e) { const int krow = 8 * g + 4 * hh + e; const bool keep = !diag || (dir == 0 ? krow <= r : krow >= r);
                        const float wgt = __builtin_amdgcn_exp2f(keep ? Ft - gv[e] : -1.0e30f); const float sw = S[4 * g + e] * wgt; S[4 * g + e] = sw; den += sw; } }
                bf16x8 pf[2];
#pragma unroll
                for (int s2 = 0; s2 < 2; ++s2) { u32x4 w;
#pragma unroll
                    for (int e = 0; e < 4; ++e) w[e] = pk(S[8 * s2 + 2 * e], S[8 * s2 + 2 * e + 1]);
                    pf[s2] = __builtin_bit_cast(bf16x8, w); }
#pragma unroll
                for (int dvb = 0; dvb < 2; ++dvb)
#pragma unroll
                    for (int s2 = 0; s2 < 2; ++s2) {
                        const bf16x8 vf = *(const LAS bf16x8*)(lds + O_VT + (dvb * 32 + r) * TP + (kt * 32 + s2 * 16) * 2 + hh * 16);
                        O[dvb] = __builtin_amdgcn_mfma_f32_32x32x16_bf16(vf, pf[s2], O[dvb], 0, 0, 0); }
            }
            f32x16 I[2];
#pragma unroll
            for (int dvb = 0; dvb < 2; ++dvb)
#pragma unroll
                for (int i = 0; i < 16; ++i) I[dvb][i] = 0.f;
            float dint = 0.f;
#pragma unroll
            for (int ks = 0; ks < 4; ++ks) {
#pragma unroll
                for (int dvb = 0; dvb < 2; ++dvb) { const bf16x8 cf = *(const LAS bf16x8*)(lds + O_CT + (dir * 64 + dvb * 32 + r) * KP + ks * 32 + hh * 16);
                    I[dvb] = __builtin_amdgcn_mfma_f32_32x32x16_bf16(cf, qf[ks], I[dvb], 0, 0, 0); }
                const u32x4 qr = __builtin_bit_cast(u32x4, qf[ks]);
                const f32x4 n0 = *(const LAS f32x4*)(lds + O_NL + (dir * 64 + ks * 16 + hh * 8) * 4), n1 = *(const LAS f32x4*)(lds + O_NL + (dir * 64 + ks * 16 + hh * 8 + 4) * 4);
                dint += (bfl(qr[0]) * n0[0] + bfh(qr[0]) * n0[1]) + (bfl(qr[1]) * n0[2] + bfh(qr[1]) * n0[3]) + (bfl(qr[2]) * n1[0] + bfh(qr[2]) * n1[1]) + (bfl(qr[3]) * n1[2] + bfh(qr[3]) * n1[3]);
            }
            const float a = __builtin_amdgcn_exp2f(Ft);
            const float dtot = (den + xl32(den, lane)) + a * (dint + xl32(dint, lane));
            const float scl = 1.0f / fmaxf(fabsf(dtot), 1.0f);
#pragma unroll
            for (int dvb = 0; dvb < 2; ++dvb)
#pragma unroll
                for (int i = 0; i < 16; ++i) hs[dvb][i] += (O[dvb][i] + a * I[dvb][i]) * scl;
        }
        const bf16* og = pg + (unsigned)((wave * 32 + r) * NP + 2 * MW + 4 * hh);
        float ss = 0.f;
#pragma unroll
        for (int dvb = 0; dvb < 2; ++dvb)
#pragma unroll
            for (int g = 0; g < 4; ++g) { const u32x2 ov = *(const u32x2*)(og + dvb * 32 + 8 * g);
                const float o0 = bfl(ov[0]), o1 = bfh(ov[0]), o2 = bfl(ov[1]), o3 = bfh(ov[1]);
                float v0 = hs[dvb][4 * g] * rcp_f(1.0f + exp_f(-o0)), v1 = hs[dvb][4 * g + 1] * rcp_f(1.0f + exp_f(-o1)), v2 = hs[dvb][4 * g + 2] * rcp_f(1.0f + exp_f(-o2)), v3 = hs[dvb][4 * g + 3] * rcp_f(1.0f + exp_f(-o3));
                hs[dvb][4 * g] = v0; hs[dvb][4 * g + 1] = v1; hs[dvb][4 * g + 2] = v2; hs[dvb][4 * g + 3] = v3; ss += (v0 * v0 + v1 * v1) + (v2 * v2 + v3 * v3); }
        ss += xl32(ss, lane);
        const float rstd = 1.0f / sqrtf(ss / (float)MD + EPS);
        const float* ng = p.ml_norm_g + l * MW + h * MD + 4 * hh; bf16* op = wH(p.ws) + (r0 + wave * 32 + r) * D + AW + h * MD + 4 * hh;
#pragma unroll
        for (int dvb = 0; dvb < 2; ++dvb)
#pragma unroll
            for (int g = 0; g < 4; ++g) { const f32x4 gg = *(const f32x4*)(ng + dvb * 32 + 8 * g); u32x2 w;
                w[0] = pk(hs[dvb][4 * g] * rstd * gg[0], hs[dvb][4 * g + 1] * rstd * gg[1]); w[1] = pk(hs[dvb][4 * g + 2] * rstd * gg[2], hs[dvb][4 * g + 3] * rstd * gg[3]);
                *(u32x2*)(op + dvb * 32 + 8 * g) = w; }
        __syncthreads();
    }
}
}
#endif
#ifndef HOST_EMU
#define XB_TMO      128
#define XB_XCNT(j)  (256  + 64 * (j))
#define XB_XSUB(j)  (1280 + 64 * (j))
#define XB_XGEN(j)  (2304 + 64 * (j))
#define XB_TOP      3328
#define XB_TOPGEN   3392
#define XCD_BAR_WORDS 3456
#define XB_SPIN_CAP (1u << 18)

__device__ __forceinline__ unsigned xb_ld(unsigned* p)              { return __hip_atomic_load(p, __ATOMIC_RELAXED, __HIP_MEMORY_SCOPE_AGENT); }
__device__ __forceinline__ unsigned xb_add(unsigned* p, unsigned v) { return __hip_atomic_fetch_add(p, v, __ATOMIC_RELAXED, __HIP_MEMORY_SCOPE_AGENT); }
__device__ __forceinline__ unsigned xb_xcc_id() { return (unsigned)__builtin_amdgcn_s_getreg((3 << 11) | 20) & 0xFu; }
#define XB_SPIN(cond, bar) do { unsigned _sp = 0; while (cond) { __builtin_amdgcn_s_sleep(1); \
    if ((++_sp & 255u) == 0u) { if (xb_ld(&(bar)[XB_TMO])) break; if (_sp > XB_SPIN_CAP) { atomicAdd(&(bar)[XB_TMO], 1u); break; } } } } while (0)

struct XcdBarrier { unsigned* bar; unsigned x; volatile LAS unsigned* st; };

__device__ __forceinline__ XcdBarrier xcd_barrier_post(unsigned* bar, volatile LAS unsigned* st) {
    XcdBarrier b; b.bar = bar; b.x = xb_xcc_id(); b.st = st;
    if (threadIdx.x == 0) (void)xb_add(&bar[XB_XCNT(b.x)], 1u);
    return b;
}
__device__ __forceinline__ void xcd_barrier_complete(unsigned* bar, unsigned x, unsigned& nloc, unsigned& nx) {
    const unsigned G = gridDim.x * gridDim.y * gridDim.z;
    unsigned sum, cnt, mine, sp = 0u;
    for (;;) {
        sum = 0u; cnt = 0u; mine = 0u;
#pragma unroll
        for (unsigned j = 0; j < 16; ++j) { const unsigned c = xb_ld(&bar[XB_XCNT(j)]); sum += c; cnt += (c > 0u) ? 1u : 0u; mine = (j == x) ? c : mine; }
        if (sum == G) break;
        __builtin_amdgcn_s_sleep(1);
        if ((++sp & 255u) == 0u) { if (xb_ld(&bar[XB_TMO])) break; if (sp > XB_SPIN_CAP) { atomicAdd(&bar[XB_TMO], 1u); break; } }
    }
    nloc = mine > 0u ? mine : 1u; nx = cnt > 0u ? cnt : 1u;
}
__device__ __forceinline__ void xcd_barrier(const XcdBarrier& b) {
    asm volatile("s_waitcnt vmcnt(0)" ::: "memory");
    __syncthreads();
    if (threadIdx.x == 0) {
        unsigned* bar = b.bar;
        __builtin_amdgcn_s_waitcnt(0);
        unsigned nloc = b.st[0], nx = b.st[1];
        if (nloc == 0u) { xcd_barrier_complete(bar, b.x, nloc, nx); b.st[0] = nloc; b.st[1] = nx; }
        const unsigned old = xb_add(&bar[XB_XSUB(b.x)], 1u);
        const unsigned gen = old / nloc;
        if (old + 1u == (gen + 1u) * nloc) {
            __builtin_amdgcn_fence(__ATOMIC_RELEASE, "agent");
            asm volatile("s_waitcnt vmcnt(0)" ::: "memory");
            const unsigned og = xb_add(&bar[XB_TOP], 1u);
            const unsigned tg = og / nx;
            if (og + 1u == (tg + 1u) * nx) xb_add(&bar[XB_TOPGEN], 1u);
            else XB_SPIN(xb_ld(&bar[XB_TOPGEN]) == tg, bar);
            __builtin_amdgcn_fence(__ATOMIC_ACQUIRE, "agent");
            xb_add(&bar[XB_XGEN(b.x)], 1u);
            asm volatile("s_waitcnt vmcnt(0)" ::: "memory");
        } else {
            XB_SPIN(xb_ld(&bar[XB_XGEN(b.x)]) == gen, bar);
            __builtin_amdgcn_fence(__ATOMIC_ACQUIRE, "agent");
            asm volatile("s_waitcnt vmcnt(0)" ::: "memory");
        }
    }
    __syncthreads();
}
#endif

constexpr int UPT = (R + 253) / 254;
constexpr int LDS_BYTES = 163840;

#ifdef HOST_EMU
#define ATT_PHASE(l) RUN(PH_ATT, l, 0)
#define NORM1_PHASE(l) RUN(PH_NORM1, l, 0)
#define ML_B_PHASE(l) RUN(PH_ML_B, l, 0)
#define ML_O_PHASE(l) RUN(PH_ML_O, l, 0)
#define NORM2_PHASE(l) RUN(PH_NORM2, l, 0)
#define FINAL_PHASE() RUN(PH_FINAL, 0, 0)
#define MLA_A_PHASE(l) RUN(PH_MLA_A, l, 0)
#define ML_F_PHASE(l) RUN(PH_ML_F, l, 0)
#define GEMM_GEMM1(l) RUN(PH_GEMM1, l, 0)
#define GEMM_Q(l) RUN(PH_MLA_Q, l, 0)
#define GEMM_KV(l) RUN(PH_MLA_KV, l, 0)
#define GEMM_MLQK(l) RUN(PH_ML_QK, l, 0)
#define GEMM_OUT(l) RUN(PH_GEMM_OUT, l, 0)
#else
#define KARG() const Params __attribute__((address_space(4)))* kp_ = (const Params __attribute__((address_space(4)))*)__builtin_amdgcn_kernarg_segment_ptr(); asm volatile("" : "+s"(kp_)); PRef p = *kp_
#define LAT_ 0
#define GEMM_LAT(l, EPI, A_, lda_, Bt_, ldb_, N_, K_, rot, ...) do { KARG(); const int lat_ = ((l) == DEPTH - 1) && (SEQ % 256 == 0) && (CTX % 256 == 0); pg8::Gemm g_{(const bf16*)(A_), (const bf16*)(Bt_), lda_, ldb_, lat_ ? B * SEQ : R, N_, K_, 256}; \
    pg8::StaticOrder S_; S_.init(lat_ ? B * SEQ : R, N_, NBLOCKS, ((int)blockIdx.x + (rot)) % NBLOCKS, lat_); pg8::EPI E_{__VA_ARGS__}; pg8::gemm_phase<pg8::EPI, pg8::StaticOrder, true, true>((LAS unsigned char*)lds, g_, S_, E_); } while (0)
#define GEMM_CALL(EPI, A_, lda_, Bt_, ldb_, M_, N_, K_, rot, ...) GEMM_CALLX(true, EPI, A_, lda_, Bt_, ldb_, M_, N_, K_, rot, __VA_ARGS__)
#define GEMM_CALLX(SP2_, EPI, A_, lda_, Bt_, ldb_, M_, N_, K_, rot, ...) do { KARG(); pg8::Gemm g_{(const bf16*)(A_), (const bf16*)(Bt_), lda_, ldb_, M_, N_, K_, 256}; pg8::StaticOrder S_; S_.init(M_, N_, NBLOCKS, ((int)blockIdx.x + (rot)) % NBLOCKS, LAT_); \
    pg8::EPI E_{__VA_ARGS__}; pg8::gemm_phase<pg8::EPI, pg8::StaticOrder, true, SP2_>((LAS unsigned char*)lds, g_, S_, E_); } while (0)
#define ATT_PHASE(l) do { KARG(); att::attn_phase(p, l, (LAS unsigned char*)lds); } while (0)
#define NORM1_PHASE(l) do { KARG(); wv::norm_rows<0>(p, l); } while (0)
#define ML_B_PHASE(l) do { KARG(); mlk::ml_b_phase(p, (LAS unsigned char*)lds); } while (0)
#define ML_O_PHASE(l) do { KARG(); mlk::ml_o_phase(p, l, (LAS unsigned char*)lds); } while (0)
#define NORM2_PHASE(l) do { KARG(); wv::norm_rows<1>(p, l); } while (0)
#define FINAL_PHASE() do { KARG(); wv::norm_rows<2>(p, 0); } while (0)
#define MLA_A_PHASE(l) do { KARG(); wv::mla_a_rows(p); } while (0)
#define ML_F_PHASE(l) do { KARG(); wv::ml_f_rows(p, l); } while (0)
#define GEMM_GEMM1(l) GEMM_CALL(EpiBf16, wH(p.ws), D, wWinT(p.ws, l), D, R, NP, D, 0, wP(p.ws), NP, nullptr, 0)
#define GEMM_Q(l) GEMM_CALL(EpiBf16, wP(p.ws), NP, wWuqT(p.ws, l), QR, R, QW, QR, 0, wQ(p.out), QW, wRS(p.ws), 1)
#define GEMM_KV(l) do { GEMM_CALL(EpiBf16, wP(p.ws) + QR, NP, wWukvT(p.ws, l), KVR, R, AW, KVR, (R / 256 * (QW / 256)) % NBLOCKS, wKN(p.out), AW, wRS(p.ws) + R, 1); \
    GEMM_CALLX(false, EpiVT, wWukvT(p.ws, l) + (size_t)AW * KVR, KVR, wP(p.ws) + QR, NP, AW, R, KVR, (R / 256 * ((QW + AW) / 256)) % NBLOCKS, wVT(p.out), wRS(p.ws) + R); } while (0)
#define GEMM_MLQK(l) GEMM_CALL(EpiBf16, wMU(p.ws), MW, wWML(p.ws), MW, R, 2 * MW, MW, (R / 256 * ((QW + 2 * AW) / 256)) % NBLOCKS, wMQK(p.ws), 2 * MW, nullptr, 0)
#define GEMM_OUT(l) GEMM_LAT(l, EpiResid, wH(p.ws), D, wWoutT(p.ws, l), D, D, D, 0, wX(p.ws), wMOD(p.ws) + (size_t)(l) * (B + 1) * 6 * D + 2 * D, nullptr, DRY_)
#define GEMM_UP(l) do { KARG(); pg8::Gemm g_{(const bf16*)(wH(p.ws) - D), (const bf16*)wWupT(p.ws, l), D, D, UPT * 256, FF2, D, 254}; pg8::StaticOrder S_; S_.init(UPT * 256, FF2, NBLOCKS, (int)blockIdx.x); \
    pg8::EpiConvGate E_{wGF(p.ws), p.ffn_conv_w + (size_t)(l) * 3 * FF2, p.ffn_conv_b + (size_t)(l) * FF2, (LAS unsigned char*)lds + pg8::STAGE_BYTES}; pg8::gemm_phase<pg8::EpiConvGate, pg8::StaticOrder, true, true>((LAS unsigned char*)lds, g_, S_, E_); } while (0)
#define GEMM_DOWN(l) GEMM_LAT(l, EpiResid, wGF(p.ws), FF, wWdownT(p.ws, l), FF, D, FF, 0, wX(p.ws), wMOD(p.ws) + (size_t)(l) * (B + 1) * 6 * D + 5 * D, nullptr, DRY_)
#endif
#ifdef HOST_EMU
#define GRID_BAR() do {} while (0)
#define FILL_W(ln, busy, i0, i1, filt) do { const int i0_ = (i0), i1_ = (i1); emu_block_launch(i1_ - i0_, [&](int blk, unsigned char* smem) { bphase<BPH_WCVT>(p, ln, i0_ + blk, smem); }); if (filt) RUN(PH_FILT_A, ln, 0); } while (0)
#define RUN(PH, l, arg) emu_launch([&](long gtid, long gth) { phase<PH>(p, l, arg, gtid, gth); })
#define BRUN(BPH, l, nblk) emu_block_launch(nblk, [&](int blk, unsigned char* smem) { bphase<BPH>(p, l, blk, smem); })
#define BRUN_OFF(BPH, l, nblk, busy) BRUN(BPH, l, nblk)
static void fwd(const Params& p) {
#else
#define GRID_BAR() xcd_barrier(bar)
#define DRY_ 0
#define BRUN(BPH, l, nblk) do { KARG(); for (int blk_ = blockIdx.x; blk_ < (nblk); blk_ += NBLOCKS) bphase<BPH>(p, l, blk_, (LdsPtr)lds); } while (0)
#define BRUN_OFF(BPH, l, nblk, busy) do { KARG(); const int busy_ = (busy); if ((int)blockIdx.x >= busy_) for (int blk_ = (int)blockIdx.x - busy_; blk_ < (nblk); blk_ += NBLOCKS - busy_) bphase<BPH>(p, l, blk_, (LdsPtr)lds); } while (0)
#define FILL_W(ln, busy, i0, i1, filt) do { KARG(); const int busy_ = (busy), nf_ = NBLOCKS - busy_, i1_ = (i1); __syncthreads(); if ((int)blockIdx.x >= busy_) { for (int blk_ = (i0) + (int)blockIdx.x - busy_; blk_ < i1_; blk_ += nf_) bphase<BPH_WCVT>(p, ln, blk_, (LdsPtr)lds); \
    if (filt) { int t_ = threadIdx.x; asm volatile("" : "+v"(t_)); phase<PH_FILT_A>(p, ln, 0, (long)((int)blockIdx.x - busy_) * NTHREADS + t_, (long)nf_ * NTHREADS); } } } while (0)
#define RUN(PH, l, arg) do { KARG(); int t_ = threadIdx.x; asm volatile("" : "+v"(t_)); const int g_ = blockIdx.x * NTHREADS + t_; phase<PH>(p, l, arg, (long)g_, gth); } while (0)
__global__ void __launch_bounds__(NTHREADS, 2) fwd(Params p_unused) {
    extern __shared__ __attribute__((aligned(16))) unsigned char lds[];
    if (threadIdx.x < 4) ((LAS unsigned*)lds)[(LDS_BYTES - 16) / 4 + threadIdx.x] = 0u;
    __syncthreads();
    XcdBarrier bar; { KARG(); bar = xcd_barrier_post(wctl(p.ws) + 1024, (volatile LAS unsigned*)(lds + LDS_BYTES - 16)); }
    constexpr long gth = (long)NBLOCKS * NTHREADS;
#endif
    RUN(PH_MOD, 0, 0); RUN(PH_ROPE, 0, 0);
    GRID_BAR();
    RUN(PH_MOD2, 0, 0);
    for (int hs = 0; hs <= 2 * DEPTH; ++hs) {
        const int l = (hs - 1) >> 1;
        if (hs >= 1 && (hs & 1)) {
            NORM1_PHASE(l); RUN(PH_FILT_B, l, 0);
            GRID_BAR();
            GEMM_GEMM1(l); RUN(PH_FILT_C, l, 0);
            GRID_BAR();
            MLA_A_PHASE(l); if (l < DEPTH - 1) RUN(PH_HY_Z, l, 0); BRUN(BPH_HYZ, l, B * (SEQ / 64)); RUN(PH_FILT_D, l, 0); RUN(PH_ML_U, l, 0); ML_F_PHASE(l);
            GRID_BAR();
            GEMM_Q(l); GEMM_KV(l); GEMM_MLQK(l); BRUN(BPH_HFFT, l, HW); if (l < DEPTH - 1) BRUN(BPH_HYCTX, l, B * (HW / 8));
            GRID_BAR();
            ATT_PHASE(l); ML_B_PHASE(l);
            GRID_BAR();
            RUN(PH_ML_S, l, 0); BRUN(BPH_HYFFT, l, HW);
            GRID_BAR();
            ML_O_PHASE(l); BRUN_OFF(BPH_HYOUT, l, B * (SEQ / 64), l < DEPTH - 1 ? (B * MH * SCN) % NBLOCKS : 0);
            GRID_BAR();
            GEMM_OUT(l);
        }
        if (hs >= 2 && !(hs & 1)) {
            NORM2_PHASE(l);
            GRID_BAR();
#ifdef HOST_EMU
            for (int fcI = 0; fcI < NFC; ++fcI) { RUN(PH_FFN_UP, l, fcI); RUN(PH_FFN_CG, l, fcI); RUN(PH_FFN_DOWN, l, fcI); }
#else
            GEMM_UP(l);
            GRID_BAR();
            GEMM_DOWN(l);
#endif
        }
        {
            int fl = 0, busy = 0, i0 = 0, i1 = 0, filt = 0;
            if (hs == 0) { i1 = WT_SPLIT; filt = 1; }
            else if (hs == 1) { busy = DOWN_BUSY; i0 = WT_SPLIT; i1 = WT_ITEMS; }
            else if (!(hs & 1) && (hs >> 1) < DEPTH) { fl = hs >> 1; busy = DOWN_BUSY; i1 = WT_ITEMS; filt = 1; }
            else if ((hs & 1) && hs > 1) {   }
            FILL_W(fl, busy, i0, i1, filt);
        }
        GRID_BAR();
    }
    FINAL_PHASE();
}

extern "C" void kernel_launch(void* const* d_in, const int* in_sizes, int n_in, void* d_out, int out_size, void* d_ws, size_t ws_size, hipStream_t stream) {
    (void)in_sizes; (void)n_in; (void)out_size; (void)ws_size;
    Params p{};
    const float* const* in = (const float* const*)d_in;
    p.x = in[0]; p.c = in[1]; p.ctx = in[2]; p.c_ctx = in[3]; p.ada_w = in[4]; p.ada_b = in[5]; p.norm1_g = in[6]; p.norm2_g = in[7]; p.w_in = in[8];
    p.q_norm_g = in[9]; p.kv_norm_g = in[10]; p.w_uq = in[11]; p.w_ukv = in[12]; p.ml_conv_w = in[13]; p.ml_conv_b = in[14]; p.ml_wq = in[15]; p.ml_wk = in[16];
    p.ml_gate_b = in[17]; p.ml_norm_g = in[18]; p.hy_conv_w = in[19]; p.hy_conv_b = in[20]; p.hy_w1 = in[21]; p.hy_b1 = in[22]; p.hy_w2 = in[23]; p.hy_b2 = in[24];
    p.hy_w3 = in[25]; p.hy_freq = in[26]; p.hy_bias_d = in[27]; p.w_out = in[28]; p.w_up = in[29]; p.ffn_conv_w = in[30]; p.ffn_conv_b = in[31]; p.w_down = in[32]; p.final_g = in[33];
    p.out = (float*)d_out;
    p.ws = (char*)d_ws;
#ifdef HOST_EMU
    fwd(p);
#else
    static int grid = 0;
    if (grid == 0) {
        int dev = 0, cus = 0;
        if (hipGetDevice(&dev) != hipSuccess || hipDeviceGetAttribute(&cus, hipDeviceAttributeMultiprocessorCount, dev) != hipSuccess) { grid = -1; return; }
        if (hipFuncSetAttribute((const void*)fwd, hipFuncAttributeMaxDynamicSharedMemorySize, LDS_BYTES) != hipSuccess) { grid = -1; return; }
        int per_cu = 0;
        (void)hipOccupancyMaxActiveBlocksPerMultiprocessor(&per_cu, (const void*)fwd, NTHREADS, LDS_BYTES);
        (void)hipGetLastError();
        grid = (cus >= NBLOCKS) ? NBLOCKS : -1;
    }
    if (grid < 0) return;
    (void)hipMemsetAsync(d_ws, 0, CTL_BYTES, stream);
    hipLaunchKernelGGL(fwd, dim3(grid), dim3(NTHREADS), LDS_BYTES, stream, p);
#endif
}
```

```cpp
#ifndef HOST_EMU
#include <hip/hip_runtime.h>
#endif
#include <stdint.h>
#include <math.h>

#ifndef CFG_D_MODEL
#define CFG_D_MODEL 1024
#define CFG_BATCH 8
#define CFG_SEQ 4096
#define CFG_CTX 256
#define CFG_SCS 256
#define CFG_NFC 4
#endif

#define DEV __device__ __forceinline__

namespace cfg {
constexpr int D = CFG_D_MODEL, B = CFG_BATCH, SEQ = CFG_SEQ, CTX = CFG_CTX, DEPTH = 2, GRID_W = 64;
constexpr int RPB = CTX + SEQ;
constexpr int R = B * RPB;
constexpr float EPS = 1e-6f;
constexpr int AH = D / 128, NOPE = 64, ROPE = 32, AV = 64, QR = 3 * D / 8, KVR = D / 4, AW = AH * AV;
constexpr int QW = AH * (NOPE + ROPE);
constexpr int KVW = AH * (NOPE + AV);
constexpr int MH = 4, MD = D / 16, MW = MH * MD;
constexpr int HW = D / 4, HB = 16, HE = 33, HH = 64;
constexpr int N_MLA = QR + KVR + ROPE, N_ML = 3 * MW + 4 * MH, N_HY = 3 * HW, N_IN = N_MLA + N_ML + N_HY;
constexpr int ML_LO = N_MLA, HY_LO = N_MLA + N_ML;
constexpr int NP = (N_IN + 255) / 256 * 256;
constexpr int FF = ((8 * D / 3 + 255) / 256) * 256, FF2 = 2 * FF;
constexpr int SCS = CFG_SCS;
constexpr int SCN = RPB / SCS, NCS = CTX / SCS;
constexpr int NFC = CFG_NFC;
constexpr int FCR = (B / NFC) * RPB;
static_assert(CTX % SCS == 0 && SEQ % SCS == 0, "super-chunk must divide ctx and seq");
static_assert(B % NFC == 0, "ffn chunks");
static_assert(MD == 64 || MD == 16, "mlstm head dim");
}
using namespace cfg;
constexpr int NTHREADS = 512, NBLOCKS = 256;

typedef unsigned short bf16;
struct alignas(16) U4 { unsigned x, y, z, w; };

DEV float u2f(unsigned u) { union { unsigned u; float f; } c; c.u = u; return c.f; }
DEV unsigned f2u(float f) { union { unsigned u; float f; } c; c.f = f; return c.u; }
DEV float bf2f(bf16 v) { return u2f(((unsigned)v) << 16); }
DEV bf16 f2bf(float f) { unsigned u = f2u(f); u += 0x7FFFu + ((u >> 16) & 1u); return (bf16)(u >> 16); }
DEV float bflo(unsigned w) { return u2f(w << 16); }
DEV float bfhi(unsigned w) { return u2f(w & 0xFFFF0000u); }
#ifdef HOST_EMU
DEV float sin_f(float x) { return sinf(x); }
DEV float cos_t(float turns) { return cosf(6.283185307179586f * turns); }
DEV float sin_t(float turns) { return sinf(6.283185307179586f * turns); }
#else
DEV float sin_f(float x) { return __builtin_amdgcn_sinf(__builtin_amdgcn_fractf(x * 0.15915494309189535f)); }
DEV float cos_t(float turns) { return __builtin_amdgcn_cosf(turns); }
DEV float sin_t(float turns) { return __builtin_amdgcn_sinf(turns); }
#endif
#ifdef HOST_EMU
DEV float exp_f(float x) { return expf(x); }
DEV float log1p_f(float y) { return log1pf(y); }
#else
DEV float exp_f(float x) { return __builtin_amdgcn_exp2f(x * 1.4426950408889634f); }
DEV float log1p_f(float y) { return __builtin_amdgcn_logf(1.0f + y) * 0.6931471805599453f; }
#endif
#ifdef HOST_EMU
DEV float rcp_f(float x) { return 1.0f / x; }
#else
DEV float rcp_f(float x) { return __builtin_amdgcn_rcpf(x); }
#endif
DEV float silu_f(float x) { return x * rcp_f(1.0f + exp_f(-x)); }
DEV float sigmoid_f(float x) { return rcp_f(1.0f + exp_f(-x)); }
DEV float logsigmoid_f(float x) { return x >= 0.f ? -log1p_f(exp_f(-x)) : x - log1p_f(exp_f(x)); }
DEV float dot8(const U4& a, const U4& b) {
    return bflo(a.x) * bflo(b.x) + bfhi(a.x) * bfhi(b.x) + bflo(a.y) * bflo(b.y) + bfhi(a.y) * bfhi(b.y) +
           bflo(a.z) * bflo(b.z) + bfhi(a.z) * bfhi(b.z) + bflo(a.w) * bflo(b.w) + bfhi(a.w) * bfhi(b.w);
}

constexpr size_t CTL_BYTES = 65536;
constexpr size_t al256(size_t x) { return (x + 255) & ~(size_t)255; }
constexpr size_t OFF_ctl = 0, SZ_ctl = al256(CTL_BYTES);
constexpr size_t OFF_X = OFF_ctl + SZ_ctl, SZ_X = al256((size_t)R * D * 2);
constexpr size_t OFF_H = OFF_X + SZ_X, SZ_H = al256((size_t)R * D * 2);
constexpr size_t OFF_MOD = OFF_H + SZ_H, SZ_MOD = al256((size_t)DEPTH * (B + 1) * 6 * D * 4);
constexpr size_t OFF_MODP = OFF_MOD + SZ_MOD, SZ_MODP = al256((size_t)8 * DEPTH * (B + 1) * 6 * D * 4);
constexpr size_t OFF_ROPET = OFF_MODP + SZ_MODP, SZ_ROPET = al256((size_t)SEQ * 16 * 2 * 4);
constexpr size_t OFF_WinT = OFF_ROPET + SZ_ROPET, SZ_WinT = al256((size_t)NP * D * 2);
constexpr size_t OFF_WuqT = OFF_WinT + SZ_WinT, SZ_WuqT = al256((size_t)QW * QR * 2);
constexpr size_t OFF_WukvT = OFF_WuqT + SZ_WuqT, SZ_WukvT = al256((size_t)KVW * KVR * 2);
constexpr size_t OFF_WoutT = OFF_WukvT + SZ_WukvT, SZ_WoutT = al256((size_t)D * D * 2);
constexpr size_t OFF_WupT = OFF_WoutT + SZ_WoutT, SZ_WupT = al256((size_t)FF2 * D * 2);
constexpr size_t OFF_WdownT = OFF_WupT + SZ_WupT, SZ_WdownT = al256((size_t)D * FF * 2);
constexpr size_t OFF_HD1 = OFF_WdownT + SZ_WdownT, SZ_HD1 = al256((size_t)2 * SEQ * HH * 4);
constexpr size_t OFF_HD2 = OFF_HD1 + SZ_HD1, SZ_HD2 = al256((size_t)2 * SEQ * HH * 4);
constexpr size_t OFF_FT = OFF_HD2 + SZ_HD2, SZ_FT = al256((size_t)2 * HW * SEQ * 4);
constexpr size_t OFF_FT1 = OFF_FT + SZ_FT, SZ_FT1 = al256((size_t)CTX * 2 * HW * 4);
constexpr size_t OFF_FL1 = OFF_FT1 + SZ_FT1, SZ_FL1 = al256((size_t)2 * HW * 64 * 4);
constexpr size_t OFF_HSPEC = OFF_FL1 + SZ_FL1, SZ_HSPEC = al256((size_t)HW * 2 * SEQ * 8);
constexpr size_t OFF_P = OFF_HSPEC + SZ_HSPEC, SZ_P = al256((size_t)R * NP * 2);
constexpr size_t OFF_KR = OFF_P + SZ_P, SZ_KR = al256((size_t)R * ROPE * 2);
constexpr size_t OFF_RS = OFF_KR + SZ_KR, SZ_RS = al256((size_t)R * 2 * 4);
constexpr size_t OFF_MQK = OFF_RS + SZ_RS, SZ_MQK = al256((size_t)R * 2 * MW * 2);
constexpr size_t OFF_WML = OFF_MQK + SZ_MQK, SZ_WML = al256((size_t)2 * MW * MW * 2);
constexpr size_t OFF_FG = OFF_WML + SZ_WML, SZ_FG = al256((size_t)R * 2 * MH * 2 * 4);
constexpr size_t OFF_MS = OFF_FG + SZ_FG, SZ_MS = al256((size_t)B * MH * 2 * SCN * (MD + 1) * MD * 4);
constexpr size_t OFF_Z = OFF_MS + SZ_MS, SZ_Z = al256((size_t)B * CTX * HW * 4);
constexpr size_t OFF_ZT = OFF_Z + SZ_Z, SZ_ZT = al256((size_t)B * HW * SEQ * 2);
#ifdef HOST_EMU
constexpr size_t OFF_UF = OFF_P, SZ_UF = al256((size_t)FCR * FF2 * 2), OFF_GF = OFF_UF + SZ_UF, SZ_GF = al256((size_t)FCR * FF * 2);
#else
constexpr size_t OFF_UF = OFF_P, SZ_UF = 0, OFF_GF = OFF_P, SZ_GF = al256((size_t)R * FF * 2);
#endif
constexpr size_t WS_BASE = (OFF_ZT + SZ_ZT) > (OFF_GF + SZ_GF) ? (OFF_ZT + SZ_ZT) : (OFF_GF + SZ_GF);
constexpr size_t OFF_WSET1 = WS_BASE, SZ_WSET = OFF_HD1 - OFF_WinT, WSET_STRIDE = OFF_WSET1 - OFF_WinT;
constexpr size_t WS_NEED = OFF_WSET1 + SZ_WSET;
static_assert(WS_NEED <= (size_t)536870912 || D != 1024, "workspace");
constexpr size_t OFF_Q = 0, OFF_KN = al256((size_t)R * QW * 2), OFF_VT = OFF_KN + al256((size_t)R * AW * 2);
static_assert(OFF_VT + (size_t)R * AW * 2 <= (size_t)B * SEQ * D * 4 || D != 1024, "d_out scratch");
struct Params {
    const float *x, *c, *ctx, *c_ctx, *ada_w, *ada_b, *norm1_g, *norm2_g, *w_in, *q_norm_g, *kv_norm_g, *w_uq, *w_ukv;
    const float *ml_conv_w, *ml_conv_b, *ml_wq, *ml_wk, *ml_gate_b, *ml_norm_g;
    const float *hy_conv_w, *hy_conv_b, *hy_w1, *hy_b1, *hy_w2, *hy_b2, *hy_w3, *hy_freq, *hy_bias_d;
    const float *w_out, *w_up, *ffn_conv_w, *ffn_conv_b, *w_down, *final_g;
    float* out;
    char* ws;
};

DEV unsigned* wctl(char* ws) { return (unsigned*)(ws + OFF_ctl); }
DEV bf16* wX(char* ws) { return (bf16*)(ws + OFF_X); }
DEV bf16* wH(char* ws) { return (bf16*)(ws + OFF_H); }
DEV float* wMOD(char* ws) { return (float*)(ws + OFF_MOD); }
DEV float* wROPET(char* ws) { return (float*)(ws + OFF_ROPET); }
DEV bf16* wWinT(char* ws, int l) { return (bf16*)(ws + OFF_WinT + (size_t)(l & 1) * WSET_STRIDE); }
DEV bf16* wWuqT(char* ws, int l) { return (bf16*)(ws + OFF_WuqT + (size_t)(l & 1) * WSET_STRIDE); }
DEV bf16* wWukvT(char* ws, int l) { return (bf16*)(ws + OFF_WukvT + (size_t)(l & 1) * WSET_STRIDE); }
DEV bf16* wWoutT(char* ws, int l) { return (bf16*)(ws + OFF_WoutT + (size_t)(l & 1) * WSET_STRIDE); }
DEV bf16* wWupT(char* ws, int l) { return (bf16*)(ws + OFF_WupT + (size_t)(l & 1) * WSET_STRIDE); }
DEV bf16* wWdownT(char* ws, int l) { return (bf16*)(ws + OFF_WdownT + (size_t)(l & 1) * WSET_STRIDE); }
DEV float* wHD1(char* ws) { return (float*)(ws + OFF_HD1); }
DEV float* wHD2(char* ws) { return (float*)(ws + OFF_HD2); }
DEV float* wFT(char* ws) { return (float*)(ws + OFF_FT); }
DEV float* wFL1(char* ws) { return (float*)(ws + OFF_FL1); }
DEV float* wMODP(char* ws) { return (float*)(ws + OFF_MODP); }
DEV float* wFT1(char* ws) { return (float*)(ws + OFF_FT1); }
DEV bf16* wZT(char* ws) { return (bf16*)(ws + OFF_ZT); }
struct alignas(8) C2 { float x, y; };
DEV C2* wHSPEC(char* ws) { return (C2*)(ws + OFF_HSPEC); }
DEV bf16* wP(char* ws) { return (bf16*)(ws + OFF_P); }
DEV bf16* wKR(char* ws) { return (bf16*)(ws + OFF_KR); }
DEV float* wRS(char* ws) { return (float*)(ws + OFF_RS); }
DEV bf16* wMQK(char* ws) { return (bf16*)(ws + OFF_MQK); }
DEV bf16* wWML(char* ws) { return (bf16*)(ws + OFF_WML); }
DEV bf16* wMU(char* ws) { return (bf16*)(ws + OFF_MS); }
static_assert((size_t)R * MW * 2 <= SZ_MS, "MU aliases MS");
DEV float* wFG(char* ws) { return (float*)(ws + OFF_FG); }
DEV float* wMS(char* ws) { return (float*)(ws + OFF_MS); }
DEV float* wZ(char* ws) { return (float*)(ws + OFF_Z); }
DEV bf16* wUF(char* ws) { return (bf16*)(ws + OFF_UF); }
DEV bf16* wGF(char* ws) { return (bf16*)(ws + OFF_GF); }
DEV bf16* wQ(float* out) { return (bf16*)((char*)out + OFF_Q); }
DEV bf16* wKN(float* out) { return (bf16*)((char*)out + OFF_KN); }
DEV bf16* wVT(float* out) { return (bf16*)((char*)out + OFF_VT); }

#ifdef HOST_EMU
typedef const Params& PRef;
#else
typedef const Params __attribute__((address_space(4)))& PRef;
#endif

struct RowI { int b, o, t, bi; bool ctx; };
DEV RowI rowinfo(int r) { RowI i; i.b = r / RPB; i.o = r % RPB; i.ctx = i.o < CTX; i.t = i.ctx ? i.o : i.o - CTX; i.bi = i.ctx ? B : i.b; return i; }
DEV int swap23(int o) { return (o & 3) | ((o & 4) << 1) | ((o & 8) >> 1); }
DEV int vperm32(int o) { return (o & 3) | (((o >> 4) & 1) << 2) | (((o >> 2) & 3) << 3); }
DEV bool has_prev(const RowI& i) { return i.t > 0; }
DEV bool has_next(const RowI& i) { return i.t + 1 < (i.ctx ? CTX : SEQ); }

enum { PH_MOD, PH_MOD2, PH_ROPE, PH_FILT_A, PH_FILT_B, PH_FILT_C, PH_FILT_D, PH_NORM1, PH_GEMM1, PH_MLA_A, PH_MLA_Q, PH_MLA_KV, PH_ATT,
       PH_ML_U, PH_ML_QK, PH_ML_F, PH_ML_B, PH_ML_S, PH_ML_O, PH_HY_Z, PH_HY_O, PH_GEMM_OUT, PH_NORM2, PH_FFN_UP, PH_FFN_CG, PH_FFN_DOWN, PH_FINAL };

DEV float dot_bf16(const bf16* a, const bf16* b, int K) {
    float acc = 0.f;
    for (int k = 0; k < K; k += 8) { const U4 av = *(const U4*)(a + k), bv = *(const U4*)(b + k); acc += dot8(av, bv); }
    return acc;
}


#ifndef HOST_EMU
namespace pg8 {
#define PG8_LAS __attribute__((address_space(3)))
typedef unsigned short bf16_t;
typedef short bf16x8 __attribute__((ext_vector_type(8)));
typedef float f32x4 __attribute__((ext_vector_type(4)));
typedef unsigned u32x4 __attribute__((ext_vector_type(4)));
constexpr int BM = 256, BK = 64, HALF = 128, HTB = HALF * BK * 2  , STAGE_BYTES = 8 * HTB, NXCD = 8, WGM = 8;

__host__ __device__ __forceinline__ int lds_byte(int r, int c) { const int st = (r >> 4) * 2 + (c >> 5), rr = r & 15, cc = c & 31, ob = rr * 64 + cc * 2; return st * 1024 + (ob ^ (((ob >> 9) & 1) << 5)); }
__host__ __device__ __forceinline__ void stage_rc(int b, int& R, int& C) { const int st = b / 1024, sb = b % 1024, swz = sb ^ (((sb >> 9) & 1) << 5); R = (st >> 1) * 16 + swz / 64; C = (st & 1) * 32 + (swz % 64) / 2; }
__host__ __device__ __forceinline__ int perm32(int rho) { const int n = rho >> 4, i = rho & 15; return 8 * (i >> 2) + 4 * n + (i & 3); }

struct Unit { int pm, pn; };
struct Gemm { const bf16_t* A; const bf16_t* Bt; int lda, ldb, M, N, K, mstep; };

struct StaticOrder {
    int nM, nN, nwg, G, c, lat;
    __host__ __device__ void init(int M, int N, int G_, int c_, int lat_ = 0) { nM = M / BM; nN = N / BM; nwg = nM * nN; G = G_; c = c_; lat = lat_; }
    __host__ __device__ bool next(int i, Unit& u) const {
        const long L = (long)i * G + c; if (L >= nwg) return false;
        int wgid = (int)L; { const int q = nwg / NXCD, r = nwg % NXCD, xcd = wgid % NXCD, off = wgid / NXCD; wgid = (xcd < r ? xcd * (q + 1) : r * (q + 1) + (xcd - r) * q) + off; }
        const int nig = WGM * nN, gid = wgid / nig, fm = gid * WGM, gsz = (nM - fm) < WGM ? (nM - fm) : WGM;
        u.pm = fm + ((wgid % nig) % gsz); u.pn = (wgid % nig) / gsz;
        if (lat) u.pm = u.pm + (u.pm / (SEQ / BM) + 1) * (CTX / BM);
        return true;
    }
    __device__ __forceinline__ void a_ready(const Unit&) const {}
    __device__ __forceinline__ void done(const Unit&) const {}
};
__device__ __forceinline__ unsigned cvt_pk_bf16(float lo, float hi) { unsigned r; asm volatile("v_cvt_pk_bf16_f32 %0, %1, %2" : "=v"(r) : "v"(lo), "v"(hi)); return r; }

template <class Epi, class Sched, bool ALIGN_EPI = false, bool SP2 = false>
__device__ __forceinline__ void gemm_phase(PG8_LAS unsigned char* lds, const Gemm g, const Sched& S, const Epi& E) {
    int tid_ = threadIdx.x; asm volatile("" : "+v"(tid_));
    const int tid = tid_, wid = __builtin_amdgcn_readfirstlane(tid >> 6), lane = tid & 63, wr = wid >> 2, wc = wid & 3, fr = lane & 15, fq = lane >> 4;
    const int K = g.K, nt = K / BK;
    unsigned vvoffA, vvoffB;
    { int R_, C_; stage_rc(tid * 16, R_, C_); const int Rb = Epi::PERM ? ((R_ & ~31) + perm32(R_ & 31)) : R_;
      vvoffA = (unsigned)(R_ * g.lda + C_) * 2u; vvoffB = (unsigned)(Rb * g.ldb + C_) * 2u; }
    const size_t pvoffA = (size_t)64 * g.lda * 2, pvoffB = (size_t)64 * g.ldb * 2;
    const size_t kstep = (size_t)(BK * 2);
    const size_t hstepA = (size_t)HALF * g.lda * 2, hstepB = (size_t)HALF * g.ldb * 2;
    const size_t tstepA = (size_t)g.mstep * g.lda * 2, tstepB = 2 * hstepB;
    const unsigned ldsw = (unsigned)wid * 1024u;
    const int aoff = lds_byte(wr * 64 + fr, fq * 8), boff = lds_byte(wc * 32 + fr, fq * 8);
#define PG8_SA(b, h) (((b) * 2 + (h)) * HTB)
#define PG8_SB(b, h) ((4 + (b) * 2 + (h)) * HTB)
#define PG8_STAGE(bufoff, gbase, voff) do { _Pragma("unroll") for (int _i = 0; _i < 2; ++_i) \
        __builtin_amdgcn_global_load_lds((const unsigned*)((const char*)(gbase) + (size_t)_i * p##voff + (v##voff)), (PG8_LAS unsigned*)(lds + (bufoff) + ldsw + _i * 8192), 16, 0, 0); } while (0)
#define PG8_LDA(dst, b, h) do { _Pragma("unroll") for (int m = 0; m < 4; ++m) _Pragma("unroll") for (int k = 0; k < 2; ++k) dst[m][k] = *(const PG8_LAS bf16x8*)(lds + PG8_SA(b, h) + aoff + m * 2048 + k * 1024); } while (0)
#define PG8_LDB(dst, b, h) do { _Pragma("unroll") for (int n = 0; n < 2; ++n) _Pragma("unroll") for (int k = 0; k < 2; ++k) dst[n][k] = *(const PG8_LAS bf16x8*)(lds + PG8_SB(b, h) + boff + n * 2048 + k * 1024); } while (0)
#define PG8_MMA(ai, bj, At, Bt) do { __builtin_amdgcn_s_setprio(1); _Pragma("unroll") for (int m = 0; m < 4; ++m) _Pragma("unroll") for (int n = 0; n < 2; ++n) _Pragma("unroll") for (int k = 0; k < 2; ++k) \
        acc[ai][bj][m][n] = __builtin_amdgcn_mfma_f32_16x16x32_bf16(Bt[n][k], At[m][k], acc[ai][bj][m][n], 0, 0, 0); __builtin_amdgcn_s_setprio(0); } while (0)
#define PG8_WAIT_V(n) asm volatile("s_waitcnt vmcnt(" #n ")" ::: "memory")
#define PG8_WAIT_L(n) asm volatile("s_waitcnt lgkmcnt(" #n ")" ::: "memory")
#define PG8_BAR __builtin_amdgcn_s_barrier()
#define PG8_SCHED __builtin_amdgcn_sched_barrier(0)
    Unit cur, nxt; int ui = 0;
    if (!S.next(0, cur)) return;
    f32x4 acc[2][2][4][2];
#pragma unroll
    for (int a = 0; a < 2; ++a)
#pragma unroll
        for (int b = 0; b < 2; ++b)
#pragma unroll
            for (int m = 0; m < 4; ++m)
#pragma unroll
                for (int n = 0; n < 2; ++n) acc[a][b][m][n] = (f32x4){0.f, 0.f, 0.f, 0.f};
    bf16x8 At[4][2], B0[2][2], B1[2][2];
    const char* cA = (const char*)g.A + (size_t)cur.pm * tstepA; const char* cB = (const char*)g.Bt + (size_t)cur.pn * tstepB;
    S.a_ready(cur);
    if constexpr (SP2) {
        PG8_STAGE(PG8_SB(0, 0), cB, voffB); PG8_STAGE(PG8_SB(0, 1), cB + hstepB, voffB); PG8_STAGE(PG8_SA(0, 0), cA, voffA); PG8_STAGE(PG8_SA(0, 1), cA + hstepA, voffA);
        if (wr == 1) PG8_BAR;
        PG8_WAIT_V(2); PG8_BAR;
        PG8_STAGE(PG8_SB(1, 0), cB + kstep, voffB); PG8_STAGE(PG8_SA(1, 0), cA + kstep, voffA); PG8_STAGE(PG8_SB(1, 1), cB + hstepB + kstep, voffB);
        PG8_WAIT_V(6); PG8_BAR;
    } else {
        PG8_STAGE(PG8_SB(0, 0), cB, voffB); PG8_STAGE(PG8_SA(0, 0), cA, voffA); PG8_STAGE(PG8_SB(0, 1), cB + hstepB, voffB); PG8_STAGE(PG8_SA(0, 1), cA + hstepA, voffA);
        if (wr == 1) PG8_BAR;
        PG8_WAIT_V(4); PG8_BAR;
        PG8_STAGE(PG8_SB(1, 0), cB + kstep, voffB); PG8_STAGE(PG8_SA(1, 0), cA + kstep, voffA); PG8_STAGE(PG8_SB(1, 1), cB + hstepB + kstep, voffB);
        PG8_WAIT_V(6); PG8_BAR;
    }
    for (;;) {
        const bool has_next = S.next(ui + 1, nxt);
        const char* nA = has_next ? (const char*)g.A + (size_t)nxt.pm * tstepA : cA; const char* nB = has_next ? (const char*)g.Bt + (size_t)nxt.pn * tstepB : cB;
        for (int t = 0; t < nt; t += 2) {
            const bool last = (t == nt - 2);
            const char* a1 = cA + (size_t)(t + 1) * kstep;
            const char* a2 = last ? nA : cA + (size_t)(t + 2) * kstep; const char* b2 = last ? nB : cB + (size_t)(t + 2) * kstep;
            const char* a3 = a2 + kstep; const char* b3 = b2 + kstep;
            if (last && has_next) S.a_ready(nxt);
            if constexpr (SP2) {
            PG8_LDB(B0, 0, 0); PG8_LDB(B1, 0, 1); PG8_SCHED; PG8_LDA(At, 0, 0); PG8_STAGE(PG8_SA(1, 1), a1 + hstepA, voffA);
            PG8_WAIT_V(8); PG8_WAIT_L(0); PG8_BAR; PG8_MMA(0, 0, At, B0); PG8_MMA(0, 1, At, B1); PG8_BAR; PG8_SCHED;
            PG8_LDA(At, 0, 1); PG8_STAGE(PG8_SB(0, 0), b2, voffB); PG8_STAGE(PG8_SB(0, 1), b2 + hstepB, voffB); PG8_STAGE(PG8_SA(0, 0), a2, voffA);
            PG8_WAIT_V(8); PG8_WAIT_L(0); PG8_BAR; PG8_MMA(1, 0, At, B0); PG8_MMA(1, 1, At, B1); PG8_BAR; PG8_SCHED;
            PG8_LDB(B0, 1, 0); PG8_LDB(B1, 1, 1); PG8_SCHED; PG8_LDA(At, 1, 0); PG8_STAGE(PG8_SA(0, 1), a2 + hstepA, voffA);
            PG8_WAIT_V(8); PG8_WAIT_L(0); PG8_BAR; PG8_MMA(0, 0, At, B0); PG8_MMA(0, 1, At, B1); PG8_BAR; PG8_SCHED;
            PG8_LDA(At, 1, 1); PG8_STAGE(PG8_SB(1, 0), b3, voffB); PG8_STAGE(PG8_SB(1, 1), b3 + hstepB, voffB); PG8_STAGE(PG8_SA(1, 0), a3, voffA);
            PG8_WAIT_V(8); PG8_WAIT_L(0); PG8_BAR; PG8_MMA(1, 0, At, B0); PG8_MMA(1, 1, At, B1); PG8_BAR; PG8_SCHED;
            } else {
            PG8_LDB(B0, 0, 0); PG8_SCHED; PG8_LDA(At, 0, 0); PG8_STAGE(PG8_SA(1, 1), a1 + hstepA, voffA);
            PG8_WAIT_L(8); PG8_BAR; PG8_WAIT_L(0); PG8_MMA(0, 0, At, B0); PG8_BAR; PG8_SCHED;
            PG8_LDB(B1, 0, 1); PG8_STAGE(PG8_SB(0, 0), b2, voffB);
            PG8_BAR; PG8_WAIT_L(0); PG8_MMA(0, 1, At, B1); PG8_BAR;
            PG8_LDA(At, 0, 1); PG8_STAGE(PG8_SA(0, 0), a2, voffA);
            PG8_BAR; PG8_WAIT_L(0); PG8_MMA(1, 0, At, B0); PG8_BAR; PG8_SCHED;
            PG8_STAGE(PG8_SB(0, 1), b2 + hstepB, voffB);
            PG8_WAIT_V(6); PG8_BAR; PG8_MMA(1, 1, At, B1); PG8_BAR;
            PG8_LDB(B0, 1, 0); PG8_SCHED; PG8_LDA(At, 1, 0); PG8_STAGE(PG8_SA(0, 1), a2 + hstepA, voffA);
            PG8_WAIT_L(8); PG8_BAR; PG8_WAIT_L(0); PG8_MMA(0, 0, At, B0); PG8_BAR; PG8_SCHED;
            PG8_LDB(B1, 1, 1); PG8_STAGE(PG8_SB(1, 0), b3, voffB);
            PG8_BAR; PG8_WAIT_L(0); PG8_MMA(0, 1, At, B1); PG8_BAR;
            PG8_LDA(At, 1, 1); PG8_STAGE(PG8_SA(1, 0), a3, voffA);
            PG8_BAR; PG8_WAIT_L(0); PG8_MMA(1, 0, At, B0); PG8_BAR; PG8_SCHED;
            PG8_STAGE(PG8_SB(1, 1), b3 + hstepB, voffB);
            PG8_WAIT_V(6); PG8_BAR; PG8_MMA(1, 1, At, B1); PG8_BAR;
            }
        }
        if constexpr (ALIGN_EPI) { if (wr == 0) PG8_BAR; }
        E(acc, cur, wr, wc, fr, fq); S.done(cur);
        if (!has_next) break;
#pragma unroll
        for (int a = 0; a < 2; ++a)
#pragma unroll
            for (int b = 0; b < 2; ++b)
#pragma unroll
                for (int m = 0; m < 4; ++m)
#pragma unroll
                    for (int n = 0; n < 2; ++n) acc[a][b][m][n] = (f32x4){0.f, 0.f, 0.f, 0.f};
        cur = nxt; cA = nA; cB = nB; ++ui;
        if constexpr (ALIGN_EPI) { if (wr == 1) PG8_BAR; }
    }
    PG8_WAIT_V(0);
    if constexpr (!ALIGN_EPI) { if (wr == 0) PG8_BAR; }
    PG8_BAR;
#undef PG8_SA
#undef PG8_SB
#undef PG8_STAGE
#undef PG8_LDA
#undef PG8_LDB
#undef PG8_MMA
#undef PG8_WAIT_V
#undef PG8_WAIT_L
#undef PG8_BAR
#undef PG8_SCHED
}

struct EpiBf16 {
    static constexpr bool PERM = true;
    bf16_t* O; int ldc; const float* rs; int rs_stride;
    __device__ __forceinline__ void operator()(const f32x4 (&acc)[2][2][4][2], const Unit& u, int wr, int wc, int, int) const {
        __builtin_amdgcn_sched_barrier(0);
        int t_ = threadIdx.x; asm volatile("" : "+v"(t_)); const int fr = t_ & 15, fq = (t_ >> 4) & 3;
        const int row0 = u.pm * BM + wr * 64 + fr, col0 = u.pn * BM + wc * 32 + 8 * fq;
#pragma unroll
        for (int ai = 0; ai < 2; ++ai)
#pragma unroll
            for (int m = 0; m < 4; ++m) { const int row = row0 + ai * HALF + m * 16; bf16_t* rowp = O + (size_t)row * ldc + col0;
                const float sc = rs ? rs[(size_t)row * rs_stride] : 1.0f;
#pragma unroll
                for (int bj = 0; bj < 2; ++bj) { const f32x4 v0 = acc[ai][bj][m][0] * sc, v1 = acc[ai][bj][m][1] * sc;
                    u32x4 w; w.x = cvt_pk_bf16(v0[0], v0[1]); w.y = cvt_pk_bf16(v0[2], v0[3]); w.z = cvt_pk_bf16(v1[0], v1[1]); w.w = cvt_pk_bf16(v1[2], v1[3]);
                    *(u32x4*)(rowp + bj * HALF) = w; } }
    }
};
struct EpiVT {
    static constexpr bool PERM = true;
    bf16_t* O; const float* rs;
    __device__ __forceinline__ void operator()(const f32x4 (&acc)[2][2][4][2], const Unit& u, int wr, int wc, int, int) const {
        __builtin_amdgcn_sched_barrier(0);
        int t_ = threadIdx.x; asm volatile("" : "+v"(t_)); const int fr = t_ & 15, fq = (t_ >> 4) & 3;
        const int row0 = u.pm * BM + wr * 64 + fr, col0 = u.pn * BM + wc * 32;
        typedef unsigned u32x2 __attribute__((ext_vector_type(2)));
#pragma unroll
        for (int bj = 0; bj < 2; ++bj) { const int cb = col0 + bj * HALF;
            const float* rsp = rs + cb + 8 * fq;
            typedef bf16_t __attribute__((address_space(1))) gbf16;
            gbf16* rowp = (gbf16*)(O + (size_t)row0 * R + cb + 4 * (fq >> 1) + 16 * (fq & 1));
#pragma unroll
            for (int ai = 0; ai < 2; ++ai)
#pragma unroll
                for (int m = 0; m < 4; ++m) {
                    const f32x4 v0 = acc[ai][bj][m][0] * *(const f32x4*)(rsp), v1 = acc[ai][bj][m][1] * *(const f32x4*)(rsp + 4);
                    u32x2 w0, w1; w0.x = cvt_pk_bf16(v0[0], v0[1]); w0.y = cvt_pk_bf16(v0[2], v0[3]); w1.x = cvt_pk_bf16(v1[0], v1[1]); w1.y = cvt_pk_bf16(v1[2], v1[3]);
                    *(__attribute__((address_space(1))) u32x2*)(rowp) = w0; *(__attribute__((address_space(1))) u32x2*)(rowp + 8) = w1;
                    rowp += (size_t)(m == 3 ? HALF - 48 : 16) * R; asm volatile("" : "+v"(rowp)); } }
    }
};
struct EpiConvGate {
    static constexpr bool PERM = true;
    bf16_t* O; const float* cw; const float* cb; PG8_LAS unsigned char* xl;
    __device__ __forceinline__ void operator()(f32x4 (&acc)[2][2][4][2], const Unit& u, int wr, int wc, int, int) const {
        __builtin_amdgcn_sched_barrier(0);
        int t_ = threadIdx.x; asm volatile("" : "+v"(t_)); const int lane = t_ & 63, fr = t_ & 15, fq = (t_ >> 4) & 3, wave = wr * 4 + wc;
        PG8_LAS f32x4* myx = (PG8_LAS f32x4*)(xl + wave * 1024);
#pragma unroll
        for (int ai = 0; ai < 2; ++ai)
#pragma unroll
            for (int bj = 0; bj < 2; ++bj)
#pragma unroll
                for (int n = 0; n < 2; ++n) { if (fr == 0) myx[(((ai * 2 + 0) * 2 + bj) * 2 + n) * 4 + fq] = acc[ai][bj][0][n]; if (fr == 15) myx[(((ai * 2 + 1) * 2 + bj) * 2 + n) * 4 + fq] = acc[ai][bj][3][n]; }
        asm volatile("s_waitcnt lgkmcnt(0)" ::: "memory"); __builtin_amdgcn_s_barrier(); asm volatile("" ::: "memory");
        const int rg0 = u.pm * 254 - 1 + wr * 64 + fr;
        unsigned hpm = 0u, hnm = 0u;
#pragma unroll
        for (int ai = 0; ai < 2; ++ai)
#pragma unroll
            for (int m = 0; m < 4; ++m) { const int rg = rg0 + ai * HALF + m * 16; const int o = ((rg % RPB) + RPB) % RPB;
                if (o != 0 && o != CTX) hpm |= 1u << (ai * 4 + m); if (o != CTX - 1 && o != RPB - 1) hnm |= 1u << (ai * 4 + m); }
        typedef float f32x2 __attribute__((ext_vector_type(2)));
        {
#pragma unroll
            for (int bj = 0; bj < 2; ++bj)
#pragma unroll
                for (int n = 0; n < 2; ++n) {
                    const int jj = bj * FF + u.pn * HALF + wc * 32 + 8 * fq + 4 * n;
                    const f32x4 w0 = *(const f32x4*)(cw + jj), w1 = *(const f32x4*)(cw + FF2 + jj), w2 = *(const f32x4*)(cw + 2 * FF2 + jj), bb = *(const f32x4*)(cb + jj);
#pragma unroll
                    for (int ai = 0; ai < 2; ++ai) {
                        const int blk = 2 * ai + wr;
                        f32x4 prow = (f32x4){0.f, 0.f, 0.f, 0.f}, nrow = prow;
                        if (blk > 0) prow = *(const PG8_LAS f32x4*)(xl + (((blk - 1) & 1) * 4 + wc) * 1024 + ((((((blk - 1) >> 1) * 2 + 1) * 2 + bj) * 2 + n) * 4 + fq) * 16);
                        if (blk < 3) nrow = *(const PG8_LAS f32x4*)(xl + (((blk + 1) & 1) * 4 + wc) * 1024 + ((((((blk + 1) >> 1) * 2 + 0) * 2 + bj) * 2 + n) * 4 + fq) * 16);
#pragma unroll
                        for (int ep = 0; ep < 2; ++ep) {
                            f32x2 ru[4], rd[4], res[4];
#pragma unroll
                            for (int m = 0; m < 4; ++m)
#pragma unroll
                                for (int k = 0; k < 2; ++k) { int vi = __float_as_int(acc[ai][bj][m][n][2 * ep + k]); asm volatile("" : "+v"(vi));
                                    ru[m][k] = __int_as_float(__builtin_amdgcn_update_dpp(0, vi, 0x121, 0xf, 0xf, false));
                                    rd[m][k] = __int_as_float(__builtin_amdgcn_update_dpp(0, vi, 0x12F, 0xf, 0xf, false)); }
                            const f32x2 w0p = {w0[2 * ep], w0[2 * ep + 1]}, w1p = {w1[2 * ep], w1[2 * ep + 1]}, w2p = {w2[2 * ep], w2[2 * ep + 1]}, bbp = {bb[2 * ep], bb[2 * ep + 1]};
                            const f32x2 pr2 = {prow[2 * ep], prow[2 * ep + 1]}, nr2 = {nrow[2 * ep], nrow[2 * ep + 1]};
#pragma unroll
                            for (int m = 0; m < 4; ++m) {
                                const f32x2 xv = {acc[ai][bj][m][n][2 * ep], acc[ai][bj][m][n][2 * ep + 1]};
                                const f32x2 upv = fr == 0 ? (m == 0 ? pr2 : ru[m == 0 ? 0 : m - 1]) : ru[m];
                                const f32x2 dnv = fr == 15 ? (m == 3 ? nr2 : rd[m == 3 ? 3 : m + 1]) : rd[m];
                                const bool hp = (hpm >> (ai * 4 + m)) & 1u, hn = (hnm >> (ai * 4 + m)) & 1u;
                                const f32x2 z = {0.f, 0.f};
                                res[m] = bbp + w1p * xv + (hp ? w0p * upv : z) + (hn ? w2p * dnv : z); }
                            asm volatile("" : "+v"(res[0]), "+v"(res[1]), "+v"(res[2]), "+v"(res[3]));
#pragma unroll
                            for (int m = 0; m < 4; ++m) { acc[ai][bj][m][n][2 * ep] = res[m][0]; acc[ai][bj][m][n][2 * ep + 1] = res[m][1]; }
                        }
                    }
                }
        }
#pragma unroll
        for (int ai = 0; ai < 2; ++ai)
#pragma unroll
            for (int m = 0; m < 4; ++m) { const int tr = ai * HALF + wr * 64 + m * 16 + fr, rg = u.pm * 254 - 1 + tr;
                if (tr == 0 || tr == 255 || rg >= R) continue;
                const f32x4 a0 = acc[ai][0][m][0], a1 = acc[ai][0][m][1], g0 = acc[ai][1][m][0], g1 = acc[ai][1][m][1];
                float o[8];
#pragma unroll
                for (int e = 0; e < 4; ++e) { o[e] = a0[e] * __builtin_amdgcn_rcpf(1.0f + __builtin_amdgcn_exp2f(-1.4426950408889634f * a0[e])) * g0[e]; o[4 + e] = a1[e] * __builtin_amdgcn_rcpf(1.0f + __builtin_amdgcn_exp2f(-1.4426950408889634f * a1[e])) * g1[e]; }
                u32x4 w; w.x = cvt_pk_bf16(o[0], o[1]); w.y = cvt_pk_bf16(o[2], o[3]); w.z = cvt_pk_bf16(o[4], o[5]); w.w = cvt_pk_bf16(o[6], o[7]);
                *(u32x4*)(O + (size_t)rg * FF + u.pn * HALF + wc * 32 + 8 * fq) = w; }
    }
};
struct EpiResid {
    static constexpr bool PERM = true;
    bf16_t* X; const float* gate; float* outf; int dry;
    __device__ __forceinline__ void operator()(const f32x4 (&acc)[2][2][4][2], const Unit& u, int wr, int wc, int, int) const {
        __builtin_amdgcn_sched_barrier(0);
        int t_ = threadIdx.x; asm volatile("" : "+v"(t_)); const int fr = t_ & 15, fq = (t_ >> 4) & 3;
        const int row0 = u.pm * BM + wr * 64 + fr, col0 = u.pn * BM + wc * 32 + 8 * fq;
#pragma unroll
        for (int ai = 0; ai < 2; ++ai)
#pragma unroll
            for (int m = 0; m < 4; ++m) { const int row = row0 + ai * HALF + m * 16; const RowI ri = rowinfo(row);
                bf16_t* rowp = X + (size_t)row * D + col0; const float* gp = gate + (size_t)ri.bi * 6 * D + col0;
                float* op = outf ? outf + ((size_t)ri.b * SEQ + ri.t) * D + col0 : nullptr;
#pragma unroll
                for (int bj = 0; bj < 2; ++bj) { const int co = bj * HALF;
                    const u32x4 xw = *(const u32x4*)(rowp + co); const f32x4 g0 = *(const f32x4*)(gp + co), g1 = *(const f32x4*)(gp + co + 4);
                    f32x4 n0, n1;
                    n0[0] = __uint_as_float(xw.x << 16); n0[1] = __uint_as_float(xw.x & 0xFFFF0000u); n0[2] = __uint_as_float(xw.y << 16); n0[3] = __uint_as_float(xw.y & 0xFFFF0000u);
                    n1[0] = __uint_as_float(xw.z << 16); n1[1] = __uint_as_float(xw.z & 0xFFFF0000u); n1[2] = __uint_as_float(xw.w << 16); n1[3] = __uint_as_float(xw.w & 0xFFFF0000u);
                    n0 = n0 + g0 * acc[ai][bj][m][0]; n1 = n1 + g1 * acc[ai][bj][m][1];
                    if (dry) continue;
                    if (outf) { *(f32x4*)(op + co) = n0; *(f32x4*)(op + co + 4) = n1; }
                    else { u32x4 w; w.x = cvt_pk_bf16(n0[0], n0[1]); w.y = cvt_pk_bf16(n0[2], n0[3]); w.z = cvt_pk_bf16(n1[0], n1[1]); w.w = cvt_pk_bf16(n1[2], n1[3]); *(u32x4*)(rowp + co) = w; } } }
    }
};
}
#endif


DEV void ld8(const bf16* q, float (&f)[8]) { const U4 u = *(const U4*)q; f[0] = bflo(u.x); f[1] = bfhi(u.x); f[2] = bflo(u.y); f[3] = bfhi(u.y); f[4] = bflo(u.z); f[5] = bfhi(u.z); f[6] = bflo(u.w); f[7] = bfhi(u.w); }
DEV void ldf8(const float* q, float (&f)[8]) {
#pragma unroll
    for (int e = 0; e < 8; ++e) f[e] = q[e]; }
DEV U4 pack8(const float (&f)[8]) { U4 u; u.x = f2bf(f[0]) | ((unsigned)f2bf(f[1]) << 16); u.y = f2bf(f[2]) | ((unsigned)f2bf(f[3]) << 16); u.z = f2bf(f[4]) | ((unsigned)f2bf(f[5]) << 16); u.w = f2bf(f[6]) | ((unsigned)f2bf(f[7]) << 16); return u; }
DEV void conv4x8(const bf16* src, int ld, const float* w  , int wn, const float* bias, bool hp0, bool hn3, float (&out)[4][8]) {
    float w0[8], w1[8], w2[8], bb[8], x[6][8];
    ldf8(w, w0); ldf8(w + wn, w1); ldf8(w + 2 * wn, w2); ldf8(bias, bb);
#pragma unroll
    for (int i = 0; i < 6; ++i) { if ((i == 0 && !hp0) || (i == 5 && !hn3)) {
#pragma unroll
            for (int e = 0; e < 8; ++e) x[i][e] = 0.f; } else ld8(src + (long)(i - 1) * ld, x[i]); }
#pragma unroll
    for (int i = 0; i < 4; ++i)
#pragma unroll
        for (int e = 0; e < 8; ++e) out[i][e] = bb[e] + w0[e] * x[i][e] + w1[e] * x[i + 1][e] + w2[e] * x[i + 2][e];
}

template <int PH> DEV void phase(PRef p, int l, int arg, long gtid, long gth);


template <> DEV void phase<PH_MOD>(PRef p, int, int, long gtid, long gth) {
    constexpr int KC = D / 8;
    for (long i = gtid; i < (long)8 * DEPTH * 6 * D; i += gth) {
        const int j = (int)(i % (6 * D)), l = (int)((i / (6 * D)) % DEPTH), kc = (int)(i / ((long)6 * D * DEPTH));
        const float* w = p.ada_w + (long)l * D * 6 * D + j;
        float acc[B + 1];
#pragma unroll
        for (int bi = 0; bi <= B; ++bi) acc[bi] = 0.f;
        for (int k = kc * KC; k < (kc + 1) * KC; ++k) { const float wv = w[(long)k * 6 * D];
#pragma unroll
            for (int bi = 0; bi <= B; ++bi) acc[bi] += silu_f(bi < B ? p.c[(long)bi * D + k] : p.c_ctx[k]) * wv; }
#pragma unroll
        for (int bi = 0; bi <= B; ++bi) wMODP(p.ws)[(((long)kc * DEPTH + l) * (B + 1) + bi) * 6 * D + j] = acc[bi];
    }
}
template <> DEV void phase<PH_MOD2>(PRef p, int, int, long gtid, long gth) {
    for (long i = gtid; i < (long)DEPTH * (B + 1) * 6 * D; i += gth) {
        const int j = (int)(i % (6 * D)), l = (int)(i / ((long)6 * D * (B + 1)));
        float acc = p.ada_b[(long)l * 6 * D + j];
        for (int kc = 0; kc < 8; ++kc) acc += wMODP(p.ws)[(long)kc * DEPTH * (B + 1) * 6 * D + i];
        wMOD(p.ws)[i] = acc;
    }
}
template <> DEV void phase<PH_ROPE>(PRef p, int, int, long gtid, long gth) {
    for (long i = gtid; i < (long)SEQ * 16; i += gth) {
        const int j = (int)(i % 16), t = (int)(i / 16);
        const int jj = j & 7;
        const float inv = (jj & 1 ? 0.31622776601683794f : 1.0f) * (jj >> 1 == 0 ? 1.0f : jj >> 1 == 1 ? 0.1f : jj >> 1 == 2 ? 0.01f : 0.001f);
        const float pos = j < 8 ? (float)(t / GRID_W) : (float)(t % GRID_W);
        const float a = pos * inv;
        wROPET(p.ws)[i * 2] = cosf(a); wROPET(p.ws)[i * 2 + 1] = sinf(a);
    }
}
template <> DEV void phase<PH_FILT_A>(PRef p, int l, int, long gtid, long gth) {
    for (long i = gtid; i < (long)2 * SEQ * HH; i += gth) {
        const int j = (int)(i % HH), pos = (int)((i / HH) % SEQ), set = (int)(i / ((long)HH * SEQ));
        const int L = set ? CTX : SEQ; if (pos >= L) continue;
        const float* w1 = p.hy_w1 + (long)l * HE * HH;
        const float tl = (float)pos / (float)(L - 1);
        float acc = p.hy_b1[l * HH + j] + tl * w1[j];
        for (int e = 0; e < HB; ++e) {
            const float band = 1e-4f + (float)e * (((float)(HB - 1) - 1e-4f) / (float)(HB - 1));
            float turns = (float)pos * band / (float)L; turns -= floorf(turns);
            acc += cos_t(turns) * w1[(1 + e) * HH + j] - sin_t(turns) * w1[(1 + HB + e) * HH + j];
        }
        wHD1(p.ws)[i] = sin_f(p.hy_freq[l * HH + j] * acc);
    }
}
template <> DEV void phase<PH_FILT_B>(PRef p, int l, int, long gtid, long gth) {
    for (long i = gtid; i < (long)2 * SEQ * HH; i += gth) {
        const int j = (int)(i % HH), pos = (int)((i / HH) % SEQ), set = (int)(i / ((long)HH * SEQ));
        const int L = set ? CTX : SEQ; if (pos >= L) continue;
        const float* w2 = p.hy_w2 + (long)l * HH * HH;
        const float* h1 = wHD1(p.ws) + (i - j);
        float acc = p.hy_b2[l * HH + j];
        for (int e = 0; e < HH; ++e) acc += h1[e] * w2[e * HH + j];
        wHD2(p.ws)[i] = sin_f(p.hy_freq[l * HH + j] * acc);
    }
}
template <> DEV void phase<PH_FILT_C>(PRef p, int l, int, long gtid, long gth) {
    const float* w3 = p.hy_w3 + (long)l * HH * 2 * HW;
    for (long i = gtid; i < (long)2 * (SEQ / 4) * 2 * HW; i += gth) {
        const int c2 = (int)(i % (2 * HW)), pq = (int)((i / (2 * HW)) % (SEQ / 4)), set = (int)(i / ((long)2 * HW * (SEQ / 4)));
        const int L = set ? CTX : SEQ, pos0 = pq * 4; if (pos0 >= L) continue;
        const float* h2 = wHD2(p.ws) + ((long)set * SEQ + pos0) * HH;
        float acc[4] = {0.f, 0.f, 0.f, 0.f};
        for (int e = 0; e < HH; ++e) { const float w = w3[e * 2 * HW + c2];
#pragma unroll
            for (int k = 0; k < 4; ++k) acc[k] += h2[k * HH + e] * w; }
        const int c = c2 % HW;
        const float a0 = -4.605170185988091f / 1.5f, a1 = -4.605170185988091f / 0.3f;
        const float delta = fabsf(a0 + (a1 - a0) * (float)c / (float)(HW - 1));
#pragma unroll
        for (int k = 0; k < 4; ++k) { const int pos = pos0 + k; const float tl = (float)pos / (float)(L - 1); const float v = acc[k] * (exp_f(-tl * delta) + 0.05f);
            if (set == 0) wFT(p.ws)[(long)c2 * SEQ + pos] = v; else wFT1(p.ws)[(long)pos * 2 * HW + c2] = v; }
    }
}
DEV float filt_tap(PRef p, int set, int c2, int pos) { return set == 0 ? wFT(p.ws)[(long)c2 * SEQ + pos] : wFT1(p.ws)[(long)pos * 2 * HW + c2]; }
template <> DEV void phase<PH_FILT_D>(PRef p, int, int, long gtid, long gth) {
    for (long i = gtid; i < (long)2 * HW * 64; i += gth) {
        const int part = (int)(i % 64), c = (int)((i / 64) % HW), set = (int)(i / (64 * HW)); const int L = set ? CTX : SEQ, per = L / 64;
        float s = 0.f;
        for (int pos = part * per; pos < (part + 1) * per; ++pos) { s += fabsf(filt_tap(p, set, c, pos)); if (pos >= 1) s += fabsf(filt_tap(p, set, HW + c, pos)); }
        wFL1(p.ws)[i] = s;
    }
}
DEV float filt_l1(PRef p, int set, int c) { const float* q = wFL1(p.ws) + ((long)set * HW + c) * 64; float s = 0.f; for (int i = 0; i < 64; ++i) s += q[i]; return s; }
template <> DEV void phase<PH_NORM1>(PRef p, int l, int, long gtid, long gth) {
    for (long r = gtid; r < R; r += gth) {
        const RowI ri = rowinfo((int)r);
        bf16* xr = wX(p.ws) + r * D; const float* src = ri.ctx ? p.ctx + ((long)ri.b * CTX + ri.t) * D : p.x + ((long)ri.b * SEQ + ri.t) * D;
        if (l == 0) for (int k = 0; k < D; ++k) xr[k] = f2bf(src[k]);
        float ss = 0.f; for (int k = 0; k < D; ++k) { const float v = l == 0 ? src[k] : bf2f(xr[k]); ss += v * v; }
        const float rstd = 1.0f / sqrtf(ss / (float)D + EPS);
        const float* mod = wMOD(p.ws) + ((long)l * (B + 1) + ri.bi) * 6 * D;
        const float* g = p.norm1_g + l * D;
        for (int k = 0; k < D; ++k) { const float v = l == 0 ? src[k] : bf2f(xr[k]); wH(p.ws)[r * D + k] = f2bf(v * rstd * g[k] * (1.0f + mod[D + k]) + mod[k]); }
    }
}
template <> DEV void phase<PH_GEMM1>(PRef p, int l, int, long gtid, long gth) {
    for (long i = gtid; i < (long)R * NP; i += gth) { const int n = (int)(i % NP); const long r = i / NP;
        wP(p.ws)[i] = f2bf(dot_bf16(wH(p.ws) + r * D, wWinT(p.ws, l) + (long)n * D, D)); }
}
template <> DEV void phase<PH_MLA_A>(PRef p, int, int, long gtid, long gth) {
    for (long r = gtid; r < R; r += gth) {
        const RowI ri = rowinfo((int)r); const bf16* pr = wP(p.ws) + r * NP;
        float s = 0.f; for (int k = 0; k < QR; ++k) { const float v = bf2f(pr[k]); s += v * v; }
        wRS(p.ws)[r] = 1.0f / sqrtf(s / (float)QR + EPS);
        s = 0.f; for (int k = 0; k < KVR; ++k) { const float v = bf2f(pr[QR + k]); s += v * v; }
        wRS(p.ws)[R + r] = 1.0f / sqrtf(s / (float)KVR + EPS);
        for (int j = 0; j < 16; ++j) {
            const float x1 = bf2f(pr[QR + KVR + j]), x2 = bf2f(pr[QR + KVR + 16 + j]);
            float cs = 1.f, sn = 0.f; if (!ri.ctx) { cs = wROPET(p.ws)[((long)ri.t * 16 + j) * 2]; sn = wROPET(p.ws)[((long)ri.t * 16 + j) * 2 + 1]; }
            wKR(p.ws)[r * ROPE + j] = f2bf(x1 * cs - x2 * sn); wKR(p.ws)[r * ROPE + 16 + j] = f2bf(x1 * sn + x2 * cs);
        }
    }
}
template <> DEV void phase<PH_MLA_Q>(PRef p, int l, int, long gtid, long gth) {
    for (long i = gtid; i < (long)R * QW; i += gth) { const int n = (int)(i % QW); const long r = i / QW;
        const RowI ri = rowinfo((int)r);
        const float rs = wRS(p.ws)[r]; const bf16* a = wP(p.ws) + r * NP;
        float v = rs * dot_bf16(a, wWuqT(p.ws, l) + (long)n * QR, QR);
        wQ(p.out)[i] = f2bf(v);
    }
}
template <> DEV void phase<PH_MLA_KV>(PRef p, int l, int, long gtid, long gth) {
    for (long i = gtid; i < (long)R * KVW; i += gth) { const int n = (int)(i % KVW); const long r = i / KVW;
        const bf16 v = f2bf(wRS(p.ws)[R + r] * dot_bf16(wP(p.ws) + r * NP + QR, wWukvT(p.ws, l) + (long)n * KVR, KVR));
        if (n < AW) wKN(p.out)[r * AW + n] = v; else wVT(p.out)[(long)(n - AW) * R + (r & ~31L) + vperm32((int)(r & 31))] = v; }
}
template <> DEV void phase<PH_ATT>(PRef p, int l, int, long gtid, long gth) {
    const bool last = (l == DEPTH - 1);
    const float scale = 1.0f / sqrtf((float)(NOPE + ROPE));
    for (long i = gtid; i < (long)AH * R; i += gth) {
        const int h = (int)(i / R); const long r = i % R; const RowI ri = rowinfo((int)r);
        if (ri.ctx && last) continue;
        const bf16* qp = wQ(p.out) + r * QW + h * (NOPE + ROPE);
        float qr[ROPE];
#pragma unroll
        for (int j = 0; j < 16; ++j) { const float x1 = bf2f(qp[NOPE + j]), x2 = bf2f(qp[NOPE + 16 + j]);
            float cs = 1.f, sn = 0.f; if (!ri.ctx) { cs = wROPET(p.ws)[((long)ri.t * 16 + j) * 2]; sn = wROPET(p.ws)[((long)ri.t * 16 + j) * 2 + 1]; }
            qr[j] = x1 * cs - x2 * sn; qr[16 + j] = x1 * sn + x2 * cs; }
        float o[AV];
#pragma unroll
        for (int d = 0; d < AV; ++d) o[d] = 0.f;
        float m = -1e30f, ssum = 0.f;
        const long k0 = (long)ri.b * RPB; const int nk = ri.ctx ? CTX : RPB;
        for (int kk = 0; kk < nk; ++kk) {
            const bf16* kv = wKN(p.out) + (k0 + kk) * AW + h * NOPE; const bf16* kr = wKR(p.ws) + (k0 + kk) * ROPE;
            const bf16* vt = wVT(p.out) + (long)h * AV * R + ((k0 + kk) & ~31L) + vperm32((int)((k0 + kk) & 31));
            float s = 0.f;
#pragma unroll
            for (int d = 0; d < NOPE; d += 8) s += dot8(*(const U4*)(qp + d), *(const U4*)(kv + d));
#pragma unroll
            for (int d = 0; d < ROPE; ++d) s += qr[d] * bf2f(kr[d]);
            s *= scale;
            const float mn = fmaxf(m, s); const float corr = exp_f(m - mn), pw = exp_f(s - mn);
            ssum = ssum * corr + pw; m = mn;
#pragma unroll
            for (int d = 0; d < AV; ++d) o[d] = o[d] * corr + pw * bf2f(vt[(long)d * R]);
        }
        const float inv = 1.0f / ssum;
#pragma unroll
        for (int d = 0; d < AV; ++d) wH(p.ws)[r * D + h * AV + d] = f2bf(o[d] * inv);
    }
}
template <> DEV void phase<PH_ML_U>(PRef p, int l, int, long gtid, long gth) {
    for (long i = gtid; i < (long)(R / 4) * (MW / 8); i += gth) { const int cg = (int)(i % (MW / 8)); const long r = (i / (MW / 8)) * 4; const RowI ri = rowinfo((int)r);
        const int L = ri.ctx ? CTX : SEQ; float o[4][8];
        conv4x8(wP(p.ws) + r * NP + ML_LO + cg * 8, NP, p.ml_conv_w + (long)l * 3 * MW + cg * 8, MW, p.ml_conv_b + l * MW + cg * 8, ri.t > 0, ri.t + 4 < L, o);
#pragma unroll
        for (int k = 0; k < 4; ++k) {
#pragma unroll
            for (int e = 0; e < 8; ++e) o[k][e] = silu_f(o[k][e]);
            *(U4*)(wMU(p.ws) + (r + k) * MW + cg * 8) = pack8(o[k]); } }
    const float ksc = 1.0f / sqrtf((float)MD);
    for (long i = gtid; i < (long)2 * MW * MW; i += gth) { const int k = (int)(i % MW), n = (int)(i / MW); const int isk = n >= MW, nn = n % MW, h = nn / MD, e = nn % MD;
        float v = 0.f; if (k / MD == h) v = isk ? p.ml_wk[(((long)l * MH + h) * MD + k % MD) * MD + e] * ksc : p.ml_wq[(((long)l * MH + h) * MD + k % MD) * MD + e];
        wWML(p.ws)[i] = f2bf(v); }
}
template <> DEV void phase<PH_ML_QK>(PRef p, int, int, long gtid, long gth) {
    for (long i = gtid; i < (long)R * 2 * MW; i += gth) { const int n = (int)(i % (2 * MW)); const long r = i / (2 * MW);
        wMQK(p.ws)[i] = f2bf(dot_bf16(wMU(p.ws) + r * MW, wWML(p.ws) + (long)n * MW, MW)); }
}
DEV int ml_scan_sc(int dir, int k) { return dir == 0 ? k : (k < NCS ? NCS - 1 - k : SCN - 1 - (k - NCS)); }
DEV int ml_sc_rank(int dir, int sc) { return dir == 0 ? sc : (sc < NCS ? NCS - 1 - sc : NCS + (SCN - 1 - sc)); }
template <> DEV void phase<PH_ML_F>(PRef p, int l, int, long gtid, long gth) {
    for (long i = gtid; i < (long)B * SCN * MH * 2; i += gth) { const int dir = (int)(i % 2), h = (int)((i / 2) % MH), sc = (int)((i / (2 * MH)) % SCN), b = (int)(i / (2 * MH * SCN));
        const float bi_ = p.ml_gate_b[(l * 4 + 2 * dir) * MH + h], bf_ = p.ml_gate_b[(l * 4 + 2 * dir + 1) * MH + h];
        float F = 0.f;
        for (int pos = 0; pos < SCS; ++pos) { const long r = (long)b * RPB + (long)sc * SCS + (dir == 0 ? pos : SCS - 1 - pos);
            const bf16* g = wP(p.ws) + r * NP + ML_LO + 3 * MW;
            const float li = bf2f(g[(2 * dir) * MH + h]) + bi_, lf = logsigmoid_f(bf2f(g[(2 * dir + 1) * MH + h]) + bf_);
            F += lf; float* fg = wFG(p.ws) + ((r * 2 + dir) * MH + h) * 2; fg[0] = F; fg[1] = F - li; }
    }
}
template <> DEV void phase<PH_ML_B>(PRef p, int, int, long gtid, long gth) {
    for (long i = gtid; i < (long)B * MH * 2 * SCN * (MD + 1) * MD; i += gth) {
        const int e = (int)(i % MD), jrow = (int)((i / MD) % (MD + 1)); long t = i / ((long)MD * (MD + 1));
        const int sc = (int)(t % SCN); t /= SCN; const int dir = (int)(t % 2); t /= 2; const int h = (int)(t % MH); const int b = (int)(t / MH);
        const long r0 = (long)b * RPB + (long)sc * SCS; const long rend = dir == 0 ? r0 + SCS - 1 : r0;
        const float Fend = wFG(p.ws)[((rend * 2 + dir) * MH + h) * 2];
        float acc = 0.f;
        for (int s = 0; s < SCS; ++s) { const long r = r0 + s; const float w = exp_f(Fend - wFG(p.ws)[((r * 2 + dir) * MH + h) * 2 + 1]);
            if (jrow < MD) acc += w * bf2f(wMQK(p.ws)[r * 2 * MW + MW + h * MD + jrow]) * bf2f(wP(p.ws)[r * NP + ML_LO + MW + h * MD + e]);
            else acc += w * bf2f(wMQK(p.ws)[r * 2 * MW + MW + h * MD + e]); }
        wMS(p.ws)[i] = acc;
    }
}
template <> DEV void phase<PH_ML_S>(PRef p, int, int dry, long gtid, long gth) {
    for (long i = gtid; i < (long)B * MH * 2 * (MD + 1) * MD; i += gth) {
        const int el = (int)(i % ((MD + 1) * MD)); long t = i / ((MD + 1) * MD); const int dir = (int)(t % 2); t /= 2; const int h = (int)(t % MH); const int b = (int)(t / MH);
        float* base = wMS(p.ws) + ((((long)b * MH + h) * 2 + dir) * SCN) * (MD + 1) * MD + el;
        float C = 0.f;
        for (int k = 0; k < SCN; ++k) { const int sc = ml_scan_sc(dir, k);
            const long r0 = (long)b * RPB + (long)sc * SCS; const long rend = dir == 0 ? r0 + SCS - 1 : r0;
            const float Ftot = wFG(p.ws)[((rend * 2 + dir) * MH + h) * 2];
            float* slot = base + (long)sc * (MD + 1) * MD; const float Bk = *slot; if (!dry) *slot = C;
            C = exp_f(Ftot) * C + Bk; }
    }
}
template <> DEV void phase<PH_ML_O>(PRef p, int l, int, long gtid, long gth) {
    const bool last = (l == DEPTH - 1);
    constexpr int HV = MD / 2;
    for (long i = gtid; i < (long)MH * R; i += gth) {
        const int h = (int)(i / R); const long r = i % R; const RowI ri = rowinfo((int)r);
        if (ri.ctx && last) continue;
        const bf16* qp = wMQK(p.ws) + r * 2 * MW + h * MD;
        const int sc = ri.o / SCS; const long r0 = (long)ri.b * RPB + (long)sc * SCS;
        float ss = 0.f;
        for (int half = 0; half < 2; ++half) {
            float hs[HV], num[HV];
#pragma unroll
            for (int d = 0; d < HV; ++d) hs[d] = 0.f;
            for (int dir = 0; dir < 2; ++dir) {
#pragma unroll
                for (int d = 0; d < HV; ++d) num[d] = 0.f;
                float den = 0.f;
                const float Ft = wFG(p.ws)[((r * 2 + dir) * MH + h) * 2];
                const long sa = dir == 0 ? r0 : r, sb = dir == 0 ? r : r0 + SCS - 1;
                for (long s = sa; s <= sb; ++s) {
                    const float w = exp_f(Ft - wFG(p.ws)[((s * 2 + dir) * MH + h) * 2 + 1]);
                    float dt = 0.f;
#pragma unroll
                    for (int d = 0; d < MD; d += 8) dt += dot8(*(const U4*)(qp + d), *(const U4*)(wMQK(p.ws) + s * 2 * MW + MW + h * MD + d));
                    dt *= w; den += dt;
#pragma unroll
                    for (int d = 0; d < HV; ++d) num[d] += dt * bf2f(wP(p.ws)[s * NP + ML_LO + MW + h * MD + half * HV + d]);
                }
                if (ml_sc_rank(dir, sc) > 0) {
                    const float a = exp_f(Ft);
                    const float* Cin = wMS(p.ws) + (((((long)ri.b * MH + h) * 2 + dir) * SCN) + sc) * (MD + 1) * MD;
#pragma unroll 1
                    for (int d = 0; d < MD; ++d) { const float qa = bf2f(qp[d]) * a; den += qa * Cin[MD * MD + d];
#pragma unroll
                        for (int e = 0; e < HV; ++e) num[e] += qa * Cin[d * MD + half * HV + e]; }
                }
                const float dn = 1.0f / fmaxf(fabsf(den), 1.0f);
#pragma unroll
                for (int d = 0; d < HV; ++d) hs[d] += num[d] * dn;
            }
#pragma unroll
            for (int d = 0; d < HV; ++d) { const float v = hs[d] * sigmoid_f(bf2f(wP(p.ws)[r * NP + ML_LO + 2 * MW + h * MD + half * HV + d])); ss += v * v;
                wH(p.ws)[r * D + AW + h * MD + half * HV + d] = f2bf(v); }
        }
        const float rstd = 1.0f / sqrtf(ss / (float)MD + EPS);
        for (int d = 0; d < MD; ++d) { bf16* o = wH(p.ws) + r * D + AW + h * MD + d; *o = f2bf(bf2f(*o) * rstd * p.ml_norm_g[l * MW + h * MD + d]); }
    }
}

DEV float hy_conv(PRef p, int l, long r, const RowI& ri, int ch) {
    const float* w = p.hy_conv_w + (long)l * 3 * N_HY; const bf16* pr = wP(p.ws) + r * NP + HY_LO + ch;
    float y = p.hy_conv_b[l * N_HY + ch] + w[N_HY + ch] * bf2f(pr[0]);
    if (has_prev(ri)) y += w[ch] * bf2f(pr[-NP]);
    if (has_next(ri)) y += w[2 * N_HY + ch] * bf2f(pr[NP]);
    return y;
}
template <> DEV void phase<PH_HY_Z>(PRef p, int l, int, long gtid, long gth) {
    for (long i = gtid; i < (long)B * CTX * HW; i += gth) { const int c = (int)(i % HW); const long q = i / HW; const long r = (q / CTX) * RPB + (q % CTX); const RowI ri = rowinfo((int)r);
        wZ(p.ws)[i] = hy_conv(p, l, r, ri, HW + c) * hy_conv(p, l, r, ri, 2 * HW + c); }
}
template <> DEV void phase<PH_HY_O>(PRef p, int l, int, long gtid, long gth) {
    if (l == DEPTH - 1) return;
    for (long i = gtid; i < (long)B * CTX * HW; i += gth) { const int c = (int)(i % HW); const long q = i / HW; const int b = (int)(q / CTX), t = (int)(q % CTX); const long r = (long)b * RPB + t; const RowI ri = rowinfo((int)r);
        const float* z = wZ(p.ws) + (long)b * CTX * HW + c;
        float y = 0.f;
        for (int s2 = 0; s2 <= t; ++s2) y += filt_tap(p, 1, c, t - s2) * z[(long)s2 * HW];
        for (int s2 = t + 1; s2 < CTX; ++s2) y += filt_tap(p, 1, HW + c, s2 - t) * z[(long)s2 * HW];
        y = y / filt_l1(p, 1, c) + z[(long)t * HW] * p.hy_bias_d[l * HW + c];
        wH(p.ws)[r * D + AW + MW + c] = f2bf(hy_conv(p, l, r, ri, c) * y); }
}
#ifdef HOST_EMU
#define BLOCK_FOR(tid) for (int tid = 0; tid < NTHREADS; ++tid)
#define BLOCK_SYNC() do {} while (0)
typedef unsigned char* LdsPtr;
DEV C2 twid(float turns) { C2 w; w.x = cosf(6.283185307179586f * turns); w.y = -sinf(6.283185307179586f * turns); return w; }
#else
DEV int opaque_tid() { int t = threadIdx.x; asm volatile("" : "+v"(t)); return t; }
#define BLOCK_FOR(tid) for (int tid = opaque_tid(), once_ = 1; once_; once_ = 0)
#define BLOCK_SYNC() __syncthreads()
typedef __attribute__((address_space(3))) unsigned char* LdsPtr;
DEV C2 twid(float turns) { C2 w; w.x = __builtin_amdgcn_cosf(turns); w.y = -__builtin_amdgcn_sinf(turns); return w; }
#endif
#ifdef HOST_EMU
typedef float* LdsC2; typedef bf16* LdsBf;
#else
typedef __attribute__((address_space(3))) float* LdsC2; typedef __attribute__((address_space(3))) bf16* LdsBf;
#endif
constexpr int NF = 2 * SEQ, NBF = NF / 8;
static_assert(SEQ == 4096 || SEQ == 512, "FFT passes: one radix-2 step then radix-8 steps (SEQ a power of 8)");
DEV int PI(int i) { return i + (i >> 3); }
DEV C2 ldc(LdsC2 buf, int i) { C2 r; r.x = buf[2 * i]; r.y = buf[2 * i + 1]; return r; }
DEV void stc(LdsC2 buf, int i, C2 v) { buf[2 * i] = v.x; buf[2 * i + 1] = v.y; }
DEV C2 cmul(C2 a, C2 b) { C2 r; r.x = a.x * b.x - a.y * b.y; r.y = a.x * b.y + a.y * b.x; return r; }
DEV C2 cmulc(C2 a, C2 b) { C2 r; r.x = a.x * b.x + a.y * b.y; r.y = a.y * b.x - a.x * b.y; return r; }
DEV void dft4(C2& u0, C2& u1, C2& u2, C2& u3) {
    const C2 t0 = {u0.x + u2.x, u0.y + u2.y}, t1 = {u0.x - u2.x, u0.y - u2.y}, t2 = {u1.x + u3.x, u1.y + u3.y}, d = {u1.x - u3.x, u1.y - u3.y};
    const C2 t3 = {d.y, -d.x};
    u0.x = t0.x + t2.x; u0.y = t0.y + t2.y; u2.x = t0.x - t2.x; u2.y = t0.y - t2.y; u1.x = t1.x + t3.x; u1.y = t1.y + t3.y; u3.x = t1.x - t3.x; u3.y = t1.y - t3.y;
}
DEV void dft8(C2 (&a)[8]) {
    const float c = 0.70710678118654752f;
    C2 b0 = {a[0].x + a[4].x, a[0].y + a[4].y}, b4 = {a[0].x - a[4].x, a[0].y - a[4].y};
    C2 b1 = {a[1].x + a[5].x, a[1].y + a[5].y}, d5 = {a[1].x - a[5].x, a[1].y - a[5].y};
    C2 b2 = {a[2].x + a[6].x, a[2].y + a[6].y}, d6 = {a[2].x - a[6].x, a[2].y - a[6].y};
    C2 b3 = {a[3].x + a[7].x, a[3].y + a[7].y}, d7 = {a[3].x - a[7].x, a[3].y - a[7].y};
    C2 b5 = {c * (d5.x + d5.y), c * (d5.y - d5.x)};
    C2 b6 = {d6.y, -d6.x};
    C2 b7 = {c * (d7.y - d7.x), -c * (d7.x + d7.y)};
    dft4(b0, b1, b2, b3); dft4(b4, b5, b6, b7);
    a[0] = b0; a[2] = b1; a[4] = b2; a[6] = b3; a[1] = b4; a[3] = b5; a[5] = b6; a[7] = b7;
}
DEV void idft8(C2 (&a)[8]) {
#pragma unroll
    for (int k = 0; k < 8; ++k) a[k].y = -a[k].y;
    dft8(a);
#pragma unroll
    for (int k = 0; k < 8; ++k) a[k].y = -a[k].y;
}
DEV void twpow(C2 w1, C2 (&w)[8]) { w[0].x = 1.f; w[0].y = 0.f; w[1] = w1; w[2] = cmul(w1, w1); w[3] = cmul(w[2], w1); w[4] = cmul(w[2], w[2]); w[5] = cmul(w[4], w1); w[6] = cmul(w[3], w[3]); w[7] = cmul(w[4], w[3]); }
template <bool INV> DEV void fft_pass8(LdsC2 buf, int s, int ls, int tid) {
    for (int q = tid; q < NBF; q += NTHREADS) {
        const int blk = q >> ls, j = q & (s - 1), base = (blk << (ls + 3)) + j;
        C2 a[8], w[8];
#pragma unroll
        for (int k = 0; k < 8; ++k) a[k] = ldc(buf, PI(base + (k << ls)));
        twpow(twid((float)j / (float)(8 * s)), w);
        if (!INV) { dft8(a);
#pragma unroll
            for (int m = 1; m < 8; ++m) a[m] = cmul(a[m], w[m]);
        } else {
#pragma unroll
            for (int m = 1; m < 8; ++m) a[m] = cmulc(a[m], w[m]);
            idft8(a); }
#pragma unroll
        for (int k = 0; k < 8; ++k) stc(buf, PI(base + (k << ls)), a[k]);
    }
}
DEV void fft_fwd_passes(LdsC2 buf, LdsC2 buf2 = nullptr) {
    int ls = (SEQ == 4096 ? 9 : 6);
    for (int s = SEQ / 8; s >= 8; s >>= 3, ls -= 3) { BLOCK_FOR(tid) { fft_pass8<false>(buf, s, ls, tid); if (buf2) fft_pass8<false>(buf2, s, ls, tid); } BLOCK_SYNC(); }
}
DEV void fft_inv_passes(LdsC2 buf, LdsC2 buf2 = nullptr) {
    int ls = 3;
    for (int s = 8; s <= SEQ / 8; s <<= 3, ls += 3) { BLOCK_FOR(tid) { fft_pass8<true>(buf, s, ls, tid); if (buf2) fft_pass8<true>(buf2, s, ls, tid); } BLOCK_SYNC(); }
}
enum { BPH_HFFT, BPH_HYFFT, BPH_HYZ, BPH_HYOUT, BPH_WCVT, BPH_HYCTX };
template <int BPH> DEV void bphase(PRef p, int l, int blk, LdsPtr lds);
constexpr int WT_UP = (D / 32) * (FF2 / 64), WT_DOWN = (FF / 32) * (D / 64), WT_IN = (D / 32) * (NP / 64), WT_UQ = (QR / 32) * (QW / 64), WT_UKV = (KVR / 32) * (KVW / 64), WT_OUT = (D / 32) * (D / 64);
constexpr int WT_ALL = WT_IN + WT_UQ + WT_UKV + WT_OUT + WT_UP + WT_DOWN;
static_assert(QR % 32 == 0 && KVR % 32 == 0 && QW % 64 == 0 && FF % 64 == 0 && NP % 64 == 0, "weight tiles");
struct WTile { const float* W; const float* gain; bf16* WT; int K, N, k0, n0, s0; };
DEV WTile wtile_decode(PRef p, int l, int t) {
    WTile w; w.gain = nullptr; int NT, which;
    if (t < WT_IN) { which = 0; w.W = p.w_in + (long)l * D * N_IN; w.WT = wWinT(p.ws, l); w.K = D; w.N = N_IN; NT = NP; }
    else if ((t -= WT_IN) < WT_UQ) { which = 1; w.W = p.w_uq + (long)l * QR * QW; w.gain = p.q_norm_g + l * QR; w.WT = wWuqT(p.ws, l); w.K = QR; w.N = QW; NT = QW; }
    else if ((t -= WT_UQ) < WT_UKV) { which = 2; w.W = p.w_ukv + (long)l * KVR * KVW; w.gain = p.kv_norm_g + l * KVR; w.WT = wWukvT(p.ws, l); w.K = KVR; w.N = KVW; NT = KVW; }
    else if ((t -= WT_UKV) < WT_OUT) { which = 3; w.W = p.w_out + (long)l * D * D; w.WT = wWoutT(p.ws, l); w.K = D; w.N = D; NT = D; }
    else if ((t -= WT_OUT) < WT_UP) { which = 4; w.W = p.w_up + (long)l * D * FF2; w.WT = wWupT(p.ws, l); w.K = D; w.N = FF2; NT = FF2; }
    else { t -= WT_UP; which = 5; w.W = p.w_down + (long)l * FF * D; w.WT = wWdownT(p.ws, l); w.K = FF; w.N = D; NT = D; }
    const int ntn = NT / 64, kb = t / ntn, nb = t % ntn; w.k0 = kb * 32; w.n0 = nb * 64;
    w.s0 = w.n0;
    if (which == 2) { const int hd = (w.n0 % AW) / 64; w.s0 = hd * (NOPE + AV) + (w.n0 < AW ? 0 : NOPE); }
#ifndef HOST_EMU
    if (which == 4) { const int tile = w.n0 / 256, within = w.n0 % 256; w.s0 = within < 128 ? tile * 128 + within : FF + tile * 128 + (within - 128); }
#endif
    return w;
}
constexpr int DOWN_BUSY = (R / 256 * (D / 256)) % NBLOCKS, NFILL = NBLOCKS - DOWN_BUSY;
constexpr int WT_PER = 4, WT_ITEMS = (WT_ALL + WT_PER - 1) / WT_PER, WT_SPLIT = (WT_IN + WT_UQ + WT_UKV + WT_OUT + WT_PER - 1) / WT_PER;
template <> DEV void bphase<BPH_WCVT>(PRef p, int l, int blk, LdsPtr lds) {
#ifdef HOST_EMU
    float* sm = (float*)lds;
#else
    __attribute__((address_space(3))) float* sm = (__attribute__((address_space(3))) float*)lds;
#endif
    BLOCK_FOR(tid) {
        for (int sub = 0; sub < WT_PER; ++sub) { const int t = blk * WT_PER + sub; if (t >= WT_ALL) break; const WTile w = wtile_decode(p, l, t);
            for (int idx = tid; idx < 32 * 64; idx += NTHREADS) { const int kk = idx >> 6, nn = idx & 63;
                float v = 0.f; if (w.s0 + nn < w.N) v = w.W[(long)(w.k0 + kk) * w.N + w.s0 + nn];
                if (w.gain) v *= w.gain[w.k0 + kk];
                sm[sub * 64 * 33 + nn * 33 + kk] = v; } }
    }
    BLOCK_SYNC();
    BLOCK_FOR(tid) {
        for (int sub = 0; sub < WT_PER; ++sub) { const int t = blk * WT_PER + sub; if (t >= WT_ALL) break; const WTile w = wtile_decode(p, l, t);
            for (int idx = tid; idx < 64 * 4; idx += NTHREADS) { const int nn = idx >> 2, ch = idx & 3; const int so = sub * 64 * 33 + nn * 33 + ch * 8;
                U4 o;
                o.x = f2bf(sm[so + 0]) | ((unsigned)f2bf(sm[so + 1]) << 16); o.y = f2bf(sm[so + 2]) | ((unsigned)f2bf(sm[so + 3]) << 16);
                o.z = f2bf(sm[so + 4]) | ((unsigned)f2bf(sm[so + 5]) << 16); o.w = f2bf(sm[so + 6]) | ((unsigned)f2bf(sm[so + 7]) << 16);
                *(U4*)(w.WT + (long)(w.n0 + nn) * w.K + w.k0 + ch * 8) = o; } }
    }
    BLOCK_SYNC();
}
template <> DEV void bphase<BPH_HFFT>(PRef p, int l, int blk, LdsPtr lds) {
    LdsC2 buf = (LdsC2)lds; const int c = blk;
    BLOCK_FOR(tid) {
        const float inv = 1.0f / filt_l1(p, 0, c), bias = p.hy_bias_d[l * HW + c];
        const float* fw = wFT(p.ws) + (long)c * SEQ; const float* bw = wFT(p.ws) + (long)(HW + c) * SEQ;
        for (int i = tid; i < SEQ; i += NTHREADS) {
            const float t0 = fw[i] * inv + (i == 0 ? bias : 0.f), t1 = (i == 0) ? 0.f : bw[SEQ - i] * inv;
            C2 e; e.x = t0 + t1; e.y = 0.f; stc(buf, PI(i), e);
            const C2 w = twid((float)i / (float)NF); const float d = t0 - t1; C2 o; o.x = d * w.x; o.y = d * w.y; stc(buf, PI(i + SEQ), o); }
    }
    BLOCK_SYNC();
    fft_fwd_passes(buf);
    BLOCK_FOR(tid) {
        C2* hs = wHSPEC(p.ws) + (long)c * NF; const float sc = 1.0f / (float)NF;
        for (int q = tid; q < NBF; q += NTHREADS) { C2 a[8];
#pragma unroll
            for (int k = 0; k < 8; ++k) a[k] = ldc(buf, 9 * q + k);
            dft8(a);
#pragma unroll
            for (int k = 0; k < 8; ++k) { C2 o; o.x = a[k].x * sc; o.y = a[k].y * sc; hs[8 * q + k] = o; } }
    }
    BLOCK_SYNC();
}
template <> DEV void bphase<BPH_HYFFT>(PRef p, int lflag, int blk, LdsPtr lds) {
    const int c = blk;
    constexpr int NPB = (B >= 4 && B % 4 == 0) ? 2 : 1;
    LdsC2 bufs[2] = {(LdsC2)lds, (LdsC2)(lds + (NPB == 2 ? (NF + NF / 8) * 8 : 0))};
    for (int pr = 0; pr < B / 2; pr += NPB) {
        BLOCK_FOR(tid) {
#pragma unroll
            for (int k = 0; k < NPB; ++k) { LdsC2 buf = bufs[k]; const bf16* z1 = wZT(p.ws) + ((long)(2 * (pr + k)) * HW + c) * SEQ; const bf16* z2 = z1 + (long)HW * SEQ;
                for (int i = tid; i < SEQ; i += NTHREADS) { C2 e; e.x = bf2f(z1[i]); e.y = bf2f(z2[i]); stc(buf, PI(i), e); stc(buf, PI(i + SEQ), cmul(e, twid((float)i / (float)NF))); } }
        }
        BLOCK_SYNC();
        fft_fwd_passes(bufs[0], NPB == 2 ? bufs[1] : nullptr);
        BLOCK_FOR(tid) {
            const C2* hs = wHSPEC(p.ws) + (long)c * NF;
            for (int q = tid; q < NBF; q += NTHREADS) { C2 hv[8];
#pragma unroll
                for (int k = 0; k < 8; ++k) hv[k] = hs[8 * q + k];
#pragma unroll
                for (int kb = 0; kb < NPB; ++kb) { LdsC2 buf = bufs[kb]; C2 a[8];
#pragma unroll
                    for (int k = 0; k < 8; ++k) a[k] = ldc(buf, 9 * q + k);
                    dft8(a);
#pragma unroll
                    for (int k = 0; k < 8; ++k) a[k] = cmul(a[k], hv[k]);
                    idft8(a);
#pragma unroll
                    for (int k = 0; k < 8; ++k) stc(buf, 9 * q + k, a[k]); } }
        }
        BLOCK_SYNC();
        fft_inv_passes(bufs[0], NPB == 2 ? bufs[1] : nullptr);
        BLOCK_FOR(tid) {
#pragma unroll
            for (int k = 0; k < NPB; ++k) { LdsC2 buf = bufs[k]; bf16* z1 = wZT(p.ws) + ((long)(2 * (pr + k)) * HW + c) * SEQ; bf16* z2 = z1 + (long)HW * SEQ;
                for (int i = tid; i < SEQ; i += NTHREADS) { const C2 a = ldc(buf, PI(i)), bb = ldc(buf, PI(i + SEQ)); const C2 y = cmulc(bb, twid((float)i / (float)NF));
                    if (!(lflag & 256)) { z1[i] = f2bf(a.x + y.x); z2[i] = f2bf(a.y + y.y); } } }
        }
        BLOCK_SYNC();
    }
}
template <> DEV void bphase<BPH_HYCTX>(PRef p, int l, int blk, LdsPtr lds) {
#ifdef HOST_EMU
    float* sm = (float*)lds;
#else
    __attribute__((address_space(3))) float* sm = (__attribute__((address_space(3))) float*)lds;
#endif
    const int b = blk / (HW / 8), c0 = (blk % (HW / 8)) * 8;
    BLOCK_FOR(tid) {
        for (int idx = tid; idx < CTX * 8; idx += NTHREADS) { const int t = idx >> 3, c = idx & 7;
            sm[idx] = wZ(p.ws)[((long)b * CTX + t) * HW + c0 + c];
            sm[CTX * 8 + idx] = wFT1(p.ws)[(long)t * 2 * HW + c0 + c]; sm[2 * CTX * 8 + idx] = wFT1(p.ws)[(long)t * 2 * HW + HW + c0 + c]; }
    }
    BLOCK_SYNC();
    BLOCK_FOR(tid) {
        for (int idx = tid; idx < CTX * 8; idx += NTHREADS) { const int t = idx >> 3, c = idx & 7;
            float y = 0.f;
            for (int s2 = 0; s2 <= t; ++s2) y += sm[CTX * 8 + (t - s2) * 8 + c] * sm[s2 * 8 + c];
            for (int s2 = t + 1; s2 < CTX; ++s2) y += sm[2 * CTX * 8 + (s2 - t) * 8 + c] * sm[s2 * 8 + c];
            const long r = (long)b * RPB + t; const RowI ri = rowinfo((int)r);
            y = y / filt_l1(p, 1, c0 + c) + sm[t * 8 + c] * p.hy_bias_d[l * HW + c0 + c];
            wH(p.ws)[r * D + AW + MW + c0 + c] = f2bf(hy_conv(p, l, r, ri, c0 + c) * y); }
    }
    BLOCK_SYNC();
}
constexpr int HZP = 72;
template <> DEV void bphase<BPH_HYZ>(PRef p, int l, int blk, LdsPtr lds) {
    LdsBf sm = (LdsBf)lds; const int b = blk / (SEQ / 64), tt = blk % (SEQ / 64); const long r0 = (long)b * RPB + CTX + (long)tt * 64;
    BLOCK_FOR(tid) { for (int it = tid; it < (HW / 8) * 16; it += NTHREADS) {
        const int cg = it % (HW / 8), rs = it / (HW / 8); const int t0 = tt * 64 + rs * 4; const long r = r0 + rs * 4;
        float a[4][8], v[4][8];
        conv4x8(wP(p.ws) + r * NP + HY_LO + HW + cg * 8, NP, p.hy_conv_w + (long)l * 3 * N_HY + HW + cg * 8, N_HY, p.hy_conv_b + l * N_HY + HW + cg * 8, t0 > 0, t0 + 4 < SEQ, a);
        conv4x8(wP(p.ws) + r * NP + HY_LO + 2 * HW + cg * 8, NP, p.hy_conv_w + (long)l * 3 * N_HY + 2 * HW + cg * 8, N_HY, p.hy_conv_b + l * N_HY + 2 * HW + cg * 8, t0 > 0, t0 + 4 < SEQ, v);
#pragma unroll
        for (int e = 0; e < 8; ++e)
#pragma unroll
            for (int k = 0; k < 4; ++k) sm[(cg * 8 + e) * HZP + rs * 4 + k] = f2bf(a[k][e] * v[k][e]);
    } }
    BLOCK_SYNC();
    BLOCK_FOR(tid) {
        for (int idx = tid; idx < HW * 8; idx += NTHREADS) { const int c = idx >> 3, ch = idx & 7;
            U4 v; const LdsBf q = sm + c * HZP + ch * 8;
            v.x = q[0] | ((unsigned)q[1] << 16); v.y = q[2] | ((unsigned)q[3] << 16); v.z = q[4] | ((unsigned)q[5] << 16); v.w = q[6] | ((unsigned)q[7] << 16);
            *(U4*)(wZT(p.ws) + ((long)b * HW + c) * SEQ + tt * 64 + ch * 8) = v; }
    }
    BLOCK_SYNC();
}
template <> DEV void bphase<BPH_HYOUT>(PRef p, int l, int blk, LdsPtr lds) {
    LdsBf sm = (LdsBf)lds; const int b = blk / (SEQ / 64), tt = blk % (SEQ / 64); const long r0 = (long)b * RPB + CTX + (long)tt * 64;
    BLOCK_FOR(tid) {
        for (int idx = tid; idx < HW * 8; idx += NTHREADS) { const int c = idx >> 3, ch = idx & 7;
            const U4 v = *(const U4*)(wZT(p.ws) + ((long)b * HW + c) * SEQ + tt * 64 + ch * 8); LdsBf q = sm + c * HZP + ch * 8;
            q[0] = (bf16)v.x; q[1] = (bf16)(v.x >> 16); q[2] = (bf16)v.y; q[3] = (bf16)(v.y >> 16); q[4] = (bf16)v.z; q[5] = (bf16)(v.z >> 16); q[6] = (bf16)v.w; q[7] = (bf16)(v.w >> 16); }
    }
    BLOCK_SYNC();
    BLOCK_FOR(tid) { for (int it = tid; it < (HW / 8) * 16; it += NTHREADS) {
        const int cg = it % (HW / 8), rs = it / (HW / 8); const int t0 = tt * 64 + rs * 4; const long r = r0 + rs * 4;
        float x0[4][8];
        conv4x8(wP(p.ws) + r * NP + HY_LO + cg * 8, NP, p.hy_conv_w + (long)l * 3 * N_HY + cg * 8, N_HY, p.hy_conv_b + l * N_HY + cg * 8, t0 > 0, t0 + 4 < SEQ, x0);
#pragma unroll
        for (int k = 0; k < 4; ++k) {
#pragma unroll
            for (int e = 0; e < 8; ++e) x0[k][e] *= bf2f(sm[(cg * 8 + e) * HZP + rs * 4 + k]);
            *(U4*)(wH(p.ws) + (r + k) * D + AW + MW + cg * 8) = pack8(x0[k]); }
    } }
    BLOCK_SYNC();
}
template <> DEV void phase<PH_GEMM_OUT>(PRef p, int l, int, long gtid, long gth) {
    for (long i = gtid; i < (long)R * D; i += gth) { const int n = (int)(i % D); const long r = i / D; const RowI ri = rowinfo((int)r);
        const float g1 = wMOD(p.ws)[((long)l * (B + 1) + ri.bi) * 6 * D + 2 * D + n];
        wX(p.ws)[i] = f2bf(bf2f(wX(p.ws)[i]) + g1 * dot_bf16(wH(p.ws) + r * D, wWoutT(p.ws, l) + (long)n * D, D)); }
}
template <> DEV void phase<PH_NORM2>(PRef p, int l, int, long gtid, long gth) {
    for (long r = gtid; r < R; r += gth) { const RowI ri = rowinfo((int)r); const bf16* xr = wX(p.ws) + r * D;
        float ss = 0.f; for (int k = 0; k < D; ++k) ss += bf2f(xr[k]) * bf2f(xr[k]);
        const float rstd = 1.0f / sqrtf(ss / (float)D + EPS);
        const float* mod = wMOD(p.ws) + ((long)l * (B + 1) + ri.bi) * 6 * D; const float* g = p.norm2_g + l * D;
        for (int k = 0; k < D; ++k) wH(p.ws)[r * D + k] = f2bf(bf2f(xr[k]) * rstd * g[k] * (1.0f + mod[4 * D + k]) + mod[3 * D + k]); }
}
template <> DEV void phase<PH_FFN_UP>(PRef p, int l, int fc, long gtid, long gth) {
    for (long i = gtid; i < (long)FCR * FF2; i += gth) { const int n = (int)(i % FF2); const long rr = i / FF2; const long r = (long)fc * FCR + rr;
        wUF(p.ws)[i] = f2bf(dot_bf16(wH(p.ws) + r * D, wWupT(p.ws, l) + (long)n * D, D)); }
}
template <> DEV void phase<PH_FFN_CG>(PRef p, int l, int fc, long gtid, long gth) {
    for (long i = gtid; i < (long)FCR * FF; i += gth) { const int j = (int)(i % FF); const long rr = i / FF; const long r = (long)fc * FCR + rr; const RowI ri = rowinfo((int)r);
        const float* w = p.ffn_conv_w + (long)l * 3 * FF2; const float* cb = p.ffn_conv_b + (long)l * FF2; const bf16* u = wUF(p.ws) + rr * FF2;
        float a = cb[j] + w[FF2 + j] * bf2f(u[j]), g = cb[FF + j] + w[FF2 + FF + j] * bf2f(u[FF + j]);
        if (has_prev(ri)) { a += w[j] * bf2f(u[j - FF2]); g += w[FF + j] * bf2f(u[FF + j - FF2]); }
        if (has_next(ri)) { a += w[2 * FF2 + j] * bf2f(u[j + FF2]); g += w[2 * FF2 + FF + j] * bf2f(u[FF + j + FF2]); }
        wGF(p.ws)[i] = f2bf(silu_f(a) * g); }
}
template <> DEV void phase<PH_FFN_DOWN>(PRef p, int l, int fc, long gtid, long gth) {
    for (long i = gtid; i < (long)FCR * D; i += gth) { const int n = (int)(i % D); const long rr = i / D; const long r = (long)fc * FCR + rr; const RowI ri = rowinfo((int)r);
        const float g2 = wMOD(p.ws)[((long)l * (B + 1) + ri.bi) * 6 * D + 5 * D + n];
        const float xn = bf2f(wX(p.ws)[r * D + n]) + g2 * dot_bf16(wGF(p.ws) + rr * FF, wWdownT(p.ws, l) + (long)n * FF, FF);
        wX(p.ws)[r * D + n] = f2bf(xn); }
}
template <> DEV void phase<PH_FINAL>(PRef p, int, int, long gtid, long gth) {
    for (long q = gtid; q < (long)B * SEQ; q += gth) { const bf16* xr = wX(p.ws) + ((q / SEQ) * RPB + CTX + q % SEQ) * D;
        float ss = 0.f; for (int k = 0; k < D; ++k) ss += bf2f(xr[k]) * bf2f(xr[k]);
        const float rstd = 1.0f / sqrtf(ss / (float)D + EPS);
        for (int k = 0; k < D; ++k) p.out[q * D + k] = bf2f(xr[k]) * rstd * p.final_g[k]; }
}


#ifndef HOST_EMU
namespace wv {
typedef float f32x4 __attribute__((ext_vector_type(4)));
typedef unsigned u32x2 __attribute__((ext_vector_type(2)));
__device__ __forceinline__ float wsum(float v, int lane) {
#pragma unroll
    for (int o = 32; o; o >>= 1) v += __int_as_float(__builtin_amdgcn_ds_bpermute((lane ^ o) << 2, __float_as_int(v)));
    return v;
}
typedef __bf16 bf2_t __attribute__((ext_vector_type(2)));
typedef float f32x2_t __attribute__((ext_vector_type(2)));
__device__ __forceinline__ unsigned pk(float lo, float hi) { f32x2_t v = {lo, hi}; return __builtin_bit_cast(unsigned, __builtin_convertvector(v, bf2_t)); }
constexpr int NW = NBLOCKS * (NTHREADS / 64), NV = D / 256;
template <int MODE> __device__ __forceinline__ void norm_rows(PRef p, int l) {
    int t_ = threadIdx.x; asm volatile("" : "+v"(t_)); const int lane = t_ & 63, gw = (int)blockIdx.x * (NTHREADS / 64) + (t_ >> 6);
    const int nrows = MODE == 2 ? B * SEQ : R;
    for (int q0 = gw; q0 < nrows; q0 += 2 * NW) {
        const bool two = q0 + NW < nrows;
        long r[2]; int bi[2]; const float* src[2] = {nullptr, nullptr}; bf16* xdst[2] = {nullptr, nullptr};
        f32x4 v[2][NV];
#pragma unroll
        for (int u = 0; u < 2; ++u) if (u == 0 || two) {
            const int q = q0 + u * NW;
            if (MODE == 2) { r[u] = (long)(q / SEQ) * RPB + CTX + (q % SEQ); bi[u] = 0; }
            else { r[u] = q; const RowI ri = rowinfo(q); bi[u] = ri.bi;
                if (MODE == 0 && l == 0) { src[u] = ri.ctx ? p.ctx + ((long)ri.b * CTX + ri.t) * D : p.x + ((long)ri.b * SEQ + ri.t) * D; xdst[u] = wX(p.ws) + r[u] * D; } }
#pragma unroll
            for (int j = 0; j < NV; ++j) {
                if (src[u]) v[u][j] = *(const f32x4*)(src[u] + 4 * lane + 256 * j);
                else { const u32x2 xw = *(const u32x2*)(wX(p.ws) + r[u] * D + 4 * lane + 256 * j); v[u][j][0] = __uint_as_float(xw.x << 16); v[u][j][1] = __uint_as_float(xw.x & 0xFFFF0000u); v[u][j][2] = __uint_as_float(xw.y << 16); v[u][j][3] = __uint_as_float(xw.y & 0xFFFF0000u); } }
        }
#pragma unroll
        for (int u = 0; u < 2; ++u) if (u == 0 || two) {
            const int q = q0 + u * NW;
            float ss = 0.f;
#pragma unroll
            for (int j = 0; j < NV; ++j) ss += (v[u][j][0] * v[u][j][0] + v[u][j][1] * v[u][j][1]) + (v[u][j][2] * v[u][j][2] + v[u][j][3] * v[u][j][3]);
            if (xdst[u]) {
#pragma unroll
                for (int j = 0; j < NV; ++j) { u32x2 w; w.x = pk(v[u][j][0], v[u][j][1]); w.y = pk(v[u][j][2], v[u][j][3]); *(u32x2*)(xdst[u] + 4 * lane + 256 * j) = w; } }
            const float rstd = 1.0f / sqrtf(wsum(ss, lane) / (float)D + EPS);
            if (MODE == 2) {
#pragma unroll
                for (int j = 0; j < NV; ++j) { const f32x4 g = *(const f32x4*)(p.final_g + 4 * lane + 256 * j); *(f32x4*)(p.out + (long)q * D + 4 * lane + 256 * j) = v[u][j] * rstd * g; }
            } else {
                const float* mod = wMOD(p.ws) + ((long)l * (B + 1) + bi[u]) * 6 * D + (MODE == 0 ? 0 : 3 * D); const float* g = (MODE == 0 ? p.norm1_g : p.norm2_g) + l * D;
#pragma unroll
                for (int j = 0; j < NV; ++j) { const int k = 4 * lane + 256 * j; const f32x4 gg = *(const f32x4*)(g + k), sh = *(const f32x4*)(mod + k), sc = *(const f32x4*)(mod + D + k);
                    const f32x4 o = v[u][j] * rstd * gg * (sc + 1.0f) + sh; u32x2 w; w.x = pk(o[0], o[1]); w.y = pk(o[2], o[3]); *(u32x2*)(wH(p.ws) + r[u] * D + k) = w; }
            }
        }
    }
}
__device__ __forceinline__ float rsum16(float v) {
    v += __int_as_float(__builtin_amdgcn_update_dpp(0, __float_as_int(v), 0x128, 0xf, 0xf, false));
    v += __int_as_float(__builtin_amdgcn_update_dpp(0, __float_as_int(v), 0x124, 0xf, 0xf, false));
    v += __int_as_float(__builtin_amdgcn_update_dpp(0, __float_as_int(v), 0x122, 0xf, 0xf, false));
    v += __int_as_float(__builtin_amdgcn_update_dpp(0, __float_as_int(v), 0x121, 0xf, 0xf, false));
    return v;
}
__device__ __forceinline__ void mla_a_rows(PRef p) {
    int t_ = threadIdx.x; asm volatile("" : "+v"(t_)); const int lane = t_ & 63, i = lane & 15, g = lane >> 4, gw = (int)blockIdx.x * (NTHREADS / 64) + (t_ >> 6);
    static_assert(QR == 3 * 128 && KVR == 2 * 128 && ROPE == 32 && R % 4 == 0, "mla_a lane map");
    for (int q0 = gw * 4; q0 < R; q0 += 8 * NW) {
        U4 uq[2][3], uk[2][2]; float x1[2], x2[2], cs[2], sn[2]; bool ok[2], cx[2] = {false, false};
#pragma unroll
        for (int u = 0; u < 2; ++u) {
            const int r = q0 + u * 4 * NW + g; ok[u] = r < R;
            if (ok[u]) { const RowI ri = rowinfo(r); const bf16* pr = wP(p.ws) + (long)r * NP;
#pragma unroll
                for (int c = 0; c < 3; ++c) uq[u][c] = *(const U4*)(pr + (i + 16 * c) * 8);
#pragma unroll
                for (int c = 0; c < 2; ++c) uk[u][c] = *(const U4*)(pr + QR + (i + 16 * c) * 8);
                x1[u] = bf2f(pr[QR + KVR + i]); x2[u] = bf2f(pr[QR + KVR + 16 + i]);
                const int tt = ri.ctx ? 0 : ri.t; cx[u] = ri.ctx; cs[u] = wROPET(p.ws)[((long)tt * 16 + i) * 2]; sn[u] = wROPET(p.ws)[((long)tt * 16 + i) * 2 + 1]; }
        }
#pragma unroll
        for (int u = 0; u < 2; ++u) {
            const int r = q0 + u * 4 * NW + g;
            float sq = 0.f, sk = 0.f;
            if (ok[u]) { sq = dot8(uq[u][0], uq[u][0]) + dot8(uq[u][1], uq[u][1]) + dot8(uq[u][2], uq[u][2]); sk = dot8(uk[u][0], uk[u][0]) + dot8(uk[u][1], uk[u][1]); }
            sq = rsum16(sq); sk = rsum16(sk);
            if (ok[u]) {
                if (i == 0) { wRS(p.ws)[r] = 1.0f / sqrtf(sq / (float)QR + EPS); wRS(p.ws)[R + r] = 1.0f / sqrtf(sk / (float)KVR + EPS); }
                const float c_ = cx[u] ? 1.0f : cs[u], s_ = cx[u] ? 0.0f : sn[u];
                wKR(p.ws)[(long)r * ROPE + i] = f2bf(x1[u] * c_ - x2[u] * s_); wKR(p.ws)[(long)r * ROPE + 16 + i] = f2bf(x1[u] * s_ + x2[u] * c_); }
        }
    }
}
__device__ __forceinline__ void ml_f_rows(PRef p, int l) {
    int t_ = threadIdx.x; asm volatile("" : "+v"(t_)); const int lane = t_ & 63, gw = (int)blockIdx.x * (NTHREADS / 64) + (t_ >> 6);
    static_assert(SCS == 256, "ml_f_rows: 64 lanes x 4 positions");
    for (int u = NW - 1 - gw; u < B * SCN * MH * 2; u += NW) {
        const int dir = u % 2, h = (u / 2) % MH, sc = (u / (2 * MH)) % SCN, b = u / (2 * MH * SCN);
        const float bi_ = p.ml_gate_b[(l * 4 + 2 * dir) * MH + h], bf_ = p.ml_gate_b[(l * 4 + 2 * dir + 1) * MH + h];
        const long rb = (long)b * RPB + (long)sc * SCS;
        float li[4], c[4]; float run = 0.f;
#pragma unroll
        for (int i = 0; i < 4; ++i) { const int pos = 4 * lane + i; const long r = rb + (dir == 0 ? pos : SCS - 1 - pos);
            const bf16* g = wP(p.ws) + r * NP + ML_LO + 3 * MW;
            li[i] = bf2f(g[(2 * dir) * MH + h]) + bi_; run += logsigmoid_f(bf2f(g[(2 * dir + 1) * MH + h]) + bf_); c[i] = run; }
        float inc = run;
#pragma unroll
        for (int o = 1; o < 64; o <<= 1) { const float t = __int_as_float(__builtin_amdgcn_ds_bpermute(((lane - o) & 63) << 2, __float_as_int(inc))); if (lane >= o) inc += t; }
        const float excl = inc - run;
#pragma unroll
        for (int i = 0; i < 4; ++i) { const int pos = 4 * lane + i; const long r = rb + (dir == 0 ? pos : SCS - 1 - pos); const float F = excl + c[i];
            float* fg = wFG(p.ws) + ((r * 2 + dir) * MH + h) * 2; fg[0] = F; fg[1] = F - li[i]; }
    }
}

constexpr int FROWS = (SEQ + CTX) / NBLOCKS;
static_assert((SEQ + CTX) % NBLOCKS == 0 && HH == 64 && 2 * HW == NTHREADS && FROWS * HH * 4 <= 65536, "filter block phases");
__device__ __forceinline__ void filt_b_block(PRef p, int l, __attribute__((address_space(3))) unsigned char* lds) {
    int t_ = threadIdx.x; asm volatile("" : "+v"(t_)); const int t = t_, j = t & 63, wv_ = t >> 6;
    __attribute__((address_space(3))) float* hs = (__attribute__((address_space(3))) float*)lds;
    const long g0 = (long)blockIdx.x * FROWS;
    __syncthreads();
    for (int idx = t; idx < FROWS * HH; idx += NTHREADS) hs[idx] = wHD1(p.ws)[g0 * HH + idx];
    const float* w2 = p.hy_w2 + (long)l * HH * HH;
    float w[HH];
#pragma unroll
    for (int e = 0; e < HH; ++e) w[e] = w2[e * HH + j];
    const float bj = p.hy_b2[l * HH + j], fj = p.hy_freq[l * HH + j];
    __syncthreads();
    for (int k = wv_; k < FROWS; k += NTHREADS / 64) {
        float acc = bj;
#pragma unroll
        for (int e4 = 0; e4 < HH / 4; ++e4) { const f32x4 h = *(const __attribute__((address_space(3))) f32x4*)(hs + k * HH + e4 * 4);
            acc += h[0] * w[4 * e4]; acc += h[1] * w[4 * e4 + 1]; acc += h[2] * w[4 * e4 + 2]; acc += h[3] * w[4 * e4 + 3]; }
        wHD2(p.ws)[(g0 + k) * HH + j] = sin_f(fj * acc);
    }
    __syncthreads();
}
__device__ __forceinline__ void filt_c_block(PRef p, int l, __attribute__((address_space(3))) unsigned char* lds) {
    int t_ = threadIdx.x; asm volatile("" : "+v"(t_)); const int c2 = t_;
    __attribute__((address_space(3))) float* hs = (__attribute__((address_space(3))) float*)lds;
    const long g0 = (long)blockIdx.x * FROWS;
    __syncthreads();
    for (int idx = c2; idx < FROWS * HH; idx += NTHREADS) hs[idx] = wHD2(p.ws)[g0 * HH + idx];
    const float* w3 = p.hy_w3 + (long)l * HH * 2 * HW;
    float w[HH];
#pragma unroll
    for (int e = 0; e < HH; ++e) w[e] = w3[e * 2 * HW + c2];
    const int c = c2 % HW;
    const float a0 = -4.605170185988091f / 1.5f, a1 = -4.605170185988091f / 0.3f;
    const float delta = fabsf(a0 + (a1 - a0) * (float)c / (float)(HW - 1));
    __syncthreads();
    for (int k = 0; k < FROWS; ++k) {
        float acc = 0.f;
#pragma unroll
        for (int e4 = 0; e4 < HH / 4; ++e4) { const f32x4 h = *(const __attribute__((address_space(3))) f32x4*)(hs + k * HH + e4 * 4);
            acc += h[0] * w[4 * e4]; acc += h[1] * w[4 * e4 + 1]; acc += h[2] * w[4 * e4 + 2]; acc += h[3] * w[4 * e4 + 3]; }
        const long g = g0 + k; const int set = g >= SEQ, pos = (int)(set ? g - SEQ : g), L = set ? CTX : SEQ;
        const float tl = (float)pos / (float)(L - 1); const float v = acc * (exp_f(-tl * delta) + 0.05f);
        if (set == 0) wFT(p.ws)[(long)c2 * SEQ + pos] = v; else wFT1(p.ws)[(long)pos * 2 * HW + c2] = v;
    }
    __syncthreads();
}
}
#endif
#ifndef HOST_EMU
#define LAS __attribute__((address_space(3)))
#endif

#ifndef HOST_EMU
namespace att {
typedef short bf16x8 __attribute__((ext_vector_type(8)));
typedef float f32x4 __attribute__((ext_vector_type(4)));
typedef unsigned u32x4 __attribute__((ext_vector_type(4)));
typedef unsigned u32x2 __attribute__((ext_vector_type(2)));
constexpr int TK = 128;
constexpr int KROW = 224, VROW = TK * 2 + 32, KT_BYTES = TK * KROW, VT_BYTES = 64 * VROW;
constexpr int QBLK = 256, NQB = SEQ / QBLK, NLAT = B * AH * NQB, NCQ = CTX / QBLK;
static_assert(SEQ % QBLK == 0 && RPB % TK == 0 && CTX % TK == 0 && CTX % QBLK == 0, "attention tiling");
__device__ __forceinline__ float bfl(unsigned w) { return __uint_as_float(w << 16); }
__device__ __forceinline__ float bfh(unsigned w) { return __uint_as_float(w & 0xFFFF0000u); }
typedef __bf16 bf2_t __attribute__((ext_vector_type(2)));
typedef float f32x2_t __attribute__((ext_vector_type(2)));
__device__ __forceinline__ unsigned pk(float lo, float hi) { f32x2_t v = {lo, hi}; return __builtin_bit_cast(unsigned, __builtin_convertvector(v, bf2_t)); }
__device__ __forceinline__ float xl(float v, int lane, int m) { return __int_as_float(__builtin_amdgcn_ds_bpermute((lane ^ m) << 2, __float_as_int(v))); }
__device__ __forceinline__ void attn_phase(PRef p, int l, LAS unsigned char* lds) {
    const int wave = __builtin_amdgcn_readfirstlane((int)threadIdx.x >> 6);
    const bool last = (l == DEPTH - 1);
    const int vcu = ((int)blockIdx.x % 8) * (NBLOCKS / 8) + (int)blockIdx.x / 8;
    const int nunits = NLAT + (last ? 0 : B * AH * NCQ);
    const float qscale = 0.14724420716f;
    const bf16* Qg = wQ(p.out); const bf16* KNg = wKN(p.out); const bf16* KRg = wKR(p.ws); const bf16* VTg = wVT(p.out); const float* ROPEg = wROPET(p.ws); bf16* Og = wH(p.ws);
    for (int u = vcu; u < nunits; u += NBLOCKS) {
        int tid_ = threadIdx.x; asm volatile("" : "+v"(tid_));
        const int tid = tid_, lane = tid & 63, i16 = lane & 15, g = lane >> 4;
        const bool isctx = u >= NLAT;
        int b, hd, nkeys; long q0;
        if (!isctx) { b = u / (AH * NQB); hd = (u / NQB) % AH; q0 = (long)b * RPB + CTX + (long)(u % NQB) * QBLK; nkeys = RPB; }
        else { const int uu = u - NLAT; b = uu / (AH * NCQ); hd = (uu / NCQ) % AH; q0 = (long)b * RPB + (long)(uu % NCQ) * QBLK; nkeys = CTX; }
        const long k0 = (long)b * RPB;
        const long qw = q0 + wave * 32;
        bf16x8 qf[2][3];
#pragma unroll
        for (int qb = 0; qb < 2; ++qb) {
            const bf16* qp = (Qg + qw * QW + hd * (NOPE + ROPE)) + (unsigned)((qb * 16 + i16) * QW + g * 8);
            u32x4 raw[3];
#pragma unroll
            for (int ks = 0; ks < 3; ++ks) raw[ks] = *(const u32x4*)(qp + ks * 32);
#pragma unroll
            for (int ks = 0; ks < 2; ++ks) { u32x4 w;
#pragma unroll
                for (int e = 0; e < 4; ++e) w[e] = pk(bfl(raw[ks][e]) * qscale, bfh(raw[ks][e]) * qscale);
                qf[qb][ks] = __builtin_bit_cast(bf16x8, w); }
            u32x4 w2;
            if (!isctx) {
                u32x4 pr;
#pragma unroll
                for (int e = 0; e < 4; ++e) pr[e] = (unsigned)__builtin_amdgcn_ds_bpermute((lane ^ 32) << 2, (int)raw[2][e]);
                const float* tb = (ROPEg + (qw - k0 - CTX) * 32) + (unsigned)((qb * 16 + i16) * 32 + 16 * (g & 1));
                const float sg = g < 2 ? -1.0f : 1.0f;
#pragma unroll
                for (int e = 0; e < 4; ++e) { const f32x4 cs = *(const f32x4*)(tb + 4 * e);
                    const float m0 = bfl(raw[2][e]), m1 = bfh(raw[2][e]), o0 = bfl(pr[e]), o1 = bfh(pr[e]);
                    w2[e] = pk((m0 * cs[0] + sg * o0 * cs[1]) * qscale, (m1 * cs[2] + sg * o1 * cs[3]) * qscale); }
            } else {
#pragma unroll
                for (int e = 0; e < 4; ++e) w2[e] = pk(bfl(raw[2][e]) * qscale, bfh(raw[2][e]) * qscale);
            }
            qf[qb][2] = __builtin_bit_cast(bf16x8, w2);
        }
        const bf16* knb = KNg + k0 * AW + hd * NOPE; const bf16* krb = KRg + k0 * ROPE; const bf16* vb = VTg + (long)hd * AV * R + k0;
        const unsigned kn_off0 = (unsigned)((tid >> 3) * AW + (tid & 7) * 8), kn_off1 = kn_off0 + 64u * AW, kr_off = (unsigned)((tid >> 2) * ROPE + (tid & 3) * 8);
        const unsigned v_off0 = (unsigned)((tid >> 4) * R + (tid & 15) * 8), v_off1 = v_off0 + 32u * R;
        const int kn_dst0 = (tid >> 3) * KROW + (tid & 7) * 16, kn_dst1 = kn_dst0 + 64 * KROW, kr_dst = (tid >> 2) * KROW + 128 + (tid & 3) * 16;
        const int v_dst0 = 2 * KT_BYTES + (tid >> 4) * VROW + (tid & 15) * 16, v_dst1 = v_dst0 + 32 * VROW;
        const int nt = nkeys / TK;
        f32x4 O[2][4];
#pragma unroll
        for (int qb = 0; qb < 2; ++qb)
#pragma unroll
            for (int dvt = 0; dvt < 4; ++dvt) O[qb][dvt] = (f32x4){0.f, 0.f, 0.f, 0.f};
        float mrun[2] = {0.f, 0.f}, lsum[2] = {0.f, 0.f};
        f32x4 negm[2] = {(f32x4){0.f, 0.f, 0.f, 0.f}, (f32x4){0.f, 0.f, 0.f, 0.f}};
        const int kfo = i16 * KROW + g * 16, vfo = 2 * KT_BYTES + i16 * VROW + g * 16;
        u32x4 s1, s2, s3, s4, s5;
        auto load_stage = [&](int tt) { s1 = *(const u32x4*)(knb + (long)tt * TK * AW + kn_off0); s2 = *(const u32x4*)(knb + (long)tt * TK * AW + kn_off1); s3 = *(const u32x4*)(krb + (long)tt * TK * ROPE + kr_off);
            s4 = *(const u32x4*)(vb + (long)tt * TK + v_off0); s5 = *(const u32x4*)(vb + (long)tt * TK + v_off1); };
        auto store_stage = [&](int buf) { const int nk = buf * KT_BYTES, nv = buf * VT_BYTES;
            *(LAS u32x4*)(lds + nk + kn_dst0) = s1; *(LAS u32x4*)(lds + nk + kn_dst1) = s2; *(LAS u32x4*)(lds + nk + kr_dst) = s3; *(LAS u32x4*)(lds + nv + v_dst0) = s4; *(LAS u32x4*)(lds + nv + v_dst1) = s5; };
        auto subtile = [&](int kb_off, int vb_off, bool first) {
            bf16x8 kf[12];
#pragma unroll
            for (int kb = 0; kb < 4; ++kb)
#pragma unroll
                for (int ks = 0; ks < 3; ++ks) kf[kb * 3 + ks] = *(const LAS bf16x8*)(lds + kb_off + kb * 16 * KROW + ks * 64);
            asm volatile("s_waitcnt lgkmcnt(0)" : "+v"(kf[0]), "+v"(kf[1]), "+v"(kf[2]), "+v"(kf[3]), "+v"(kf[4]), "+v"(kf[5]), "+v"(kf[6]), "+v"(kf[7]), "+v"(kf[8]), "+v"(kf[9]), "+v"(kf[10]), "+v"(kf[11]) :: "memory");
            f32x4 S[2][4];
#pragma unroll
            for (int kb = 0; kb < 4; ++kb)
#pragma unroll
                for (int ks = 0; ks < 3; ++ks) {
                    S[0][kb] = __builtin_amdgcn_mfma_f32_16x16x32_bf16(kf[kb * 3 + ks], qf[0][ks], ks == 0 ? negm[0] : S[0][kb], 0, 0, 0);
                    S[1][kb] = __builtin_amdgcn_mfma_f32_16x16x32_bf16(kf[kb * 3 + ks], qf[1][ks], ks == 0 ? negm[1] : S[1][kb], 0, 0, 0); }
            bf16x8 vf[8];
#pragma unroll
            for (int dvt = 0; dvt < 4; ++dvt)
#pragma unroll
                for (int kp = 0; kp < 2; ++kp) vf[dvt * 2 + kp] = *(const LAS bf16x8*)(lds + vb_off + dvt * 16 * VROW + kp * 64);
            asm volatile("" ::: "memory");
            bf16x8 pf[2][2];
#pragma unroll
            for (int qb = 0; qb < 2; ++qb) {
                float mx = S[qb][0][0];
#pragma unroll
                for (int kb = 0; kb < 4; ++kb)
#pragma unroll
                    for (int e = 0; e < 4; ++e) mx = fmaxf(mx, S[qb][kb][e]);
                if (first || __builtin_amdgcn_ballot_w64(mx > 8.0f) != 0ull) {
                    mx = fmaxf(mx, xl(mx, lane, 16)); mx = fmaxf(mx, xl(mx, lane, 32));
                    const float d = first ? mx : fmaxf(mx, 0.0f), corr = first ? 1.0f : __builtin_amdgcn_exp2f(-d);
                    mrun[qb] += d; lsum[qb] *= corr; negm[qb] = (f32x4){-mrun[qb], -mrun[qb], -mrun[qb], -mrun[qb]};
#pragma unroll
                    for (int dvt = 0; dvt < 4; ++dvt) O[qb][dvt] = O[qb][dvt] * corr;
#pragma unroll
                    for (int kb = 0; kb < 4; ++kb) S[qb][kb] = S[qb][kb] - d;
                }
                float ps = 0.f;
#pragma unroll
                for (int kb = 0; kb < 4; ++kb)
#pragma unroll
                    for (int e = 0; e < 4; ++e) { const float ex = __builtin_amdgcn_exp2f(S[qb][kb][e]); S[qb][kb][e] = ex; ps += ex; }
                lsum[qb] += ps;
#pragma unroll
                for (int kp = 0; kp < 2; ++kp) { u32x4 w; w[0] = pk(S[qb][2 * kp][0], S[qb][2 * kp][1]); w[1] = pk(S[qb][2 * kp][2], S[qb][2 * kp][3]); w[2] = pk(S[qb][2 * kp + 1][0], S[qb][2 * kp + 1][1]); w[3] = pk(S[qb][2 * kp + 1][2], S[qb][2 * kp + 1][3]);
                    pf[qb][kp] = __builtin_bit_cast(bf16x8, w); }
            }
            asm volatile("s_waitcnt lgkmcnt(0)" : "+v"(vf[0]), "+v"(vf[1]), "+v"(vf[2]), "+v"(vf[3]), "+v"(vf[4]), "+v"(vf[5]), "+v"(vf[6]), "+v"(vf[7]) :: "memory");
#pragma unroll
            for (int dvt = 0; dvt < 4; ++dvt)
#pragma unroll
                for (int kp = 0; kp < 2; ++kp) {
                    O[0][dvt] = __builtin_amdgcn_mfma_f32_16x16x32_bf16(vf[dvt * 2 + kp], pf[0][kp], O[0][dvt], 0, 0, 0);
                    O[1][dvt] = __builtin_amdgcn_mfma_f32_16x16x32_bf16(vf[dvt * 2 + kp], pf[1][kp], O[1][dvt], 0, 0, 0); }
        };
        load_stage(0); store_stage(0);
        __syncthreads();
        for (int t = 0; t < nt; ++t) {
            const int buf = t & 1;
            if (t + 1 < nt) load_stage(t + 1);
#pragma unroll
            for (int sub = 0; sub < TK / 64; ++sub) subtile(buf * KT_BYTES + sub * 64 * KROW + kfo, buf * VT_BYTES + sub * 128 + vfo, sub == 0 && t == 0);
            if (t + 1 < nt) store_stage(buf ^ 1);
            __syncthreads();
        }
#pragma unroll
        for (int qb = 0; qb < 2; ++qb) {
            float lt = lsum[qb]; lt += xl(lt, lane, 16); lt += xl(lt, lane, 32); const float inv = 1.0f / lt;
            bf16* op = (Og + qw * D + hd * AV) + (unsigned)((qb * 16 + i16) * D + 4 * g);
#pragma unroll
            for (int dvt = 0; dvt < 4; ++dvt) { u32x2 w; w.x = pk(O[qb][dvt][0] * inv, O[qb][dvt][1] * inv); w.y = pk(O[qb][dvt][2] * inv, O[qb][dvt][3] * inv); *(u32x2*)(op + dvt * 16) = w; }
        }
    }
}
}
#endif

#ifndef HOST_EMU
namespace mlk {
typedef short bf16x8 __attribute__((ext_vector_type(8)));
typedef float f32x16 __attribute__((ext_vector_type(16)));
typedef float f32x4 __attribute__((ext_vector_type(4)));
typedef unsigned u32x4 __attribute__((ext_vector_type(4)));
typedef unsigned u32x2 __attribute__((ext_vector_type(2)));
static_assert(SCS == 256 && MD == 64, "mlstm MFMA phases: 256-row super-chunks, head dim 64");
constexpr int KP = 144, TP = 528;
constexpr int O_KL = 0, O_VT = 256 * KP, O_CT = O_VT + 64 * TP, O_FG = O_CT + 2 * 64 * KP, O_NL = O_FG + 2 * 2 * 256 * 4, O_END = O_NL + 2 * 64 * 4;
constexpr int B_KT = 0, B_VT = 64 * TP, B_WL = 2 * 64 * TP, B_END = B_WL + 2 * 256 * 4;
constexpr float LOG2E = 1.4426950408889634f;
__device__ __forceinline__ float bfl(unsigned w) { return __uint_as_float(w << 16); }
__device__ __forceinline__ float bfh(unsigned w) { return __uint_as_float(w & 0xFFFF0000u); }
__device__ __forceinline__ unsigned pk(float lo, float hi) { unsigned r; asm volatile("v_cvt_pk_bf16_f32 %0, %1, %2" : "=v"(r) : "v"(lo), "v"(hi)); return r; }
__device__ __forceinline__ float xl32(float v, int lane) { return __int_as_float(__builtin_amdgcn_ds_bpermute((lane ^ 32) << 2, __float_as_int(v))); }
__device__ __forceinline__ int kpos(int key) { return (key & ~15) | swap23(key & 15); }
__device__ __forceinline__ void stage_t(LAS unsigned char* img, const u32x4 v, int dim0, int key) {
    const int kb = kpos(key) * 2;
#pragma unroll
    for (int e = 0; e < 4; ++e) { *(LAS unsigned short*)(img + (dim0 + 2 * e) * TP + kb) = (unsigned short)(v[e] & 0xFFFFu); *(LAS unsigned short*)(img + (dim0 + 2 * e + 1) * TP + kb) = (unsigned short)(v[e] >> 16); }
}
__device__ __forceinline__ void ml_b_phase(PRef p, LAS unsigned char* lds) {
    const int wave = __builtin_amdgcn_readfirstlane((int)threadIdx.x >> 6);
    for (int u = ((((int)blockIdx.x % 8) + 6) % 8) * (NBLOCKS / 8) + (int)blockIdx.x / 8; u < B * MH * SCN; u += NBLOCKS) {
        int tid_ = threadIdx.x; asm volatile("" : "+v"(tid_)); const int tid = tid_, lane = tid & 63, r = lane & 31, hh = lane >> 5;
        const int sc = u % SCN, h = (u / SCN) % MH, b = u / (SCN * MH); const long r0 = (long)b * RPB + (long)sc * SCS;
        const bf16* kg = wMQK(p.ws) + r0 * 2 * MW + MW + h * MD; const bf16* vg = wP(p.ws) + r0 * NP + ML_LO + MW + h * MD; const float* fg = wFG(p.ws);
#pragma unroll
        for (int i = 0; i < 4; ++i) { const int ci = tid + 512 * i, key = ci >> 3, part = ci & 7;
            stage_t(lds + B_KT, *(const u32x4*)(kg + (unsigned)(key * 2 * MW + part * 8)), part * 8, key);
            stage_t(lds + B_VT, *(const u32x4*)(vg + (unsigned)(key * NP + part * 8)), part * 8, key); }
        { const int dir = tid >> 8, key = tid & 255; const long rend = dir == 0 ? r0 + SCS - 1 : r0;
          const float Fend = fg[((rend * 2 + dir) * MH + h) * 2], G = fg[(((r0 + key) * 2 + dir) * MH + h) * 2 + 1];
          *(LAS float*)(lds + B_WL + (dir * 256 + kpos(key)) * 4) = __builtin_amdgcn_exp2f((Fend - G) * LOG2E); }
        __syncthreads();
        const int dir = wave >> 2, dvb = (wave >> 1) & 1, kb = wave & 1;
        f32x16 acc;
#pragma unroll
        for (int i = 0; i < 16; ++i) acc[i] = 0.f;
        float nacc = 0.f;
#pragma unroll 4
        for (int ks = 0; ks < 16; ++ks) {
            const bf16x8 vf = *(const LAS bf16x8*)(lds + B_VT + (dvb * 32 + r) * TP + ks * 32 + hh * 16);
            const u32x4 kr = *(const LAS u32x4*)(lds + B_KT + (kb * 32 + r) * TP + ks * 32 + hh * 16);
            const f32x4 w0 = *(const LAS f32x4*)(lds + B_WL + (dir * 256 + ks * 16 + hh * 8) * 4), w1 = *(const LAS f32x4*)(lds + B_WL + (dir * 256 + ks * 16 + hh * 8 + 4) * 4);
            const float k0 = bfl(kr[0]) * w0[0], k1 = bfh(kr[0]) * w0[1], k2 = bfl(kr[1]) * w0[2], k3 = bfh(kr[1]) * w0[3], k4 = bfl(kr[2]) * w1[0], k5 = bfh(kr[2]) * w1[1], k6 = bfl(kr[3]) * w1[2], k7 = bfh(kr[3]) * w1[3];
            nacc += ((k0 + k1) + (k2 + k3)) + ((k4 + k5) + (k6 + k7));
            u32x4 kw; kw[0] = pk(k0, k1); kw[1] = pk(k2, k3); kw[2] = pk(k4, k5); kw[3] = pk(k6, k7);
            acc = __builtin_amdgcn_mfma_f32_32x32x16_bf16(vf, __builtin_bit_cast(bf16x8, kw), acc, 0, 0, 0);
        }
        float* ms = wMS(p.ws) + ((((long)b * MH + h) * 2 + dir) * SCN + sc) * (MD + 1) * MD;
#pragma unroll
        for (int g = 0; g < 4; ++g) { f32x4 o; o[0] = acc[4 * g]; o[1] = acc[4 * g + 1]; o[2] = acc[4 * g + 2]; o[3] = acc[4 * g + 3];
            *(f32x4*)(ms + (unsigned)((kb * 32 + r) * MD + dvb * 32 + 8 * g + 4 * hh)) = o; }
        const float nt = nacc + xl32(nacc, lane);
        if (dvb == 0 && hh == 0) ms[MD * MD + kb * 32 + r] = nt;
        __syncthreads();
    }
}
__device__ __forceinline__ void ml_o_phase(PRef p, int l, LAS unsigned char* lds) {
    const int wave = __builtin_amdgcn_readfirstlane((int)threadIdx.x >> 6);
    const bool last = (l == DEPTH - 1);
    for (int u = blockIdx.x; u < B * MH * SCN; u += NBLOCKS) {
        const int sc = u % SCN, h = (u / SCN) % MH, b = u / (SCN * MH);
        if (last && sc < NCS) continue;
        int tid_ = threadIdx.x; asm volatile("" : "+v"(tid_)); const int tid = tid_, lane = tid & 63, r = lane & 31, hh = lane >> 5;
        const long r0 = (long)b * RPB + (long)sc * SCS;
        const bf16* qg = wMQK(p.ws) + r0 * 2 * MW + h * MD; const bf16* kg = qg + MW; const bf16* pg = wP(p.ws) + r0 * NP + ML_LO + h * MD; const float* fg = wFG(p.ws);
        const float* msb = wMS(p.ws) + (((long)b * MH + h) * 2 * SCN + sc) * (MD + 1) * MD;
#pragma unroll
        for (int i = 0; i < 4; ++i) { const int ci = tid + 512 * i, key = ci >> 3, part = ci & 7;
            *(LAS u32x4*)(lds + O_KL + key * KP + part * 16) = *(const u32x4*)(kg + (unsigned)(key * 2 * MW + part * 8));
            stage_t(lds + O_VT, *(const u32x4*)(pg + (unsigned)(key * NP + MW + part * 8)), part * 8, key); }
#pragma unroll
        for (int i = 0; i < 4; ++i) { const int ci = tid + 512 * i, dir = ci >> 10, kdim = (ci >> 4) & 63, d4 = ci & 15;
            const f32x4 c = *(const f32x4*)(msb + (unsigned)(dir * SCN * (MD + 1) * MD + kdim * MD + d4 * 4));
#pragma unroll
            for (int e = 0; e < 4; ++e) *(LAS unsigned short*)(lds + O_CT + (dir * 64 + d4 * 4 + e) * KP + kdim * 2) = (unsigned short)f2bf(c[e]); }
        if (tid < 128) { const int dir = tid >> 6, kdim = tid & 63; *(LAS float*)(lds + O_NL + tid * 4) = msb[(unsigned)(dir * SCN * (MD + 1) * MD + MD * MD + kdim)]; }
        { const int dir = tid >> 8, key = tid & 255; const float F = fg[(((r0 + key) * 2 + dir) * MH + h) * 2], G = fg[(((r0 + key) * 2 + dir) * MH + h) * 2 + 1];
          *(LAS float*)(lds + O_FG + ((dir * 2 + 0) * 256 + key) * 4) = F * LOG2E; *(LAS float*)(lds + O_FG + ((dir * 2 + 1) * 256 + key) * 4) = G * LOG2E; }
        bf16x8 qf[4];
#pragma unroll
        for (int ks = 0; ks < 4; ++ks) qf[ks] = *(const bf16x8*)(qg + (unsigned)((wave * 32 + r) * 2 * MW + ks * 16 + hh * 8));
        __syncthreads();
        f32x16 hs[2];
#pragma unroll
        for (int dvb = 0; dvb < 2; ++dvb)
#pragma unroll
            for (int i = 0; i < 16; ++i) hs[dvb][i] = 0.f;
#pragma unroll 1
        for (int dir = 0; dir < 2; ++dir) {
            const float Ft = *(const LAS float*)(lds + O_FG + ((dir * 2 + 0) * 256 + wave * 32 + r) * 4);
            f32x16 O[2];
#pragma unroll
            for (int dvb = 0; dvb < 2; ++dvb)
#pragma unroll
                for (int i = 0; i < 16; ++i) O[dvb][i] = 0.f;
            float den = 0.f;
            const int kt0 = dir == 0 ? 0 : wave, kt1 = dir == 0 ? wave : 7;
            for (int kt = kt0; kt <= kt1; ++kt) {
                f32x16 S;
#pragma unroll
                for (int i = 0; i < 16; ++i) S[i] = 0.f;
#pragma unroll
                for (int ks = 0; ks < 4; ++ks) {
                    const bf16x8 kf = *(const LAS bf16x8*)(lds + O_KL + (kt * 32 + r) * KP + ks * 32 + hh * 16);
                    S = __builtin_amdgcn_mfma_f32_32x32x16_bf16(kf, qf[ks], S, 0, 0, 0); }
                const bool diag = (kt == wave);
#pragma unroll
                for (int g = 0; g < 4; ++g) { const f32x4 gv = *(const LAS f32x4*)(lds + O_FG + ((dir * 2 + 1) * 256 + kt * 32 + 8 * g + 4 * hh) * 4);
#pragma unroll
                    for (int e = 0; e < 4; ++e) { const int krow = 8 * g + 4 * hh + e; const bool keep = !diag || (dir == 0 ? krow <= r : krow >= r);
                        const float wgt = __builtin_amdgcn_exp2f(keep ? Ft - gv[e] : -1.0e30f); const float sw = S[4 * g + e] * wgt; S[4 * g + e] = sw; den += sw; } }
                bf16x8 pf[2];
#pragma unroll
                for (int s2 = 0; s2 < 2; ++s2) { u32x4 w;
#pragma unroll
                    for (int e = 0; e < 4; ++e) w[e] = pk(S[8 * s2 + 2 * e], S[8 * s2 + 2 * e + 1]);
                    pf[s2] = __builtin_bit_cast(bf16x8, w); }
#pragma unroll
                for (int dvb = 0; dvb < 2; ++dvb)
#pragma unroll
                    for (int s2 = 0; s2 < 2; ++s2) {
                        const bf16x8 vf = *(const LAS bf16x8*)(lds + O_VT + (dvb * 32 + r) * TP + (kt * 32 + s2 * 16) * 2 + hh * 16);
                        O[dvb] = __builtin_amdgcn_mfma_f32_32x32x16_bf16(vf, pf[s2], O[dvb], 0, 0, 0); }
            }
            f32x16 I[2];
#pragma unroll
            for (int dvb = 0; dvb < 2; ++dvb)
#pragma unroll
                for (int i = 0; i < 16; ++i) I[dvb][i] = 0.f;
            float dint = 0.f;
#pragma unroll
            for (int ks = 0; ks < 4; ++ks) {
#pragma unroll
                for (int dvb = 0; dvb < 2; ++dvb) { const bf16x8 cf = *(const LAS bf16x8*)(lds + O_CT + (dir * 64 + dvb * 32 + r) * KP + ks * 32 + hh * 16);
                    I[dvb] = __builtin_amdgcn_mfma_f32_32x32x16_bf16(cf, qf[ks], I[dvb], 0, 0, 0); }
                const u32x4 qr = __builtin_bit_cast(u32x4, qf[ks]);
                const f32x4 n0 = *(const LAS f32x4*)(lds + O_NL + (dir * 64 + ks * 16 + hh * 8) * 4), n1 = *(const LAS f32x4*)(lds + O_NL + (dir * 64 + ks * 16 + hh * 8 + 4) * 4);
                dint += (bfl(qr[0]) * n0[0] + bfh(qr[0]) * n0[1]) + (bfl(qr[1]) * n0[2] + bfh(qr[1]) * n0[3]) + (bfl(qr[2]) * n1[0] + bfh(qr[2]) * n1[1]) + (bfl(qr[3]) * n1[2] + bfh(qr[3]) * n1[3]);
            }
            const float a = __builtin_amdgcn_exp2f(Ft);
            const float dtot = (den + xl32(den, lane)) + a * (dint + xl32(dint, lane));
            const float scl = 1.0f / fmaxf(fabsf(dtot), 1.0f);
#pragma unroll
            for (int dvb = 0; dvb < 2; ++dvb)
#pragma unroll
                for (int i = 0; i < 16; ++i) hs[dvb][i] += (O[dvb][i] + a * I[dvb][i]) * scl;
        }
        const bf16* og = pg + (unsigned)((wave * 32 + r) * NP + 2 * MW + 4 * hh);
        float ss = 0.f;
#pragma unroll
        for (int dvb = 0; dvb < 2; ++dvb)
#pragma unroll
            for (int g = 0; g < 4; ++g) { const u32x2 ov = *(const u32x2*)(og + dvb * 32 + 8 * g);
                const float o0 = bfl(ov[0]), o1 = bfh(ov[0]), o2 = bfl(ov[1]), o3 = bfh(ov[1]);
                float v0 = hs[dvb][4 * g] * rcp_f(1.0f + exp_f(-o0)), v1 = hs[dvb][4 * g + 1] * rcp_f(1.0f + exp_f(-o1)), v2 = hs[dvb][4 * g + 2] * rcp_f(1.0f + exp_f(-o2)), v3 = hs[dvb][4 * g + 3] * rcp_f(1.0f + exp_f(-o3));
                hs[dvb][4 * g] = v0; hs[dvb][4 * g + 1] = v1; hs[dvb][4 * g + 2] = v2; hs[dvb][4 * g + 3] = v3; ss += (v0 * v0 + v1 * v1) + (v2 * v2 + v3 * v3); }
        ss += xl32(ss, lane);
        const float rstd = 1.0f / sqrtf(ss / (float)MD + EPS);
        const float* ng = p.ml_norm_g + l * MW + h * MD + 4 * hh; bf16* op = wH(p.ws) + (r0 + wave * 32 + r) * D + AW + h * MD + 4 * hh;
#pragma unroll
        for (int dvb = 0; dvb < 2; ++dvb)
#pragma unroll
            for (int g = 0; g < 4; ++g) { const f32x4 gg = *(const f32x4*)(ng + dvb * 32 + 8 * g); u32x2 w;
                w[0] = pk(hs[dvb][4 * g] * rstd * gg[0], hs[dvb][4 * g + 1] * rstd * gg[1]); w[1] = pk(hs[dvb][4 * g + 2] * rstd * gg[2], hs[dvb][4 * g + 3] * rstd * gg[3]);
                *(u32x2*)(op + dvb * 32 + 8 * g) = w; }
        __syncthreads();
    }
}
}
#endif
#ifndef HOST_EMU
#define XB_TMO      128
#define XB_XCNT(j)  (256  + 64 * (j))
#define XB_XSUB(j)  (1280 + 64 * (j))
#define XB_XGEN(j)  (2304 + 64 * (j))
#define XB_TOP      3328
#define XB_TOPGEN   3392
#define XCD_BAR_WORDS 3456
#define XB_SPIN_CAP (1u << 18)

__device__ __forceinline__ unsigned xb_ld(unsigned* p)              { return __hip_atomic_load(p, __ATOMIC_RELAXED, __HIP_MEMORY_SCOPE_AGENT); }
__device__ __forceinline__ unsigned xb_add(unsigned* p, unsigned v) { return __hip_atomic_fetch_add(p, v, __ATOMIC_RELAXED, __HIP_MEMORY_SCOPE_AGENT); }
__device__ __forceinline__ unsigned xb_xcc_id() { return (unsigned)__builtin_amdgcn_s_getreg((3 << 11) | 20) & 0xFu; }
#define XB_SPIN(cond, bar) do { unsigned _sp = 0; while (cond) { __builtin_amdgcn_s_sleep(1); \
    if ((++_sp & 255u) == 0u) { if (xb_ld(&(bar)[XB_TMO])) break; if (_sp > XB_SPIN_CAP) { atomicAdd(&(bar)[XB_TMO], 1u); break; } } } } while (0)

struct XcdBarrier { unsigned* bar; unsigned x; volatile LAS unsigned* st; };

__device__ __forceinline__ XcdBarrier xcd_barrier_post(unsigned* bar, volatile LAS unsigned* st) {
    XcdBarrier b; b.bar = bar; b.x = xb_xcc_id(); b.st = st;
    if (threadIdx.x == 0) (void)xb_add(&bar[XB_XCNT(b.x)], 1u);
    return b;
}
__device__ __forceinline__ void xcd_barrier_complete(unsigned* bar, unsigned x, unsigned& nloc, unsigned& nx) {
    const unsigned G = gridDim.x * gridDim.y * gridDim.z;
    unsigned sum, cnt, mine, sp = 0u;
    for (;;) {
        sum = 0u; cnt = 0u; mine = 0u;
#pragma unroll
        for (unsigned j = 0; j < 16; ++j) { const unsigned c = xb_ld(&bar[XB_XCNT(j)]); sum += c; cnt += (c > 0u) ? 1u : 0u; mine = (j == x) ? c : mine; }
        if (sum == G) break;
        __builtin_amdgcn_s_sleep(1);
        if ((++sp & 255u) == 0u) { if (xb_ld(&bar[XB_TMO])) break; if (sp > XB_SPIN_CAP) { atomicAdd(&bar[XB_TMO], 1u); break; } }
    }
    nloc = mine > 0u ? mine : 1u; nx = cnt > 0u ? cnt : 1u;
}
__device__ __forceinline__ void xcd_barrier(const XcdBarrier& b) {
    asm volatile("s_waitcnt vmcnt(0)" ::: "memory");
    __syncthreads();
    if (threadIdx.x == 0) {
        unsigned* bar = b.bar;
        __builtin_amdgcn_s_waitcnt(0);
        unsigned nloc = b.st[0], nx = b.st[1];
        if (nloc == 0u) { xcd_barrier_complete(bar, b.x, nloc, nx); b.st[0] = nloc; b.st[1] = nx; }
        const unsigned old = xb_add(&bar[XB_XSUB(b.x)], 1u);
        const unsigned gen = old / nloc;
        if (old + 1u == (gen + 1u) * nloc) {
            __builtin_amdgcn_fence(__ATOMIC_RELEASE, "agent");
            asm volatile("s_waitcnt vmcnt(0)" ::: "memory");
            const unsigned og = xb_add(&bar[XB_TOP], 1u);
            const unsigned tg = og / nx;
            if (og + 1u == (tg + 1u) * nx) xb_add(&bar[XB_TOPGEN], 1u);
            else XB_SPIN(xb_ld(&bar[XB_TOPGEN]) == tg, bar);
            __builtin_amdgcn_fence(__ATOMIC_ACQUIRE, "agent");
            xb_add(&bar[XB_XGEN(b.x)], 1u);
            asm volatile("s_waitcnt vmcnt(0)" ::: "memory");
        } else {
            XB_SPIN(xb_ld(&bar[XB_XGEN(b.x)]) == gen, bar);
            __builtin_amdgcn_fence(__ATOMIC_ACQUIRE, "agent");
            asm volatile("s_waitcnt vmcnt(0)" ::: "memory");
        }
    }
    __syncthreads();
}
#endif

constexpr int UPT = (R + 253) / 254;
constexpr int LDS_BYTES = 163840;

#ifdef HOST_EMU
#define ATT_PHASE(l) RUN(PH_ATT, l, 0)
#define NORM1_PHASE(l) RUN(PH_NORM1, l, 0)
#define FILT_B_PHASE(l) RUN(PH_FILT_B, l, 0)
#define FILT_C_PHASE(l) RUN(PH_FILT_C, l, 0)
#define ML_B_PHASE(l) RUN(PH_ML_B, l, 0)
#define ML_O_PHASE(l) RUN(PH_ML_O, l, 0)
#define NORM2_PHASE(l) RUN(PH_NORM2, l, 0)
#define FINAL_PHASE() RUN(PH_FINAL, 0, 0)
#define MLA_A_PHASE(l) RUN(PH_MLA_A, l, 0)
#define ML_F_PHASE(l) RUN(PH_ML_F, l, 0)
#define GEMM_GEMM1(l) RUN(PH_GEMM1, l, 0)
#define GEMM_Q(l) RUN(PH_MLA_Q, l, 0)
#define GEMM_KV(l) RUN(PH_MLA_KV, l, 0)
#define GEMM_MLQK(l) RUN(PH_ML_QK, l, 0)
#define GEMM_OUT(l) RUN(PH_GEMM_OUT, l, 0)
#else
#define KARG() const Params __attribute__((address_space(4)))* kp_ = (const Params __attribute__((address_space(4)))*)__builtin_amdgcn_kernarg_segment_ptr(); asm volatile("" : "+s"(kp_)); PRef p = *kp_
#define LAT_ 0
#define GEMM_LAT(l, EPI, A_, lda_, Bt_, ldb_, N_, K_, rot, ...) do { KARG(); const int lat_ = ((l) == DEPTH - 1) && (SEQ % 256 == 0) && (CTX % 256 == 0); pg8::Gemm g_{(const bf16*)(A_), (const bf16*)(Bt_), lda_, ldb_, lat_ ? B * SEQ : R, N_, K_, 256}; \
    pg8::StaticOrder S_; S_.init(lat_ ? B * SEQ : R, N_, NBLOCKS, ((int)blockIdx.x + (rot)) % NBLOCKS, lat_); pg8::EPI E_{__VA_ARGS__}; pg8::gemm_phase<pg8::EPI, pg8::StaticOrder, true, true>((LAS unsigned char*)lds, g_, S_, E_); } while (0)
#define GEMM_CALL(EPI, A_, lda_, Bt_, ldb_, M_, N_, K_, rot, ...) GEMM_CALLX(true, EPI, A_, lda_, Bt_, ldb_, M_, N_, K_, rot, __VA_ARGS__)
#define GEMM_CALLX(SP2_, EPI, A_, lda_, Bt_, ldb_, M_, N_, K_, rot, ...) do { KARG(); pg8::Gemm g_{(const bf16*)(A_), (const bf16*)(Bt_), lda_, ldb_, M_, N_, K_, 256}; pg8::StaticOrder S_; S_.init(M_, N_, NBLOCKS, ((int)blockIdx.x + (rot)) % NBLOCKS, LAT_); \
    pg8::EPI E_{__VA_ARGS__}; pg8::gemm_phase<pg8::EPI, pg8::StaticOrder, true, SP2_>((LAS unsigned char*)lds, g_, S_, E_); } while (0)
#define ATT_PHASE(l) do { KARG(); att::attn_phase(p, l, (LAS unsigned char*)lds); } while (0)
#define NORM1_PHASE(l) do { KARG(); wv::norm_rows<0>(p, l); } while (0)
#define FILT_B_PHASE(l) do { KARG(); wv::filt_b_block(p, l, (LAS unsigned char*)lds); } while (0)
#define FILT_C_PHASE(l) do { KARG(); wv::filt_c_block(p, l, (LAS unsigned char*)lds); } while (0)
#define ML_B_PHASE(l) do { KARG(); mlk::ml_b_phase(p, (LAS unsigned char*)lds); } while (0)
#define ML_O_PHASE(l) do { KARG(); mlk::ml_o_phase(p, l, (LAS unsigned char*)lds); } while (0)
#define NORM2_PHASE(l) do { KARG(); wv::norm_rows<1>(p, l); } while (0)
#define FINAL_PHASE() do { KARG(); wv::norm_rows<2>(p, 0); } while (0)
#define MLA_A_PHASE(l) do { KARG(); wv::mla_a_rows(p); } while (0)
#define ML_F_PHASE(l) do { KARG(); wv::ml_f_rows(p, l); } while (0)
#define GEMM_GEMM1(l) GEMM_CALL(EpiBf16, wH(p.ws), D, wWinT(p.ws, l), D, R, NP, D, 0, wP(p.ws), NP, nullptr, 0)
#define GEMM_Q(l) GEMM_CALL(EpiBf16, wP(p.ws), NP, wWuqT(p.ws, l), QR, R, QW, QR, 0, wQ(p.out), QW, wRS(p.ws), 1)
#define GEMM_KV(l) do { GEMM_CALL(EpiBf16, wP(p.ws) + QR, NP, wWukvT(p.ws, l), KVR, R, AW, KVR, (R / 256 * (QW / 256)) % NBLOCKS, wKN(p.out), AW, wRS(p.ws) + R, 1); \
    GEMM_CALLX(false, EpiVT, wWukvT(p.ws, l) + (size_t)AW * KVR, KVR, wP(p.ws) + QR, NP, AW, R, KVR, (R / 256 * ((QW + AW) / 256)) % NBLOCKS, wVT(p.out), wRS(p.ws) + R); } while (0)
#define GEMM_MLQK(l) GEMM_CALL(EpiBf16, wMU(p.ws), MW, wWML(p.ws), MW, R, 2 * MW, MW, (R / 256 * ((QW + 2 * AW) / 256)) % NBLOCKS, wMQK(p.ws), 2 * MW, nullptr, 0)
#define GEMM_OUT(l) GEMM_LAT(l, EpiResid, wH(p.ws), D, wWoutT(p.ws, l), D, D, D, 0, wX(p.ws), wMOD(p.ws) + (size_t)(l) * (B + 1) * 6 * D + 2 * D, nullptr, DRY_)
#define GEMM_UP(l) do { KARG(); pg8::Gemm g_{(const bf16*)(wH(p.ws) - D), (const bf16*)wWupT(p.ws, l), D, D, UPT * 256, FF2, D, 254}; pg8::StaticOrder S_; S_.init(UPT * 256, FF2, NBLOCKS, (int)blockIdx.x); \
    pg8::EpiConvGate E_{wGF(p.ws), p.ffn_conv_w + (size_t)(l) * 3 * FF2, p.ffn_conv_b + (size_t)(l) * FF2, (LAS unsigned char*)lds + pg8::STAGE_BYTES}; pg8::gemm_phase<pg8::EpiConvGate, pg8::StaticOrder, true, true>((LAS unsigned char*)lds, g_, S_, E_); } while (0)
#define GEMM_DOWN(l) GEMM_LAT(l, EpiResid, wGF(p.ws), FF, wWdownT(p.ws, l), FF, D, FF, 0, wX(p.ws), wMOD(p.ws) + (size_t)(l) * (B + 1) * 6 * D + 5 * D, nullptr, DRY_)
#endif
#ifdef HOST_EMU
#define GRID_BAR() do {} while (0)
#define FILL_W(ln, busy, i0, i1, filt) do { const int i0_ = (i0), i1_ = (i1); emu_block_launch(i1_ - i0_, [&](int blk, unsigned char* smem) { bphase<BPH_WCVT>(p, ln, i0_ + blk, smem); }); if (filt) RUN(PH_FILT_A, ln, 0); } while (0)
#define RUN(PH, l, arg) emu_launch([&](long gtid, long gth) { phase<PH>(p, l, arg, gtid, gth); })
#define BRUN(BPH, l, nblk) emu_block_launch(nblk, [&](int blk, unsigned char* smem) { bphase<BPH>(p, l, blk, smem); })
#define BRUN_OFF(BPH, l, nblk, busy) BRUN(BPH, l, nblk)
static void fwd(const Params& p) {
#else
#define GRID_BAR() xcd_barrier(bar)
#define DRY_ 0
#define BRUN(BPH, l, nblk) do { KARG(); for (int blk_ = blockIdx.x; blk_ < (nblk); blk_ += NBLOCKS) bphase<BPH>(p, l, blk_, (LdsPtr)lds); } while (0)
#define BRUN_OFF(BPH, l, nblk, busy) do { KARG(); const int busy_ = (busy); if ((int)blockIdx.x >= busy_) for (int blk_ = (int)blockIdx.x - busy_; blk_ < (nblk); blk_ += NBLOCKS - busy_) bphase<BPH>(p, l, blk_, (LdsPtr)lds); } while (0)
#define FILL_W(ln, busy, i0, i1, filt) do { KARG(); const int busy_ = (busy), nf_ = NBLOCKS - busy_, i1_ = (i1); __syncthreads(); if ((int)blockIdx.x >= busy_) { for (int blk_ = (i0) + (int)blockIdx.x - busy_; blk_ < i1_; blk_ += nf_) bphase<BPH_WCVT>(p, ln, blk_, (LdsPtr)lds); \
    if (filt) { int t_ = threadIdx.x; asm volatile("" : "+v"(t_)); phase<PH_FILT_A>(p, ln, 0, (long)((int)blockIdx.x - busy_) * NTHREADS + t_, (long)nf_ * NTHREADS); } } } while (0)
#define RUN(PH, l, arg) do { KARG(); int t_ = threadIdx.x; asm volatile("" : "+v"(t_)); const int g_ = blockIdx.x * NTHREADS + t_; phase<PH>(p, l, arg, (long)g_, gth); } while (0)
__global__ void __launch_bounds__(NTHREADS, 2) fwd(Params p_unused) {
    extern __shared__ __attribute__((aligned(16))) unsigned char lds[];
    if (threadIdx.x < 4) ((LAS unsigned*)lds)[(LDS_BYTES - 16) / 4 + threadIdx.x] = 0u;
    __syncthreads();
    XcdBarrier bar; { KARG(); bar = xcd_barrier_post(wctl(p.ws) + 1024, (volatile LAS unsigned*)(lds + LDS_BYTES - 16)); }
    constexpr long gth = (long)NBLOCKS * NTHREADS;
#endif
    RUN(PH_MOD, 0, 0); RUN(PH_ROPE, 0, 0);
    GRID_BAR();
    RUN(PH_MOD2, 0, 0);
    for (int hs = 0; hs <= 2 * DEPTH; ++hs) {
        const int l = (hs - 1) >> 1;
        if (hs >= 1 && (hs & 1)) {
            NORM1_PHASE(l); FILT_B_PHASE(l);
            GRID_BAR();
            GEMM_GEMM1(l); FILT_C_PHASE(l);
            GRID_BAR();
            MLA_A_PHASE(l); if (l < DEPTH - 1) RUN(PH_HY_Z, l, 0); BRUN(BPH_HYZ, l, B * (SEQ / 64)); RUN(PH_FILT_D, l, 0); RUN(PH_ML_U, l, 0); ML_F_PHASE(l);
            GRID_BAR();
            GEMM_Q(l); GEMM_KV(l); GEMM_MLQK(l); BRUN(BPH_HFFT, l, HW); if (l < DEPTH - 1) BRUN(BPH_HYCTX, l, B * (HW / 8));
            GRID_BAR();
            ATT_PHASE(l); ML_B_PHASE(l);
            GRID_BAR();
            RUN(PH_ML_S, l, 0); BRUN(BPH_HYFFT, l, HW);
            GRID_BAR();
            ML_O_PHASE(l); BRUN_OFF(BPH_HYOUT, l, B * (SEQ / 64), l < DEPTH - 1 ? (B * MH * SCN) % NBLOCKS : 0);
            GRID_BAR();
            GEMM_OUT(l);
        }
        if (hs >= 2 && !(hs & 1)) {
            NORM2_PHASE(l);
            GRID_BAR();
#ifdef HOST_EMU
            for (int fcI = 0; fcI < NFC; ++fcI) { RUN(PH_FFN_UP, l, fcI); RUN(PH_FFN_CG, l, fcI); RUN(PH_FFN_DOWN, l, fcI); }
#else
            GEMM_UP(l);
            GRID_BAR();
            GEMM_DOWN(l);
#endif
        }
        {
            int fl = 0, busy = 0, i0 = 0, i1 = 0, filt = 0;
            if (hs == 0) { i1 = WT_SPLIT; filt = 1; }
            else if (hs == 1) { busy = DOWN_BUSY; i0 = WT_SPLIT; i1 = WT_ITEMS; }
            else if (!(hs & 1) && (hs >> 1) < DEPTH) { fl = hs >> 1; busy = DOWN_BUSY; i1 = WT_ITEMS; filt = 1; }
            else if ((hs & 1) && hs > 1) {   }
            FILL_W(fl, busy, i0, i1, filt);
        }
        GRID_BAR();
    }
    FINAL_PHASE();
}

extern "C" void kernel_launch(void* const* d_in, const int* in_sizes, int n_in, void* d_out, int out_size, void* d_ws, size_t ws_size, hipStream_t stream) {
    (void)in_sizes; (void)n_in; (void)out_size; (void)ws_size;
    Params p{};
    const float* const* in = (const float* const*)d_in;
    p.x = in[0]; p.c = in[1]; p.ctx = in[2]; p.c_ctx = in[3]; p.ada_w = in[4]; p.ada_b = in[5]; p.norm1_g = in[6]; p.norm2_g = in[7]; p.w_in = in[8];
    p.q_norm_g = in[9]; p.kv_norm_g = in[10]; p.w_uq = in[11]; p.w_ukv = in[12]; p.ml_conv_w = in[13]; p.ml_conv_b = in[14]; p.ml_wq = in[15]; p.ml_wk = in[16];
    p.ml_gate_b = in[17]; p.ml_norm_g = in[18]; p.hy_conv_w = in[19]; p.hy_conv_b = in[20]; p.hy_w1 = in[21]; p.hy_b1 = in[22]; p.hy_w2 = in[23]; p.hy_b2 = in[24];
    p.hy_w3 = in[25]; p.hy_freq = in[26]; p.hy_bias_d = in[27]; p.w_out = in[28]; p.w_up = in[29]; p.ffn_conv_w = in[30]; p.ffn_conv_b = in[31]; p.w_down = in[32]; p.final_g = in[33];
    p.out = (float*)d_out;
    p.ws = (char*)d_ws;
#ifdef HOST_EMU
    fwd(p);
#else
    static int grid = 0;
    if (grid == 0) {
        int dev = 0, cus = 0;
        if (hipGetDevice(&dev) != hipSuccess || hipDeviceGetAttribute(&cus, hipDeviceAttributeMultiprocessorCount, dev) != hipSuccess) { grid = -1; return; }
        if (hipFuncSetAttribute((const void*)fwd, hipFuncAttributeMaxDynamicSharedMemorySize, LDS_BYTES) != hipSuccess) { grid = -1; return; }
        int per_cu = 0;
        (void)hipOccupancyMaxActiveBlocksPerMultiprocessor(&per_cu, (const void*)fwd, NTHREADS, LDS_BYTES);
        (void)hipGetLastError();
        grid = (cus >= NBLOCKS) ? NBLOCKS : -1;
    }
    if (grid < 0) return;
    (void)hipMemsetAsync(d_ws, 0, CTL_BYTES, stream);
    hipLaunchKernelGGL(fwd, dim3(grid), dim3(NTHREADS), LDS_BYTES, stream, p);
#endif
}
```

```cpp
#ifndef HOST_EMU
#include <hip/hip_runtime.h>
#endif
#include <stdint.h>
#include <math.h>

#ifndef CFG_D_MODEL
#define CFG_D_MODEL 1024
#define CFG_BATCH 8
#define CFG_SEQ 4096
#define CFG_CTX 256
#define CFG_SCS 256
#define CFG_NFC 4
#endif

#define DEV __device__ __forceinline__

namespace cfg {
constexpr int D = CFG_D_MODEL, B = CFG_BATCH, SEQ = CFG_SEQ, CTX = CFG_CTX, DEPTH = 2, GRID_W = 64;
constexpr int RPB = CTX + SEQ;
constexpr int R = B * RPB;
constexpr float EPS = 1e-6f;
constexpr int AH = D / 128, NOPE = 64, ROPE = 32, AV = 64, QR = 3 * D / 8, KVR = D / 4, AW = AH * AV;
constexpr int QW = AH * (NOPE + ROPE);
constexpr int KVW = AH * (NOPE + AV);
constexpr int MH = 4, MD = D / 16, MW = MH * MD;
constexpr int HW = D / 4, HB = 16, HE = 33, HH = 64;
constexpr int N_MLA = QR + KVR + ROPE, N_ML = 3 * MW + 4 * MH, N_HY = 3 * HW, N_IN = N_MLA + N_ML + N_HY;
constexpr int ML_LO = N_MLA, HY_LO = N_MLA + N_ML;
constexpr int NP = (N_IN + 255) / 256 * 256;
constexpr int FF = ((8 * D / 3 + 255) / 256) * 256, FF2 = 2 * FF;
constexpr int SCS = CFG_SCS;
constexpr int SCN = RPB / SCS, NCS = CTX / SCS;
constexpr int NFC = CFG_NFC;
constexpr int FCR = (B / NFC) * RPB;
static_assert(CTX % SCS == 0 && SEQ % SCS == 0, "super-chunk must divide ctx and seq");
static_assert(B % NFC == 0, "ffn chunks");
static_assert(MD == 64 || MD == 16, "mlstm head dim");
}
using namespace cfg;
constexpr int NTHREADS = 512, NBLOCKS = 256;

typedef unsigned short bf16;
struct alignas(16) U4 { unsigned x, y, z, w; };

DEV float u2f(unsigned u) { union { unsigned u; float f; } c; c.u = u; return c.f; }
DEV unsigned f2u(float f) { union { unsigned u; float f; } c; c.f = f; return c.u; }
DEV float bf2f(bf16 v) { return u2f(((unsigned)v) << 16); }
DEV bf16 f2bf(float f) { unsigned u = f2u(f); u += 0x7FFFu + ((u >> 16) & 1u); return (bf16)(u >> 16); }
DEV float bflo(unsigned w) { return u2f(w << 16); }
DEV float bfhi(unsigned w) { return u2f(w & 0xFFFF0000u); }
#ifdef HOST_EMU
DEV float sin_f(float x) { return sinf(x); }
DEV float cos_t(float turns) { return cosf(6.283185307179586f * turns); }
DEV float sin_t(float turns) { return sinf(6.283185307179586f * turns); }
#else
DEV float sin_f(float x) { return __builtin_amdgcn_sinf(__builtin_amdgcn_fractf(x * 0.15915494309189535f)); }
DEV float cos_t(float turns) { return __builtin_amdgcn_cosf(turns); }
DEV float sin_t(float turns) { return __builtin_amdgcn_sinf(turns); }
#endif
#ifdef HOST_EMU
DEV float exp_f(float x) { return expf(x); }
DEV float log1p_f(float y) { return log1pf(y); }
#else
DEV float exp_f(float x) { return __builtin_amdgcn_exp2f(x * 1.4426950408889634f); }
DEV float log1p_f(float y) { return __builtin_amdgcn_logf(1.0f + y) * 0.6931471805599453f; }
#endif
#ifdef HOST_EMU
DEV float rcp_f(float x) { return 1.0f / x; }
#else
DEV float rcp_f(float x) { return __builtin_amdgcn_rcpf(x); }
#endif
DEV float silu_f(float x) { return x * rcp_f(1.0f + exp_f(-x)); }
DEV float sigmoid_f(float x) { return rcp_f(1.0f + exp_f(-x)); }
DEV float logsigmoid_f(float x) { return x >= 0.f ? -log1p_f(exp_f(-x)) : x - log1p_f(exp_f(x)); }
DEV float dot8(const U4& a, const U4& b) {
    return bflo(a.x) * bflo(b.x) + bfhi(a.x) * bfhi(b.x) + bflo(a.y) * bflo(b.y) + bfhi(a.y) * bfhi(b.y) +
           bflo(a.z) * bflo(b.z) + bfhi(a.z) * bfhi(b.z) + bflo(a.w) * bflo(b.w) + bfhi(a.w) * bfhi(b.w);
}

constexpr size_t CTL_BYTES = 65536;
constexpr size_t al256(size_t x) { return (x + 255) & ~(size_t)255; }
constexpr size_t OFF_ctl = 0, SZ_ctl = al256(CTL_BYTES);
constexpr size_t OFF_X = OFF_ctl + SZ_ctl, SZ_X = al256((size_t)R * D * 2);
constexpr size_t OFF_H = OFF_X + SZ_X, SZ_H = al256((size_t)R * D * 2);
constexpr size_t OFF_MOD = OFF_H + SZ_H, SZ_MOD = al256((size_t)DEPTH * (B + 1) * 6 * D * 4);
constexpr size_t OFF_MODP = OFF_MOD + SZ_MOD, SZ_MODP = al256((size_t)8 * DEPTH * (B + 1) * 6 * D * 4);
constexpr size_t OFF_ROPET = OFF_MODP + SZ_MODP, SZ_ROPET = al256((size_t)SEQ * 16 * 2 * 4);
constexpr size_t OFF_WinT = OFF_ROPET + SZ_ROPET, SZ_WinT = al256((size_t)NP * D * 2);
constexpr size_t OFF_WuqT = OFF_WinT + SZ_WinT, SZ_WuqT = al256((size_t)QW * QR * 2);
constexpr size_t OFF_WukvT = OFF_WuqT + SZ_WuqT, SZ_WukvT = al256((size_t)KVW * KVR * 2);
constexpr size_t OFF_WoutT = OFF_WukvT + SZ_WukvT, SZ_WoutT = al256((size_t)D * D * 2);
constexpr size_t OFF_WupT = OFF_WoutT + SZ_WoutT, SZ_WupT = al256((size_t)FF2 * D * 2);
constexpr size_t OFF_WdownT = OFF_WupT + SZ_WupT, SZ_WdownT = al256((size_t)D * FF * 2);
constexpr size_t OFF_HD1 = OFF_WdownT + SZ_WdownT, SZ_HD1 = al256((size_t)2 * SEQ * HH * 4);
constexpr size_t OFF_HD2 = OFF_HD1 + SZ_HD1, SZ_HD2 = al256((size_t)2 * SEQ * HH * 4);
constexpr size_t OFF_FT = OFF_HD2 + SZ_HD2, SZ_FT = al256((size_t)2 * HW * SEQ * 4);
constexpr size_t OFF_FT1 = OFF_FT + SZ_FT, SZ_FT1 = al256((size_t)CTX * 2 * HW * 4);
constexpr size_t OFF_FL1 = OFF_FT1 + SZ_FT1, SZ_FL1 = al256((size_t)2 * HW * 64 * 4);
constexpr size_t OFF_HSPEC = OFF_FL1 + SZ_FL1, SZ_HSPEC = al256((size_t)HW * 2 * SEQ * 8);
constexpr size_t OFF_P = OFF_HSPEC + SZ_HSPEC, SZ_P = al256((size_t)R * NP * 2);
constexpr size_t OFF_KR = OFF_P + SZ_P, SZ_KR = al256((size_t)R * ROPE * 2);
constexpr size_t OFF_RS = OFF_KR + SZ_KR, SZ_RS = al256((size_t)R * 2 * 4);
constexpr size_t OFF_MQK = OFF_RS + SZ_RS, SZ_MQK = al256((size_t)R * 2 * MW * 2);
constexpr size_t OFF_WML = OFF_MQK + SZ_MQK, SZ_WML = al256((size_t)2 * MW * MW * 2);
constexpr size_t OFF_FG = OFF_WML + SZ_WML, SZ_FG = al256((size_t)R * 2 * MH * 2 * 4);
constexpr size_t OFF_MS = OFF_FG + SZ_FG, SZ_MS = al256((size_t)B * MH * 2 * SCN * (MD + 1) * MD * 4);
constexpr size_t OFF_Z = OFF_MS + SZ_MS, SZ_Z = al256((size_t)B * CTX * HW * 4);
constexpr size_t OFF_ZT = OFF_Z + SZ_Z, SZ_ZT = al256((size_t)B * HW * SEQ * 2);
#ifdef HOST_EMU
constexpr size_t OFF_UF = OFF_P, SZ_UF = al256((size_t)FCR * FF2 * 2), OFF_GF = OFF_UF + SZ_UF, SZ_GF = al256((size_t)FCR * FF * 2);
#else
constexpr size_t OFF_UF = OFF_P, SZ_UF = 0, OFF_GF = OFF_P, SZ_GF = al256((size_t)R * FF * 2);
#endif
constexpr size_t WS_BASE = (OFF_ZT + SZ_ZT) > (OFF_GF + SZ_GF) ? (OFF_ZT + SZ_ZT) : (OFF_GF + SZ_GF);
constexpr size_t OFF_WSET1 = WS_BASE, SZ_WSET = OFF_HD1 - OFF_WinT, WSET_STRIDE = OFF_WSET1 - OFF_WinT;
constexpr size_t WS_NEED = OFF_WSET1 + SZ_WSET;
static_assert(WS_NEED <= (size_t)536870912 || D != 1024, "workspace");
constexpr size_t OFF_Q = 0, OFF_KN = al256((size_t)R * QW * 2), OFF_VT = OFF_KN + al256((size_t)R * AW * 2);
static_assert(OFF_VT + (size_t)R * AW * 2 <= (size_t)B * SEQ * D * 4 || D != 1024, "d_out scratch");
struct Params {
    const float *x, *c, *ctx, *c_ctx, *ada_w, *ada_b, *norm1_g, *norm2_g, *w_in, *q_norm_g, *kv_norm_g, *w_uq, *w_ukv;
    const float *ml_conv_w, *ml_conv_b, *ml_wq, *ml_wk, *ml_gate_b, *ml_norm_g;
    const float *hy_conv_w, *hy_conv_b, *hy_w1, *hy_b1, *hy_w2, *hy_b2, *hy_w3, *hy_freq, *hy_bias_d;
    const float *w_out, *w_up, *ffn_conv_w, *ffn_conv_b, *w_down, *final_g;
    float* out;
    char* ws;
};

DEV unsigned* wctl(char* ws) { return (unsigned*)(ws + OFF_ctl); }
DEV bf16* wX(char* ws) { return (bf16*)(ws + OFF_X); }
DEV bf16* wH(char* ws) { return (bf16*)(ws + OFF_H); }
DEV float* wMOD(char* ws) { return (float*)(ws + OFF_MOD); }
DEV float* wROPET(char* ws) { return (float*)(ws + OFF_ROPET); }
DEV bf16* wWinT(char* ws, int l) { return (bf16*)(ws + OFF_WinT + (size_t)(l & 1) * WSET_STRIDE); }
DEV bf16* wWuqT(char* ws, int l) { return (bf16*)(ws + OFF_WuqT + (size_t)(l & 1) * WSET_STRIDE); }
DEV bf16* wWukvT(char* ws, int l) { return (bf16*)(ws + OFF_WukvT + (size_t)(l & 1) * WSET_STRIDE); }
DEV bf16* wWoutT(char* ws, int l) { return (bf16*)(ws + OFF_WoutT + (size_t)(l & 1) * WSET_STRIDE); }
DEV bf16* wWupT(char* ws, int l) { return (bf16*)(ws + OFF_WupT + (size_t)(l & 1) * WSET_STRIDE); }
DEV bf16* wWdownT(char* ws, int l) { return (bf16*)(ws + OFF_WdownT + (size_t)(l & 1) * WSET_STRIDE); }
DEV float* wHD1(char* ws) { return (float*)(ws + OFF_HD1); }
DEV float* wHD2(char* ws) { return (float*)(ws + OFF_HD2); }
DEV float* wFT(char* ws) { return (float*)(ws + OFF_FT); }
DEV float* wFL1(char* ws) { return (float*)(ws + OFF_FL1); }
DEV float* wMODP(char* ws) { return (float*)(ws + OFF_MODP); }
DEV float* wFT1(char* ws) { return (float*)(ws + OFF_FT1); }
DEV bf16* wZT(char* ws) { return (bf16*)(ws + OFF_ZT); }
struct alignas(8) C2 { float x, y; };
DEV C2* wHSPEC(char* ws) { return (C2*)(ws + OFF_HSPEC); }
DEV bf16* wP(char* ws) { return (bf16*)(ws + OFF_P); }
DEV bf16* wKR(char* ws) { return (bf16*)(ws + OFF_KR); }
DEV float* wRS(char* ws) { return (float*)(ws + OFF_RS); }
DEV bf16* wMQK(char* ws) { return (bf16*)(ws + OFF_MQK); }
DEV bf16* wWML(char* ws) { return (bf16*)(ws + OFF_WML); }
DEV bf16* wMU(char* ws) { return (bf16*)(ws + OFF_MS); }
static_assert((size_t)R * MW * 2 <= SZ_MS, "MU aliases MS");
DEV float* wFG(char* ws) { return (float*)(ws + OFF_FG); }
DEV float* wMS(char* ws) { return (float*)(ws + OFF_MS); }
DEV float* wZ(char* ws) { return (float*)(ws + OFF_Z); }
DEV bf16* wUF(char* ws) { return (bf16*)(ws + OFF_UF); }
DEV bf16* wGF(char* ws) { return (bf16*)(ws + OFF_GF); }
DEV bf16* wQ(float* out) { return (bf16*)((char*)out + OFF_Q); }
DEV bf16* wKN(float* out) { return (bf16*)((char*)out + OFF_KN); }
DEV bf16* wVT(float* out) { return (bf16*)((char*)out + OFF_VT); }

#ifdef HOST_EMU
typedef const Params& PRef;
#else
typedef const Params __attribute__((address_space(4)))& PRef;
#endif

struct RowI { int b, o, t, bi; bool ctx; };
DEV RowI rowinfo(int r) { RowI i; i.b = r / RPB; i.o = r % RPB; i.ctx = i.o < CTX; i.t = i.ctx ? i.o : i.o - CTX; i.bi = i.ctx ? B : i.b; return i; }
DEV int swap23(int o) { return (o & 3) | ((o & 4) << 1) | ((o & 8) >> 1); }
DEV int vperm32(int o) { return (o & 3) | (((o >> 4) & 1) << 2) | (((o >> 2) & 3) << 3); }
DEV bool has_prev(const RowI& i) { return i.t > 0; }
DEV bool has_next(const RowI& i) { return i.t + 1 < (i.ctx ? CTX : SEQ); }

enum { PH_MOD, PH_MOD2, PH_ROPE, PH_FILT_A, PH_FILT_B, PH_FILT_C, PH_FILT_D, PH_NORM1, PH_GEMM1, PH_MLA_A, PH_MLA_Q, PH_MLA_KV, PH_ATT,
       PH_ML_U, PH_ML_QK, PH_ML_F, PH_ML_B, PH_ML_S, PH_ML_O, PH_HY_Z, PH_HY_O, PH_GEMM_OUT, PH_NORM2, PH_FFN_UP, PH_FFN_CG, PH_FFN_DOWN, PH_FINAL };

DEV float dot_bf16(const bf16* a, const bf16* b, int K) {
    float acc = 0.f;
    for (int k = 0; k < K; k += 8) { const U4 av = *(const U4*)(a + k), bv = *(const U4*)(b + k); acc += dot8(av, bv); }
    return acc;
}


#ifndef HOST_EMU
namespace pg8 {
#define PG8_LAS __attribute__((address_space(3)))
typedef unsigned short bf16_t;
typedef short bf16x8 __attribute__((ext_vector_type(8)));
typedef float f32x4 __attribute__((ext_vector_type(4)));
typedef unsigned u32x4 __attribute__((ext_vector_type(4)));
constexpr int BM = 256, BK = 64, HALF = 128, HTB = HALF * BK * 2  , STAGE_BYTES = 8 * HTB, NXCD = 8, WGM = 8;

__host__ __device__ __forceinline__ int lds_byte(int r, int c) { const int st = (r >> 4) * 2 + (c >> 5), rr = r & 15, cc = c & 31, ob = rr * 64 + cc * 2; return st * 1024 + (ob ^ (((ob >> 9) & 1) << 5)); }
__host__ __device__ __forceinline__ void stage_rc(int b, int& R, int& C) { const int st = b / 1024, sb = b % 1024, swz = sb ^ (((sb >> 9) & 1) << 5); R = (st >> 1) * 16 + swz / 64; C = (st & 1) * 32 + (swz % 64) / 2; }
__host__ __device__ __forceinline__ int perm32(int rho) { const int n = rho >> 4, i = rho & 15; return 8 * (i >> 2) + 4 * n + (i & 3); }

struct Unit { int pm, pn; };
struct Gemm { const bf16_t* A; const bf16_t* Bt; int lda, ldb, M, N, K, mstep; };

struct StaticOrder {
    int nM, nN, nwg, G, c, lat;
    __host__ __device__ void init(int M, int N, int G_, int c_, int lat_ = 0) { nM = M / BM; nN = N / BM; nwg = nM * nN; G = G_; c = c_; lat = lat_; }
    __host__ __device__ bool next(int i, Unit& u) const {
        const long L = (long)i * G + c; if (L >= nwg) return false;
        int wgid = (int)L; { const int q = nwg / NXCD, r = nwg % NXCD, xcd = wgid % NXCD, off = wgid / NXCD; wgid = (xcd < r ? xcd * (q + 1) : r * (q + 1) + (xcd - r) * q) + off; }
        const int nig = WGM * nN, gid = wgid / nig, fm = gid * WGM, gsz = (nM - fm) < WGM ? (nM - fm) : WGM;
        u.pm = fm + ((wgid % nig) % gsz); u.pn = (wgid % nig) / gsz;
        if (lat) u.pm = u.pm + (u.pm / (SEQ / BM) + 1) * (CTX / BM);
        return true;
    }
    __device__ __forceinline__ void a_ready(const Unit&) const {}
    __device__ __forceinline__ void done(const Unit&) const {}
};
__device__ __forceinline__ unsigned cvt_pk_bf16(float lo, float hi) { unsigned r; asm volatile("v_cvt_pk_bf16_f32 %0, %1, %2" : "=v"(r) : "v"(lo), "v"(hi)); return r; }

template <class Epi, class Sched, bool ALIGN_EPI = false, bool SP2 = false>
__device__ __forceinline__ void gemm_phase(PG8_LAS unsigned char* lds, const Gemm g, const Sched& S, const Epi& E) {
    int tid_ = threadIdx.x; asm volatile("" : "+v"(tid_));
    const int tid = tid_, wid = __builtin_amdgcn_readfirstlane(tid >> 6), lane = tid & 63, wr = wid >> 2, wc = wid & 3, fr = lane & 15, fq = lane >> 4;
    const int K = g.K, nt = K / BK;
    unsigned vvoffA, vvoffB;
    { int R_, C_; stage_rc(tid * 16, R_, C_); const int Rb = Epi::PERM ? ((R_ & ~31) + perm32(R_ & 31)) : R_;
      vvoffA = (unsigned)(R_ * g.lda + C_) * 2u; vvoffB = (unsigned)(Rb * g.ldb + C_) * 2u; }
    const size_t pvoffA = (size_t)64 * g.lda * 2, pvoffB = (size_t)64 * g.ldb * 2;
    const size_t kstep = (size_t)(BK * 2);
    const size_t hstepA = (size_t)HALF * g.lda * 2, hstepB = (size_t)HALF * g.ldb * 2;
    const size_t tstepA = (size_t)g.mstep * g.lda * 2, tstepB = 2 * hstepB;
    const unsigned ldsw = (unsigned)wid * 1024u;
    const int aoff = lds_byte(wr * 64 + fr, fq * 8), boff = lds_byte(wc * 32 + fr, fq * 8);
#define PG8_SA(b, h) (((b) * 2 + (h)) * HTB)
#define PG8_SB(b, h) ((4 + (b) * 2 + (h)) * HTB)
#define PG8_STAGE(bufoff, gbase, voff) do { _Pragma("unroll") for (int _i = 0; _i < 2; ++_i) \
        __builtin_amdgcn_global_load_lds((const unsigned*)((const char*)(gbase) + (size_t)_i * p##voff + (v##voff)), (PG8_LAS unsigned*)(lds + (bufoff) + ldsw + _i * 8192), 16, 0, 0); } while (0)
#define PG8_LDA(dst, b, h) do { _Pragma("unroll") for (int m = 0; m < 4; ++m) _Pragma("unroll") for (int k = 0; k < 2; ++k) dst[m][k] = *(const PG8_LAS bf16x8*)(lds + PG8_SA(b, h) + aoff + m * 2048 + k * 1024); } while (0)
#define PG8_LDB(dst, b, h) do { _Pragma("unroll") for (int n = 0; n < 2; ++n) _Pragma("unroll") for (int k = 0; k < 2; ++k) dst[n][k] = *(const PG8_LAS bf16x8*)(lds + PG8_SB(b, h) + boff + n * 2048 + k * 1024); } while (0)
#define PG8_MMA(ai, bj, At, Bt) do { __builtin_amdgcn_s_setprio(1); _Pragma("unroll") for (int m = 0; m < 4; ++m) _Pragma("unroll") for (int n = 0; n < 2; ++n) _Pragma("unroll") for (int k = 0; k < 2; ++k) \
        acc[ai][bj][m][n] = __builtin_amdgcn_mfma_f32_16x16x32_bf16(Bt[n][k], At[m][k], acc[ai][bj][m][n], 0, 0, 0); __builtin_amdgcn_s_setprio(0); } while (0)
#define PG8_WAIT_V(n) asm volatile("s_waitcnt vmcnt(" #n ")" ::: "memory")
#define PG8_WAIT_L(n) asm volatile("s_waitcnt lgkmcnt(" #n ")" ::: "memory")
#define PG8_BAR __builtin_amdgcn_s_barrier()
#define PG8_SCHED __builtin_amdgcn_sched_barrier(0)
    Unit cur, nxt; int ui = 0;
    if (!S.next(0, cur)) return;
    f32x4 acc[2][2][4][2];
#pragma unroll
    for (int a = 0; a < 2; ++a)
#pragma unroll
        for (int b = 0; b < 2; ++b)
#pragma unroll
            for (int m = 0; m < 4; ++m)
#pragma unroll
                for (int n = 0; n < 2; ++n) acc[a][b][m][n] = (f32x4){0.f, 0.f, 0.f, 0.f};
    bf16x8 At[4][2], B0[2][2], B1[2][2];
    const char* cA = (const char*)g.A + (size_t)cur.pm * tstepA; const char* cB = (const char*)g.Bt + (size_t)cur.pn * tstepB;
    S.a_ready(cur);
    if constexpr (SP2) {
        PG8_STAGE(PG8_SB(0, 0), cB, voffB); PG8_STAGE(PG8_SB(0, 1), cB + hstepB, voffB); PG8_STAGE(PG8_SA(0, 0), cA, voffA); PG8_STAGE(PG8_SA(0, 1), cA + hstepA, voffA);
        if (wr == 1) PG8_BAR;
        PG8_WAIT_V(2); PG8_BAR;
        PG8_STAGE(PG8_SB(1, 0), cB + kstep, voffB); PG8_STAGE(PG8_SA(1, 0), cA + kstep, voffA); PG8_STAGE(PG8_SB(1, 1), cB + hstepB + kstep, voffB);
        PG8_WAIT_V(6); PG8_BAR;
    } else {
        PG8_STAGE(PG8_SB(0, 0), cB, voffB); PG8_STAGE(PG8_SA(0, 0), cA, voffA); PG8_STAGE(PG8_SB(0, 1), cB + hstepB, voffB); PG8_STAGE(PG8_SA(0, 1), cA + hstepA, voffA);
        if (wr == 1) PG8_BAR;
        PG8_WAIT_V(4); PG8_BAR;
        PG8_STAGE(PG8_SB(1, 0), cB + kstep, voffB); PG8_STAGE(PG8_SA(1, 0), cA + kstep, voffA); PG8_STAGE(PG8_SB(1, 1), cB + hstepB + kstep, voffB);
        PG8_WAIT_V(6); PG8_BAR;
    }
    for (;;) {
        const bool has_next = S.next(ui + 1, nxt);
        const char* nA = has_next ? (const char*)g.A + (size_t)nxt.pm * tstepA : cA; const char* nB = has_next ? (const char*)g.Bt + (size_t)nxt.pn * tstepB : cB;
        for (int t = 0; t < nt; t += 2) {
            const bool last = (t == nt - 2);
            const char* a1 = cA + (size_t)(t + 1) * kstep;
            const char* a2 = last ? nA : cA + (size_t)(t + 2) * kstep; const char* b2 = last ? nB : cB + (size_t)(t + 2) * kstep;
            const char* a3 = a2 + kstep; const char* b3 = b2 + kstep;
            if (last && has_next) S.a_ready(nxt);
            if constexpr (SP2) {
            PG8_LDB(B0, 0, 0); PG8_LDB(B1, 0, 1); PG8_SCHED; PG8_LDA(At, 0, 0); PG8_STAGE(PG8_SA(1, 1), a1 + hstepA, voffA);
            PG8_WAIT_V(8); PG8_WAIT_L(0); PG8_BAR; PG8_MMA(0, 0, At, B0); PG8_MMA(0, 1, At, B1); PG8_BAR; PG8_SCHED;
            PG8_LDA(At, 0, 1); PG8_STAGE(PG8_SB(0, 0), b2, voffB); PG8_STAGE(PG8_SB(0, 1), b2 + hstepB, voffB); PG8_STAGE(PG8_SA(0, 0), a2, voffA);
            PG8_WAIT_V(8); PG8_WAIT_L(0); PG8_BAR; PG8_MMA(1, 0, At, B0); PG8_MMA(1, 1, At, B1); PG8_BAR; PG8_SCHED;
            PG8_LDB(B0, 1, 0); PG8_LDB(B1, 1, 1); PG8_SCHED; PG8_LDA(At, 1, 0); PG8_STAGE(PG8_SA(0, 1), a2 + hstepA, voffA);
            PG8_WAIT_V(8); PG8_WAIT_L(0); PG8_BAR; PG8_MMA(0, 0, At, B0); PG8_MMA(0, 1, At, B1); PG8_BAR; PG8_SCHED;
            PG8_LDA(At, 1, 1); PG8_STAGE(PG8_SB(1, 0), b3, voffB); PG8_STAGE(PG8_SB(1, 1), b3 + hstepB, voffB); PG8_STAGE(PG8_SA(1, 0), a3, voffA);
            PG8_WAIT_V(8); PG8_WAIT_L(0); PG8_BAR; PG8_MMA(1, 0, At, B0); PG8_MMA(1, 1, At, B1); PG8_BAR; PG8_SCHED;
            } else {
            PG8_LDB(B0, 0, 0); PG8_SCHED; PG8_LDA(At, 0, 0); PG8_STAGE(PG8_SA(1, 1), a1 + hstepA, voffA);
            PG8_WAIT_L(8); PG8_BAR; PG8_WAIT_L(0); PG8_MMA(0, 0, At, B0); PG8_BAR; PG8_SCHED;
            PG8_LDB(B1, 0, 1); PG8_STAGE(PG8_SB(0, 0), b2, voffB);
            PG8_BAR; PG8_WAIT_L(0); PG8_MMA(0, 1, At, B1); PG8_BAR;
            PG8_LDA(At, 0, 1); PG8_STAGE(PG8_SA(0, 0), a2, voffA);
            PG8_BAR; PG8_WAIT_L(0); PG8_MMA(1, 0, At, B0); PG8_BAR; PG8_SCHED;
            PG8_STAGE(PG8_SB(0, 1), b2 + hstepB, voffB);
            PG8_WAIT_V(6); PG8_BAR; PG8_MMA(1, 1, At, B1); PG8_BAR;
            PG8_LDB(B0, 1, 0); PG8_SCHED; PG8_LDA(At, 1, 0); PG8_STAGE(PG8_SA(0, 1), a2 + hstepA, voffA);
            PG8_WAIT_L(8); PG8_BAR; PG8_WAIT_L(0); PG8_MMA(0, 0, At, B0); PG8_BAR; PG8_SCHED;
            PG8_LDB(B1, 1, 1); PG8_STAGE(PG8_SB(1, 0), b3, voffB);
            PG8_BAR; PG8_WAIT_L(0); PG8_MMA(0, 1, At, B1); PG8_BAR;
            PG8_LDA(At, 1, 1); PG8_STAGE(PG8_SA(1, 0), a3, voffA);
            PG8_BAR; PG8_WAIT_L(0); PG8_MMA(1, 0, At, B0); PG8_BAR; PG8_SCHED;
            PG8_STAGE(PG8_SB(1, 1), b3 + hstepB, voffB);
            PG8_WAIT_V(6); PG8_BAR; PG8_MMA(1, 1, At, B1); PG8_BAR;
            }
        }
        if constexpr (ALIGN_EPI) { if (wr == 0) PG8_BAR; }
        E(acc, cur, wr, wc, fr, fq); S.done(cur);
        if (!has_next) break;
#pragma unroll
        for (int a = 0; a < 2; ++a)
#pragma unroll
            for (int b = 0; b < 2; ++b)
#pragma unroll
                for (int m = 0; m < 4; ++m)
#pragma unroll
                    for (int n = 0; n < 2; ++n) acc[a][b][m][n] = (f32x4){0.f, 0.f, 0.f, 0.f};
        cur = nxt; cA = nA; cB = nB; ++ui;
        if constexpr (ALIGN_EPI) { if (wr == 1) PG8_BAR; }
    }
    PG8_WAIT_V(0);
    if constexpr (!ALIGN_EPI) { if (wr == 0) PG8_BAR; }
    PG8_BAR;
#undef PG8_SA
#undef PG8_SB
#undef PG8_STAGE
#undef PG8_LDA
#undef PG8_LDB
#undef PG8_MMA
#undef PG8_WAIT_V
#undef PG8_WAIT_L
#undef PG8_BAR
#undef PG8_SCHED
}

struct EpiBf16 {
    static constexpr bool PERM = true;
    bf16_t* O; int ldc; const float* rs; int rs_stride;
    __device__ __forceinline__ void operator()(const f32x4 (&acc)[2][2][4][2], const Unit& u, int wr, int wc, int, int) const {
        __builtin_amdgcn_sched_barrier(0);
        int t_ = threadIdx.x; asm volatile("" : "+v"(t_)); const int fr = t_ & 15, fq = (t_ >> 4) & 3;
        const int row0 = u.pm * BM + wr * 64 + fr, col0 = u.pn * BM + wc * 32 + 8 * fq;
#pragma unroll
        for (int ai = 0; ai < 2; ++ai)
#pragma unroll
            for (int m = 0; m < 4; ++m) { const int row = row0 + ai * HALF + m * 16; bf16_t* rowp = O + (size_t)row * ldc + col0;
                const float sc = rs ? rs[(size_t)row * rs_stride] : 1.0f;
#pragma unroll
                for (int bj = 0; bj < 2; ++bj) { const f32x4 v0 = acc[ai][bj][m][0] * sc, v1 = acc[ai][bj][m][1] * sc;
                    u32x4 w; w.x = cvt_pk_bf16(v0[0], v0[1]); w.y = cvt_pk_bf16(v0[2], v0[3]); w.z = cvt_pk_bf16(v1[0], v1[1]); w.w = cvt_pk_bf16(v1[2], v1[3]);
                    *(u32x4*)(rowp + bj * HALF) = w; } }
    }
};
struct EpiVT {
    static constexpr bool PERM = true;
    bf16_t* O; const float* rs;
    __device__ __forceinline__ void operator()(const f32x4 (&acc)[2][2][4][2], const Unit& u, int wr, int wc, int, int) const {
        __builtin_amdgcn_sched_barrier(0);
        int t_ = threadIdx.x; asm volatile("" : "+v"(t_)); const int fr = t_ & 15, fq = (t_ >> 4) & 3;
        const int row0 = u.pm * BM + wr * 64 + fr, col0 = u.pn * BM + wc * 32;
        typedef unsigned u32x2 __attribute__((ext_vector_type(2)));
#pragma unroll
        for (int bj = 0; bj < 2; ++bj) { const int cb = col0 + bj * HALF;
            const float* rsp = rs + cb + 8 * fq;
            typedef bf16_t __attribute__((address_space(1))) gbf16;
            gbf16* rowp = (gbf16*)(O + (size_t)row0 * R + cb + 4 * (fq >> 1) + 16 * (fq & 1));
#pragma unroll
            for (int ai = 0; ai < 2; ++ai)
#pragma unroll
                for (int m = 0; m < 4; ++m) {
                    const f32x4 v0 = acc[ai][bj][m][0] * *(const f32x4*)(rsp), v1 = acc[ai][bj][m][1] * *(const f32x4*)(rsp + 4);
                    u32x2 w0, w1; w0.x = cvt_pk_bf16(v0[0], v0[1]); w0.y = cvt_pk_bf16(v0[2], v0[3]); w1.x = cvt_pk_bf16(v1[0], v1[1]); w1.y = cvt_pk_bf16(v1[2], v1[3]);
                    *(__attribute__((address_space(1))) u32x2*)(rowp) = w0; *(__attribute__((address_space(1))) u32x2*)(rowp + 8) = w1;
                    rowp += (size_t)(m == 3 ? HALF - 48 : 16) * R; asm volatile("" : "+v"(rowp)); } }
    }
};
struct EpiConvGate {
    static constexpr bool PERM = true;
    bf16_t* O; const float* cw; const float* cb; PG8_LAS unsigned char* xl;
    __device__ __forceinline__ void operator()(f32x4 (&acc)[2][2][4][2], const Unit& u, int wr, int wc, int, int) const {
        __builtin_amdgcn_sched_barrier(0);
        int t_ = threadIdx.x; asm volatile("" : "+v"(t_)); const int lane = t_ & 63, fr = t_ & 15, fq = (t_ >> 4) & 3, wave = wr * 4 + wc;
        PG8_LAS f32x4* myx = (PG8_LAS f32x4*)(xl + wave * 1024);
#pragma unroll
        for (int ai = 0; ai < 2; ++ai)
#pragma unroll
            for (int bj = 0; bj < 2; ++bj)
#pragma unroll
                for (int n = 0; n < 2; ++n) { if (fr == 0) myx[(((ai * 2 + 0) * 2 + bj) * 2 + n) * 4 + fq] = acc[ai][bj][0][n]; if (fr == 15) myx[(((ai * 2 + 1) * 2 + bj) * 2 + n) * 4 + fq] = acc[ai][bj][3][n]; }
        asm volatile("s_waitcnt lgkmcnt(0)" ::: "memory"); __builtin_amdgcn_s_barrier(); asm volatile("" ::: "memory");
        const int rg0 = u.pm * 254 - 1 + wr * 64 + fr;
        unsigned hpm = 0u, hnm = 0u;
#pragma unroll
        for (int ai = 0; ai < 2; ++ai)
#pragma unroll
            for (int m = 0; m < 4; ++m) { const int rg = rg0 + ai * HALF + m * 16; const int o = ((rg % RPB) + RPB) % RPB;
                if (o != 0 && o != CTX) hpm |= 1u << (ai * 4 + m); if (o != CTX - 1 && o != RPB - 1) hnm |= 1u << (ai * 4 + m); }
        typedef float f32x2 __attribute__((ext_vector_type(2)));
        {
#pragma unroll
            for (int bj = 0; bj < 2; ++bj)
#pragma unroll
                for (int n = 0; n < 2; ++n) {
                    const int jj = bj * FF + u.pn * HALF + wc * 32 + 8 * fq + 4 * n;
                    const f32x4 w0 = *(const f32x4*)(cw + jj), w1 = *(const f32x4*)(cw + FF2 + jj), w2 = *(const f32x4*)(cw + 2 * FF2 + jj), bb = *(const f32x4*)(cb + jj);
#pragma unroll
                    for (int ai = 0; ai < 2; ++ai) {
                        const int blk = 2 * ai + wr;
                        f32x4 prow = (f32x4){0.f, 0.f, 0.f, 0.f}, nrow = prow;
                        if (blk > 0) prow = *(const PG8_LAS f32x4*)(xl + (((blk - 1) & 1) * 4 + wc) * 1024 + ((((((blk - 1) >> 1) * 2 + 1) * 2 + bj) * 2 + n) * 4 + fq) * 16);
                        if (blk < 3) nrow = *(const PG8_LAS f32x4*)(xl + (((blk + 1) & 1) * 4 + wc) * 1024 + ((((((blk + 1) >> 1) * 2 + 0) * 2 + bj) * 2 + n) * 4 + fq) * 16);
#pragma unroll
                        for (int ep = 0; ep < 2; ++ep) {
                            f32x2 ru[4], rd[4], res[4];
#pragma unroll
                            for (int m = 0; m < 4; ++m)
#pragma unroll
                                for (int k = 0; k < 2; ++k) { int vi = __float_as_int(acc[ai][bj][m][n][2 * ep + k]); asm volatile("" : "+v"(vi));
                                    ru[m][k] = __int_as_float(__builtin_amdgcn_update_dpp(0, vi, 0x121, 0xf, 0xf, false));
                                    rd[m][k] = __int_as_float(__builtin_amdgcn_update_dpp(0, vi, 0x12F, 0xf, 0xf, false)); }
                            const f32x2 w0p = {w0[2 * ep], w0[2 * ep + 1]}, w1p = {w1[2 * ep], w1[2 * ep + 1]}, w2p = {w2[2 * ep], w2[2 * ep + 1]}, bbp = {bb[2 * ep], bb[2 * ep + 1]};
                            const f32x2 pr2 = {prow[2 * ep], prow[2 * ep + 1]}, nr2 = {nrow[2 * ep], nrow[2 * ep + 1]};
#pragma unroll
                            for (int m = 0; m < 4; ++m) {
                                const f32x2 xv = {acc[ai][bj][m][n][2 * ep], acc[ai][bj][m][n][2 * ep + 1]};
                                const f32x2 upv = fr == 0 ? (m == 0 ? pr2 : ru[m == 0 ? 0 : m - 1]) : ru[m];
                                const f32x2 dnv = fr == 15 ? (m == 3 ? nr2 : rd[m == 3 ? 3 : m + 1]) : rd[m];
                                const bool hp = (hpm >> (ai * 4 + m)) & 1u, hn = (hnm >> (ai * 4 + m)) & 1u;
                                const f32x2 z = {0.f, 0.f};
                                res[m] = bbp + w1p * xv + (hp ? w0p * upv : z) + (hn ? w2p * dnv : z); }
                            asm volatile("" : "+v"(res[0]), "+v"(res[1]), "+v"(res[2]), "+v"(res[3]));
#pragma unroll
                            for (int m = 0; m < 4; ++m) { acc[ai][bj][m][n][2 * ep] = res[m][0]; acc[ai][bj][m][n][2 * ep + 1] = res[m][1]; }
                        }
                    }
                }
        }
#pragma unroll
        for (int ai = 0; ai < 2; ++ai)
#pragma unroll
            for (int m = 0; m < 4; ++m) { const int tr = ai * HALF + wr * 64 + m * 16 + fr, rg = u.pm * 254 - 1 + tr;
                if (tr == 0 || tr == 255 || rg >= R) continue;
                const f32x4 a0 = acc[ai][0][m][0], a1 = acc[ai][0][m][1], g0 = acc[ai][1][m][0], g1 = acc[ai][1][m][1];
                float o[8];
#pragma unroll
                for (int e = 0; e < 4; ++e) { o[e] = a0[e] * __builtin_amdgcn_rcpf(1.0f + __builtin_amdgcn_exp2f(-1.4426950408889634f * a0[e])) * g0[e]; o[4 + e] = a1[e] * __builtin_amdgcn_rcpf(1.0f + __builtin_amdgcn_exp2f(-1.4426950408889634f * a1[e])) * g1[e]; }
                u32x4 w; w.x = cvt_pk_bf16(o[0], o[1]); w.y = cvt_pk_bf16(o[2], o[3]); w.z = cvt_pk_bf16(o[4], o[5]); w.w = cvt_pk_bf16(o[6], o[7]);
                *(u32x4*)(O + (size_t)rg * FF + u.pn * HALF + wc * 32 + 8 * fq) = w; }
    }
};
struct EpiResid {
    static constexpr bool PERM = true;
    bf16_t* X; const float* gate; float* outf; int dry;
    __device__ __forceinline__ void operator()(const f32x4 (&acc)[2][2][4][2], const Unit& u, int wr, int wc, int, int) const {
        __builtin_amdgcn_sched_barrier(0);
        int t_ = threadIdx.x; asm volatile("" : "+v"(t_)); const int fr = t_ & 15, fq = (t_ >> 4) & 3;
        const int row0 = u.pm * BM + wr * 64 + fr, col0 = u.pn * BM + wc * 32 + 8 * fq;
#pragma unroll
        for (int ai = 0; ai < 2; ++ai)
#pragma unroll
            for (int m = 0; m < 4; ++m) { const int row = row0 + ai * HALF + m * 16; const RowI ri = rowinfo(row);
                bf16_t* rowp = X + (size_t)row * D + col0; const float* gp = gate + (size_t)ri.bi * 6 * D + col0;
                float* op = outf ? outf + ((size_t)ri.b * SEQ + ri.t) * D + col0 : nullptr;
#pragma unroll
                for (int bj = 0; bj < 2; ++bj) { const int co = bj * HALF;
                    const u32x4 xw = *(const u32x4*)(rowp + co); const f32x4 g0 = *(const f32x4*)(gp + co), g1 = *(const f32x4*)(gp + co + 4);
                    f32x4 n0, n1;
                    n0[0] = __uint_as_float(xw.x << 16); n0[1] = __uint_as_float(xw.x & 0xFFFF0000u); n0[2] = __uint_as_float(xw.y << 16); n0[3] = __uint_as_float(xw.y & 0xFFFF0000u);
                    n1[0] = __uint_as_float(xw.z << 16); n1[1] = __uint_as_float(xw.z & 0xFFFF0000u); n1[2] = __uint_as_float(xw.w << 16); n1[3] = __uint_as_float(xw.w & 0xFFFF0000u);
                    n0 = n0 + g0 * acc[ai][bj][m][0]; n1 = n1 + g1 * acc[ai][bj][m][1];
                    if (dry) continue;
                    if (outf) { *(f32x4*)(op + co) = n0; *(f32x4*)(op + co + 4) = n1; }
                    else { u32x4 w; w.x = cvt_pk_bf16(n0[0], n0[1]); w.y = cvt_pk_bf16(n0[2], n0[3]); w.z = cvt_pk_bf16(n1[0], n1[1]); w.w = cvt_pk_bf16(n1[2], n1[3]); *(u32x4*)(rowp + co) = w; } } }
    }
};
}
#endif


DEV void ld8(const bf16* q, float (&f)[8]) { const U4 u = *(const U4*)q; f[0] = bflo(u.x); f[1] = bfhi(u.x); f[2] = bflo(u.y); f[3] = bfhi(u.y); f[4] = bflo(u.z); f[5] = bfhi(u.z); f[6] = bflo(u.w); f[7] = bfhi(u.w); }
DEV void ldf8(const float* q, float (&f)[8]) {
#pragma unroll
    for (int e = 0; e < 8; ++e) f[e] = q[e]; }
DEV U4 pack8(const float (&f)[8]) { U4 u; u.x = f2bf(f[0]) | ((unsigned)f2bf(f[1]) << 16); u.y = f2bf(f[2]) | ((unsigned)f2bf(f[3]) << 16); u.z = f2bf(f[4]) | ((unsigned)f2bf(f[5]) << 16); u.w = f2bf(f[6]) | ((unsigned)f2bf(f[7]) << 16); return u; }
DEV void conv4x8(const bf16* src, int ld, const float* w  , int wn, const float* bias, bool hp0, bool hn3, float (&out)[4][8]) {
    float w0[8], w1[8], w2[8], bb[8], x[6][8];
    ldf8(w, w0); ldf8(w + wn, w1); ldf8(w + 2 * wn, w2); ldf8(bias, bb);
#pragma unroll
    for (int i = 0; i < 6; ++i) { if ((i == 0 && !hp0) || (i == 5 && !hn3)) {
#pragma unroll
            for (int e = 0; e < 8; ++e) x[i][e] = 0.f; } else ld8(src + (long)(i - 1) * ld, x[i]); }
#pragma unroll
    for (int i = 0; i < 4; ++i)
#pragma unroll
        for (int e = 0; e < 8; ++e) out[i][e] = bb[e] + w0[e] * x[i][e] + w1[e] * x[i + 1][e] + w2[e] * x[i + 2][e];
}

template <int PH> DEV void phase(PRef p, int l, int arg, long gtid, long gth);


template <> DEV void phase<PH_MOD>(PRef p, int, int, long gtid, long gth) {
    constexpr int KC = D / 8;
    for (long i = gtid; i < (long)8 * DEPTH * 6 * D; i += gth) {
        const int j = (int)(i % (6 * D)), l = (int)((i / (6 * D)) % DEPTH), kc = (int)(i / ((long)6 * D * DEPTH));
        const float* w = p.ada_w + (long)l * D * 6 * D + j;
        float acc[B + 1];
#pragma unroll
        for (int bi = 0; bi <= B; ++bi) acc[bi] = 0.f;
        for (int k = kc * KC; k < (kc + 1) * KC; ++k) { const float wv = w[(long)k * 6 * D];
#pragma unroll
            for (int bi = 0; bi <= B; ++bi) acc[bi] += silu_f(bi < B ? p.c[(long)bi * D + k] : p.c_ctx[k]) * wv; }
#pragma unroll
        for (int bi = 0; bi <= B; ++bi) wMODP(p.ws)[(((long)kc * DEPTH + l) * (B + 1) + bi) * 6 * D + j] = acc[bi];
    }
}
template <> DEV void phase<PH_MOD2>(PRef p, int, int, long gtid, long gth) {
    for (long i = gtid; i < (long)DEPTH * (B + 1) * 6 * D; i += gth) {
        const int j = (int)(i % (6 * D)), l = (int)(i / ((long)6 * D * (B + 1)));
        float acc = p.ada_b[(long)l * 6 * D + j];
        for (int kc = 0; kc < 8; ++kc) acc += wMODP(p.ws)[(long)kc * DEPTH * (B + 1) * 6 * D + i];
        wMOD(p.ws)[i] = acc;
    }
}
template <> DEV void phase<PH_ROPE>(PRef p, int, int, long gtid, long gth) {
    for (long i = gtid; i < (long)SEQ * 16; i += gth) {
        const int j = (int)(i % 16), t = (int)(i / 16);
        const int jj = j & 7;
        const float inv = (jj & 1 ? 0.31622776601683794f : 1.0f) * (jj >> 1 == 0 ? 1.0f : jj >> 1 == 1 ? 0.1f : jj >> 1 == 2 ? 0.01f : 0.001f);
        const float pos = j < 8 ? (float)(t / GRID_W) : (float)(t % GRID_W);
        const float a = pos * inv;
        wROPET(p.ws)[i * 2] = cosf(a); wROPET(p.ws)[i * 2 + 1] = sinf(a);
    }
}
template <> DEV void phase<PH_FILT_A>(PRef p, int l, int, long gtid, long gth) {
    for (long i = gtid; i < (long)2 * SEQ * HH; i += gth) {
        const int j = (int)(i % HH), pos = (int)((i / HH) % SEQ), set = (int)(i / ((long)HH * SEQ));
        const int L = set ? CTX : SEQ; if (pos >= L) continue;
        const float* w1 = p.hy_w1 + (long)l * HE * HH;
        const float tl = (float)pos / (float)(L - 1);
        float acc = p.hy_b1[l * HH + j] + tl * w1[j];
        for (int e = 0; e < HB; ++e) {
            const float band = 1e-4f + (float)e * (((float)(HB - 1) - 1e-4f) / (float)(HB - 1));
            float turns = (float)pos * band / (float)L; turns -= floorf(turns);
            acc += cos_t(turns) * w1[(1 + e) * HH + j] - sin_t(turns) * w1[(1 + HB + e) * HH + j];
        }
        wHD1(p.ws)[i] = sin_f(p.hy_freq[l * HH + j] * acc);
    }
}
template <> DEV void phase<PH_FILT_B>(PRef p, int l, int, long gtid, long gth) {
    for (long i = gtid; i < (long)2 * SEQ * HH; i += gth) {
        const int j = (int)(i % HH), pos = (int)((i / HH) % SEQ), set = (int)(i / ((long)HH * SEQ));
        const int L = set ? CTX : SEQ; if (pos >= L) continue;
        const float* w2 = p.hy_w2 + (long)l * HH * HH;
        const float* h1 = wHD1(p.ws) + (i - j);
        float acc = p.hy_b2[l * HH + j];
        for (int e = 0; e < HH; ++e) acc += h1[e] * w2[e * HH + j];
        wHD2(p.ws)[i] = sin_f(p.hy_freq[l * HH + j] * acc);
    }
}
template <> DEV void phase<PH_FILT_C>(PRef p, int l, int, long gtid, long gth) {
    const float* w3 = p.hy_w3 + (long)l * HH * 2 * HW;
    for (long i = gtid; i < (long)2 * (SEQ / 4) * 2 * HW; i += gth) {
        const int c2 = (int)(i % (2 * HW)), pq = (int)((i / (2 * HW)) % (SEQ / 4)), set = (int)(i / ((long)2 * HW * (SEQ / 4)));
        const int L = set ? CTX : SEQ, pos0 = pq * 4; if (pos0 >= L) continue;
        const float* h2 = wHD2(p.ws) + ((long)set * SEQ + pos0) * HH;
        float acc[4] = {0.f, 0.f, 0.f, 0.f};
        for (int e = 0; e < HH; ++e) { const float w = w3[e * 2 * HW + c2];
#pragma unroll
            for (int k = 0; k < 4; ++k) acc[k] += h2[k * HH + e] * w; }
        const int c = c2 % HW;
        const float a0 = -4.605170185988091f / 1.5f, a1 = -4.605170185988091f / 0.3f;
        const float delta = fabsf(a0 + (a1 - a0) * (float)c / (float)(HW - 1));
#pragma unroll
        for (int k = 0; k < 4; ++k) { const int pos = pos0 + k; const float tl = (float)pos / (float)(L - 1); const float v = acc[k] * (exp_f(-tl * delta) + 0.05f);
            if (set == 0) wFT(p.ws)[(long)c2 * SEQ + pos] = v; else wFT1(p.ws)[(long)pos * 2 * HW + c2] = v; }
    }
}
DEV float filt_tap(PRef p, int set, int c2, int pos) { return set == 0 ? wFT(p.ws)[(long)c2 * SEQ + pos] : wFT1(p.ws)[(long)pos * 2 * HW + c2]; }
template <> DEV void phase<PH_FILT_D>(PRef p, int, int, long gtid, long gth) {
    for (long i = gtid; i < (long)2 * HW * 64; i += gth) {
        const int part = (int)(i % 64), c = (int)((i / 64) % HW), set = (int)(i / (64 * HW)); const int L = set ? CTX : SEQ, per = L / 64;
        float s = 0.f;
        for (int pos = part * per; pos < (part + 1) * per; ++pos) { s += fabsf(filt_tap(p, set, c, pos)); if (pos >= 1) s += fabsf(filt_tap(p, set, HW + c, pos)); }
        wFL1(p.ws)[i] = s;
    }
}
DEV float filt_l1(PRef p, int set, int c) { const float* q = wFL1(p.ws) + ((long)set * HW + c) * 64; float s = 0.f; for (int i = 0; i < 64; ++i) s += q[i]; return s; }
template <> DEV void phase<PH_NORM1>(PRef p, int l, int, long gtid, long gth) {
    for (long r = gtid; r < R; r += gth) {
        const RowI ri = rowinfo((int)r);
        bf16* xr = wX(p.ws) + r * D; const float* src = ri.ctx ? p.ctx + ((long)ri.b * CTX + ri.t) * D : p.x + ((long)ri.b * SEQ + ri.t) * D;
        if (l == 0) for (int k = 0; k < D; ++k) xr[k] = f2bf(src[k]);
        float ss = 0.f; for (int k = 0; k < D; ++k) { const float v = l == 0 ? src[k] : bf2f(xr[k]); ss += v * v; }
        const float rstd = 1.0f / sqrtf(ss / (float)D + EPS);
        const float* mod = wMOD(p.ws) + ((long)l * (B + 1) + ri.bi) * 6 * D;
        const float* g = p.norm1_g + l * D;
        for (int k = 0; k < D; ++k) { const float v = l == 0 ? src[k] : bf2f(xr[k]); wH(p.ws)[r * D + k] = f2bf(v * rstd * g[k] * (1.0f + mod[D + k]) + mod[k]); }
    }
}
template <> DEV void phase<PH_GEMM1>(PRef p, int l, int, long gtid, long gth) {
    for (long i = gtid; i < (long)R * NP; i += gth) { const int n = (int)(i % NP); const long r = i / NP;
        wP(p.ws)[i] = f2bf(dot_bf16(wH(p.ws) + r * D, wWinT(p.ws, l) + (long)n * D, D)); }
}
template <> DEV void phase<PH_MLA_A>(PRef p, int, int, long gtid, long gth) {
    for (long r = gtid; r < R; r += gth) {
        const RowI ri = rowinfo((int)r); const bf16* pr = wP(p.ws) + r * NP;
        float s = 0.f; for (int k = 0; k < QR; ++k) { const float v = bf2f(pr[k]); s += v * v; }
        wRS(p.ws)[r] = 1.0f / sqrtf(s / (float)QR + EPS);
        s = 0.f; for (int k = 0; k < KVR; ++k) { const float v = bf2f(pr[QR + k]); s += v * v; }
        wRS(p.ws)[R + r] = 1.0f / sqrtf(s / (float)KVR + EPS);
        for (int j = 0; j < 16; ++j) {
            const float x1 = bf2f(pr[QR + KVR + j]), x2 = bf2f(pr[QR + KVR + 16 + j]);
            float cs = 1.f, sn = 0.f; if (!ri.ctx) { cs = wROPET(p.ws)[((long)ri.t * 16 + j) * 2]; sn = wROPET(p.ws)[((long)ri.t * 16 + j) * 2 + 1]; }
            wKR(p.ws)[r * ROPE + j] = f2bf(x1 * cs - x2 * sn); wKR(p.ws)[r * ROPE + 16 + j] = f2bf(x1 * sn + x2 * cs);
        }
    }
}
template <> DEV void phase<PH_MLA_Q>(PRef p, int l, int, long gtid, long gth) {
    for (long i = gtid; i < (long)R * QW; i += gth) { const int n = (int)(i % QW); const long r = i / QW;
        const RowI ri = rowinfo((int)r);
        const float rs = wRS(p.ws)[r]; const bf16* a = wP(p.ws) + r * NP;
        float v = rs * dot_bf16(a, wWuqT(p.ws, l) + (long)n * QR, QR);
        wQ(p.out)[i] = f2bf(v);
    }
}
template <> DEV void phase<PH_MLA_KV>(PRef p, int l, int, long gtid, long gth) {
    for (long i = gtid; i < (long)R * KVW; i += gth) { const int n = (int)(i % KVW); const long r = i / KVW;
        const bf16 v = f2bf(wRS(p.ws)[R + r] * dot_bf16(wP(p.ws) + r * NP + QR, wWukvT(p.ws, l) + (long)n * KVR, KVR));
        if (n < AW) wKN(p.out)[r * AW + n] = v; else wVT(p.out)[(long)(n - AW) * R + (r & ~31L) + vperm32((int)(r & 31))] = v; }
}
template <> DEV void phase<PH_ATT>(PRef p, int l, int, long gtid, long gth) {
    const bool last = (l == DEPTH - 1);
    const float scale = 1.0f / sqrtf((float)(NOPE + ROPE));
    for (long i = gtid; i < (long)AH * R; i += gth) {
        const int h = (int)(i / R); const long r = i % R; const RowI ri = rowinfo((int)r);
        if (ri.ctx && last) continue;
        const bf16* qp = wQ(p.out) + r * QW + h * (NOPE + ROPE);
        float qr[ROPE];
#pragma unroll
        for (int j = 0; j < 16; ++j) { const float x1 = bf2f(qp[NOPE + j]), x2 = bf2f(qp[NOPE + 16 + j]);
            float cs = 1.f, sn = 0.f; if (!ri.ctx) { cs = wROPET(p.ws)[((long)ri.t * 16 + j) * 2]; sn = wROPET(p.ws)[((long)ri.t * 16 + j) * 2 + 1]; }
            qr[j] = x1 * cs - x2 * sn; qr[16 + j] = x1 * sn + x2 * cs; }
        float o[AV];
#pragma unroll
        for (int d = 0; d < AV; ++d) o[d] = 0.f;
        float m = -1e30f, ssum = 0.f;
        const long k0 = (long)ri.b * RPB; const int nk = ri.ctx ? CTX : RPB;
        for (int kk = 0; kk < nk; ++kk) {
            const bf16* kv = wKN(p.out) + (k0 + kk) * AW + h * NOPE; const bf16* kr = wKR(p.ws) + (k0 + kk) * ROPE;
            const bf16* vt = wVT(p.out) + (long)h * AV * R + ((k0 + kk) & ~31L) + vperm32((int)((k0 + kk) & 31));
            float s = 0.f;
#pragma unroll
            for (int d = 0; d < NOPE; d += 8) s += dot8(*(const U4*)(qp + d), *(const U4*)(kv + d));
#pragma unroll
            for (int d = 0; d < ROPE; ++d) s += qr[d] * bf2f(kr[d]);
            s *= scale;
            const float mn = fmaxf(m, s); const float corr = exp_f(m - mn), pw = exp_f(s - mn);
            ssum = ssum * corr + pw; m = mn;
#pragma unroll
            for (int d = 0; d < AV; ++d) o[d] = o[d] * corr + pw * bf2f(vt[(long)d * R]);
        }
        const float inv = 1.0f / ssum;
#pragma unroll
        for (int d = 0; d < AV; ++d) wH(p.ws)[r * D + h * AV + d] = f2bf(o[d] * inv);
    }
}
template <> DEV void phase<PH_ML_U>(PRef p, int l, int, long gtid, long gth) {
    for (long i = gtid; i < (long)(R / 4) * (MW / 8); i += gth) { const int cg = (int)(i % (MW / 8)); const long r = (i / (MW / 8)) * 4; const RowI ri = rowinfo((int)r);
        const int L = ri.ctx ? CTX : SEQ; float o[4][8];
        conv4x8(wP(p.ws) + r * NP + ML_LO + cg * 8, NP, p.ml_conv_w + (long)l * 3 * MW + cg * 8, MW, p.ml_conv_b + l * MW + cg * 8, ri.t > 0, ri.t + 4 < L, o);
#pragma unroll
        for (int k = 0; k < 4; ++k) {
#pragma unroll
            for (int e = 0; e < 8; ++e) o[k][e] = silu_f(o[k][e]);
            *(U4*)(wMU(p.ws) + (r + k) * MW + cg * 8) = pack8(o[k]); } }
    const float ksc = 1.0f / sqrtf((float)MD);
    for (long i = gtid; i < (long)2 * MW * MW; i += gth) { const int k = (int)(i % MW), n = (int)(i / MW); const int isk = n >= MW, nn = n % MW, h = nn / MD, e = nn % MD;
        float v = 0.f; if (k / MD == h) v = isk ? p.ml_wk[(((long)l * MH + h) * MD + k % MD) * MD + e] * ksc : p.ml_wq[(((long)l * MH + h) * MD + k % MD) * MD + e];
        wWML(p.ws)[i] = f2bf(v); }
}
template <> DEV void phase<PH_ML_QK>(PRef p, int, int, long gtid, long gth) {
    for (long i = gtid; i < (long)R * 2 * MW; i += gth) { const int n = (int)(i % (2 * MW)); const long r = i / (2 * MW);
        wMQK(p.ws)[i] = f2bf(dot_bf16(wMU(p.ws) + r * MW, wWML(p.ws) + (long)n * MW, MW)); }
}
DEV int ml_scan_sc(int dir, int k) { return dir == 0 ? k : (k < NCS ? NCS - 1 - k : SCN - 1 - (k - NCS)); }
DEV int ml_sc_rank(int dir, int sc) { return dir == 0 ? sc : (sc < NCS ? NCS - 1 - sc : NCS + (SCN - 1 - sc)); }
template <> DEV void phase<PH_ML_F>(PRef p, int l, int, long gtid, long gth) {
    for (long i = gtid; i < (long)B * SCN * MH * 2; i += gth) { const int dir = (int)(i % 2), h = (int)((i / 2) % MH), sc = (int)((i / (2 * MH)) % SCN), b = (int)(i / (2 * MH * SCN));
        const float bi_ = p.ml_gate_b[(l * 4 + 2 * dir) * MH + h], bf_ = p.ml_gate_b[(l * 4 + 2 * dir + 1) * MH + h];
        float F = 0.f;
        for (int pos = 0; pos < SCS; ++pos) { const long r = (long)b * RPB + (long)sc * SCS + (dir == 0 ? pos : SCS - 1 - pos);
            const bf16* g = wP(p.ws) + r * NP + ML_LO + 3 * MW;
            const float li = bf2f(g[(2 * dir) * MH + h]) + bi_, lf = logsigmoid_f(bf2f(g[(2 * dir + 1) * MH + h]) + bf_);
            F += lf; float* fg = wFG(p.ws) + ((r * 2 + dir) * MH + h) * 2; fg[0] = F; fg[1] = F - li; }
    }
}
template <> DEV void phase<PH_ML_B>(PRef p, int, int, long gtid, long gth) {
    for (long i = gtid; i < (long)B * MH * 2 * SCN * (MD + 1) * MD; i += gth) {
        const int e = (int)(i % MD), jrow = (int)((i / MD) % (MD + 1)); long t = i / ((long)MD * (MD + 1));
        const int sc = (int)(t % SCN); t /= SCN; const int dir = (int)(t % 2); t /= 2; const int h = (int)(t % MH); const int b = (int)(t / MH);
        const long r0 = (long)b * RPB + (long)sc * SCS; const long rend = dir == 0 ? r0 + SCS - 1 : r0;
        const float Fend = wFG(p.ws)[((rend * 2 + dir) * MH + h) * 2];
        float acc = 0.f;
        for (int s = 0; s < SCS; ++s) { const long r = r0 + s; const float w = exp_f(Fend - wFG(p.ws)[((r * 2 + dir) * MH + h) * 2 + 1]);
            if (jrow < MD) acc += w * bf2f(wMQK(p.ws)[r * 2 * MW + MW + h * MD + jrow]) * bf2f(wP(p.ws)[r * NP + ML_LO + MW + h * MD + e]);
            else acc += w * bf2f(wMQK(p.ws)[r * 2 * MW + MW + h * MD + e]); }
        wMS(p.ws)[i] = acc;
    }
}
template <> DEV void phase<PH_ML_S>(PRef p, int, int dry, long gtid, long gth) {
    for (long i = gtid; i < (long)B * MH * 2 * (MD + 1) * MD; i += gth) {
        const int el = (int)(i % ((MD + 1) * MD)); long t = i / ((MD + 1) * MD); const int dir = (int)(t % 2); t /= 2; const int h = (int)(t % MH); const int b = (int)(t / MH);
        float* base = wMS(p.ws) + ((((long)b * MH + h) * 2 + dir) * SCN) * (MD + 1) * MD + el;
        float C = 0.f;
        for (int k = 0; k < SCN; ++k) { const int sc = ml_scan_sc(dir, k);
            const long r0 = (long)b * RPB + (long)sc * SCS; const long rend = dir == 0 ? r0 + SCS - 1 : r0;
            const float Ftot = wFG(p.ws)[((rend * 2 + dir) * MH + h) * 2];
            float* slot = base + (long)sc * (MD + 1) * MD; const float Bk = *slot; if (!dry) *slot = C;
            C = exp_f(Ftot) * C + Bk; }
    }
}
template <> DEV void phase<PH_ML_O>(PRef p, int l, int, long gtid, long gth) {
    const bool last = (l == DEPTH - 1);
    constexpr int HV = MD / 2;
    for (long i = gtid; i < (long)MH * R; i += gth) {
        const int h = (int)(i / R); const long r = i % R; const RowI ri = rowinfo((int)r);
        if (ri.ctx && last) continue;
        const bf16* qp = wMQK(p.ws) + r * 2 * MW + h * MD;
        const int sc = ri.o / SCS; const long r0 = (long)ri.b * RPB + (long)sc * SCS;
        float ss = 0.f;
        for (int half = 0; half < 2; ++half) {
            float hs[HV], num[HV];
#pragma unroll
            for (int d = 0; d < HV; ++d) hs[d] = 0.f;
            for (int dir = 0; dir < 2; ++dir) {
#pragma unroll
                for (int d = 0; d < HV; ++d) num[d] = 0.f;
                float den = 0.f;
                const float Ft = wFG(p.ws)[((r * 2 + dir) * MH + h) * 2];
                const long sa = dir == 0 ? r0 : r, sb = dir == 0 ? r : r0 + SCS - 1;
                for (long s = sa; s <= sb; ++s) {
                    const float w = exp_f(Ft - wFG(p.ws)[((s * 2 + dir) * MH + h) * 2 + 1]);
                    float dt = 0.f;
#pragma unroll
                    for (int d = 0; d < MD; d += 8) dt += dot8(*(const U4*)(qp + d), *(const U4*)(wMQK(p.ws) + s * 2 * MW + MW + h * MD + d));
                    dt *= w; den += dt;
#pragma unroll
                    for (int d = 0; d < HV; ++d) num[d] += dt * bf2f(wP(p.ws)[s * NP + ML_LO + MW + h * MD + half * HV + d]);
                }
                if (ml_sc_rank(dir, sc) > 0) {
                    const float a = exp_f(Ft);
                    const float* Cin = wMS(p.ws) + (((((long)ri.b * MH + h) * 2 + dir) * SCN) + sc) * (MD + 1) * MD;
#pragma unroll 1
                    for (int d = 0; d < MD; ++d) { const float qa = bf2f(qp[d]) * a; den += qa * Cin[MD * MD + d];
#pragma unroll
                        for (int e = 0; e < HV; ++e) num[e] += qa * Cin[d * MD + half * HV + e]; }
                }
                const float dn = 1.0f / fmaxf(fabsf(den), 1.0f);
#pragma unroll
                for (int d = 0; d < HV; ++d) hs[d] += num[d] * dn;
            }
#pragma unroll
            for (int d = 0; d < HV; ++d) { const float v = hs[d] * sigmoid_f(bf2f(wP(p.ws)[r * NP + ML_LO + 2 * MW + h * MD + half * HV + d])); ss += v * v;
                wH(p.ws)[r * D + AW + h * MD + half * HV + d] = f2bf(v); }
        }
        const float rstd = 1.0f / sqrtf(ss / (float)MD + EPS);
        for (int d = 0; d < MD; ++d) { bf16* o = wH(p.ws) + r * D + AW + h * MD + d; *o = f2bf(bf2f(*o) * rstd * p.ml_norm_g[l * MW + h * MD + d]); }
    }
}

DEV float hy_conv(PRef p, int l, long r, const RowI& ri, int ch) {
    const float* w = p.hy_conv_w + (long)l * 3 * N_HY; const bf16* pr = wP(p.ws) + r * NP + HY_LO + ch;
    float y = p.hy_conv_b[l * N_HY + ch] + w[N_HY + ch] * bf2f(pr[0]);
    if (has_prev(ri)) y += w[ch] * bf2f(pr[-NP]);
    if (has_next(ri)) y += w[2 * N_HY + ch] * bf2f(pr[NP]);
    return y;
}
template <> DEV void phase<PH_HY_Z>(PRef p, int l, int, long gtid, long gth) {
    for (long i = gtid; i < (long)B * CTX * HW; i += gth) { const int c = (int)(i % HW); const long q = i / HW; const long r = (q / CTX) * RPB + (q % CTX); const RowI ri = rowinfo((int)r);
        wZ(p.ws)[i] = hy_conv(p, l, r, ri, HW + c) * hy_conv(p, l, r, ri, 2 * HW + c); }
}
template <> DEV void phase<PH_HY_O>(PRef p, int l, int, long gtid, long gth) {
    if (l == DEPTH - 1) return;
    for (long i = gtid; i < (long)B * CTX * HW; i += gth) { const int c = (int)(i % HW); const long q = i / HW; const int b = (int)(q / CTX), t = (int)(q % CTX); const long r = (long)b * RPB + t; const RowI ri = rowinfo((int)r);
        const float* z = wZ(p.ws) + (long)b * CTX * HW + c;
        float y = 0.f;
        for (int s2 = 0; s2 <= t; ++s2) y += filt_tap(p, 1, c, t - s2) * z[(long)s2 * HW];
        for (int s2 = t + 1; s2 < CTX; ++s2) y += filt_tap(p, 1, HW + c, s2 - t) * z[(long)s2 * HW];
        y = y / filt_l1(p, 1, c) + z[(long)t * HW] * p.hy_bias_d[l * HW + c];
        wH(p.ws)[r * D + AW + MW + c] = f2bf(hy_conv(p, l, r, ri, c) * y); }
}
#ifdef HOST_EMU
#define BLOCK_FOR(tid) for (int tid = 0; tid < NTHREADS; ++tid)
#define BLOCK_SYNC() do {} while (0)
typedef unsigned char* LdsPtr;
DEV C2 twid(float turns) { C2 w; w.x = cosf(6.283185307179586f * turns); w.y = -sinf(6.283185307179586f * turns); return w; }
#else
DEV int opaque_tid() { int t = threadIdx.x; asm volatile("" : "+v"(t)); return t; }
#define BLOCK_FOR(tid) for (int tid = opaque_tid(), once_ = 1; once_; once_ = 0)
#define BLOCK_SYNC() __syncthreads()
typedef __attribute__((address_space(3))) unsigned char* LdsPtr;
DEV C2 twid(float turns) { C2 w; w.x = __builtin_amdgcn_cosf(turns); w.y = -__builtin_amdgcn_sinf(turns); return w; }
#endif
#ifdef HOST_EMU
typedef float* LdsC2; typedef bf16* LdsBf;
#else
typedef __attribute__((address_space(3))) float* LdsC2; typedef __attribute__((address_space(3))) bf16* LdsBf;
#endif
constexpr int NF = 2 * SEQ, NBF = NF / 8;
static_assert(SEQ == 4096 || SEQ == 512, "FFT passes: one radix-2 step then radix-8 steps (SEQ a power of 8)");
DEV int PI(int i) { return i + (i >> 3); }
DEV C2 ldc(LdsC2 buf, int i) { C2 r; r.x = buf[2 * i]; r.y = buf[2 * i + 1]; return r; }
DEV void stc(LdsC2 buf, int i, C2 v) { buf[2 * i] = v.x; buf[2 * i + 1] = v.y; }
DEV C2 cmul(C2 a, C2 b) { C2 r; r.x = a.x * b.x - a.y * b.y; r.y = a.x * b.y + a.y * b.x; return r; }
DEV C2 cmulc(C2 a, C2 b) { C2 r; r.x = a.x * b.x + a.y * b.y; r.y = a.y * b.x - a.x * b.y; return r; }
DEV void dft4(C2& u0, C2& u1, C2& u2, C2& u3) {
    const C2 t0 = {u0.x + u2.x, u0.y + u2.y}, t1 = {u0.x - u2.x, u0.y - u2.y}, t2 = {u1.x + u3.x, u1.y + u3.y}, d = {u1.x - u3.x, u1.y - u3.y};
    const C2 t3 = {d.y, -d.x};
    u0.x = t0.x + t2.x; u0.y = t0.y + t2.y; u2.x = t0.x - t2.x; u2.y = t0.y - t2.y; u1.x = t1.x + t3.x; u1.y = t1.y + t3.y; u3.x = t1.x - t3.x; u3.y = t1.y - t3.y;
}
DEV void dft8(C2 (&a)[8]) {
    const float c = 0.70710678118654752f;
    C2 b0 = {a[0].x + a[4].x, a[0].y + a[4].y}, b4 = {a[0].x - a[4].x, a[0].y - a[4].y};
    C2 b1 = {a[1].x + a[5].x, a[1].y + a[5].y}, d5 = {a[1].x - a[5].x, a[1].y - a[5].y};
    C2 b2 = {a[2].x + a[6].x, a[2].y + a[6].y}, d6 = {a[2].x - a[6].x, a[2].y - a[6].y};
    C2 b3 = {a[3].x + a[7].x, a[3].y + a[7].y}, d7 = {a[3].x - a[7].x, a[3].y - a[7].y};
    C2 b5 = {c * (d5.x + d5.y), c * (d5.y - d5.x)};
    C2 b6 = {d6.y, -d6.x};
    C2 b7 = {c * (d7.y - d7.x), -c * (d7.x + d7.y)};
    dft4(b0, b1, b2, b3); dft4(b4, b5, b6, b7);
    a[0] = b0; a[2] = b1; a[4] = b2; a[6] = b3; a[1] = b4; a[3] = b5; a[5] = b6; a[7] = b7;
}
DEV void idft8(C2 (&a)[8]) {
#pragma unroll
    for (int k = 0; k < 8; ++k) a[k].y = -a[k].y;
    dft8(a);
#pragma unroll
    for (int k = 0; k < 8; ++k) a[k].y = -a[k].y;
}
DEV void twpow(C2 w1, C2 (&w)[8]) { w[0].x = 1.f; w[0].y = 0.f; w[1] = w1; w[2] = cmul(w1, w1); w[3] = cmul(w[2], w1); w[4] = cmul(w[2], w[2]); w[5] = cmul(w[4], w1); w[6] = cmul(w[3], w[3]); w[7] = cmul(w[4], w[3]); }
template <bool INV> DEV void fft_pass8(LdsC2 buf, int s, int ls, int tid) {
    for (int q = tid; q < NBF; q += NTHREADS) {
        const int blk = q >> ls, j = q & (s - 1), base = (blk << (ls + 3)) + j;
        C2 a[8], w[8];
#pragma unroll
        for (int k = 0; k < 8; ++k) a[k] = ldc(buf, PI(base + (k << ls)));
        twpow(twid((float)j / (float)(8 * s)), w);
        if (!INV) { dft8(a);
#pragma unroll
            for (int m = 1; m < 8; ++m) a[m] = cmul(a[m], w[m]);
        } else {
#pragma unroll
            for (int m = 1; m < 8; ++m) a[m] = cmulc(a[m], w[m]);
            idft8(a); }
#pragma unroll
        for (int k = 0; k < 8; ++k) stc(buf, PI(base + (k << ls)), a[k]);
    }
}
DEV void fft_fwd_passes(LdsC2 buf, LdsC2 buf2 = nullptr) {
    int ls = (SEQ == 4096 ? 9 : 6);
    for (int s = SEQ / 8; s >= 8; s >>= 3, ls -= 3) { BLOCK_FOR(tid) { fft_pass8<false>(buf, s, ls, tid); if (buf2) fft_pass8<false>(buf2, s, ls, tid); } BLOCK_SYNC(); }
}
DEV void fft_inv_passes(LdsC2 buf, LdsC2 buf2 = nullptr) {
    int ls = 3;
    for (int s = 8; s <= SEQ / 8; s <<= 3, ls += 3) { BLOCK_FOR(tid) { fft_pass8<true>(buf, s, ls, tid); if (buf2) fft_pass8<true>(buf2, s, ls, tid); } BLOCK_SYNC(); }
}
enum { BPH_HFFT, BPH_HYFFT, BPH_HYZ, BPH_HYOUT, BPH_WCVT, BPH_HYCTX };
template <int BPH> DEV void bphase(PRef p, int l, int blk, LdsPtr lds);
constexpr int WT_UP = (D / 32) * (FF2 / 64), WT_DOWN = (FF / 32) * (D / 64), WT_IN = (D / 32) * (NP / 64), WT_UQ = (QR / 32) * (QW / 64), WT_UKV = (KVR / 32) * (KVW / 64), WT_OUT = (D / 32) * (D / 64);
constexpr int WT_ALL = WT_IN + WT_UQ + WT_UKV + WT_OUT + WT_UP + WT_DOWN;
static_assert(QR % 32 == 0 && KVR % 32 == 0 && QW % 64 == 0 && FF % 64 == 0 && NP % 64 == 0, "weight tiles");
struct WTile { const float* W; const float* gain; bf16* WT; int K, N, k0, n0, s0; };
DEV WTile wtile_decode(PRef p, int l, int t) {
    WTile w; w.gain = nullptr; int NT, which;
    if (t < WT_IN) { which = 0; w.W = p.w_in + (long)l * D * N_IN; w.WT = wWinT(p.ws, l); w.K = D; w.N = N_IN; NT = NP; }
    else if ((t -= WT_IN) < WT_UQ) { which = 1; w.W = p.w_uq + (long)l * QR * QW; w.gain = p.q_norm_g + l * QR; w.WT = wWuqT(p.ws, l); w.K = QR; w.N = QW; NT = QW; }
    else if ((t -= WT_UQ) < WT_UKV) { which = 2; w.W = p.w_ukv + (long)l * KVR * KVW; w.gain = p.kv_norm_g + l * KVR; w.WT = wWukvT(p.ws, l); w.K = KVR; w.N = KVW; NT = KVW; }
    else if ((t -= WT_UKV) < WT_OUT) { which = 3; w.W = p.w_out + (long)l * D * D; w.WT = wWoutT(p.ws, l); w.K = D; w.N = D; NT = D; }
    else if ((t -= WT_OUT) < WT_UP) { which = 4; w.W = p.w_up + (long)l * D * FF2; w.WT = wWupT(p.ws, l); w.K = D; w.N = FF2; NT = FF2; }
    else { t -= WT_UP; which = 5; w.W = p.w_down + (long)l * FF * D; w.WT = wWdownT(p.ws, l); w.K = FF; w.N = D; NT = D; }
    const int ntn = NT / 64, kb = t / ntn, nb = t % ntn; w.k0 = kb * 32; w.n0 = nb * 64;
    w.s0 = w.n0;
    if (which == 2) { const int hd = (w.n0 % AW) / 64; w.s0 = hd * (NOPE + AV) + (w.n0 < AW ? 0 : NOPE); }
#ifndef HOST_EMU
    if (which == 4) { const int tile = w.n0 / 256, within = w.n0 % 256; w.s0 = within < 128 ? tile * 128 + within : FF + tile * 128 + (within - 128); }
#endif
    return w;
}
constexpr int DOWN_BUSY = (R / 256 * (D / 256)) % NBLOCKS, NFILL = NBLOCKS - DOWN_BUSY;
constexpr int WT_PER = 4, WT_ITEMS = (WT_ALL + WT_PER - 1) / WT_PER, WT_SPLIT = (WT_IN + WT_UQ + WT_UKV + WT_OUT + WT_PER - 1) / WT_PER;
template <> DEV void bphase<BPH_WCVT>(PRef p, int l, int blk, LdsPtr lds) {
#ifdef HOST_EMU
    float* sm = (float*)lds;
#else
    __attribute__((address_space(3))) float* sm = (__attribute__((address_space(3))) float*)lds;
#endif
    BLOCK_FOR(tid) {
        for (int sub = 0; sub < WT_PER; ++sub) { const int t = blk * WT_PER + sub; if (t >= WT_ALL) break; const WTile w = wtile_decode(p, l, t);
            for (int idx = tid; idx < 32 * 64; idx += NTHREADS) { const int kk = idx >> 6, nn = idx & 63;
                float v = 0.f; if (w.s0 + nn < w.N) v = w.W[(long)(w.k0 + kk) * w.N + w.s0 + nn];
                if (w.gain) v *= w.gain[w.k0 + kk];
                sm[sub * 64 * 33 + nn * 33 + kk] = v; } }
    }
    BLOCK_SYNC();
    BLOCK_FOR(tid) {
        for (int sub = 0; sub < WT_PER; ++sub) { const int t = blk * WT_PER + sub; if (t >= WT_ALL) break; const WTile w = wtile_decode(p, l, t);
            for (int idx = tid; idx < 64 * 4; idx += NTHREADS) { const int nn = idx >> 2, ch = idx & 3; const int so = sub * 64 * 33 + nn * 33 + ch * 8;
                U4 o;
                o.x = f2bf(sm[so + 0]) | ((unsigned)f2bf(sm[so + 1]) << 16); o.y = f2bf(sm[so + 2]) | ((unsigned)f2bf(sm[so + 3]) << 16);
                o.z = f2bf(sm[so + 4]) | ((unsigned)f2bf(sm[so + 5]) << 16); o.w = f2bf(sm[so + 6]) | ((unsigned)f2bf(sm[so + 7]) << 16);
                *(U4*)(w.WT + (long)(w.n0 + nn) * w.K + w.k0 + ch * 8) = o; } }
    }
    BLOCK_SYNC();
}
template <> DEV void bphase<BPH_HFFT>(PRef p, int l, int blk, LdsPtr lds) {
    LdsC2 buf = (LdsC2)lds; const int c = blk;
    BLOCK_FOR(tid) {
        const float inv = 1.0f / filt_l1(p, 0, c), bias = p.hy_bias_d[l * HW + c];
        const float* fw = wFT(p.ws) + (long)c * SEQ; const float* bw = wFT(p.ws) + (long)(HW + c) * SEQ;
        for (int i = tid; i < SEQ; i += NTHREADS) {
            const float t0 = fw[i] * inv + (i == 0 ? bias : 0.f), t1 = (i == 0) ? 0.f : bw[SEQ - i] * inv;
            C2 e; e.x = t0 + t1; e.y = 0.f; stc(buf, PI(i), e);
            const C2 w = twid((float)i / (float)NF); const float d = t0 - t1; C2 o; o.x = d * w.x; o.y = d * w.y; stc(buf, PI(i + SEQ), o); }
    }
    BLOCK_SYNC();
    fft_fwd_passes(buf);
    BLOCK_FOR(tid) {
        C2* hs = wHSPEC(p.ws) + (long)c * NF; const float sc = 1.0f / (float)NF;
        for (int q = tid; q < NBF; q += NTHREADS) { C2 a[8];
#pragma unroll
            for (int k = 0; k < 8; ++k) a[k] = ldc(buf, 9 * q + k);
            dft8(a);
#pragma unroll
            for (int k = 0; k < 8; ++k) { C2 o; o.x = a[k].x * sc; o.y = a[k].y * sc; hs[8 * q + k] = o; } }
    }
    BLOCK_SYNC();
}
template <> DEV void bphase<BPH_HYFFT>(PRef p, int lflag, int blk, LdsPtr lds) {
    const int c = blk;
    constexpr int NPB = (B >= 4 && B % 4 == 0) ? 2 : 1;
    LdsC2 bufs[2] = {(LdsC2)lds, (LdsC2)(lds + (NPB == 2 ? (NF + NF / 8) * 8 : 0))};
    for (int pr = 0; pr < B / 2; pr += NPB) {
        BLOCK_FOR(tid) {
#pragma unroll
            for (int k = 0; k < NPB; ++k) { LdsC2 buf = bufs[k]; const bf16* z1 = wZT(p.ws) + ((long)(2 * (pr + k)) * HW + c) * SEQ; const bf16* z2 = z1 + (long)HW * SEQ;
                for (int i = tid; i < SEQ; i += NTHREADS) { C2 e; e.x = bf2f(z1[i]); e.y = bf2f(z2[i]); stc(buf, PI(i), e); stc(buf, PI(i + SEQ), cmul(e, twid((float)i / (float)NF))); } }
        }
        BLOCK_SYNC();
        fft_fwd_passes(bufs[0], NPB == 2 ? bufs[1] : nullptr);
        BLOCK_FOR(tid) {
            const C2* hs = wHSPEC(p.ws) + (long)c * NF;
            for (int q = tid; q < NBF; q += NTHREADS) { C2 hv[8];
#pragma unroll
                for (int k = 0; k < 8; ++k) hv[k] = hs[8 * q + k];
#pragma unroll
                for (int kb = 0; kb < NPB; ++kb) { LdsC2 buf = bufs[kb]; C2 a[8];
#pragma unroll
                    for (int k = 0; k < 8; ++k) a[k] = ldc(buf, 9 * q + k);
                    dft8(a);
#pragma unroll
                    for (int k = 0; k < 8; ++k) a[k] = cmul(a[k], hv[k]);
                    idft8(a);
#pragma unroll
                    for (int k = 0; k < 8; ++k) stc(buf, 9 * q + k, a[k]); } }
        }
        BLOCK_SYNC();
        fft_inv_passes(bufs[0], NPB == 2 ? bufs[1] : nullptr);
        BLOCK_FOR(tid) {
#pragma unroll
            for (int k = 0; k < NPB; ++k) { LdsC2 buf = bufs[k]; bf16* z1 = wZT(p.ws) + ((long)(2 * (pr + k)) * HW + c) * SEQ; bf16* z2 = z1 + (long)HW * SEQ;
                for (int i = tid; i < SEQ; i += NTHREADS) { const C2 a = ldc(buf, PI(i)), bb = ldc(buf, PI(i + SEQ)); const C2 y = cmulc(bb, twid((float)i / (float)NF));
                    if (!(lflag & 256)) { z1[i] = f2bf(a.x + y.x); z2[i] = f2bf(a.y + y.y); } } }
        }
        BLOCK_SYNC();
    }
}
template <> DEV void bphase<BPH_HYCTX>(PRef p, int l, int blk, LdsPtr lds) {
#ifdef HOST_EMU
    float* sm = (float*)lds;
#else
    __attribute__((address_space(3))) float* sm = (__attribute__((address_space(3))) float*)lds;
#endif
    const int b = blk / (HW / 8), c0 = (blk % (HW / 8)) * 8;
    BLOCK_FOR(tid) {
        for (int idx = tid; idx < CTX * 8; idx += NTHREADS) { const int t = idx >> 3, c = idx & 7;
            sm[idx] = wZ(p.ws)[((long)b * CTX + t) * HW + c0 + c];
            sm[CTX * 8 + idx] = wFT1(p.ws)[(long)t * 2 * HW + c0 + c]; sm[2 * CTX * 8 + idx] = wFT1(p.ws)[(long)t * 2 * HW + HW + c0 + c]; }
    }
    BLOCK_SYNC();
    BLOCK_FOR(tid) {
        for (int idx = tid; idx < CTX * 8; idx += NTHREADS) { const int t = idx >> 3, c = idx & 7;
            float y = 0.f;
            for (int s2 = 0; s2 <= t; ++s2) y += sm[CTX * 8 + (t - s2) * 8 + c] * sm[s2 * 8 + c];
            for (int s2 = t + 1; s2 < CTX; ++s2) y += sm[2 * CTX * 8 + (s2 - t) * 8 + c] * sm[s2 * 8 + c];
            const long r = (long)b * RPB + t; const RowI ri = rowinfo((int)r);
            y = y / filt_l1(p, 1, c0 + c) + sm[t * 8 + c] * p.hy_bias_d[l * HW + c0 + c];
            wH(p.ws)[r * D + AW + MW + c0 + c] = f2bf(hy_conv(p, l, r, ri, c0 + c) * y); }
    }
    BLOCK_SYNC();
}
constexpr int HZP = 72;
template <> DEV void bphase<BPH_HYZ>(PRef p, int l, int blk, LdsPtr lds) {
    LdsBf sm = (LdsBf)lds; const int b = blk / (SEQ / 64), tt = blk % (SEQ / 64); const long r0 = (long)b * RPB + CTX + (long)tt * 64;
    BLOCK_FOR(tid) { for (int it = tid; it < (HW / 8) * 16; it += NTHREADS) {
        const int cg = it % (HW / 8), rs = it / (HW / 8); const int t0 = tt * 64 + rs * 4; const long r = r0 + rs * 4;
        float a[4][8], v[4][8];
        conv4x8(wP(p.ws) + r * NP + HY_LO + HW + cg * 8, NP, p.hy_conv_w + (long)l * 3 * N_HY + HW + cg * 8, N_HY, p.hy_conv_b + l * N_HY + HW + cg * 8, t0 > 0, t0 + 4 < SEQ, a);
        conv4x8(wP(p.ws) + r * NP + HY_LO + 2 * HW + cg * 8, NP, p.hy_conv_w + (long)l * 3 * N_HY + 2 * HW + cg * 8, N_HY, p.hy_conv_b + l * N_HY + 2 * HW + cg * 8, t0 > 0, t0 + 4 < SEQ, v);
#pragma unroll
        for (int e = 0; e < 8; ++e)
#pragma unroll
            for (int k = 0; k < 4; ++k) sm[(cg * 8 + e) * HZP + rs * 4 + k] = f2bf(a[k][e] * v[k][e]);
    } }
    BLOCK_SYNC();
    BLOCK_FOR(tid) {
        for (int idx = tid; idx < HW * 8; idx += NTHREADS) { const int c = idx >> 3, ch = idx & 7;
            U4 v; const LdsBf q = sm + c * HZP + ch * 8;
            v.x = q[0] | ((unsigned)q[1] << 16); v.y = q[2] | ((unsigned)q[3] << 16); v.z = q[4] | ((unsigned)q[5] << 16); v.w = q[6] | ((unsigned)q[7] << 16);
            *(U4*)(wZT(p.ws) + ((long)b * HW + c) * SEQ + tt * 64 + ch * 8) = v; }
    }
    BLOCK_SYNC();
}
template <> DEV void bphase<BPH_HYOUT>(PRef p, int l, int blk, LdsPtr lds) {
    LdsBf sm = (LdsBf)lds; const int b = blk / (SEQ / 64), tt = blk % (SEQ / 64); const long r0 = (long)b * RPB + CTX + (long)tt * 64;
    BLOCK_FOR(tid) {
        for (int idx = tid; idx < HW * 8; idx += NTHREADS) { const int c = idx >> 3, ch = idx & 7;
            const U4 v = *(const U4*)(wZT(p.ws) + ((long)b * HW + c) * SEQ + tt * 64 + ch * 8); LdsBf q = sm + c * HZP + ch * 8;
            q[0] = (bf16)v.x; q[1] = (bf16)(v.x >> 16); q[2] = (bf16)v.y; q[3] = (bf16)(v.y >> 16); q[4] = (bf16)v.z; q[5] = (bf16)(v.z >> 16); q[6] = (bf16)v.w; q[7] = (bf16)(v.w >> 16); }
    }
    BLOCK_SYNC();
    BLOCK_FOR(tid) { for (int it = tid; it < (HW / 8) * 16; it += NTHREADS) {
        const int cg = it % (HW / 8), rs = it / (HW / 8); const int t0 = tt * 64 + rs * 4; const long r = r0 + rs * 4;
        float x0[4][8];
        conv4x8(wP(p.ws) + r * NP + HY_LO + cg * 8, NP, p.hy_conv_w + (long)l * 3 * N_HY + cg * 8, N_HY, p.hy_conv_b + l * N_HY + cg * 8, t0 > 0, t0 + 4 < SEQ, x0);
#pragma unroll
        for (int k = 0; k < 4; ++k) {
#pragma unroll
            for (int e = 0; e < 8; ++e) x0[k][e] *= bf2f(sm[(cg * 8 + e) * HZP + rs * 4 + k]);
            *(U4*)(wH(p.ws) + (r + k) * D + AW + MW + cg * 8) = pack8(x0[k]); }
    } }
    BLOCK_SYNC();
}
template <> DEV void phase<PH_GEMM_OUT>(PRef p, int l, int, long gtid, long gth) {
    for (long i = gtid; i < (long)R * D; i += gth) { const int n = (int)(i % D); const long r = i / D; const RowI ri = rowinfo((int)r);
        const float g1 = wMOD(p.ws)[((long)l * (B + 1) + ri.bi) * 6 * D + 2 * D + n];
        wX(p.ws)[i] = f2bf(bf2f(wX(p.ws)[i]) + g1 * dot_bf16(wH(p.ws) + r * D, wWoutT(p.ws, l) + (long)n * D, D)); }
}
template <> DEV void phase<PH_NORM2>(PRef p, int l, int, long gtid, long gth) {
    for (long r = gtid; r < R; r += gth) { const RowI ri = rowinfo((int)r); const bf16* xr = wX(p.ws) + r * D;
        float ss = 0.f; for (int k = 0; k < D; ++k) ss += bf2f(xr[k]) * bf2f(xr[k]);
        const float rstd = 1.0f / sqrtf(ss / (float)D + EPS);
        const float* mod = wMOD(p.ws) + ((long)l * (B + 1) + ri.bi) * 6 * D; const float* g = p.norm2_g + l * D;
        for (int k = 0; k < D; ++k) wH(p.ws)[r * D + k] = f2bf(bf2f(xr[k]) * rstd * g[k] * (1.0f + mod[4 * D + k]) + mod[3 * D + k]); }
}
template <> DEV void phase<PH_FFN_UP>(PRef p, int l, int fc, long gtid, long gth) {
    for (long i = gtid; i < (long)FCR * FF2; i += gth) { const int n = (int)(i % FF2); const long rr = i / FF2; const long r = (long)fc * FCR + rr;
        wUF(p.ws)[i] = f2bf(dot_bf16(wH(p.ws) + r * D, wWupT(p.ws, l) + (long)n * D, D)); }
}
template <> DEV void phase<PH_FFN_CG>(PRef p, int l, int fc, long gtid, long gth) {
    for (long i = gtid; i < (long)FCR * FF; i += gth) { const int j = (int)(i % FF); const long rr = i / FF; const long r = (long)fc * FCR + rr; const RowI ri = rowinfo((int)r);
        const float* w = p.ffn_conv_w + (long)l * 3 * FF2; const float* cb = p.ffn_conv_b + (long)l * FF2; const bf16* u = wUF(p.ws) + rr * FF2;
        float a = cb[j] + w[FF2 + j] * bf2f(u[j]), g = cb[FF + j] + w[FF2 + FF + j] * bf2f(u[FF + j]);
        if (has_prev(ri)) { a += w[j] * bf2f(u[j - FF2]); g += w[FF + j] * bf2f(u[FF + j - FF2]); }
        if (has_next(ri)) { a += w[2 * FF2 + j] * bf2f(u[j + FF2]); g += w[2 * FF2 + FF + j] * bf2f(u[FF + j + FF2]); }
        wGF(p.ws)[i] = f2bf(silu_f(a) * g); }
}
template <> DEV void phase<PH_FFN_DOWN>(PRef p, int l, int fc, long gtid, long gth) {
    for (long i = gtid; i < (long)FCR * D; i += gth) { const int n = (int)(i % D); const long rr = i / D; const long r = (long)fc * FCR + rr; const RowI ri = rowinfo((int)r);
        const float g2 = wMOD(p.ws)[((long)l * (B + 1) + ri.bi) * 6 * D + 5 * D + n];
        const float xn = bf2f(wX(p.ws)[r * D + n]) + g2 * dot_bf16(wGF(p.ws) + rr * FF, wWdownT(p.ws, l) + (long)n * FF, FF);
        wX(p.ws)[r * D + n] = f2bf(xn); }
}
template <> DEV void phase<PH_FINAL>(PRef p, int, int, long gtid, long gth) {
    for (long q = gtid; q < (long)B * SEQ; q += gth) { const bf16* xr = wX(p.ws) + ((q / SEQ) * RPB + CTX + q % SEQ) * D;
        float ss = 0.f; for (int k = 0; k < D; ++k) ss += bf2f(xr[k]) * bf2f(xr[k]);
        const float rstd = 1.0f / sqrtf(ss / (float)D + EPS);
        for (int k = 0; k < D; ++k) p.out[q * D + k] = bf2f(xr[k]) * rstd * p.final_g[k]; }
}


#ifndef HOST_EMU
namespace wv {
typedef float f32x4 __attribute__((ext_vector_type(4)));
typedef unsigned u32x2 __attribute__((ext_vector_type(2)));
__device__ __forceinline__ float wsum(float v, int lane) {
#pragma unroll
    for (int o = 32; o; o >>= 1) v += __int_as_float(__builtin_amdgcn_ds_bpermute((lane ^ o) << 2, __float_as_int(v)));
    return v;
}
typedef __bf16 bf2_t __attribute__((ext_vector_type(2)));
typedef float f32x2_t __attribute__((ext_vector_type(2)));
__device__ __forceinline__ unsigned pk(float lo, float hi) { f32x2_t v = {lo, hi}; return __builtin_bit_cast(unsigned, __builtin_convertvector(v, bf2_t)); }
constexpr int NW = NBLOCKS * (NTHREADS / 64), NV = D / 256;
template <int MODE> __device__ __forceinline__ void norm_rows(PRef p, int l) {
    int t_ = threadIdx.x; asm volatile("" : "+v"(t_)); const int lane = t_ & 63, gw = (int)blockIdx.x * (NTHREADS / 64) + (t_ >> 6);
    const int nrows = MODE == 2 ? B * SEQ : R;
    for (int q0 = gw; q0 < nrows; q0 += 2 * NW) {
        const bool two = q0 + NW < nrows;
        long r[2]; int bi[2]; const float* src[2] = {nullptr, nullptr}; bf16* xdst[2] = {nullptr, nullptr};
        f32x4 v[2][NV];
#pragma unroll
        for (int u = 0; u < 2; ++u) if (u == 0 || two) {
            const int q = q0 + u * NW;
            if (MODE == 2) { r[u] = (long)(q / SEQ) * RPB + CTX + (q % SEQ); bi[u] = 0; }
            else { r[u] = q; const RowI ri = rowinfo(q); bi[u] = ri.bi;
                if (MODE == 0 && l == 0) { src[u] = ri.ctx ? p.ctx + ((long)ri.b * CTX + ri.t) * D : p.x + ((long)ri.b * SEQ + ri.t) * D; xdst[u] = wX(p.ws) + r[u] * D; } }
#pragma unroll
            for (int j = 0; j < NV; ++j) {
                if (src[u]) v[u][j] = *(const f32x4*)(src[u] + 4 * lane + 256 * j);
                else { const u32x2 xw = *(const u32x2*)(wX(p.ws) + r[u] * D + 4 * lane + 256 * j); v[u][j][0] = __uint_as_float(xw.x << 16); v[u][j][1] = __uint_as_float(xw.x & 0xFFFF0000u); v[u][j][2] = __uint_as_float(xw.y << 16); v[u][j][3] = __uint_as_float(xw.y & 0xFFFF0000u); } }
        }
#pragma unroll
        for (int u = 0; u < 2; ++u) if (u == 0 || two) {
            const int q = q0 + u * NW;
            float ss = 0.f;
#pragma unroll
            for (int j = 0; j < NV; ++j) ss += (v[u][j][0] * v[u][j][0] + v[u][j][1] * v[u][j][1]) + (v[u][j][2] * v[u][j][2] + v[u][j][3] * v[u][j][3]);
            if (xdst[u]) {
#pragma unroll
                for (int j = 0; j < NV; ++j) { u32x2 w; w.x = pk(v[u][j][0], v[u][j][1]); w.y = pk(v[u][j][2], v[u][j][3]); *(u32x2*)(xdst[u] + 4 * lane + 256 * j) = w; } }
            const float rstd = 1.0f / sqrtf(wsum(ss, lane) / (float)D + EPS);
            if (MODE == 2) {
#pragma unroll
                for (int j = 0; j < NV; ++j) { const f32x4 g = *(const f32x4*)(p.final_g + 4 * lane + 256 * j); *(f32x4*)(p.out + (long)q * D + 4 * lane + 256 * j) = v[u][j] * rstd * g; }
            } else {
                const float* mod = wMOD(p.ws) + ((long)l * (B + 1) + bi[u]) * 6 * D + (MODE == 0 ? 0 : 3 * D); const float* g = (MODE == 0 ? p.norm1_g : p.norm2_g) + l * D;
#pragma unroll
                for (int j = 0; j < NV; ++j) { const int k = 4 * lane + 256 * j; const f32x4 gg = *(const f32x4*)(g + k), sh = *(const f32x4*)(mod + k), sc = *(const f32x4*)(mod + D + k);
                    const f32x4 o = v[u][j] * rstd * gg * (sc + 1.0f) + sh; u32x2 w; w.x = pk(o[0], o[1]); w.y = pk(o[2], o[3]); *(u32x2*)(wH(p.ws) + r[u] * D + k) = w; }
            }
        }
    }
}
__device__ __forceinline__ float rsum16(float v) {
    v += __int_as_float(__builtin_amdgcn_update_dpp(0, __float_as_int(v), 0x128, 0xf, 0xf, false));
    v += __int_as_float(__builtin_amdgcn_update_dpp(0, __float_as_int(v), 0x124, 0xf, 0xf, false));
    v += __int_as_float(__builtin_amdgcn_update_dpp(0, __float_as_int(v), 0x122, 0xf, 0xf, false));
    v += __int_as_float(__builtin_amdgcn_update_dpp(0, __float_as_int(v), 0x121, 0xf, 0xf, false));
    return v;
}
__device__ __forceinline__ void mla_a_rows(PRef p) {
    int t_ = threadIdx.x; asm volatile("" : "+v"(t_)); const int lane = t_ & 63, i = lane & 15, g = lane >> 4, gw = (int)blockIdx.x * (NTHREADS / 64) + (t_ >> 6);
    static_assert(QR == 3 * 128 && KVR == 2 * 128 && ROPE == 32 && R % 4 == 0, "mla_a lane map");
    for (int q0 = gw * 4; q0 < R; q0 += 8 * NW) {
        U4 uq[2][3], uk[2][2]; float x1[2], x2[2], cs[2], sn[2]; bool ok[2], cx[2] = {false, false};
#pragma unroll
        for (int u = 0; u < 2; ++u) {
            const int r = q0 + u * 4 * NW + g; ok[u] = r < R;
            if (ok[u]) { const RowI ri = rowinfo(r); const bf16* pr = wP(p.ws) + (long)r * NP;
#pragma unroll
                for (int c = 0; c < 3; ++c) uq[u][c] = *(const U4*)(pr + (i + 16 * c) * 8);
#pragma unroll
                for (int c = 0; c < 2; ++c) uk[u][c] = *(const U4*)(pr + QR + (i + 16 * c) * 8);
                x1[u] = bf2f(pr[QR + KVR + i]); x2[u] = bf2f(pr[QR + KVR + 16 + i]);
                const int tt = ri.ctx ? 0 : ri.t; cx[u] = ri.ctx; cs[u] = wROPET(p.ws)[((long)tt * 16 + i) * 2]; sn[u] = wROPET(p.ws)[((long)tt * 16 + i) * 2 + 1]; }
        }
#pragma unroll
        for (int u = 0; u < 2; ++u) {
            const int r = q0 + u * 4 * NW + g;
            float sq = 0.f, sk = 0.f;
            if (ok[u]) { sq = dot8(uq[u][0], uq[u][0]) + dot8(uq[u][1], uq[u][1]) + dot8(uq[u][2], uq[u][2]); sk = dot8(uk[u][0], uk[u][0]) + dot8(uk[u][1], uk[u][1]); }
            sq = rsum16(sq); sk = rsum16(sk);
            if (ok[u]) {
                if (i == 0) { wRS(p.ws)[r] = 1.0f / sqrtf(sq / (float)QR + EPS); wRS(p.ws)[R + r] = 1.0f / sqrtf(sk / (float)KVR + EPS); }
                const float c_ = cx[u] ? 1.0f : cs[u], s_ = cx[u] ? 0.0f : sn[u];
                wKR(p.ws)[(long)r * ROPE + i] = f2bf(x1[u] * c_ - x2[u] * s_); wKR(p.ws)[(long)r * ROPE + 16 + i] = f2bf(x1[u] * s_ + x2[u] * c_); }
        }
    }
}
__device__ __forceinline__ void ml_f_rows(PRef p, int l) {
    int t_ = threadIdx.x; asm volatile("" : "+v"(t_)); const int lane = t_ & 63, gw = (int)blockIdx.x * (NTHREADS / 64) + (t_ >> 6);
    static_assert(SCS == 256, "ml_f_rows: 64 lanes x 4 positions");
    for (int u = NW - 1 - gw; u < B * SCN * MH * 2; u += NW) {
        const int dir = u % 2, h = (u / 2) % MH, sc = (u / (2 * MH)) % SCN, b = u / (2 * MH * SCN);
        const float bi_ = p.ml_gate_b[(l * 4 + 2 * dir) * MH + h], bf_ = p.ml_gate_b[(l * 4 + 2 * dir + 1) * MH + h];
        const long rb = (long)b * RPB + (long)sc * SCS;
        float li[4], c[4]; float run = 0.f;
#pragma unroll
        for (int i = 0; i < 4; ++i) { const int pos = 4 * lane + i; const long r = rb + (dir == 0 ? pos : SCS - 1 - pos);
            const bf16* g = wP(p.ws) + r * NP + ML_LO + 3 * MW;
            li[i] = bf2f(g[(2 * dir) * MH + h]) + bi_; run += logsigmoid_f(bf2f(g[(2 * dir + 1) * MH + h]) + bf_); c[i] = run; }
        float inc = run;
#pragma unroll
        for (int o = 1; o < 64; o <<= 1) { const float t = __int_as_float(__builtin_amdgcn_ds_bpermute(((lane - o) & 63) << 2, __float_as_int(inc))); if (lane >= o) inc += t; }
        const float excl = inc - run;
#pragma unroll
        for (int i = 0; i < 4; ++i) { const int pos = 4 * lane + i; const long r = rb + (dir == 0 ? pos : SCS - 1 - pos); const float F = excl + c[i];
            float* fg = wFG(p.ws) + ((r * 2 + dir) * MH + h) * 2; fg[0] = F; fg[1] = F - li[i]; }
    }
}

constexpr int FROWS = (SEQ + CTX) / NBLOCKS;
static_assert((SEQ + CTX) % NBLOCKS == 0 && HH == 64 && 2 * HW == NTHREADS && FROWS * HH * 4 <= 65536, "filter block phases");
__device__ __forceinline__ void filt_b_block(PRef p, int l, __attribute__((address_space(3))) unsigned char* lds) {
    int t_ = threadIdx.x; asm volatile("" : "+v"(t_)); const int t = t_, j = t & 63, wv_ = t >> 6;
    __attribute__((address_space(3))) float* hs = (__attribute__((address_space(3))) float*)lds;
    const long g0 = (long)blockIdx.x * FROWS;
    __syncthreads();
    for (int idx = t; idx < FROWS * HH; idx += NTHREADS) hs[idx] = wHD1(p.ws)[g0 * HH + idx];
    const float* w2 = p.hy_w2 + (long)l * HH * HH;
    float w[HH];
#pragma unroll
    for (int e = 0; e < HH; ++e) w[e] = w2[e * HH + j];
    const float bj = p.hy_b2[l * HH + j], fj = p.hy_freq[l * HH + j];
    __syncthreads();
    for (int k = wv_; k < FROWS; k += NTHREADS / 64) {
        float acc = bj;
#pragma unroll
        for (int e4 = 0; e4 < HH / 4; ++e4) { const f32x4 h = *(const __attribute__((address_space(3))) f32x4*)(hs + k * HH + e4 * 4);
            acc += h[0] * w[4 * e4]; acc += h[1] * w[4 * e4 + 1]; acc += h[2] * w[4 * e4 + 2]; acc += h[3] * w[4 * e4 + 3]; }
        wHD2(p.ws)[(g0 + k) * HH + j] = sin_f(fj * acc);
    }
    __syncthreads();
}
__device__ __forceinline__ void filt_c_block(PRef p, int l, __attribute__((address_space(3))) unsigned char* lds) {
    int t_ = threadIdx.x; asm volatile("" : "+v"(t_)); const int c2 = t_;
    __attribute__((address_space(3))) float* hs = (__attribute__((address_space(3))) float*)lds;
    const long g0 = (long)blockIdx.x * FROWS;
    __syncthreads();
    for (int idx = c2; idx < FROWS * HH; idx += NTHREADS) hs[idx] = wHD2(p.ws)[g0 * HH + idx];
    const float* w3 = p.hy_w3 + (long)l * HH * 2 * HW;
    float w[HH];
#pragma unroll
    for (int e = 0; e < HH; ++e) w[e] = w3[e * 2 * HW + c2];
    const int c = c2 % HW;
    const float a0 = -4.605170185988091f / 1.5f, a1 = -4.605170185988091f / 0.3f;
    const float delta = fabsf(a0 + (a1 - a0) * (float)c / (float)(HW - 1));
    __syncthreads();
    for (int k = 0; k < FROWS; ++k) {
        float acc = 0.f;
#pragma unroll
        for (int e4 = 0; e4 < HH / 4; ++e4) { const f32x4 h = *(const __attribute__((address_space(3))) f32x4*)(hs + k * HH + e4 * 4);
            acc += h[0] * w[4 * e4]; acc += h[1] * w[4 * e4 + 1]; acc += h[2] * w[4 * e4 + 2]; acc += h[3] * w[4 * e4 + 3]; }
        const long g = g0 + k; const int set = g >= SEQ, pos = (int)(set ? g - SEQ : g), L = set ? CTX : SEQ;
        const float tl = (float)pos / (float)(L - 1); const float v = acc * (exp_f(-tl * delta) + 0.05f);
        if (set == 0) wFT(p.ws)[(long)c2 * SEQ + pos] = v; else wFT1(p.ws)[(long)pos * 2 * HW + c2] = v;
    }
    __syncthreads();
}

constexpr int MOD_KC = D / 8, MOD_BLOCKS = 8 * DEPTH * 6 * D / NTHREADS;
static_assert((DEPTH * 6 * D) % NTHREADS == 0 && MOD_KC % 4 == 0 && MOD_BLOCKS <= NBLOCKS, "mod block phase");
__device__ __forceinline__ void mod_block(PRef p, __attribute__((address_space(3))) unsigned char* lds) {
    if ((int)blockIdx.x >= MOD_BLOCKS) return;
    int t_ = threadIdx.x; asm volatile("" : "+v"(t_)); const int t = t_;
    __attribute__((address_space(3))) float* sm = (__attribute__((address_space(3))) float*)lds;
    const long i = (long)blockIdx.x * NTHREADS + t;
    const int j = (int)(i % (6 * D)), l = (int)((i / (6 * D)) % DEPTH), kc = (int)(i / ((long)6 * D * DEPTH));
    for (int idx = t; idx < (B + 1) * MOD_KC; idx += NTHREADS) { const int bi = idx / MOD_KC, k = kc * MOD_KC + idx % MOD_KC; sm[idx] = silu_f(bi < B ? p.c[(long)bi * D + k] : p.c_ctx[k]); }
    __syncthreads();
    const float* w = p.ada_w + (long)l * D * 6 * D + (long)kc * MOD_KC * 6 * D + j;
    float acc[B + 1];
#pragma unroll
    for (int bi = 0; bi <= B; ++bi) acc[bi] = 0.f;
#pragma unroll 2
    for (int k4 = 0; k4 < MOD_KC / 4; ++k4) {
        float wq[4];
#pragma unroll
        for (int q = 0; q < 4; ++q) wq[q] = w[(long)(4 * k4 + q) * 6 * D];
#pragma unroll
        for (int bi = 0; bi <= B; ++bi) { const f32x4 sv = *(const __attribute__((address_space(3))) f32x4*)(sm + bi * MOD_KC + 4 * k4);
            acc[bi] += sv[0] * wq[0]; acc[bi] += sv[1] * wq[1]; acc[bi] += sv[2] * wq[2]; acc[bi] += sv[3] * wq[3]; }
    }
#pragma unroll
    for (int bi = 0; bi <= B; ++bi) wMODP(p.ws)[(((long)kc * DEPTH + l) * (B + 1) + bi) * 6 * D + j] = acc[bi];
    __syncthreads();
}
}
#endif
#ifndef HOST_EMU
#define LAS __attribute__((address_space(3)))
#endif

#ifndef HOST_EMU
namespace att {
typedef short bf16x8 __attribute__((ext_vector_type(8)));
typedef float f32x4 __attribute__((ext_vector_type(4)));
typedef unsigned u32x4 __attribute__((ext_vector_type(4)));
typedef unsigned u32x2 __attribute__((ext_vector_type(2)));
constexpr int TK = 128;
constexpr int KROW = 224, VROW = TK * 2 + 32, KT_BYTES = TK * KROW, VT_BYTES = 64 * VROW;
constexpr int QBLK = 256, NQB = SEQ / QBLK, NLAT = B * AH * NQB, NCQ = CTX / QBLK;
static_assert(SEQ % QBLK == 0 && RPB % TK == 0 && CTX % TK == 0 && CTX % QBLK == 0, "attention tiling");
__device__ __forceinline__ float bfl(unsigned w) { return __uint_as_float(w << 16); }
__device__ __forceinline__ float bfh(unsigned w) { return __uint_as_float(w & 0xFFFF0000u); }
typedef __bf16 bf2_t __attribute__((ext_vector_type(2)));
typedef float f32x2_t __attribute__((ext_vector_type(2)));
__device__ __forceinline__ unsigned pk(float lo, float hi) { f32x2_t v = {lo, hi}; return __builtin_bit_cast(unsigned, __builtin_convertvector(v, bf2_t)); }
__device__ __forceinline__ float xl(float v, int lane, int m) { return __int_as_float(__builtin_amdgcn_ds_bpermute((lane ^ m) << 2, __float_as_int(v))); }
__device__ __forceinline__ void attn_phase(PRef p, int l, LAS unsigned char* lds) {
    const int wave = __builtin_amdgcn_readfirstlane((int)threadIdx.x >> 6);
    const bool last = (l == DEPTH - 1);
    const int vcu = ((int)blockIdx.x % 8) * (NBLOCKS / 8) + (int)blockIdx.x / 8;
    const int nunits = NLAT + (last ? 0 : B * AH * NCQ);
    const float qscale = 0.14724420716f;
    const bf16* Qg = wQ(p.out); const bf16* KNg = wKN(p.out); const bf16* KRg = wKR(p.ws); const bf16* VTg = wVT(p.out); const float* ROPEg = wROPET(p.ws); bf16* Og = wH(p.ws);
    for (int u = vcu; u < nunits; u += NBLOCKS) {
        int tid_ = threadIdx.x; asm volatile("" : "+v"(tid_));
        const int tid = tid_, lane = tid & 63, i16 = lane & 15, g = lane >> 4;
        const bool isctx = u >= NLAT;
        int b, hd, nkeys; long q0;
        if (!isctx) { b = u / (AH * NQB); hd = (u / NQB) % AH; q0 = (long)b * RPB + CTX + (long)(u % NQB) * QBLK; nkeys = RPB; }
        else { const int uu = u - NLAT; b = uu / (AH * NCQ); hd = (uu / NCQ) % AH; q0 = (long)b * RPB + (long)(uu % NCQ) * QBLK; nkeys = CTX; }
        const long k0 = (long)b * RPB;
        const long qw = q0 + wave * 32;
        bf16x8 qf[2][3];
#pragma unroll
        for (int qb = 0; qb < 2; ++qb) {
            const bf16* qp = (Qg + qw * QW + hd * (NOPE + ROPE)) + (unsigned)((qb * 16 + i16) * QW + g * 8);
            u32x4 raw[3];
#pragma unroll
            for (int ks = 0; ks < 3; ++ks) raw[ks] = *(const u32x4*)(qp + ks * 32);
#pragma unroll
            for (int ks = 0; ks < 2; ++ks) { u32x4 w;
#pragma unroll
                for (int e = 0; e < 4; ++e) w[e] = pk(bfl(raw[ks][e]) * qscale, bfh(raw[ks][e]) * qscale);
                qf[qb][ks] = __builtin_bit_cast(bf16x8, w); }
            u32x4 w2;
            if (!isctx) {
                u32x4 pr;
#pragma unroll
                for (int e = 0; e < 4; ++e) pr[e] = (unsigned)__builtin_amdgcn_ds_bpermute((lane ^ 32) << 2, (int)raw[2][e]);
                const float* tb = (ROPEg + (qw - k0 - CTX) * 32) + (unsigned)((qb * 16 + i16) * 32 + 16 * (g & 1));
                const float sg = g < 2 ? -1.0f : 1.0f;
#pragma unroll
                for (int e = 0; e < 4; ++e) { const f32x4 cs = *(const f32x4*)(tb + 4 * e);
                    const float m0 = bfl(raw[2][e]), m1 = bfh(raw[2][e]), o0 = bfl(pr[e]), o1 = bfh(pr[e]);
                    w2[e] = pk((m0 * cs[0] + sg * o0 * cs[1]) * qscale, (m1 * cs[2] + sg * o1 * cs[3]) * qscale); }
            } else {
#pragma unroll
                for (int e = 0; e < 4; ++e) w2[e] = pk(bfl(raw[2][e]) * qscale, bfh(raw[2][e]) * qscale);
            }
            qf[qb][2] = __builtin_bit_cast(bf16x8, w2);
        }
        const bf16* knb = KNg + k0 * AW + hd * NOPE; const bf16* krb = KRg + k0 * ROPE; const bf16* vb = VTg + (long)hd * AV * R + k0;
        const unsigned kn_off0 = (unsigned)((tid >> 3) * AW + (tid & 7) * 8), kn_off1 = kn_off0 + 64u * AW, kr_off = (unsigned)((tid >> 2) * ROPE + (tid & 3) * 8);
        const unsigned v_off0 = (unsigned)((tid >> 4) * R + (tid & 15) * 8), v_off1 = v_off0 + 32u * R;
        const int kn_dst0 = (tid >> 3) * KROW + (tid & 7) * 16, kn_dst1 = kn_dst0 + 64 * KROW, kr_dst = (tid >> 2) * KROW + 128 + (tid & 3) * 16;
        const int v_dst0 = 2 * KT_BYTES + (tid >> 4) * VROW + (tid & 15) * 16, v_dst1 = v_dst0 + 32 * VROW;
        const int nt = nkeys / TK;
        f32x4 O[2][4];
#pragma unroll
        for (int qb = 0; qb < 2; ++qb)
#pragma unroll
            for (int dvt = 0; dvt < 4; ++dvt) O[qb][dvt] = (f32x4){0.f, 0.f, 0.f, 0.f};
        float mrun[2] = {0.f, 0.f}, lsum[2] = {0.f, 0.f};
        f32x4 negm[2] = {(f32x4){0.f, 0.f, 0.f, 0.f}, (f32x4){0.f, 0.f, 0.f, 0.f}};
        const int kfo = i16 * KROW + g * 16, vfo = 2 * KT_BYTES + i16 * VROW + g * 16;
        u32x4 s1, s2, s3, s4, s5;
        auto load_stage = [&](int tt) { s1 = *(const u32x4*)(knb + (long)tt * TK * AW + kn_off0); s2 = *(const u32x4*)(knb + (long)tt * TK * AW + kn_off1); s3 = *(const u32x4*)(krb + (long)tt * TK * ROPE + kr_off);
            s4 = *(const u32x4*)(vb + (long)tt * TK + v_off0); s5 = *(const u32x4*)(vb + (long)tt * TK + v_off1); };
        auto store_stage = [&](int buf) { const int nk = buf * KT_BYTES, nv = buf * VT_BYTES;
            *(LAS u32x4*)(lds + nk + kn_dst0) = s1; *(LAS u32x4*)(lds + nk + kn_dst1) = s2; *(LAS u32x4*)(lds + nk + kr_dst) = s3; *(LAS u32x4*)(lds + nv + v_dst0) = s4; *(LAS u32x4*)(lds + nv + v_dst1) = s5; };
        auto subtile = [&](int kb_off, int vb_off, bool first) {
            bf16x8 kf[12];
#pragma unroll
            for (int kb = 0; kb < 4; ++kb)
#pragma unroll
                for (int ks = 0; ks < 3; ++ks) kf[kb * 3 + ks] = *(const LAS bf16x8*)(lds + kb_off + kb * 16 * KROW + ks * 64);
            asm volatile("s_waitcnt lgkmcnt(0)" : "+v"(kf[0]), "+v"(kf[1]), "+v"(kf[2]), "+v"(kf[3]), "+v"(kf[4]), "+v"(kf[5]), "+v"(kf[6]), "+v"(kf[7]), "+v"(kf[8]), "+v"(kf[9]), "+v"(kf[10]), "+v"(kf[11]) :: "memory");
            f32x4 S[2][4];
#pragma unroll
            for (int kb = 0; kb < 4; ++kb)
#pragma unroll
                for (int ks = 0; ks < 3; ++ks) {
                    S[0][kb] = __builtin_amdgcn_mfma_f32_16x16x32_bf16(kf[kb * 3 + ks], qf[0][ks], ks == 0 ? negm[0] : S[0][kb], 0, 0, 0);
                    S[1][kb] = __builtin_amdgcn_mfma_f32_16x16x32_bf16(kf[kb * 3 + ks], qf[1][ks], ks == 0 ? negm[1] : S[1][kb], 0, 0, 0); }
            bf16x8 vf[8];
#pragma unroll
            for (int dvt = 0; dvt < 4; ++dvt)
#pragma unroll
                for (int kp = 0; kp < 2; ++kp) vf[dvt * 2 + kp] = *(const LAS bf16x8*)(lds + vb_off + dvt * 16 * VROW + kp * 64);
            asm volatile("" ::: "memory");
            bf16x8 pf[2][2];
#pragma unroll
            for (int qb = 0; qb < 2; ++qb) {
                float mx = S[qb][0][0];
#pragma unroll
                for (int kb = 0; kb < 4; ++kb)
#pragma unroll
                    for (int e = 0; e < 4; ++e) mx = fmaxf(mx, S[qb][kb][e]);
                if (first || __builtin_amdgcn_ballot_w64(mx > 8.0f) != 0ull) {
                    mx = fmaxf(mx, xl(mx, lane, 16)); mx = fmaxf(mx, xl(mx, lane, 32));
                    const float d = first ? mx : fmaxf(mx, 0.0f), corr = first ? 1.0f : __builtin_amdgcn_exp2f(-d);
                    mrun[qb] += d; lsum[qb] *= corr; negm[qb] = (f32x4){-mrun[qb], -mrun[qb], -mrun[qb], -mrun[qb]};
#pragma unroll
                    for (int dvt = 0; dvt < 4; ++dvt) O[qb][dvt] = O[qb][dvt] * corr;
#pragma unroll
                    for (int kb = 0; kb < 4; ++kb) S[qb][kb] = S[qb][kb] - d;
                }
                float ps = 0.f;
#pragma unroll
                for (int kb = 0; kb < 4; ++kb)
#pragma unroll
                    for (int e = 0; e < 4; ++e) { const float ex = __builtin_amdgcn_exp2f(S[qb][kb][e]); S[qb][kb][e] = ex; ps += ex; }
                lsum[qb] += ps;
#pragma unroll
                for (int kp = 0; kp < 2; ++kp) { u32x4 w; w[0] = pk(S[qb][2 * kp][0], S[qb][2 * kp][1]); w[1] = pk(S[qb][2 * kp][2], S[qb][2 * kp][3]); w[2] = pk(S[qb][2 * kp + 1][0], S[qb][2 * kp + 1][1]); w[3] = pk(S[qb][2 * kp + 1][2], S[qb][2 * kp + 1][3]);
                    pf[qb][kp] = __builtin_bit_cast(bf16x8, w); }
            }
            asm volatile("s_waitcnt lgkmcnt(0)" : "+v"(vf[0]), "+v"(vf[1]), "+v"(vf[2]), "+v"(vf[3]), "+v"(vf[4]), "+v"(vf[5]), "+v"(vf[6]), "+v"(vf[7]) :: "memory");
#pragma unroll
            for (int dvt = 0; dvt < 4; ++dvt)
#pragma unroll
                for (int kp = 0; kp < 2; ++kp) {
                    O[0][dvt] = __builtin_amdgcn_mfma_f32_16x16x32_bf16(vf[dvt * 2 + kp], pf[0][kp], O[0][dvt], 0, 0, 0);
                    O[1][dvt] = __builtin_amdgcn_mfma_f32_16x16x32_bf16(vf[dvt * 2 + kp], pf[1][kp], O[1][dvt], 0, 0, 0); }
        };
        load_stage(0); store_stage(0);
        __syncthreads();
        for (int t = 0; t < nt; ++t) {
            const int buf = t & 1;
            if (t + 1 < nt) load_stage(t + 1);
#pragma unroll
            for (int sub = 0; sub < TK / 64; ++sub) subtile(buf * KT_BYTES + sub * 64 * KROW + kfo, buf * VT_BYTES + sub * 128 + vfo, sub == 0 && t == 0);
            if (t + 1 < nt) store_stage(buf ^ 1);
            __syncthreads();
        }
#pragma unroll
        for (int qb = 0; qb < 2; ++qb) {
            float lt = lsum[qb]; lt += xl(lt, lane, 16); lt += xl(lt, lane, 32); const float inv = 1.0f / lt;
            bf16* op = (Og + qw * D + hd * AV) + (unsigned)((qb * 16 + i16) * D + 4 * g);
#pragma unroll
            for (int dvt = 0; dvt < 4; ++dvt) { u32x2 w; w.x = pk(O[qb][dvt][0] * inv, O[qb][dvt][1] * inv); w.y = pk(O[qb][dvt][2] * inv, O[qb][dvt][3] * inv); *(u32x2*)(op + dvt * 16) = w; }
        }
    }
}
}
#endif

#ifndef HOST_EMU
namespace mlk {
typedef short bf16x8 __attribute__((ext_vector_type(8)));
typedef float f32x16 __attribute__((ext_vector_type(16)));
typedef float f32x4 __attribute__((ext_vector_type(4)));
typedef unsigned u32x4 __attribute__((ext_vector_type(4)));
typedef unsigned u32x2 __attribute__((ext_vector_type(2)));
static_assert(SCS == 256 && MD == 64, "mlstm MFMA phases: 256-row super-chunks, head dim 64");
constexpr int KP = 144, TP = 528;
constexpr int O_KL = 0, O_VT = 256 * KP, O_CT = O_VT + 64 * TP, O_FG = O_CT + 2 * 64 * KP, O_NL = O_FG + 2 * 2 * 256 * 4, O_END = O_NL + 2 * 64 * 4;
constexpr int B_KT = 0, B_VT = 64 * TP, B_WL = 2 * 64 * TP, B_END = B_WL + 2 * 256 * 4;
constexpr float LOG2E = 1.4426950408889634f;
__device__ __forceinline__ float bfl(unsigned w) { return __uint_as_float(w << 16); }
__device__ __forceinline__ float bfh(unsigned w) { return __uint_as_float(w & 0xFFFF0000u); }
__device__ __forceinline__ unsigned pk(float lo, float hi) { unsigned r; asm volatile("v_cvt_pk_bf16_f32 %0, %1, %2" : "=v"(r) : "v"(lo), "v"(hi)); return r; }
__device__ __forceinline__ float xl32(float v, int lane) { return __int_as_float(__builtin_amdgcn_ds_bpermute((lane ^ 32) << 2, __float_as_int(v))); }
__device__ __forceinline__ int kpos(int key) { return (key & ~15) | swap23(key & 15); }
__device__ __forceinline__ void stage_t(LAS unsigned char* img, const u32x4 v, int dim0, int key) {
    const int kb = kpos(key) * 2;
#pragma unroll
    for (int e = 0; e < 4; ++e) { *(LAS unsigned short*)(img + (dim0 + 2 * e) * TP + kb) = (unsigned short)(v[e] & 0xFFFFu); *(LAS unsigned short*)(img + (dim0 + 2 * e + 1) * TP + kb) = (unsigned short)(v[e] >> 16); }
}
__device__ __forceinline__ void ml_b_phase(PRef p, LAS unsigned char* lds) {
    const int wave = __builtin_amdgcn_readfirstlane((int)threadIdx.x >> 6);
    for (int u = ((((int)blockIdx.x % 8) + 6) % 8) * (NBLOCKS / 8) + (int)blockIdx.x / 8; u < B * MH * SCN; u += NBLOCKS) {
        int tid_ = threadIdx.x; asm volatile("" : "+v"(tid_)); const int tid = tid_, lane = tid & 63, r = lane & 31, hh = lane >> 5;
        const int sc = u % SCN, h = (u / SCN) % MH, b = u / (SCN * MH); const long r0 = (long)b * RPB + (long)sc * SCS;
        const bf16* kg = wMQK(p.ws) + r0 * 2 * MW + MW + h * MD; const bf16* vg = wP(p.ws) + r0 * NP + ML_LO + MW + h * MD; const float* fg = wFG(p.ws);
#pragma unroll
        for (int i = 0; i < 4; ++i) { const int ci = tid + 512 * i, key = ci >> 3, part = ci & 7;
            stage_t(lds + B_KT, *(const u32x4*)(kg + (unsigned)(key * 2 * MW + part * 8)), part * 8, key);
            stage_t(lds + B_VT, *(const u32x4*)(vg + (unsigned)(key * NP + part * 8)), part * 8, key); }
        { const int dir = tid >> 8, key = tid & 255; const long rend = dir == 0 ? r0 + SCS - 1 : r0;
          const float Fend = fg[((rend * 2 + dir) * MH + h) * 2], G = fg[(((r0 + key) * 2 + dir) * MH + h) * 2 + 1];
          *(LAS float*)(lds + B_WL + (dir * 256 + kpos(key)) * 4) = __builtin_amdgcn_exp2f((Fend - G) * LOG2E); }
        __syncthreads();
        const int dir = wave >> 2, dvb = (wave >> 1) & 1, kb = wave & 1;
        f32x16 acc;
#pragma unroll
        for (int i = 0; i < 16; ++i) acc[i] = 0.f;
        float nacc = 0.f;
#pragma unroll 4
        for (int ks = 0; ks < 16; ++ks) {
            const bf16x8 vf = *(const LAS bf16x8*)(lds + B_VT + (dvb * 32 + r) * TP + ks * 32 + hh * 16);
            const u32x4 kr = *(const LAS u32x4*)(lds + B_KT + (kb * 32 + r) * TP + ks * 32 + hh * 16);
            const f32x4 w0 = *(const LAS f32x4*)(lds + B_WL + (dir * 256 + ks * 16 + hh * 8) * 4), w1 = *(const LAS f32x4*)(lds + B_WL + (dir * 256 + ks * 16 + hh * 8 + 4) * 4);
            const float k0 = bfl(kr[0]) * w0[0], k1 = bfh(kr[0]) * w0[1], k2 = bfl(kr[1]) * w0[2], k3 = bfh(kr[1]) * w0[3], k4 = bfl(kr[2]) * w1[0], k5 = bfh(kr[2]) * w1[1], k6 = bfl(kr[3]) * w1[2], k7 = bfh(kr[3]) * w1[3];
            nacc += ((k0 + k1) + (k2 + k3)) + ((k4 + k5) + (k6 + k7));
            u32x4 kw; kw[0] = pk(k0, k1); kw[1] = pk(k2, k3); kw[2] = pk(k4, k5); kw[3] = pk(k6, k7);
            acc = __builtin_amdgcn_mfma_f32_32x32x16_bf16(vf, __builtin_bit_cast(bf16x8, kw), acc, 0, 0, 0);
        }
        float* ms = wMS(p.ws) + ((((long)b * MH + h) * 2 + dir) * SCN + sc) * (MD + 1) * MD;
#pragma unroll
        for (int g = 0; g < 4; ++g) { f32x4 o; o[0] = acc[4 * g]; o[1] = acc[4 * g + 1]; o[2] = acc[4 * g + 2]; o[3] = acc[4 * g + 3];
            *(f32x4*)(ms + (unsigned)((kb * 32 + r) * MD + dvb * 32 + 8 * g + 4 * hh)) = o; }
        const float nt = nacc + xl32(nacc, lane);
        if (dvb == 0 && hh == 0) ms[MD * MD + kb * 32 + r] = nt;
        __syncthreads();
    }
}
__device__ __forceinline__ void ml_o_phase(PRef p, int l, LAS unsigned char* lds) {
    const int wave = __builtin_amdgcn_readfirstlane((int)threadIdx.x >> 6);
    const bool last = (l == DEPTH - 1);
    for (int u = blockIdx.x; u < B * MH * SCN; u += NBLOCKS) {
        const int sc = u % SCN, h = (u / SCN) % MH, b = u / (SCN * MH);
        if (last && sc < NCS) continue;
        int tid_ = threadIdx.x; asm volatile("" : "+v"(tid_)); const int tid = tid_, lane = tid & 63, r = lane & 31, hh = lane >> 5;
        const long r0 = (long)b * RPB + (long)sc * SCS;
        const bf16* qg = wMQK(p.ws) + r0 * 2 * MW + h * MD; const bf16* kg = qg + MW; const bf16* pg = wP(p.ws) + r0 * NP + ML_LO + h * MD; const float* fg = wFG(p.ws);
        const float* msb = wMS(p.ws) + (((long)b * MH + h) * 2 * SCN + sc) * (MD + 1) * MD;
#pragma unroll
        for (int i = 0; i < 4; ++i) { const int ci = tid + 512 * i, key = ci >> 3, part = ci & 7;
            *(LAS u32x4*)(lds + O_KL + key * KP + part * 16) = *(const u32x4*)(kg + (unsigned)(key * 2 * MW + part * 8));
            stage_t(lds + O_VT, *(const u32x4*)(pg + (unsigned)(key * NP + MW + part * 8)), part * 8, key); }
#pragma unroll
        for (int i = 0; i < 4; ++i) { const int ci = tid + 512 * i, dir = ci >> 10, kdim = (ci >> 4) & 63, d4 = ci & 15;
            const f32x4 c = *(const f32x4*)(msb + (unsigned)(dir * SCN * (MD + 1) * MD + kdim * MD + d4 * 4));
#pragma unroll
            for (int e = 0; e < 4; ++e) *(LAS unsigned short*)(lds + O_CT + (dir * 64 + d4 * 4 + e) * KP + kdim * 2) = (unsigned short)f2bf(c[e]); }
        if (tid < 128) { const int dir = tid >> 6, kdim = tid & 63; *(LAS float*)(lds + O_NL + tid * 4) = msb[(unsigned)(dir * SCN * (MD + 1) * MD + MD * MD + kdim)]; }
        { const int dir = tid >> 8, key = tid & 255; const float F = fg[(((r0 + key) * 2 + dir) * MH + h) * 2], G = fg[(((r0 + key) * 2 + dir) * MH + h) * 2 + 1];
          *(LAS float*)(lds + O_FG + ((dir * 2 + 0) * 256 + key) * 4) = F * LOG2E; *(LAS float*)(lds + O_FG + ((dir * 2 + 1) * 256 + key) * 4) = G * LOG2E; }
        bf16x8 qf[4];
#pragma unroll
        for (int ks = 0; ks < 4; ++ks) qf[ks] = *(const bf16x8*)(qg + (unsigned)((wave * 32 + r) * 2 * MW + ks * 16 + hh * 8));
        __syncthreads();
        f32x16 hs[2];
#pragma unroll
        for (int dvb = 0; dvb < 2; ++dvb)
#pragma unroll
            for (int i = 0; i < 16; ++i) hs[dvb][i] = 0.f;
#pragma unroll 1
        for (int dir = 0; dir < 2; ++dir) {
            const float Ft = *(const LAS float*)(lds + O_FG + ((dir * 2 + 0) * 256 + wave * 32 + r) * 4);
            f32x16 O[2];
#pragma unroll
            for (int dvb = 0; dvb < 2; ++dvb)
#pragma unroll
                for (int i = 0; i < 16; ++i) O[dvb][i] = 0.f;
            float den = 0.f;
            const int kt0 = dir == 0 ? 0 : wave, kt1 = dir == 0 ? wave : 7;
            for (int kt = kt0; kt <= kt1; ++kt) {
                f32x16 S;
#pragma unroll
                for (int i = 0; i < 16; ++i) S[i] = 0.f;
#pragma unroll
                for (int ks = 0; ks < 4; ++ks) {
                    const bf16x8 kf = *(const LAS bf16x8*)(lds + O_KL + (kt * 32 + r) * KP + ks * 32 + hh * 16);
                    S = __builtin_amdgcn_mfma_f32_32x32x16_bf16(kf, qf[ks], S, 0, 0, 0); }
                const bool diag = (kt == wave);
#pragma unroll
                for (int g = 0; g < 4; ++g) { const f32x4 gv = *(const LAS f32x4*)(lds + O_FG + ((dir * 2 + 1) * 256 + kt * 32 + 8 * g + 4 * hh) * 4);
#pragma unroll
                    for (int e = 0; e < 4; ++e) { const int krow = 8 * g + 4 * hh + e; const bool keep = !diag || (dir == 0 ? krow <= r : krow >= r);
                        const float wgt = __builtin_amdgcn_exp2f(keep ? Ft - gv[e] : -1.0e30f); const float sw = S[4 * g + e] * wgt; S[4 * g + e] = sw; den += sw; } }
                bf16x8 pf[2];
#pragma unroll
                for (int s2 = 0; s2 < 2; ++s2) { u32x4 w;
#pragma unroll
                    for (int e = 0; e < 4; ++e) w[e] = pk(S[8 * s2 + 2 * e], S[8 * s2 + 2 * e + 1]);
                    pf[s2] = __builtin_bit_cast(bf16x8, w); }
#pragma unroll
                for (int dvb = 0; dvb < 2; ++dvb)
#pragma unroll
                    for (int s2 = 0; s2 < 2; ++s2) {
                        const bf16x8 vf = *(const LAS bf16x8*)(lds + O_VT + (dvb * 32 + r) * TP + (kt * 32 + s2 * 16) * 2 + hh * 16);
                        O[dvb] = __builtin_amdgcn_mfma_f32_32x32x16_bf16(vf, pf[s2], O[dvb], 0, 0, 0); }
            }
            f32x16 I[2];
#pragma unroll
            for (int dvb = 0; dvb < 2; ++dvb)
#pragma unroll
                for (int i = 0; i < 16; ++i) I[dvb][i] = 0.f;
            float dint = 0.f;
#pragma unroll
            for (int ks = 0; ks < 4; ++ks) {
#pragma unroll
                for (int dvb = 0; dvb < 2; ++dvb) { const bf16x8 cf = *(const LAS bf16x8*)(lds + O_CT + (dir * 64 + dvb * 32 + r) * KP + ks * 32 + hh * 16);
                    I[dvb] = __builtin_amdgcn_mfma_f32_32x32x16_bf16(cf, qf[ks], I[dvb], 0, 0, 0); }
                const u32x4 qr = __builtin_bit_cast(u32x4, qf[ks]);
                const f32x4 n0 = *(const LAS f32x4*)(lds + O_NL + (dir * 64 + ks * 16 + hh * 8) * 4), n1 = *(const LAS f32x4*)(lds + O_NL + (dir * 64 + ks * 16 + hh * 8 + 4) * 4);
                dint += (bfl(qr[0]) * n0[0] + bfh(qr[0]) * n0[1]) + (bfl(qr[1]) * n0[2] + bfh(qr[1]) * n0[3]) + (bfl(qr[2]) * n1[0] + bfh(qr[2]) * n1[1]) + (bfl(qr[3]) * n1[2] + bfh(qr[3]) * n1[3]);
            }
            const float a = __builtin_amdgcn_exp2f(Ft);
            const float dtot = (den + xl32(den, lane)) + a * (dint + xl32(dint, lane));
            const float scl = 1.0f / fmaxf(fabsf(dtot), 1.0f);
#pragma unroll
            for (int dvb = 0; dvb < 2; ++dvb)
#pragma unroll
                for (int i = 0; i < 16; ++i) hs[dvb][i] += (O[dvb][i] + a * I[dvb][i]) * scl;
        }
        const bf16* og = pg + (unsigned)((wave * 32 + r) * NP + 2 * MW + 4 * hh);
        float ss = 0.f;
#pragma unroll
        for (int dvb = 0; dvb < 2; ++dvb)
#pragma unroll
            for (int g = 0; g < 4; ++g) { const u32x2 ov = *(const u32x2*)(og + dvb * 32 + 8 * g);
                const float o0 = bfl(ov[0]), o1 = bfh(ov[0]), o2 = bfl(ov[1]), o3 = bfh(ov[1]);
                float v0 = hs[dvb][4 * g] * rcp_f(1.0f + exp_f(-o0)), v1 = hs[dvb][4 * g + 1] * rcp_f(1.0f + exp_f(-o1)), v2 = hs[dvb][4 * g + 2] * rcp_f(1.0f + exp_f(-o2)), v3 = hs[dvb][4 * g + 3] * rcp_f(1.0f + exp_f(-o3));
                hs[dvb][4 * g] = v0; hs[dvb][4 * g + 1] = v1; hs[dvb][4 * g + 2] = v2; hs[dvb][4 * g + 3] = v3; ss += (v0 * v0 + v1 * v1) + (v2 * v2 + v3 * v3); }
        ss += xl32(ss, lane);
        const float rstd = 1.0f / sqrtf(ss / (float)MD + EPS);
        const float* ng = p.ml_norm_g + l * MW + h * MD + 4 * hh; bf16* op = wH(p.ws) + (r0 + wave * 32 + r) * D + AW + h * MD + 4 * hh;
#pragma unroll
        for (int dvb = 0; dvb < 2; ++dvb)
#pragma unroll
            for (int g = 0; g < 4; ++g) { const f32x4 gg = *(const f32x4*)(ng + dvb * 32 + 8 * g); u32x2 w;
                w[0] = pk(hs[dvb][4 * g] * rstd * gg[0], hs[dvb][4 * g + 1] * rstd * gg[1]); w[1] = pk(hs[dvb][4 * g + 2] * rstd * gg[2], hs[dvb][4 * g + 3] * rstd * gg[3]);
                *(u32x2*)(op + dvb * 32 + 8 * g) = w; }
        __syncthreads();
    }
}
}
#endif
#ifndef HOST_EMU
#define XB_TMO      128
#define XB_XCNT(j)  (256  + 64 * (j))
#define XB_XSUB(j)  (1280 + 64 * (j))
#define XB_XGEN(j)  (2304 + 64 * (j))
#define XB_TOP      3328
#define XB_TOPGEN   3392
#define XCD_BAR_WORDS 3456
#define XB_SPIN_CAP (1u << 18)

__device__ __forceinline__ unsigned xb_ld(unsigned* p)              { return __hip_atomic_load(p, __ATOMIC_RELAXED, __HIP_MEMORY_SCOPE_AGENT); }
__device__ __forceinline__ unsigned xb_add(unsigned* p, unsigned v) { return __hip_atomic_fetch_add(p, v, __ATOMIC_RELAXED, __HIP_MEMORY_SCOPE_AGENT); }
__device__ __forceinline__ unsigned xb_xcc_id() { return (unsigned)__builtin_amdgcn_s_getreg((3 << 11) | 20) & 0xFu; }
#define XB_SPIN(cond, bar) do { unsigned _sp = 0; while (cond) { __builtin_amdgcn_s_sleep(1); \
    if ((++_sp & 255u) == 0u) { if (xb_ld(&(bar)[XB_TMO])) break; if (_sp > XB_SPIN_CAP) { atomicAdd(&(bar)[XB_TMO], 1u); break; } } } } while (0)

struct XcdBarrier { unsigned* bar; unsigned x; volatile LAS unsigned* st; };

__device__ __forceinline__ XcdBarrier xcd_barrier_post(unsigned* bar, volatile LAS unsigned* st) {
    XcdBarrier b; b.bar = bar; b.x = xb_xcc_id(); b.st = st;
    if (threadIdx.x == 0) (void)xb_add(&bar[XB_XCNT(b.x)], 1u);
    return b;
}
__device__ __forceinline__ void xcd_barrier_complete(unsigned* bar, unsigned x, unsigned& nloc, unsigned& nx) {
    const unsigned G = gridDim.x * gridDim.y * gridDim.z;
    unsigned sum, cnt, mine, sp = 0u;
    for (;;) {
        sum = 0u; cnt = 0u; mine = 0u;
#pragma unroll
        for (unsigned j = 0; j < 16; ++j) { const unsigned c = xb_ld(&bar[XB_XCNT(j)]); sum += c; cnt += (c > 0u) ? 1u : 0u; mine = (j == x) ? c : mine; }
        if (sum == G) break;
        __builtin_amdgcn_s_sleep(1);
        if ((++sp & 255u) == 0u) { if (xb_ld(&bar[XB_TMO])) break; if (sp > XB_SPIN_CAP) { atomicAdd(&bar[XB_TMO], 1u); break; } }
    }
    nloc = mine > 0u ? mine : 1u; nx = cnt > 0u ? cnt : 1u;
}
__device__ __forceinline__ void xcd_barrier(const XcdBarrier& b) {
    asm volatile("s_waitcnt vmcnt(0)" ::: "memory");
    __syncthreads();
    if (threadIdx.x == 0) {
        unsigned* bar = b.bar;
        __builtin_amdgcn_s_waitcnt(0);
        unsigned nloc = b.st[0], nx = b.st[1];
        if (nloc == 0u) { xcd_barrier_complete(bar, b.x, nloc, nx); b.st[0] = nloc; b.st[1] = nx; }
        const unsigned old = xb_add(&bar[XB_XSUB(b.x)], 1u);
        const unsigned gen = old / nloc;
        if (old + 1u == (gen + 1u) * nloc) {
            __builtin_amdgcn_fence(__ATOMIC_RELEASE, "agent");
            asm volatile("s_waitcnt vmcnt(0)" ::: "memory");
            const unsigned og = xb_add(&bar[XB_TOP], 1u);
            const unsigned tg = og / nx;
            if (og + 1u == (tg + 1u) * nx) xb_add(&bar[XB_TOPGEN], 1u);
            else XB_SPIN(xb_ld(&bar[XB_TOPGEN]) == tg, bar);
            __builtin_amdgcn_fence(__ATOMIC_ACQUIRE, "agent");
            xb_add(&bar[XB_XGEN(b.x)], 1u);
            asm volatile("s_waitcnt vmcnt(0)" ::: "memory");
        } else {
            XB_SPIN(xb_ld(&bar[XB_XGEN(b.x)]) == gen, bar);
            __builtin_amdgcn_fence(__ATOMIC_ACQUIRE, "agent");
            asm volatile("s_waitcnt vmcnt(0)" ::: "memory");
        }
    }
    __syncthreads();
}
#endif

constexpr int UPT = (R + 253) / 254;
constexpr int LDS_BYTES = 163840;

#ifdef HOST_EMU
#define ATT_PHASE(l) RUN(PH_ATT, l, 0)
#define NORM1_PHASE(l) RUN(PH_NORM1, l, 0)
#define MOD_PHASE() RUN(PH_MOD, 0, 0)
#define FILT_B_PHASE(l) RUN(PH_FILT_B, l, 0)
#define FILT_C_PHASE(l) RUN(PH_FILT_C, l, 0)
#define ML_B_PHASE(l) RUN(PH_ML_B, l, 0)
#define ML_O_PHASE(l) RUN(PH_ML_O, l, 0)
#define NORM2_PHASE(l) RUN(PH_NORM2, l, 0)
#define FINAL_PHASE() RUN(PH_FINAL, 0, 0)
#define MLA_A_PHASE(l) RUN(PH_MLA_A, l, 0)
#define ML_F_PHASE(l) RUN(PH_ML_F, l, 0)
#define GEMM_GEMM1(l) RUN(PH_GEMM1, l, 0)
#define GEMM_Q(l) RUN(PH_MLA_Q, l, 0)
#define GEMM_KV(l) RUN(PH_MLA_KV, l, 0)
#define GEMM_MLQK(l) RUN(PH_ML_QK, l, 0)
#define GEMM_OUT(l) RUN(PH_GEMM_OUT, l, 0)
#else
#define KARG() const Params __attribute__((address_space(4)))* kp_ = (const Params __attribute__((address_space(4)))*)__builtin_amdgcn_kernarg_segment_ptr(); asm volatile("" : "+s"(kp_)); PRef p = *kp_
#define LAT_ 0
#define GEMM_LAT(l, EPI, A_, lda_, Bt_, ldb_, N_, K_, rot, ...) do { KARG(); const int lat_ = ((l) == DEPTH - 1) && (SEQ % 256 == 0) && (CTX % 256 == 0); pg8::Gemm g_{(const bf16*)(A_), (const bf16*)(Bt_), lda_, ldb_, lat_ ? B * SEQ : R, N_, K_, 256}; \
    pg8::StaticOrder S_; S_.init(lat_ ? B * SEQ : R, N_, NBLOCKS, ((int)blockIdx.x + (rot)) % NBLOCKS, lat_); pg8::EPI E_{__VA_ARGS__}; pg8::gemm_phase<pg8::EPI, pg8::StaticOrder, true, true>((LAS unsigned char*)lds, g_, S_, E_); } while (0)
#define GEMM_CALL(EPI, A_, lda_, Bt_, ldb_, M_, N_, K_, rot, ...) GEMM_CALLX(true, EPI, A_, lda_, Bt_, ldb_, M_, N_, K_, rot, __VA_ARGS__)
#define GEMM_CALLX(SP2_, EPI, A_, lda_, Bt_, ldb_, M_, N_, K_, rot, ...) do { KARG(); pg8::Gemm g_{(const bf16*)(A_), (const bf16*)(Bt_), lda_, ldb_, M_, N_, K_, 256}; pg8::StaticOrder S_; S_.init(M_, N_, NBLOCKS, ((int)blockIdx.x + (rot)) % NBLOCKS, LAT_); \
    pg8::EPI E_{__VA_ARGS__}; pg8::gemm_phase<pg8::EPI, pg8::StaticOrder, true, SP2_>((LAS unsigned char*)lds, g_, S_, E_); } while (0)
#define ATT_PHASE(l) do { KARG(); att::attn_phase(p, l, (LAS unsigned char*)lds); } while (0)
#define NORM1_PHASE(l) do { KARG(); wv::norm_rows<0>(p, l); } while (0)
#define MOD_PHASE() do { KARG(); wv::mod_block(p, (LAS unsigned char*)lds); } while (0)
#define FILT_B_PHASE(l) do { KARG(); wv::filt_b_block(p, l, (LAS unsigned char*)lds); } while (0)
#define FILT_C_PHASE(l) do { KARG(); wv::filt_c_block(p, l, (LAS unsigned char*)lds); } while (0)
#define ML_B_PHASE(l) do { KARG(); mlk::ml_b_phase(p, (LAS unsigned char*)lds); } while (0)
#define ML_O_PHASE(l) do { KARG(); mlk::ml_o_phase(p, l, (LAS unsigned char*)lds); } while (0)
#define NORM2_PHASE(l) do { KARG(); wv::norm_rows<1>(p, l); } while (0)
#define FINAL_PHASE() do { KARG(); wv::norm_rows<2>(p, 0); } while (0)
#define MLA_A_PHASE(l) do { KARG(); wv::mla_a_rows(p); } while (0)
#define ML_F_PHASE(l) do { KARG(); wv::ml_f_rows(p, l); } while (0)
#define GEMM_GEMM1(l) GEMM_CALL(EpiBf16, wH(p.ws), D, wWinT(p.ws, l), D, R, NP, D, 0, wP(p.ws), NP, nullptr, 0)
#define GEMM_Q(l) GEMM_CALL(EpiBf16, wP(p.ws), NP, wWuqT(p.ws, l), QR, R, QW, QR, 0, wQ(p.out), QW, wRS(p.ws), 1)
#define GEMM_KV(l) do { GEMM_CALL(EpiBf16, wP(p.ws) + QR, NP, wWukvT(p.ws, l), KVR, R, AW, KVR, (R / 256 * (QW / 256)) % NBLOCKS, wKN(p.out), AW, wRS(p.ws) + R, 1); \
    GEMM_CALLX(false, EpiVT, wWukvT(p.ws, l) + (size_t)AW * KVR, KVR, wP(p.ws) + QR, NP, AW, R, KVR, (R / 256 * ((QW + AW) / 256)) % NBLOCKS, wVT(p.out), wRS(p.ws) + R); } while (0)
#define GEMM_MLQK(l) GEMM_CALL(EpiBf16, wMU(p.ws), MW, wWML(p.ws), MW, R, 2 * MW, MW, (R / 256 * ((QW + 2 * AW) / 256)) % NBLOCKS, wMQK(p.ws), 2 * MW, nullptr, 0)
#define GEMM_OUT(l) GEMM_LAT(l, EpiResid, wH(p.ws), D, wWoutT(p.ws, l), D, D, D, 0, wX(p.ws), wMOD(p.ws) + (size_t)(l) * (B + 1) * 6 * D + 2 * D, nullptr, DRY_)
#define GEMM_UP(l) do { KARG(); pg8::Gemm g_{(const bf16*)(wH(p.ws) - D), (const bf16*)wWupT(p.ws, l), D, D, UPT * 256, FF2, D, 254}; pg8::StaticOrder S_; S_.init(UPT * 256, FF2, NBLOCKS, (int)blockIdx.x); \
    pg8::EpiConvGate E_{wGF(p.ws), p.ffn_conv_w + (size_t)(l) * 3 * FF2, p.ffn_conv_b + (size_t)(l) * FF2, (LAS unsigned char*)lds + pg8::STAGE_BYTES}; pg8::gemm_phase<pg8::EpiConvGate, pg8::StaticOrder, true, true>((LAS unsigned char*)lds, g_, S_, E_); } while (0)
#define GEMM_DOWN(l) GEMM_LAT(l, EpiResid, wGF(p.ws), FF, wWdownT(p.ws, l), FF, D, FF, 0, wX(p.ws), wMOD(p.ws) + (size_t)(l) * (B + 1) * 6 * D + 5 * D, nullptr, DRY_)
#endif
#ifdef HOST_EMU
#define GRID_BAR() do {} while (0)
#define FILL_W(ln, busy, i0, i1, filt) do { const int i0_ = (i0), i1_ = (i1); emu_block_launch(i1_ - i0_, [&](int blk, unsigned char* smem) { bphase<BPH_WCVT>(p, ln, i0_ + blk, smem); }); if (filt) RUN(PH_FILT_A, ln, 0); } while (0)
#define RUN(PH, l, arg) emu_launch([&](long gtid, long gth) { phase<PH>(p, l, arg, gtid, gth); })
#define BRUN(BPH, l, nblk) emu_block_launch(nblk, [&](int blk, unsigned char* smem) { bphase<BPH>(p, l, blk, smem); })
#define BRUN_OFF(BPH, l, nblk, busy) BRUN(BPH, l, nblk)
static void fwd(const Params& p) {
#else
#define GRID_BAR() xcd_barrier(bar)
#define DRY_ 0
#define BRUN(BPH, l, nblk) do { KARG(); for (int blk_ = blockIdx.x; blk_ < (nblk); blk_ += NBLOCKS) bphase<BPH>(p, l, blk_, (LdsPtr)lds); } while (0)
#define BRUN_OFF(BPH, l, nblk, busy) do { KARG(); const int busy_ = (busy); if ((int)blockIdx.x >= busy_) for (int blk_ = (int)blockIdx.x - busy_; blk_ < (nblk); blk_ += NBLOCKS - busy_) bphase<BPH>(p, l, blk_, (LdsPtr)lds); } while (0)
#define FILL_W(ln, busy, i0, i1, filt) do { KARG(); const int busy_ = (busy), nf_ = NBLOCKS - busy_, i1_ = (i1); __syncthreads(); if ((int)blockIdx.x >= busy_) { for (int blk_ = (i0) + (int)blockIdx.x - busy_; blk_ < i1_; blk_ += nf_) bphase<BPH_WCVT>(p, ln, blk_, (LdsPtr)lds); \
    if (filt) { int t_ = threadIdx.x; asm volatile("" : "+v"(t_)); phase<PH_FILT_A>(p, ln, 0, (long)((int)blockIdx.x - busy_) * NTHREADS + t_, (long)nf_ * NTHREADS); } } } while (0)
#define RUN(PH, l, arg) do { KARG(); int t_ = threadIdx.x; asm volatile("" : "+v"(t_)); const int g_ = blockIdx.x * NTHREADS + t_; phase<PH>(p, l, arg, (long)g_, gth); } while (0)
__global__ void __launch_bounds__(NTHREADS, 2) fwd(Params p_unused) {
    extern __shared__ __attribute__((aligned(16))) unsigned char lds[];
    if (threadIdx.x < 4) ((LAS unsigned*)lds)[(LDS_BYTES - 16) / 4 + threadIdx.x] = 0u;
    __syncthreads();
    XcdBarrier bar; { KARG(); bar = xcd_barrier_post(wctl(p.ws) + 1024, (volatile LAS unsigned*)(lds + LDS_BYTES - 16)); }
    constexpr long gth = (long)NBLOCKS * NTHREADS;
#endif
    MOD_PHASE(); RUN(PH_ROPE, 0, 0);
    GRID_BAR();
    RUN(PH_MOD2, 0, 0);
    for (int hs = 0; hs <= 2 * DEPTH; ++hs) {
        const int l = (hs - 1) >> 1;
        if (hs >= 1 && (hs & 1)) {
            NORM1_PHASE(l); FILT_B_PHASE(l);
            GRID_BAR();
            GEMM_GEMM1(l); FILT_C_PHASE(l);
            GRID_BAR();
            MLA_A_PHASE(l); if (l < DEPTH - 1) RUN(PH_HY_Z, l, 0); BRUN(BPH_HYZ, l, B * (SEQ / 64)); RUN(PH_FILT_D, l, 0); RUN(PH_ML_U, l, 0); ML_F_PHASE(l);
            GRID_BAR();
            GEMM_Q(l); GEMM_KV(l); GEMM_MLQK(l); BRUN(BPH_HFFT, l, HW); if (l < DEPTH - 1) BRUN(BPH_HYCTX, l, B * (HW / 8));
            GRID_BAR();
            ATT_PHASE(l); ML_B_PHASE(l);
            GRID_BAR();
            RUN(PH_ML_S, l, 0); BRUN(BPH_HYFFT, l, HW);
            GRID_BAR();
            ML_O_PHASE(l); BRUN_OFF(BPH_HYOUT, l, B * (SEQ / 64), l < DEPTH - 1 ? (B * MH * SCN) % NBLOCKS : 0);
            GRID_BAR();
            GEMM_OUT(l);
        }
        if (hs >= 2 && !(hs & 1)) {
            NORM2_PHASE(l);
            GRID_BAR();
#ifdef HOST_EMU
            for (int fcI = 0; fcI < NFC; ++fcI) { RUN(PH_FFN_UP, l, fcI); RUN(PH_FFN_CG, l, fcI); RUN(PH_FFN_DOWN, l, fcI); }
#else
            GEMM_UP(l);
            GRID_BAR();
            GEMM_DOWN(l);
#endif
        }
        {
            int fl = 0, busy = 0, i0 = 0, i1 = 0, filt = 0;
            if (hs == 0) { i1 = WT_SPLIT; filt = 1; }
            else if (hs == 1) { busy = DOWN_BUSY; i0 = WT_SPLIT; i1 = WT_ITEMS; }
            else if (!(hs & 1) && (hs >> 1) < DEPTH) { fl = hs >> 1; busy = DOWN_BUSY; i1 = WT_ITEMS; filt = 1; }
            else if ((hs & 1) && hs > 1) {   }
            FILL_W(fl, busy, i0, i1, filt);
        }
        GRID_BAR();
    }
    FINAL_PHASE();
}

extern "C" void kernel_launch(void* const* d_in, const int* in_sizes, int n_in, void* d_out, int out_size, void* d_ws, size_t ws_size, hipStream_t stream) {
    (void)in_sizes; (void)n_in; (void)out_size; (void)ws_size;
    Params p{};
    const float* const* in = (const float* const*)d_in;
    p.x = in[0]; p.c = in[1]; p.ctx = in[2]; p.c_ctx = in[3]; p.ada_w = in[4]; p.ada_b = in[5]; p.norm1_g = in[6]; p.norm2_g = in[7]; p.w_in = in[8];
    p.q_norm_g = in[9]; p.kv_norm_g = in[10]; p.w_uq = in[11]; p.w_ukv = in[12]; p.ml_conv_w = in[13]; p.ml_conv_b = in[14]; p.ml_wq = in[15]; p.ml_wk = in[16];
    p.ml_gate_b = in[17]; p.ml_norm_g = in[18]; p.hy_conv_w = in[19]; p.hy_conv_b = in[20]; p.hy_w1 = in[21]; p.hy_b1 = in[22]; p.hy_w2 = in[23]; p.hy_b2 = in[24];
    p.hy_w3 = in[25]; p.hy_freq = in[26]; p.hy_bias_d = in[27]; p.w_out = in[28]; p.w_up = in[29]; p.ffn_conv_w = in[30]; p.ffn_conv_b = in[31]; p.w_down = in[32]; p.final_g = in[33];
    p.out = (float*)d_out;
    p.ws = (char*)d_ws;
#ifdef HOST_EMU
    fwd(p);
#else
    static int grid = 0;
    if (grid == 0) {
        int dev = 0, cus = 0;
        if (hipGetDevice(&dev) != hipSuccess || hipDeviceGetAttribute(&cus, hipDeviceAttributeMultiprocessorCount, dev) != hipSuccess) { grid = -1; return; }
        if (hipFuncSetAttribute((const void*)fwd, hipFuncAttributeMaxDynamicSharedMemorySize, LDS_BYTES) != hipSuccess) { grid = -1; return; }
        int per_cu = 0;
        (void)hipOccupancyMaxActiveBlocksPerMultiprocessor(&per_cu, (const void*)fwd, NTHREADS, LDS_BYTES);
        (void)hipGetLastError();
        grid = (cus >= NBLOCKS) ? NBLOCKS : -1;
    }
    if (grid < 0) return;
    (void)hipMemsetAsync(d_ws, 0, CTL_BYTES, stream);
    hipLaunchKernelGGL(fwd, dim3(grid), dim3(NTHREADS), LDS_BYTES, stream, p);
#endif
}
```

```cpp
#ifndef HOST_EMU
#include <hip/hip_runtime.h>
#endif
#include <stdint.h>
#include <math.h>

#ifndef CFG_D_MODEL
#define CFG_D_MODEL 1024
#define CFG_BATCH 8
#define CFG_SEQ 4096
#define CFG_CTX 256
#define CFG_SCS 256
#define CFG_NFC 4
#endif

#define DEV __device__ __forceinline__

namespace cfg {
constexpr int D = CFG_D_MODEL, B = CFG_BATCH, SEQ = CFG_SEQ, CTX = CFG_CTX, DEPTH = 2, GRID_W = 64;
constexpr int RPB = CTX + SEQ;
constexpr int R = B * RPB;
constexpr float EPS = 1e-6f;
constexpr int AH = D / 128, NOPE = 64, ROPE = 32, AV = 64, QR = 3 * D / 8, KVR = D / 4, AW = AH * AV;
constexpr int QW = AH * (NOPE + ROPE);
constexpr int KVW = AH * (NOPE + AV);
constexpr int MH = 4, MD = D / 16, MW = MH * MD;
constexpr int HW = D / 4, HB = 16, HE = 33, HH = 64;
constexpr int N_MLA = QR + KVR + ROPE, N_ML = 3 * MW + 4 * MH, N_HY = 3 * HW, N_IN = N_MLA + N_ML + N_HY;
constexpr int ML_LO = N_MLA, HY_LO = N_MLA + N_ML;
constexpr int NP = (N_IN + 255) / 256 * 256;
constexpr int FF = ((8 * D / 3 + 255) / 256) * 256, FF2 = 2 * FF;
constexpr int SCS = CFG_SCS;
constexpr int SCN = RPB / SCS, NCS = CTX / SCS;
constexpr int NFC = CFG_NFC;
constexpr int FCR = (B / NFC) * RPB;
static_assert(CTX % SCS == 0 && SEQ % SCS == 0, "super-chunk must divide ctx and seq");
static_assert(B % NFC == 0, "ffn chunks");
static_assert(MD == 64 || MD == 16, "mlstm head dim");
}
using namespace cfg;
constexpr int NTHREADS = 512, NBLOCKS = 256;

typedef unsigned short bf16;
struct alignas(16) U4 { unsigned x, y, z, w; };

DEV float u2f(unsigned u) { union { unsigned u; float f; } c; c.u = u; return c.f; }
DEV unsigned f2u(float f) { union { unsigned u; float f; } c; c.f = f; return c.u; }
DEV float bf2f(bf16 v) { return u2f(((unsigned)v) << 16); }
DEV bf16 f2bf(float f) { unsigned u = f2u(f); u += 0x7FFFu + ((u >> 16) & 1u); return (bf16)(u >> 16); }
DEV float bflo(unsigned w) { return u2f(w << 16); }
DEV float bfhi(unsigned w) { return u2f(w & 0xFFFF0000u); }
#ifdef HOST_EMU
DEV float sin_f(float x) { return sinf(x); }
DEV float cos_t(float turns) { return cosf(6.283185307179586f * turns); }
DEV float sin_t(float turns) { return sinf(6.283185307179586f * turns); }
#else
DEV float sin_f(float x) { return __builtin_amdgcn_sinf(__builtin_amdgcn_fractf(x * 0.15915494309189535f)); }
DEV float cos_t(float turns) { return __builtin_amdgcn_cosf(turns); }
DEV float sin_t(float turns) { return __builtin_amdgcn_sinf(turns); }
#endif
#ifdef HOST_EMU
DEV float exp_f(float x) { return expf(x); }
DEV float log1p_f(float y) { return log1pf(y); }
#else
DEV float exp_f(float x) { return __builtin_amdgcn_exp2f(x * 1.4426950408889634f); }
DEV float log1p_f(float y) { return __builtin_amdgcn_logf(1.0f + y) * 0.6931471805599453f; }
#endif
#ifdef HOST_EMU
DEV float rcp_f(float x) { return 1.0f / x; }
#else
DEV float rcp_f(float x) { return __builtin_amdgcn_rcpf(x); }
#endif
DEV float silu_f(float x) { return x * rcp_f(1.0f + exp_f(-x)); }
DEV float sigmoid_f(float x) { return rcp_f(1.0f + exp_f(-x)); }
DEV float logsigmoid_f(float x) { return x >= 0.f ? -log1p_f(exp_f(-x)) : x - log1p_f(exp_f(x)); }
DEV float dot8(const U4& a, const U4& b) {
    return bflo(a.x) * bflo(b.x) + bfhi(a.x) * bfhi(b.x) + bflo(a.y) * bflo(b.y) + bfhi(a.y) * bfhi(b.y) +
           bflo(a.z) * bflo(b.z) + bfhi(a.z) * bfhi(b.z) + bflo(a.w) * bflo(b.w) + bfhi(a.w) * bfhi(b.w);
}

constexpr size_t CTL_BYTES = 65536;
constexpr size_t al256(size_t x) { return (x + 255) & ~(size_t)255; }
constexpr size_t OFF_ctl = 0, SZ_ctl = al256(CTL_BYTES);
constexpr size_t OFF_X = OFF_ctl + SZ_ctl, SZ_X = al256((size_t)R * D * 2);
constexpr size_t OFF_H = OFF_X + SZ_X, SZ_H = al256((size_t)R * D * 2);
constexpr size_t OFF_MOD = OFF_H + SZ_H, SZ_MOD = al256((size_t)DEPTH * (B + 1) * 6 * D * 4);
constexpr size_t OFF_MODP = OFF_MOD + SZ_MOD, SZ_MODP = al256((size_t)8 * DEPTH * (B + 1) * 6 * D * 4);
constexpr size_t OFF_ROPET = OFF_MODP + SZ_MODP, SZ_ROPET = al256((size_t)SEQ * 16 * 2 * 4);
constexpr size_t OFF_WinT = OFF_ROPET + SZ_ROPET, SZ_WinT = al256((size_t)NP * D * 2);
constexpr size_t OFF_WuqT = OFF_WinT + SZ_WinT, SZ_WuqT = al256((size_t)QW * QR * 2);
constexpr size_t OFF_WukvT = OFF_WuqT + SZ_WuqT, SZ_WukvT = al256((size_t)KVW * KVR * 2);
constexpr size_t OFF_WoutT = OFF_WukvT + SZ_WukvT, SZ_WoutT = al256((size_t)D * D * 2);
constexpr size_t OFF_WupT = OFF_WoutT + SZ_WoutT, SZ_WupT = al256((size_t)FF2 * D * 2);
constexpr size_t OFF_WdownT = OFF_WupT + SZ_WupT, SZ_WdownT = al256((size_t)D * FF * 2);
constexpr size_t OFF_HD1 = OFF_WdownT + SZ_WdownT, SZ_HD1 = al256((size_t)2 * SEQ * HH * 4);
constexpr size_t OFF_HD2 = OFF_HD1 + SZ_HD1, SZ_HD2 = al256((size_t)2 * SEQ * HH * 4);
constexpr size_t OFF_FT = OFF_HD2 + SZ_HD2, SZ_FT = al256((size_t)2 * HW * SEQ * 4);
constexpr size_t OFF_FT1 = OFF_FT + SZ_FT, SZ_FT1 = al256((size_t)CTX * 2 * HW * 4);
constexpr size_t OFF_FL1 = OFF_FT1 + SZ_FT1, SZ_FL1 = al256((size_t)2 * HW * 64 * 4);
constexpr size_t OFF_HSPEC = OFF_FL1 + SZ_FL1, SZ_HSPEC = al256((size_t)HW * 2 * SEQ * 8);
constexpr size_t OFF_P = OFF_HSPEC + SZ_HSPEC, SZ_P = al256((size_t)R * NP * 2);
constexpr size_t OFF_KR = OFF_P + SZ_P, SZ_KR = al256((size_t)R * ROPE * 2);
constexpr size_t OFF_RS = OFF_KR + SZ_KR, SZ_RS = al256((size_t)R * 2 * 4);
constexpr size_t OFF_MQK = OFF_RS + SZ_RS, SZ_MQK = al256((size_t)R * 2 * MW * 2);
constexpr size_t OFF_WML = OFF_MQK + SZ_MQK, SZ_WML = al256((size_t)2 * MW * MW * 2);
constexpr size_t OFF_FG = OFF_WML + SZ_WML, SZ_FG = al256((size_t)R * 2 * MH * 2 * 4);
constexpr size_t OFF_MS = OFF_FG + SZ_FG, SZ_MS = al256((size_t)B * MH * 2 * SCN * (MD + 1) * MD * 4);
constexpr size_t OFF_Z = OFF_MS + SZ_MS, SZ_Z = al256((size_t)B * CTX * HW * 4);
constexpr size_t OFF_ZT = OFF_Z + SZ_Z, SZ_ZT = al256((size_t)B * HW * SEQ * 2);
#ifdef HOST_EMU
constexpr size_t OFF_UF = OFF_P, SZ_UF = al256((size_t)FCR * FF2 * 2), OFF_GF = OFF_UF + SZ_UF, SZ_GF = al256((size_t)FCR * FF * 2);
#else
constexpr size_t OFF_UF = OFF_P, SZ_UF = 0, OFF_GF = OFF_P, SZ_GF = al256((size_t)R * FF * 2);
#endif
constexpr size_t WS_BASE = (OFF_ZT + SZ_ZT) > (OFF_GF + SZ_GF) ? (OFF_ZT + SZ_ZT) : (OFF_GF + SZ_GF);
constexpr size_t OFF_WSET1 = WS_BASE, SZ_WSET = OFF_HD1 - OFF_WinT, WSET_STRIDE = OFF_WSET1 - OFF_WinT;
constexpr size_t WS_NEED = OFF_WSET1 + SZ_WSET;
static_assert(WS_NEED <= (size_t)536870912 || D != 1024, "workspace");
constexpr size_t OFF_Q = 0, OFF_KN = al256((size_t)R * QW * 2), OFF_VT = OFF_KN + al256((size_t)R * AW * 2);
static_assert(OFF_VT + (size_t)R * AW * 2 <= (size_t)B * SEQ * D * 4 || D != 1024, "d_out scratch");
struct Params {
    const float *x, *c, *ctx, *c_ctx, *ada_w, *ada_b, *norm1_g, *norm2_g, *w_in, *q_norm_g, *kv_norm_g, *w_uq, *w_ukv;
    const float *ml_conv_w, *ml_conv_b, *ml_wq, *ml_wk, *ml_gate_b, *ml_norm_g;
    const float *hy_conv_w, *hy_conv_b, *hy_w1, *hy_b1, *hy_w2, *hy_b2, *hy_w3, *hy_freq, *hy_bias_d;
    const float *w_out, *w_up, *ffn_conv_w, *ffn_conv_b, *w_down, *final_g;
    float* out;
    char* ws;
};

DEV unsigned* wctl(char* ws) { return (unsigned*)(ws + OFF_ctl); }
DEV bf16* wX(char* ws) { return (bf16*)(ws + OFF_X); }
DEV bf16* wH(char* ws) { return (bf16*)(ws + OFF_H); }
DEV float* wMOD(char* ws) { return (float*)(ws + OFF_MOD); }
DEV float* wROPET(char* ws) { return (float*)(ws + OFF_ROPET); }
DEV bf16* wWinT(char* ws, int l) { return (bf16*)(ws + OFF_WinT + (size_t)(l & 1) * WSET_STRIDE); }
DEV bf16* wWuqT(char* ws, int l) { return (bf16*)(ws + OFF_WuqT + (size_t)(l & 1) * WSET_STRIDE); }
DEV bf16* wWukvT(char* ws, int l) { return (bf16*)(ws + OFF_WukvT + (size_t)(l & 1) * WSET_STRIDE); }
DEV bf16* wWoutT(char* ws, int l) { return (bf16*)(ws + OFF_WoutT + (size_t)(l & 1) * WSET_STRIDE); }
DEV bf16* wWupT(char* ws, int l) { return (bf16*)(ws + OFF_WupT + (size_t)(l & 1) * WSET_STRIDE); }
DEV bf16* wWdownT(char* ws, int l) { return (bf16*)(ws + OFF_WdownT + (size_t)(l & 1) * WSET_STRIDE); }
DEV float* wHD1(char* ws) { return (float*)(ws + OFF_HD1); }
DEV float* wHD2(char* ws) { return (float*)(ws + OFF_HD2); }
DEV float* wFT(char* ws) { return (float*)(ws + OFF_FT); }
DEV float* wFL1(char* ws) { return (float*)(ws + OFF_FL1); }
DEV float* wMODP(char* ws) { return (float*)(ws + OFF_MODP); }
DEV float* wFT1(char* ws) { return (float*)(ws + OFF_FT1); }
DEV bf16* wZT(char* ws) { return (bf16*)(ws + OFF_ZT); }
struct alignas(8) C2 { float x, y; };
DEV C2* wHSPEC(char* ws) { return (C2*)(ws + OFF_HSPEC); }
DEV bf16* wP(char* ws) { return (bf16*)(ws + OFF_P); }
DEV bf16* wKR(char* ws) { return (bf16*)(ws + OFF_KR); }
DEV float* wRS(char* ws) { return (float*)(ws + OFF_RS); }
DEV bf16* wMQK(char* ws) { return (bf16*)(ws + OFF_MQK); }
DEV bf16* wWML(char* ws) { return (bf16*)(ws + OFF_WML); }
DEV bf16* wMU(char* ws) { return (bf16*)(ws + OFF_MS); }
static_assert((size_t)R * MW * 2 <= SZ_MS, "MU aliases MS");
DEV float* wFG(char* ws) { return (float*)(ws + OFF_FG); }
DEV float* wMS(char* ws) { return (float*)(ws + OFF_MS); }
DEV float* wZ(char* ws) { return (float*)(ws + OFF_Z); }
DEV bf16* wUF(char* ws) { return (bf16*)(ws + OFF_UF); }
DEV bf16* wGF(char* ws) { return (bf16*)(ws + OFF_GF); }
DEV bf16* wQ(float* out) { return (bf16*)((char*)out + OFF_Q); }
DEV bf16* wKN(float* out) { return (bf16*)((char*)out + OFF_KN); }
DEV bf16* wVT(float* out) { return (bf16*)((char*)out + OFF_VT); }

#ifdef HOST_EMU
typedef const Params& PRef;
#else
typedef const Params __attribute__((address_space(4)))& PRef;
#endif

struct RowI { int b, o, t, bi; bool ctx; };
DEV RowI rowinfo(int r) { RowI i; i.b = r / RPB; i.o = r % RPB; i.ctx = i.o < CTX; i.t = i.ctx ? i.o : i.o - CTX; i.bi = i.ctx ? B : i.b; return i; }
DEV int swap23(int o) { return (o & 3) | ((o & 4) << 1) | ((o & 8) >> 1); }
DEV int vperm32(int o) { return (o & 3) | (((o >> 4) & 1) << 2) | (((o >> 2) & 3) << 3); }
DEV bool has_prev(const RowI& i) { return i.t > 0; }
DEV bool has_next(const RowI& i) { return i.t + 1 < (i.ctx ? CTX : SEQ); }

enum { PH_MOD, PH_MOD2, PH_ROPE, PH_FILT_A, PH_FILT_B, PH_FILT_C, PH_FILT_D, PH_NORM1, PH_GEMM1, PH_MLA_A, PH_MLA_Q, PH_MLA_KV, PH_ATT,
       PH_ML_U, PH_ML_QK, PH_ML_F, PH_ML_B, PH_ML_S, PH_ML_O, PH_HY_Z, PH_HY_O, PH_GEMM_OUT, PH_NORM2, PH_FFN_UP, PH_FFN_CG, PH_FFN_DOWN, PH_FINAL };

DEV float dot_bf16(const bf16* a, const bf16* b, int K) {
    float acc = 0.f;
    for (int k = 0; k < K; k += 8) { const U4 av = *(const U4*)(a + k), bv = *(const U4*)(b + k); acc += dot8(av, bv); }
    return acc;
}


#ifndef HOST_EMU
namespace pg8 {
#define PG8_LAS __attribute__((address_space(3)))
typedef unsigned short bf16_t;
typedef short bf16x8 __attribute__((ext_vector_type(8)));
typedef float f32x4 __attribute__((ext_vector_type(4)));
typedef unsigned u32x4 __attribute__((ext_vector_type(4)));
constexpr int BM = 256, BK = 64, HALF = 128, HTB = HALF * BK * 2  , STAGE_BYTES = 8 * HTB, NXCD = 8, WGM = 8;

__host__ __device__ __forceinline__ int lds_byte(int r, int c) { const int st = (r >> 4) * 2 + (c >> 5), rr = r & 15, cc = c & 31, ob = rr * 64 + cc * 2; return st * 1024 + (ob ^ (((ob >> 9) & 1) << 5)); }
__host__ __device__ __forceinline__ void stage_rc(int b, int& R, int& C) { const int st = b / 1024, sb = b % 1024, swz = sb ^ (((sb >> 9) & 1) << 5); R = (st >> 1) * 16 + swz / 64; C = (st & 1) * 32 + (swz % 64) / 2; }
__host__ __device__ __forceinline__ int perm32(int rho) { const int n = rho >> 4, i = rho & 15; return 8 * (i >> 2) + 4 * n + (i & 3); }

struct Unit { int pm, pn; };
struct Gemm { const bf16_t* A; const bf16_t* Bt; int lda, ldb, M, N, K, mstep; };

struct StaticOrder {
    int nM, nN, nwg, G, c, lat;
    __host__ __device__ void init(int M, int N, int G_, int c_, int lat_ = 0) { nM = M / BM; nN = N / BM; nwg = nM * nN; G = G_; c = c_; lat = lat_; }
    __host__ __device__ bool next(int i, Unit& u) const {
        const long L = (long)i * G + c; if (L >= nwg) return false;
        int wgid = (int)L; { const int q = nwg / NXCD, r = nwg % NXCD, xcd = wgid % NXCD, off = wgid / NXCD; wgid = (xcd < r ? xcd * (q + 1) : r * (q + 1) + (xcd - r) * q) + off; }
        const int nig = WGM * nN, gid = wgid / nig, fm = gid * WGM, gsz = (nM - fm) < WGM ? (nM - fm) : WGM;
        u.pm = fm + ((wgid % nig) % gsz); u.pn = (wgid % nig) / gsz;
        if (lat) u.pm = u.pm + (u.pm / (SEQ / BM) + 1) * (CTX / BM);
        return true;
    }
    __device__ __forceinline__ void a_ready(const Unit&) const {}
    __device__ __forceinline__ void done(const Unit&) const {}
};
__device__ __forceinline__ unsigned cvt_pk_bf16(float lo, float hi) { unsigned r; asm volatile("v_cvt_pk_bf16_f32 %0, %1, %2" : "=v"(r) : "v"(lo), "v"(hi)); return r; }

template <class Epi, class Sched, bool ALIGN_EPI = false, bool SP2 = false>
__device__ __forceinline__ void gemm_phase(PG8_LAS unsigned char* lds, const Gemm g, const Sched& S, const Epi& E) {
    int tid_ = threadIdx.x; asm volatile("" : "+v"(tid_));
    const int tid = tid_, wid = __builtin_amdgcn_readfirstlane(tid >> 6), lane = tid & 63, wr = wid >> 2, wc = wid & 3, fr = lane & 15, fq = lane >> 4;
    const int K = g.K, nt = K / BK;
    unsigned vvoffA, vvoffB;
    { int R_, C_; stage_rc(tid * 16, R_, C_); const int Rb = Epi::PERM ? ((R_ & ~31) + perm32(R_ & 31)) : R_;
      vvoffA = (unsigned)(R_ * g.lda + C_) * 2u; vvoffB = (unsigned)(Rb * g.ldb + C_) * 2u; }
    const size_t pvoffA = (size_t)64 * g.lda * 2, pvoffB = (size_t)64 * g.ldb * 2;
    const size_t kstep = (size_t)(BK * 2);
    const size_t hstepA = (size_t)HALF * g.lda * 2, hstepB = (size_t)HALF * g.ldb * 2;
    const size_t tstepA = (size_t)g.mstep * g.lda * 2, tstepB = 2 * hstepB;
    const unsigned ldsw = (unsigned)wid * 1024u;
    const int aoff = lds_byte(wr * 64 + fr, fq * 8), boff = lds_byte(wc * 32 + fr, fq * 8);
#define PG8_SA(b, h) (((b) * 2 + (h)) * HTB)
#define PG8_SB(b, h) ((4 + (b) * 2 + (h)) * HTB)
#define PG8_STAGE(bufoff, gbase, voff) do { _Pragma("unroll") for (int _i = 0; _i < 2; ++_i) \
        __builtin_amdgcn_global_load_lds((const unsigned*)((const char*)(gbase) + (size_t)_i * p##voff + (v##voff)), (PG8_LAS unsigned*)(lds + (bufoff) + ldsw + _i * 8192), 16, 0, 0); } while (0)
#define PG8_LDA(dst, b, h) do { _Pragma("unroll") for (int m = 0; m < 4; ++m) _Pragma("unroll") for (int k = 0; k < 2; ++k) dst[m][k] = *(const PG8_LAS bf16x8*)(lds + PG8_SA(b, h) + aoff + m * 2048 + k * 1024); } while (0)
#define PG8_LDB(dst, b, h) do { _Pragma("unroll") for (int n = 0; n < 2; ++n) _Pragma("unroll") for (int k = 0; k < 2; ++k) dst[n][k] = *(const PG8_LAS bf16x8*)(lds + PG8_SB(b, h) + boff + n * 2048 + k * 1024); } while (0)
#define PG8_MMA(ai, bj, At, Bt) do { __builtin_amdgcn_s_setprio(1); _Pragma("unroll") for (int m = 0; m < 4; ++m) _Pragma("unroll") for (int n = 0; n < 2; ++n) _Pragma("unroll") for (int k = 0; k < 2; ++k) \
        acc[ai][bj][m][n] = __builtin_amdgcn_mfma_f32_16x16x32_bf16(Bt[n][k], At[m][k], acc[ai][bj][m][n], 0, 0, 0); __builtin_amdgcn_s_setprio(0); } while (0)
#define PG8_WAIT_V(n) asm volatile("s_waitcnt vmcnt(" #n ")" ::: "memory")
#define PG8_WAIT_L(n) asm volatile("s_waitcnt lgkmcnt(" #n ")" ::: "memory")
#define PG8_BAR __builtin_amdgcn_s_barrier()
#define PG8_SCHED __builtin_amdgcn_sched_barrier(0)
    Unit cur, nxt; int ui = 0;
    if (!S.next(0, cur)) return;
    f32x4 acc[2][2][4][2];
#pragma unroll
    for (int a = 0; a < 2; ++a)
#pragma unroll
        for (int b = 0; b < 2; ++b)
#pragma unroll
            for (int m = 0; m < 4; ++m)
#pragma unroll
                for (int n = 0; n < 2; ++n) acc[a][b][m][n] = (f32x4){0.f, 0.f, 0.f, 0.f};
    bf16x8 At[4][2], B0[2][2], B1[2][2];
    const char* cA = (const char*)g.A + (size_t)cur.pm * tstepA; const char* cB = (const char*)g.Bt + (size_t)cur.pn * tstepB;
    S.a_ready(cur);
    if constexpr (SP2) {
        PG8_STAGE(PG8_SB(0, 0), cB, voffB); PG8_STAGE(PG8_SB(0, 1), cB + hstepB, voffB); PG8_STAGE(PG8_SA(0, 0), cA, voffA); PG8_STAGE(PG8_SA(0, 1), cA + hstepA, voffA);
        if (wr == 1) PG8_BAR;
        PG8_WAIT_V(2); PG8_BAR;
        PG8_STAGE(PG8_SB(1, 0), cB + kstep, voffB); PG8_STAGE(PG8_SA(1, 0), cA + kstep, voffA); PG8_STAGE(PG8_SB(1, 1), cB + hstepB + kstep, voffB);
        PG8_WAIT_V(6); PG8_BAR;
    } else {
        PG8_STAGE(PG8_SB(0, 0), cB, voffB); PG8_STAGE(PG8_SA(0, 0), cA, voffA); PG8_STAGE(PG8_SB(0, 1), cB + hstepB, voffB); PG8_STAGE(PG8_SA(0, 1), cA + hstepA, voffA);
        if (wr == 1) PG8_BAR;
        PG8_WAIT_V(4); PG8_BAR;
        PG8_STAGE(PG8_SB(1, 0), cB + kstep, voffB); PG8_STAGE(PG8_SA(1, 0), cA + kstep, voffA); PG8_STAGE(PG8_SB(1, 1), cB + hstepB + kstep, voffB);
        PG8_WAIT_V(6); PG8_BAR;
    }
    for (;;) {
        const bool has_next = S.next(ui + 1, nxt);
        const char* nA = has_next ? (const char*)g.A + (size_t)nxt.pm * tstepA : cA; const char* nB = has_next ? (const char*)g.Bt + (size_t)nxt.pn * tstepB : cB;
        for (int t = 0; t < nt; t += 2) {
            const bool last = (t == nt - 2);
            const char* a1 = cA + (size_t)(t + 1) * kstep;
            const char* a2 = last ? nA : cA + (size_t)(t + 2) * kstep; const char* b2 = last ? nB : cB + (size_t)(t + 2) * kstep;
            const char* a3 = a2 + kstep; const char* b3 = b2 + kstep;
            if (last && has_next) S.a_ready(nxt);
            if constexpr (SP2) {
            PG8_LDB(B0, 0, 0); PG8_LDB(B1, 0, 1); PG8_SCHED; PG8_LDA(At, 0, 0); PG8_STAGE(PG8_SA(1, 1), a1 + hstepA, voffA);
            PG8_WAIT_V(8); PG8_WAIT_L(0); PG8_BAR; PG8_MMA(0, 0, At, B0); PG8_MMA(0, 1, At, B1); PG8_BAR; PG8_SCHED;
            PG8_LDA(At, 0, 1); PG8_STAGE(PG8_SB(0, 0), b2, voffB); PG8_STAGE(PG8_SB(0, 1), b2 + hstepB, voffB); PG8_STAGE(PG8_SA(0, 0), a2, voffA);
            PG8_WAIT_V(8); PG8_WAIT_L(0); PG8_BAR; PG8_MMA(1, 0, At, B0); PG8_MMA(1, 1, At, B1); PG8_BAR; PG8_SCHED;
            PG8_LDB(B0, 1, 0); PG8_LDB(B1, 1, 1); PG8_SCHED; PG8_LDA(At, 1, 0); PG8_STAGE(PG8_SA(0, 1), a2 + hstepA, voffA);
            PG8_WAIT_V(8); PG8_WAIT_L(0); PG8_BAR; PG8_MMA(0, 0, At, B0); PG8_MMA(0, 1, At, B1); PG8_BAR; PG8_SCHED;
            PG8_LDA(At, 1, 1); PG8_STAGE(PG8_SB(1, 0), b3, voffB); PG8_STAGE(PG8_SB(1, 1), b3 + hstepB, voffB); PG8_STAGE(PG8_SA(1, 0), a3, voffA);
            PG8_WAIT_V(8); PG8_WAIT_L(0); PG8_BAR; PG8_MMA(1, 0, At, B0); PG8_MMA(1, 1, At, B1); PG8_BAR; PG8_SCHED;
            } else {
            PG8_LDB(B0, 0, 0); PG8_SCHED; PG8_LDA(At, 0, 0); PG8_STAGE(PG8_SA(1, 1), a1 + hstepA, voffA);
            PG8_WAIT_L(8); PG8_BAR; PG8_WAIT_L(0); PG8_MMA(0, 0, At, B0); PG8_BAR; PG8_SCHED;
            PG8_LDB(B1, 0, 1); PG8_STAGE(PG8_SB(0, 0), b2, voffB);
            PG8_BAR; PG8_WAIT_L(0); PG8_MMA(0, 1, At, B1); PG8_BAR;
            PG8_LDA(At, 0, 1); PG8_STAGE(PG8_SA(0, 0), a2, voffA);
            PG8_BAR; PG8_WAIT_L(0); PG8_MMA(1, 0, At, B0); PG8_BAR; PG8_SCHED;
            PG8_STAGE(PG8_SB(0, 1), b2 + hstepB, voffB);
            PG8_WAIT_V(6); PG8_BAR; PG8_MMA(1, 1, At, B1); PG8_BAR;
            PG8_LDB(B0, 1, 0); PG8_SCHED; PG8_LDA(At, 1, 0); PG8_STAGE(PG8_SA(0, 1), a2 + hstepA, voffA);
            PG8_WAIT_L(8); PG8_BAR; PG8_WAIT_L(0); PG8_MMA(0, 0, At, B0); PG8_BAR; PG8_SCHED;
            PG8_LDB(B1, 1, 1); PG8_STAGE(PG8_SB(1, 0), b3, voffB);
            PG8_BAR; PG8_WAIT_L(0); PG8_MMA(0, 1, At, B1); PG8_BAR;
            PG8_LDA(At, 1, 1); PG8_STAGE(PG8_SA(1, 0), a3, voffA);
            PG8_BAR; PG8_WAIT_L(0); PG8_MMA(1, 0, At, B0); PG8_BAR; PG8_SCHED;
            PG8_STAGE(PG8_SB(1, 1), b3 + hstepB, voffB);
            PG8_WAIT_V(6); PG8_BAR; PG8_MMA(1, 1, At, B1); PG8_BAR;
            }
        }
        if constexpr (ALIGN_EPI) { if (wr == 0) PG8_BAR; }
        E(acc, cur, wr, wc, fr, fq); S.done(cur);
        if (!has_next) break;
#pragma unroll
        for (int a = 0; a < 2; ++a)
#pragma unroll
            for (int b = 0; b < 2; ++b)
#pragma unroll
                for (int m = 0; m < 4; ++m)
#pragma unroll
                    for (int n = 0; n < 2; ++n) acc[a][b][m][n] = (f32x4){0.f, 0.f, 0.f, 0.f};
        cur = nxt; cA = nA; cB = nB; ++ui;
        if constexpr (ALIGN_EPI) { if (wr == 1) PG8_BAR; }
    }
    PG8_WAIT_V(0);
    if constexpr (!ALIGN_EPI) { if (wr == 0) PG8_BAR; }
    PG8_BAR;
#undef PG8_SA
#undef PG8_SB
#undef PG8_STAGE
#undef PG8_LDA
#undef PG8_LDB
#undef PG8_MMA
#undef PG8_WAIT_V
#undef PG8_WAIT_L
#undef PG8_BAR
#undef PG8_SCHED
}

struct EpiBf16 {
    static constexpr bool PERM = true;
    bf16_t* O; int ldc; const float* rs; int rs_stride;
    __device__ __forceinline__ void operator()(const f32x4 (&acc)[2][2][4][2], const Unit& u, int wr, int wc, int, int) const {
        __builtin_amdgcn_sched_barrier(0);
        int t_ = threadIdx.x; asm volatile("" : "+v"(t_)); const int fr = t_ & 15, fq = (t_ >> 4) & 3;
        const int row0 = u.pm * BM + wr * 64 + fr, col0 = u.pn * BM + wc * 32 + 8 * fq;
#pragma unroll
        for (int ai = 0; ai < 2; ++ai)
#pragma unroll
            for (int m = 0; m < 4; ++m) { const int row = row0 + ai * HALF + m * 16; bf16_t* rowp = O + (size_t)row * ldc + col0;
                const float sc = rs ? rs[(size_t)row * rs_stride] : 1.0f;
#pragma unroll
                for (int bj = 0; bj < 2; ++bj) { const f32x4 v0 = acc[ai][bj][m][0] * sc, v1 = acc[ai][bj][m][1] * sc;
                    u32x4 w; w.x = cvt_pk_bf16(v0[0], v0[1]); w.y = cvt_pk_bf16(v0[2], v0[3]); w.z = cvt_pk_bf16(v1[0], v1[1]); w.w = cvt_pk_bf16(v1[2], v1[3]);
                    *(u32x4*)(rowp + bj * HALF) = w; } }
    }
};
struct EpiVT {
    static constexpr bool PERM = true;
    bf16_t* O; const float* rs;
    __device__ __forceinline__ void operator()(const f32x4 (&acc)[2][2][4][2], const Unit& u, int wr, int wc, int, int) const {
        __builtin_amdgcn_sched_barrier(0);
        int t_ = threadIdx.x; asm volatile("" : "+v"(t_)); const int fr = t_ & 15, fq = (t_ >> 4) & 3;
        const int row0 = u.pm * BM + wr * 64 + fr, col0 = u.pn * BM + wc * 32;
        typedef unsigned u32x2 __attribute__((ext_vector_type(2)));
#pragma unroll
        for (int bj = 0; bj < 2; ++bj) { const int cb = col0 + bj * HALF;
            const float* rsp = rs + cb + 8 * fq;
            typedef bf16_t __attribute__((address_space(1))) gbf16;
            gbf16* rowp = (gbf16*)(O + (size_t)row0 * R + cb + 4 * (fq >> 1) + 16 * (fq & 1));
#pragma unroll
            for (int ai = 0; ai < 2; ++ai)
#pragma unroll
                for (int m = 0; m < 4; ++m) {
                    const f32x4 v0 = acc[ai][bj][m][0] * *(const f32x4*)(rsp), v1 = acc[ai][bj][m][1] * *(const f32x4*)(rsp + 4);
                    u32x2 w0, w1; w0.x = cvt_pk_bf16(v0[0], v0[1]); w0.y = cvt_pk_bf16(v0[2], v0[3]); w1.x = cvt_pk_bf16(v1[0], v1[1]); w1.y = cvt_pk_bf16(v1[2], v1[3]);
                    *(__attribute__((address_space(1))) u32x2*)(rowp) = w0; *(__attribute__((address_space(1))) u32x2*)(rowp + 8) = w1;
                    rowp += (size_t)(m == 3 ? HALF - 48 : 16) * R; asm volatile("" : "+v"(rowp)); } }
    }
};
struct EpiConvGate {
    static constexpr bool PERM = true;
    bf16_t* O; const float* cw; const float* cb; PG8_LAS unsigned char* xl;
    __device__ __forceinline__ void operator()(f32x4 (&acc)[2][2][4][2], const Unit& u, int wr, int wc, int, int) const {
        __builtin_amdgcn_sched_barrier(0);
        int t_ = threadIdx.x; asm volatile("" : "+v"(t_)); const int lane = t_ & 63, fr = t_ & 15, fq = (t_ >> 4) & 3, wave = wr * 4 + wc;
        PG8_LAS f32x4* myx = (PG8_LAS f32x4*)(xl + wave * 1024);
#pragma unroll
        for (int ai = 0; ai < 2; ++ai)
#pragma unroll
            for (int bj = 0; bj < 2; ++bj)
#pragma unroll
                for (int n = 0; n < 2; ++n) { if (fr == 0) myx[(((ai * 2 + 0) * 2 + bj) * 2 + n) * 4 + fq] = acc[ai][bj][0][n]; if (fr == 15) myx[(((ai * 2 + 1) * 2 + bj) * 2 + n) * 4 + fq] = acc[ai][bj][3][n]; }
        asm volatile("s_waitcnt lgkmcnt(0)" ::: "memory"); __builtin_amdgcn_s_barrier(); asm volatile("" ::: "memory");
        const int rg0 = u.pm * 254 - 1 + wr * 64 + fr;
        unsigned hpm = 0u, hnm = 0u;
#pragma unroll
        for (int ai = 0; ai < 2; ++ai)
#pragma unroll
            for (int m = 0; m < 4; ++m) { const int rg = rg0 + ai * HALF + m * 16; const int o = ((rg % RPB) + RPB) % RPB;
                if (o != 0 && o != CTX) hpm |= 1u << (ai * 4 + m); if (o != CTX - 1 && o != RPB - 1) hnm |= 1u << (ai * 4 + m); }
        typedef float f32x2 __attribute__((ext_vector_type(2)));
        {
#pragma unroll
            for (int bj = 0; bj < 2; ++bj)
#pragma unroll
                for (int n = 0; n < 2; ++n) {
                    const int jj = bj * FF + u.pn * HALF + wc * 32 + 8 * fq + 4 * n;
                    const f32x4 w0 = *(const f32x4*)(cw + jj), w1 = *(const f32x4*)(cw + FF2 + jj), w2 = *(const f32x4*)(cw + 2 * FF2 + jj), bb = *(const f32x4*)(cb + jj);
#pragma unroll
                    for (int ai = 0; ai < 2; ++ai) {
                        const int blk = 2 * ai + wr;
                        f32x4 prow = (f32x4){0.f, 0.f, 0.f, 0.f}, nrow = prow;
                        if (blk > 0) prow = *(const PG8_LAS f32x4*)(xl + (((blk - 1) & 1) * 4 + wc) * 1024 + ((((((blk - 1) >> 1) * 2 + 1) * 2 + bj) * 2 + n) * 4 + fq) * 16);
                        if (blk < 3) nrow = *(const PG8_LAS f32x4*)(xl + (((blk + 1) & 1) * 4 + wc) * 1024 + ((((((blk + 1) >> 1) * 2 + 0) * 2 + bj) * 2 + n) * 4 + fq) * 16);
#pragma unroll
                        for (int ep = 0; ep < 2; ++ep) {
                            f32x2 ru[4], rd[4], res[4];
#pragma unroll
                            for (int m = 0; m < 4; ++m)
#pragma unroll
                                for (int k = 0; k < 2; ++k) { int vi = __float_as_int(acc[ai][bj][m][n][2 * ep + k]); asm volatile("" : "+v"(vi));
                                    ru[m][k] = __int_as_float(__builtin_amdgcn_update_dpp(0, vi, 0x121, 0xf, 0xf, false));
                                    rd[m][k] = __int_as_float(__builtin_amdgcn_update_dpp(0, vi, 0x12F, 0xf, 0xf, false)); }
                            const f32x2 w0p = {w0[2 * ep], w0[2 * ep + 1]}, w1p = {w1[2 * ep], w1[2 * ep + 1]}, w2p = {w2[2 * ep], w2[2 * ep + 1]}, bbp = {bb[2 * ep], bb[2 * ep + 1]};
                            const f32x2 pr2 = {prow[2 * ep], prow[2 * ep + 1]}, nr2 = {nrow[2 * ep], nrow[2 * ep + 1]};
#pragma unroll
                            for (int m = 0; m < 4; ++m) {
                                const f32x2 xv = {acc[ai][bj][m][n][2 * ep], acc[ai][bj][m][n][2 * ep + 1]};
                                const f32x2 upv = fr == 0 ? (m == 0 ? pr2 : ru[m == 0 ? 0 : m - 1]) : ru[m];
                                const f32x2 dnv = fr == 15 ? (m == 3 ? nr2 : rd[m == 3 ? 3 : m + 1]) : rd[m];
                                const bool hp = (hpm >> (ai * 4 + m)) & 1u, hn = (hnm >> (ai * 4 + m)) & 1u;
                                const f32x2 z = {0.f, 0.f};
                                res[m] = bbp + w1p * xv + (hp ? w0p * upv : z) + (hn ? w2p * dnv : z); }
                            asm volatile("" : "+v"(res[0]), "+v"(res[1]), "+v"(res[2]), "+v"(res[3]));
#pragma unroll
                            for (int m = 0; m < 4; ++m) { acc[ai][bj][m][n][2 * ep] = res[m][0]; acc[ai][bj][m][n][2 * ep + 1] = res[m][1]; }
                        }
                    }
                }
        }
#pragma unroll
        for (int ai = 0; ai < 2; ++ai)
#pragma unroll
            for (int m = 0; m < 4; ++m) { const int tr = ai * HALF + wr * 64 + m * 16 + fr, rg = u.pm * 254 - 1 + tr;
                if (tr == 0 || tr == 255 || rg >= R) continue;
                const f32x4 a0 = acc[ai][0][m][0], a1 = acc[ai][0][m][1], g0 = acc[ai][1][m][0], g1 = acc[ai][1][m][1];
                float o[8];
#pragma unroll
                for (int e = 0; e < 4; ++e) { o[e] = a0[e] * __builtin_amdgcn_rcpf(1.0f + __builtin_amdgcn_exp2f(-1.4426950408889634f * a0[e])) * g0[e]; o[4 + e] = a1[e] * __builtin_amdgcn_rcpf(1.0f + __builtin_amdgcn_exp2f(-1.4426950408889634f * a1[e])) * g1[e]; }
                u32x4 w; w.x = cvt_pk_bf16(o[0], o[1]); w.y = cvt_pk_bf16(o[2], o[3]); w.z = cvt_pk_bf16(o[4], o[5]); w.w = cvt_pk_bf16(o[6], o[7]);
                *(u32x4*)(O + (size_t)rg * FF + u.pn * HALF + wc * 32 + 8 * fq) = w; }
    }
};
struct EpiResid {
    static constexpr bool PERM = true;
    bf16_t* X; const float* gate; float* outf; int dry;
    __device__ __forceinline__ void operator()(const f32x4 (&acc)[2][2][4][2], const Unit& u, int wr, int wc, int, int) const {
        __builtin_amdgcn_sched_barrier(0);
        int t_ = threadIdx.x; asm volatile("" : "+v"(t_)); const int fr = t_ & 15, fq = (t_ >> 4) & 3;
        const int row0 = u.pm * BM + wr * 64 + fr, col0 = u.pn * BM + wc * 32 + 8 * fq;
#pragma unroll
        for (int ai = 0; ai < 2; ++ai)
#pragma unroll
            for (int m = 0; m < 4; ++m) { const int row = row0 + ai * HALF + m * 16; const RowI ri = rowinfo(row);
                bf16_t* rowp = X + (size_t)row * D + col0; const float* gp = gate + (size_t)ri.bi * 6 * D + col0;
                float* op = outf ? outf + ((size_t)ri.b * SEQ + ri.t) * D + col0 : nullptr;
#pragma unroll
                for (int bj = 0; bj < 2; ++bj) { const int co = bj * HALF;
                    const u32x4 xw = *(const u32x4*)(rowp + co); const f32x4 g0 = *(const f32x4*)(gp + co), g1 = *(const f32x4*)(gp + co + 4);
                    f32x4 n0, n1;
                    n0[0] = __uint_as_float(xw.x << 16); n0[1] = __uint_as_float(xw.x & 0xFFFF0000u); n0[2] = __uint_as_float(xw.y << 16); n0[3] = __uint_as_float(xw.y & 0xFFFF0000u);
                    n1[0] = __uint_as_float(xw.z << 16); n1[1] = __uint_as_float(xw.z & 0xFFFF0000u); n1[2] = __uint_as_float(xw.w << 16); n1[3] = __uint_as_float(xw.w & 0xFFFF0000u);
                    n0 = n0 + g0 * acc[ai][bj][m][0]; n1 = n1 + g1 * acc[ai][bj][m][1];
                    if (dry) continue;
                    if (outf) { *(f32x4*)(op + co) = n0; *(f32x4*)(op + co + 4) = n1; }
                    else { u32x4 w; w.x = cvt_pk_bf16(n0[0], n0[1]); w.y = cvt_pk_bf16(n0[2], n0[3]); w.z = cvt_pk_bf16(n1[0], n1[1]); w.w = cvt_pk_bf16(n1[2], n1[3]); *(u32x4*)(rowp + co) = w; } } }
    }
};
}
#endif


DEV void ld8(const bf16* q, float (&f)[8]) { const U4 u = *(const U4*)q; f[0] = bflo(u.x); f[1] = bfhi(u.x); f[2] = bflo(u.y); f[3] = bfhi(u.y); f[4] = bflo(u.z); f[5] = bfhi(u.z); f[6] = bflo(u.w); f[7] = bfhi(u.w); }
DEV void ldf8(const float* q, float (&f)[8]) {
#pragma unroll
    for (int e = 0; e < 8; ++e) f[e] = q[e]; }
DEV U4 pack8(const float (&f)[8]) { U4 u; u.x = f2bf(f[0]) | ((unsigned)f2bf(f[1]) << 16); u.y = f2bf(f[2]) | ((unsigned)f2bf(f[3]) << 16); u.z = f2bf(f[4]) | ((unsigned)f2bf(f[5]) << 16); u.w = f2bf(f[6]) | ((unsigned)f2bf(f[7]) << 16); return u; }
DEV void conv4x8(const bf16* src, int ld, const float* w  , int wn, const float* bias, bool hp0, bool hn3, float (&out)[4][8]) {
    float w0[8], w1[8], w2[8], bb[8], x[6][8];
    ldf8(w, w0); ldf8(w + wn, w1); ldf8(w + 2 * wn, w2); ldf8(bias, bb);
#pragma unroll
    for (int i = 0; i < 6; ++i) { if ((i == 0 && !hp0) || (i == 5 && !hn3)) {
#pragma unroll
            for (int e = 0; e < 8; ++e) x[i][e] = 0.f; } else ld8(src + (long)(i - 1) * ld, x[i]); }
#pragma unroll
    for (int i = 0; i < 4; ++i)
#pragma unroll
        for (int e = 0; e < 8; ++e) out[i][e] = bb[e] + w0[e] * x[i][e] + w1[e] * x[i + 1][e] + w2[e] * x[i + 2][e];
}

template <int PH> DEV void phase(PRef p, int l, int arg, long gtid, long gth);


template <> DEV void phase<PH_MOD>(PRef p, int, int, long gtid, long gth) {
    constexpr int KC = D / 8;
    for (long i = gtid; i < (long)8 * DEPTH * 6 * D; i += gth) {
        const int j = (int)(i % (6 * D)), l = (int)((i / (6 * D)) % DEPTH), kc = (int)(i / ((long)6 * D * DEPTH));
        const float* w = p.ada_w + (long)l * D * 6 * D + j;
        float acc[B + 1];
#pragma unroll
        for (int bi = 0; bi <= B; ++bi) acc[bi] = 0.f;
        for (int k = kc * KC; k < (kc + 1) * KC; ++k) { const float wv = w[(long)k * 6 * D];
#pragma unroll
            for (int bi = 0; bi <= B; ++bi) acc[bi] += silu_f(bi < B ? p.c[(long)bi * D + k] : p.c_ctx[k]) * wv; }
#pragma unroll
        for (int bi = 0; bi <= B; ++bi) wMODP(p.ws)[(((long)kc * DEPTH + l) * (B + 1) + bi) * 6 * D + j] = acc[bi];
    }
}
template <> DEV void phase<PH_MOD2>(PRef p, int, int, long gtid, long gth) {
    for (long i = gtid; i < (long)DEPTH * (B + 1) * 6 * D; i += gth) {
        const int j = (int)(i % (6 * D)), l = (int)(i / ((long)6 * D * (B + 1)));
        float acc = p.ada_b[(long)l * 6 * D + j];
        for (int kc = 0; kc < 8; ++kc) acc += wMODP(p.ws)[(long)kc * DEPTH * (B + 1) * 6 * D + i];
        wMOD(p.ws)[i] = acc;
    }
}
template <> DEV void phase<PH_ROPE>(PRef p, int, int, long gtid, long gth) {
    for (long i = gtid; i < (long)SEQ * 16; i += gth) {
        const int j = (int)(i % 16), t = (int)(i / 16);
        const int jj = j & 7;
        const float inv = (jj & 1 ? 0.31622776601683794f : 1.0f) * (jj >> 1 == 0 ? 1.0f : jj >> 1 == 1 ? 0.1f : jj >> 1 == 2 ? 0.01f : 0.001f);
        const float pos = j < 8 ? (float)(t / GRID_W) : (float)(t % GRID_W);
        const float a = pos * inv;
        wROPET(p.ws)[i * 2] = cosf(a); wROPET(p.ws)[i * 2 + 1] = sinf(a);
    }
}
template <> DEV void phase<PH_FILT_A>(PRef p, int l, int, long gtid, long gth) {
    for (long i = gtid; i < (long)2 * SEQ * HH; i += gth) {
        const int j = (int)(i % HH), pos = (int)((i / HH) % SEQ), set = (int)(i / ((long)HH * SEQ));
        const int L = set ? CTX : SEQ; if (pos >= L) continue;
        const float* w1 = p.hy_w1 + (long)l * HE * HH;
        const float tl = (float)pos / (float)(L - 1);
        float acc = p.hy_b1[l * HH + j] + tl * w1[j];
        for (int e = 0; e < HB; ++e) {
            const float band = 1e-4f + (float)e * (((float)(HB - 1) - 1e-4f) / (float)(HB - 1));
            float turns = (float)pos * band / (float)L; turns -= floorf(turns);
            acc += cos_t(turns) * w1[(1 + e) * HH + j] - sin_t(turns) * w1[(1 + HB + e) * HH + j];
        }
        wHD1(p.ws)[i] = sin_f(p.hy_freq[l * HH + j] * acc);
    }
}
template <> DEV void phase<PH_FILT_B>(PRef p, int l, int, long gtid, long gth) {
    for (long i = gtid; i < (long)2 * SEQ * HH; i += gth) {
        const int j = (int)(i % HH), pos = (int)((i / HH) % SEQ), set = (int)(i / ((long)HH * SEQ));
        const int L = set ? CTX : SEQ; if (pos >= L) continue;
        const float* w2 = p.hy_w2 + (long)l * HH * HH;
        const float* h1 = wHD1(p.ws) + (i - j);
        float acc = p.hy_b2[l * HH + j];
        for (int e = 0; e < HH; ++e) acc += h1[e] * w2[e * HH + j];
        wHD2(p.ws)[i] = sin_f(p.hy_freq[l * HH + j] * acc);
    }
}
template <> DEV void phase<PH_FILT_C>(PRef p, int l, int, long gtid, long gth) {
    const float* w3 = p.hy_w3 + (long)l * HH * 2 * HW;
    for (long i = gtid; i < (long)2 * (SEQ / 4) * 2 * HW; i += gth) {
        const int c2 = (int)(i % (2 * HW)), pq = (int)((i / (2 * HW)) % (SEQ / 4)), set = (int)(i / ((long)2 * HW * (SEQ / 4)));
        const int L = set ? CTX : SEQ, pos0 = pq * 4; if (pos0 >= L) continue;
        const float* h2 = wHD2(p.ws) + ((long)set * SEQ + pos0) * HH;
        float acc[4] = {0.f, 0.f, 0.f, 0.f};
        for (int e = 0; e < HH; ++e) { const float w = w3[e * 2 * HW + c2];
#pragma unroll
            for (int k = 0; k < 4; ++k) acc[k] += h2[k * HH + e] * w; }
        const int c = c2 % HW;
        const float a0 = -4.605170185988091f / 1.5f, a1 = -4.605170185988091f / 0.3f;
        const float delta = fabsf(a0 + (a1 - a0) * (float)c / (float)(HW - 1));
#pragma unroll
        for (int k = 0; k < 4; ++k) { const int pos = pos0 + k; const float tl = (float)pos / (float)(L - 1); const float v = acc[k] * (exp_f(-tl * delta) + 0.05f);
            if (set == 0) wFT(p.ws)[(long)c2 * SEQ + pos] = v; else wFT1(p.ws)[(long)pos * 2 * HW + c2] = v; }
    }
}
DEV float filt_tap(PRef p, int set, int c2, int pos) { return set == 0 ? wFT(p.ws)[(long)c2 * SEQ + pos] : wFT1(p.ws)[(long)pos * 2 * HW + c2]; }
template <> DEV void phase<PH_FILT_D>(PRef p, int, int, long gtid, long gth) {
    for (long i = gtid; i < (long)2 * HW * 64; i += gth) {
        const int part = (int)(i % 64), c = (int)((i / 64) % HW), set = (int)(i / (64 * HW)); const int L = set ? CTX : SEQ, per = L / 64;
        float s = 0.f;
        for (int pos = part * per; pos < (part + 1) * per; ++pos) { s += fabsf(filt_tap(p, set, c, pos)); if (pos >= 1) s += fabsf(filt_tap(p, set, HW + c, pos)); }
        wFL1(p.ws)[i] = s;
    }
}
DEV float filt_l1(PRef p, int set, int c) { const float* q = wFL1(p.ws) + ((long)set * HW + c) * 64; float s = 0.f; for (int i = 0; i < 64; ++i) s += q[i]; return s; }
template <> DEV void phase<PH_NORM1>(PRef p, int l, int, long gtid, long gth) {
    for (long r = gtid; r < R; r += gth) {
        const RowI ri = rowinfo((int)r);
        bf16* xr = wX(p.ws) + r * D; const float* src = ri.ctx ? p.ctx + ((long)ri.b * CTX + ri.t) * D : p.x + ((long)ri.b * SEQ + ri.t) * D;
        if (l == 0) for (int k = 0; k < D; ++k) xr[k] = f2bf(src[k]);
        float ss = 0.f; for (int k = 0; k < D; ++k) { const float v = l == 0 ? src[k] : bf2f(xr[k]); ss += v * v; }
        const float rstd = 1.0f / sqrtf(ss / (float)D + EPS);
        const float* mod = wMOD(p.ws) + ((long)l * (B + 1) + ri.bi) * 6 * D;
        const float* g = p.norm1_g + l * D;
        for (int k = 0; k < D; ++k) { const float v = l == 0 ? src[k] : bf2f(xr[k]); wH(p.ws)[r * D + k] = f2bf(v * rstd * g[k] * (1.0f + mod[D + k]) + mod[k]); }
    }
}
template <> DEV void phase<PH_GEMM1>(PRef p, int l, int, long gtid, long gth) {
    for (long i = gtid; i < (long)R * NP; i += gth) { const int n = (int)(i % NP); const long r = i / NP;
        wP(p.ws)[i] = f2bf(dot_bf16(wH(p.ws) + r * D, wWinT(p.ws, l) + (long)n * D, D)); }
}
template <> DEV void phase<PH_MLA_A>(PRef p, int, int, long gtid, long gth) {
    for (long r = gtid; r < R; r += gth) {
        const RowI ri = rowinfo((int)r); const bf16* pr = wP(p.ws) + r * NP;
        float s = 0.f; for (int k = 0; k < QR; ++k) { const float v = bf2f(pr[k]); s += v * v; }
        wRS(p.ws)[r] = 1.0f / sqrtf(s / (float)QR + EPS);
        s = 0.f; for (int k = 0; k < KVR; ++k) { const float v = bf2f(pr[QR + k]); s += v * v; }
        wRS(p.ws)[R + r] = 1.0f / sqrtf(s / (float)KVR + EPS);
        for (int j = 0; j < 16; ++j) {
            const float x1 = bf2f(pr[QR + KVR + j]), x2 = bf2f(pr[QR + KVR + 16 + j]);
            float cs = 1.f, sn = 0.f; if (!ri.ctx) { cs = wROPET(p.ws)[((long)ri.t * 16 + j) * 2]; sn = wROPET(p.ws)[((long)ri.t * 16 + j) * 2 + 1]; }
            wKR(p.ws)[r * ROPE + j] = f2bf(x1 * cs - x2 * sn); wKR(p.ws)[r * ROPE + 16 + j] = f2bf(x1 * sn + x2 * cs);
        }
    }
}
template <> DEV void phase<PH_MLA_Q>(PRef p, int l, int, long gtid, long gth) {
    for (long i = gtid; i < (long)R * QW; i += gth) { const int n = (int)(i % QW); const long r = i / QW;
        const RowI ri = rowinfo((int)r);
        const float rs = wRS(p.ws)[r]; const bf16* a = wP(p.ws) + r * NP;
        float v = rs * dot_bf16(a, wWuqT(p.ws, l) + (long)n * QR, QR);
        wQ(p.out)[i] = f2bf(v);
    }
}
template <> DEV void phase<PH_MLA_KV>(PRef p, int l, int, long gtid, long gth) {
    for (long i = gtid; i < (long)R * KVW; i += gth) { const int n = (int)(i % KVW); const long r = i / KVW;
        const bf16 v = f2bf(wRS(p.ws)[R + r] * dot_bf16(wP(p.ws) + r * NP + QR, wWukvT(p.ws, l) + (long)n * KVR, KVR));
        if (n < AW) wKN(p.out)[r * AW + n] = v; else wVT(p.out)[(long)(n - AW) * R + (r & ~31L) + vperm32((int)(r & 31))] = v; }
}
template <> DEV void phase<PH_ATT>(PRef p, int l, int, long gtid, long gth) {
    const bool last = (l == DEPTH - 1);
    const float scale = 1.0f / sqrtf((float)(NOPE + ROPE));
    for (long i = gtid; i < (long)AH * R; i += gth) {
        const int h = (int)(i / R); const long r = i % R; const RowI ri = rowinfo((int)r);
        if (ri.ctx && last) continue;
        const bf16* qp = wQ(p.out) + r * QW + h * (NOPE + ROPE);
        float qr[ROPE];
#pragma unroll
        for (int j = 0; j < 16; ++j) { const float x1 = bf2f(qp[NOPE + j]), x2 = bf2f(qp[NOPE + 16 + j]);
            float cs = 1.f, sn = 0.f; if (!ri.ctx) { cs = wROPET(p.ws)[((long)ri.t * 16 + j) * 2]; sn = wROPET(p.ws)[((long)ri.t * 16 + j) * 2 + 1]; }
            qr[j] = x1 * cs - x2 * sn; qr[16 + j] = x1 * sn + x2 * cs; }
        float o[AV];
#pragma unroll
        for (int d = 0; d < AV; ++d) o[d] = 0.f;
        float m = -1e30f, ssum = 0.f;
        const long k0 = (long)ri.b * RPB; const int nk = ri.ctx ? CTX : RPB;
        for (int kk = 0; kk < nk; ++kk) {
            const bf16* kv = wKN(p.out) + (k0 + kk) * AW + h * NOPE; const bf16* kr = wKR(p.ws) + (k0 + kk) * ROPE;
            const bf16* vt = wVT(p.out) + (long)h * AV * R + ((k0 + kk) & ~31L) + vperm32((int)((k0 + kk) & 31));
            float s = 0.f;
#pragma unroll
            for (int d = 0; d < NOPE; d += 8) s += dot8(*(const U4*)(qp + d), *(const U4*)(kv + d));
#pragma unroll
            for (int d = 0; d < ROPE; ++d) s += qr[d] * bf2f(kr[d]);
            s *= scale;
            const float mn = fmaxf(m, s); const float corr = exp_f(m - mn), pw = exp_f(s - mn);
            ssum = ssum * corr + pw; m = mn;
#pragma unroll
            for (int d = 0; d < AV; ++d) o[d] = o[d] * corr + pw * bf2f(vt[(long)d * R]);
        }
        const float inv = 1.0f / ssum;
#pragma unroll
        for (int d = 0; d < AV; ++d) wH(p.ws)[r * D + h * AV + d] = f2bf(o[d] * inv);
    }
}
template <> DEV void phase<PH_ML_U>(PRef p, int l, int, long gtid, long gth) {
    for (long i = gtid; i < (long)(R / 4) * (MW / 8); i += gth) { const int cg = (int)(i % (MW / 8)); const long r = (i / (MW / 8)) * 4; const RowI ri = rowinfo((int)r);
        const int L = ri.ctx ? CTX : SEQ; float o[4][8];
        conv4x8(wP(p.ws) + r * NP + ML_LO + cg * 8, NP, p.ml_conv_w + (long)l * 3 * MW + cg * 8, MW, p.ml_conv_b + l * MW + cg * 8, ri.t > 0, ri.t + 4 < L, o);
#pragma unroll
        for (int k = 0; k < 4; ++k) {
#pragma unroll
            for (int e = 0; e < 8; ++e) o[k][e] = silu_f(o[k][e]);
            *(U4*)(wMU(p.ws) + (r + k) * MW + cg * 8) = pack8(o[k]); } }
    const float ksc = 1.0f / sqrtf((float)MD);
    for (long i = gtid; i < (long)2 * MW * MW; i += gth) { const int k = (int)(i % MW), n = (int)(i / MW); const int isk = n >= MW, nn = n % MW, h = nn / MD, e = nn % MD;
        float v = 0.f; if (k / MD == h) v = isk ? p.ml_wk[(((long)l * MH + h) * MD + k % MD) * MD + e] * ksc : p.ml_wq[(((long)l * MH + h) * MD + k % MD) * MD + e];
        wWML(p.ws)[i] = f2bf(v); }
}
template <> DEV void phase<PH_ML_QK>(PRef p, int, int, long gtid, long gth) {
    for (long i = gtid; i < (long)R * 2 * MW; i += gth) { const int n = (int)(i % (2 * MW)); const long r = i / (2 * MW);
        wMQK(p.ws)[i] = f2bf(dot_bf16(wMU(p.ws) + r * MW, wWML(p.ws) + (long)n * MW, MW)); }
}
DEV int ml_scan_sc(int dir, int k) { return dir == 0 ? k : (k < NCS ? NCS - 1 - k : SCN - 1 - (k - NCS)); }
DEV int ml_sc_rank(int dir, int sc) { return dir == 0 ? sc : (sc < NCS ? NCS - 1 - sc : NCS + (SCN - 1 - sc)); }
template <> DEV void phase<PH_ML_F>(PRef p, int l, int, long gtid, long gth) {
    for (long i = gtid; i < (long)B * SCN * MH * 2; i += gth) { const int dir = (int)(i % 2), h = (int)((i / 2) % MH), sc = (int)((i / (2 * MH)) % SCN), b = (int)(i / (2 * MH * SCN));
        const float bi_ = p.ml_gate_b[(l * 4 + 2 * dir) * MH + h], bf_ = p.ml_gate_b[(l * 4 + 2 * dir + 1) * MH + h];
        float F = 0.f;
        for (int pos = 0; pos < SCS; ++pos) { const long r = (long)b * RPB + (long)sc * SCS + (dir == 0 ? pos : SCS - 1 - pos);
            const bf16* g = wP(p.ws) + r * NP + ML_LO + 3 * MW;
            const float li = bf2f(g[(2 * dir) * MH + h]) + bi_, lf = logsigmoid_f(bf2f(g[(2 * dir + 1) * MH + h]) + bf_);
            F += lf; float* fg = wFG(p.ws) + ((r * 2 + dir) * MH + h) * 2; fg[0] = F; fg[1] = F - li; }
    }
}
template <> DEV void phase<PH_ML_B>(PRef p, int, int, long gtid, long gth) {
    for (long i = gtid; i < (long)B * MH * 2 * SCN * (MD + 1) * MD; i += gth) {
        const int e = (int)(i % MD), jrow = (int)((i / MD) % (MD + 1)); long t = i / ((long)MD * (MD + 1));
        const int sc = (int)(t % SCN); t /= SCN; const int dir = (int)(t % 2); t /= 2; const int h = (int)(t % MH); const int b = (int)(t / MH);
        const long r0 = (long)b * RPB + (long)sc * SCS; const long rend = dir == 0 ? r0 + SCS - 1 : r0;
        const float Fend = wFG(p.ws)[((rend * 2 + dir) * MH + h) * 2];
        float acc = 0.f;
        for (int s = 0; s < SCS; ++s) { const long r = r0 + s; const float w = exp_f(Fend - wFG(p.ws)[((r * 2 + dir) * MH + h) * 2 + 1]);
            if (jrow < MD) acc += w * bf2f(wMQK(p.ws)[r * 2 * MW + MW + h * MD + jrow]) * bf2f(wP(p.ws)[r * NP + ML_LO + MW + h * MD + e]);
            else acc += w * bf2f(wMQK(p.ws)[r * 2 * MW + MW + h * MD + e]); }
        wMS(p.ws)[i] = acc;
    }
}
template <> DEV void phase<PH_ML_S>(PRef p, int, int dry, long gtid, long gth) {
    for (long i = gtid; i < (long)B * MH * 2 * (MD + 1) * MD; i += gth) {
        const int el = (int)(i % ((MD + 1) * MD)); long t = i / ((MD + 1) * MD); const int dir = (int)(t % 2); t /= 2; const int h = (int)(t % MH); const int b = (int)(t / MH);
        float* base = wMS(p.ws) + ((((long)b * MH + h) * 2 + dir) * SCN) * (MD + 1) * MD + el;
        float C = 0.f;
        for (int k = 0; k < SCN; ++k) { const int sc = ml_scan_sc(dir, k);
            const long r0 = (long)b * RPB + (long)sc * SCS; const long rend = dir == 0 ? r0 + SCS - 1 : r0;
            const float Ftot = wFG(p.ws)[((rend * 2 + dir) * MH + h) * 2];
            float* slot = base + (long)sc * (MD + 1) * MD; const float Bk = *slot; if (!dry) *slot = C;
            C = exp_f(Ftot) * C + Bk; }
    }
}
template <> DEV void phase<PH_ML_O>(PRef p, int l, int, long gtid, long gth) {
    const bool last = (l == DEPTH - 1);
    constexpr int HV = MD / 2;
    for (long i = gtid; i < (long)MH * R; i += gth) {
        const int h = (int)(i / R); const long r = i % R; const RowI ri = rowinfo((int)r);
        if (ri.ctx && last) continue;
        const bf16* qp = wMQK(p.ws) + r * 2 * MW + h * MD;
        const int sc = ri.o / SCS; const long r0 = (long)ri.b * RPB + (long)sc * SCS;
        float ss = 0.f;
        for (int half = 0; half < 2; ++half) {
            float hs[HV], num[HV];
#pragma unroll
            for (int d = 0; d < HV; ++d) hs[d] = 0.f;
            for (int dir = 0; dir < 2; ++dir) {
#pragma unroll
                for (int d = 0; d < HV; ++d) num[d] = 0.f;
                float den = 0.f;
                const float Ft = wFG(p.ws)[((r * 2 + dir) * MH + h) * 2];
                const long sa = dir == 0 ? r0 : r, sb = dir == 0 ? r : r0 + SCS - 1;
                for (long s = sa; s <= sb; ++s) {
                    const float w = exp_f(Ft - wFG(p.ws)[((s * 2 + dir) * MH + h) * 2 + 1]);
                    float dt = 0.f;
#pragma unroll
                    for (int d = 0; d < MD; d += 8) dt += dot8(*(const U4*)(qp + d), *(const U4*)(wMQK(p.ws) + s * 2 * MW + MW + h * MD + d));
                    dt *= w; den += dt;
#pragma unroll
                    for (int d = 0; d < HV; ++d) num[d] += dt * bf2f(wP(p.ws)[s * NP + ML_LO + MW + h * MD + half * HV + d]);
                }
                if (ml_sc_rank(dir, sc) > 0) {
                    const float a = exp_f(Ft);
                    const float* Cin = wMS(p.ws) + (((((long)ri.b * MH + h) * 2 + dir) * SCN) + sc) * (MD + 1) * MD;
#pragma unroll 1
                    for (int d = 0; d < MD; ++d) { const float qa = bf2f(qp[d]) * a; den += qa * Cin[MD * MD + d];
#pragma unroll
                        for (int e = 0; e < HV; ++e) num[e] += qa * Cin[d * MD + half * HV + e]; }
                }
                const float dn = 1.0f / fmaxf(fabsf(den), 1.0f);
#pragma unroll
                for (int d = 0; d < HV; ++d) hs[d] += num[d] * dn;
            }
#pragma unroll
            for (int d = 0; d < HV; ++d) { const float v = hs[d] * sigmoid_f(bf2f(wP(p.ws)[r * NP + ML_LO + 2 * MW + h * MD + half * HV + d])); ss += v * v;
                wH(p.ws)[r * D + AW + h * MD + half * HV + d] = f2bf(v); }
        }
        const float rstd = 1.0f / sqrtf(ss / (float)MD + EPS);
        for (int d = 0; d < MD; ++d) { bf16* o = wH(p.ws) + r * D + AW + h * MD + d; *o = f2bf(bf2f(*o) * rstd * p.ml_norm_g[l * MW + h * MD + d]); }
    }
}

DEV float hy_conv(PRef p, int l, long r, const RowI& ri, int ch) {
    const float* w = p.hy_conv_w + (long)l * 3 * N_HY; const bf16* pr = wP(p.ws) + r * NP + HY_LO + ch;
    float y = p.hy_conv_b[l * N_HY + ch] + w[N_HY + ch] * bf2f(pr[0]);
    if (has_prev(ri)) y += w[ch] * bf2f(pr[-NP]);
    if (has_next(ri)) y += w[2 * N_HY + ch] * bf2f(pr[NP]);
    return y;
}
template <> DEV void phase<PH_HY_Z>(PRef p, int l, int, long gtid, long gth) {
    for (long i = gtid; i < (long)B * CTX * HW; i += gth) { const int c = (int)(i % HW); const long q = i / HW; const long r = (q / CTX) * RPB + (q % CTX); const RowI ri = rowinfo((int)r);
        wZ(p.ws)[i] = hy_conv(p, l, r, ri, HW + c) * hy_conv(p, l, r, ri, 2 * HW + c); }
}
template <> DEV void phase<PH_HY_O>(PRef p, int l, int, long gtid, long gth) {
    if (l == DEPTH - 1) return;
    for (long i = gtid; i < (long)B * CTX * HW; i += gth) { const int c = (int)(i % HW); const long q = i / HW; const int b = (int)(q / CTX), t = (int)(q % CTX); const long r = (long)b * RPB + t; const RowI ri = rowinfo((int)r);
        const float* z = wZ(p.ws) + (long)b * CTX * HW + c;
        float y = 0.f;
        for (int s2 = 0; s2 <= t; ++s2) y += filt_tap(p, 1, c, t - s2) * z[(long)s2 * HW];
        for (int s2 = t + 1; s2 < CTX; ++s2) y += filt_tap(p, 1, HW + c, s2 - t) * z[(long)s2 * HW];
        y = y / filt_l1(p, 1, c) + z[(long)t * HW] * p.hy_bias_d[l * HW + c];
        wH(p.ws)[r * D + AW + MW + c] = f2bf(hy_conv(p, l, r, ri, c) * y); }
}
#ifdef HOST_EMU
#define BLOCK_FOR(tid) for (int tid = 0; tid < NTHREADS; ++tid)
#define BLOCK_SYNC() do {} while (0)
typedef unsigned char* LdsPtr;
DEV C2 twid(float turns) { C2 w; w.x = cosf(6.283185307179586f * turns); w.y = -sinf(6.283185307179586f * turns); return w; }
#else
DEV int opaque_tid() { int t = threadIdx.x; asm volatile("" : "+v"(t)); return t; }
#define BLOCK_FOR(tid) for (int tid = opaque_tid(), once_ = 1; once_; once_ = 0)
#define BLOCK_SYNC() __syncthreads()
typedef __attribute__((address_space(3))) unsigned char* LdsPtr;
DEV C2 twid(float turns) { C2 w; w.x = __builtin_amdgcn_cosf(turns); w.y = -__builtin_amdgcn_sinf(turns); return w; }
#endif
#ifdef HOST_EMU
typedef float* LdsC2; typedef bf16* LdsBf;
#else
typedef __attribute__((address_space(3))) float* LdsC2; typedef __attribute__((address_space(3))) bf16* LdsBf;
#endif
constexpr int NF = 2 * SEQ, NBF = NF / 8;
static_assert(SEQ == 4096 || SEQ == 512, "FFT passes: one radix-2 step then radix-8 steps (SEQ a power of 8)");
DEV int PI(int i) { return i + (i >> 3); }
DEV C2 ldc(LdsC2 buf, int i) { C2 r; r.x = buf[2 * i]; r.y = buf[2 * i + 1]; return r; }
DEV void stc(LdsC2 buf, int i, C2 v) { buf[2 * i] = v.x; buf[2 * i + 1] = v.y; }
DEV C2 cmul(C2 a, C2 b) { C2 r; r.x = a.x * b.x - a.y * b.y; r.y = a.x * b.y + a.y * b.x; return r; }
DEV C2 cmulc(C2 a, C2 b) { C2 r; r.x = a.x * b.x + a.y * b.y; r.y = a.y * b.x - a.x * b.y; return r; }
DEV void dft4(C2& u0, C2& u1, C2& u2, C2& u3) {
    const C2 t0 = {u0.x + u2.x, u0.y + u2.y}, t1 = {u0.x - u2.x, u0.y - u2.y}, t2 = {u1.x + u3.x, u1.y + u3.y}, d = {u1.x - u3.x, u1.y - u3.y};
    const C2 t3 = {d.y, -d.x};
    u0.x = t0.x + t2.x; u0.y = t0.y + t2.y; u2.x = t0.x - t2.x; u2.y = t0.y - t2.y; u1.x = t1.x + t3.x; u1.y = t1.y + t3.y; u3.x = t1.x - t3.x; u3.y = t1.y - t3.y;
}
DEV void dft8(C2 (&a)[8]) {
    const float c = 0.70710678118654752f;
    C2 b0 = {a[0].x + a[4].x, a[0].y + a[4].y}, b4 = {a[0].x - a[4].x, a[0].y - a[4].y};
    C2 b1 = {a[1].x + a[5].x, a[1].y + a[5].y}, d5 = {a[1].x - a[5].x, a[1].y - a[5].y};
    C2 b2 = {a[2].x + a[6].x, a[2].y + a[6].y}, d6 = {a[2].x - a[6].x, a[2].y - a[6].y};
    C2 b3 = {a[3].x + a[7].x, a[3].y + a[7].y}, d7 = {a[3].x - a[7].x, a[3].y - a[7].y};
    C2 b5 = {c * (d5.x + d5.y), c * (d5.y - d5.x)};
    C2 b6 = {d6.y, -d6.x};
    C2 b7 = {c * (d7.y - d7.x), -c * (d7.x + d7.y)};
    dft4(b0, b1, b2, b3); dft4(b4, b5, b6, b7);
    a[0] = b0; a[2] = b1; a[4] = b2; a[6] = b3; a[1] = b4; a[3] = b5; a[5] = b6; a[7] = b7;
}
DEV void idft8(C2 (&a)[8]) {
#pragma unroll
    for (int k = 0; k < 8; ++k) a[k].y = -a[k].y;
    dft8(a);
#pragma unroll
    for (int k = 0; k < 8; ++k) a[k].y = -a[k].y;
}
DEV void twpow(C2 w1, C2 (&w)[8]) { w[0].x = 1.f; w[0].y = 0.f; w[1] = w1; w[2] = cmul(w1, w1); w[3] = cmul(w[2], w1); w[4] = cmul(w[2], w[2]); w[5] = cmul(w[4], w1); w[6] = cmul(w[3], w[3]); w[7] = cmul(w[4], w[3]); }
template <bool INV> DEV void fft_pass8(LdsC2 buf, int s, int ls, int tid) {
    for (int q = tid; q < NBF; q += NTHREADS) {
        const int blk = q >> ls, j = q & (s - 1), base = (blk << (ls + 3)) + j;
        C2 a[8], w[8];
#pragma unroll
        for (int k = 0; k < 8; ++k) a[k] = ldc(buf, PI(base + (k << ls)));
        twpow(twid((float)j / (float)(8 * s)), w);
        if (!INV) { dft8(a);
#pragma unroll
            for (int m = 1; m < 8; ++m) a[m] = cmul(a[m], w[m]);
        } else {
#pragma unroll
            for (int m = 1; m < 8; ++m) a[m] = cmulc(a[m], w[m]);
            idft8(a); }
#pragma unroll
        for (int k = 0; k < 8; ++k) stc(buf, PI(base + (k << ls)), a[k]);
    }
}
DEV void fft_fwd_passes(LdsC2 buf, LdsC2 buf2 = nullptr) {
    int ls = (SEQ == 4096 ? 9 : 6);
    for (int s = SEQ / 8; s >= 8; s >>= 3, ls -= 3) { BLOCK_FOR(tid) { fft_pass8<false>(buf, s, ls, tid); if (buf2) fft_pass8<false>(buf2, s, ls, tid); } BLOCK_SYNC(); }
}
DEV void fft_inv_passes(LdsC2 buf, LdsC2 buf2 = nullptr) {
    int ls = 3;
    for (int s = 8; s <= SEQ / 8; s <<= 3, ls += 3) { BLOCK_FOR(tid) { fft_pass8<true>(buf, s, ls, tid); if (buf2) fft_pass8<true>(buf2, s, ls, tid); } BLOCK_SYNC(); }
}
enum { BPH_HFFT, BPH_HYFFT, BPH_HYZ, BPH_HYOUT, BPH_WCVT, BPH_HYCTX };
template <int BPH> DEV void bphase(PRef p, int l, int blk, LdsPtr lds);
constexpr int WT_UP = (D / 32) * (FF2 / 64), WT_DOWN = (FF / 32) * (D / 64), WT_IN = (D / 32) * (NP / 64), WT_UQ = (QR / 32) * (QW / 64), WT_UKV = (KVR / 32) * (KVW / 64), WT_OUT = (D / 32) * (D / 64);
constexpr int WT_ALL = WT_IN + WT_UQ + WT_UKV + WT_OUT + WT_UP + WT_DOWN;
static_assert(QR % 32 == 0 && KVR % 32 == 0 && QW % 64 == 0 && FF % 64 == 0 && NP % 64 == 0, "weight tiles");
struct WTile { const float* W; const float* gain; bf16* WT; int K, N, k0, n0, s0; };
DEV WTile wtile_decode(PRef p, int l, int t) {
    WTile w; w.gain = nullptr; int NT, which;
    if (t < WT_IN) { which = 0; w.W = p.w_in + (long)l * D * N_IN; w.WT = wWinT(p.ws, l); w.K = D; w.N = N_IN; NT = NP; }
    else if ((t -= WT_IN) < WT_UQ) { which = 1; w.W = p.w_uq + (long)l * QR * QW; w.gain = p.q_norm_g + l * QR; w.WT = wWuqT(p.ws, l); w.K = QR; w.N = QW; NT = QW; }
    else if ((t -= WT_UQ) < WT_UKV) { which = 2; w.W = p.w_ukv + (long)l * KVR * KVW; w.gain = p.kv_norm_g + l * KVR; w.WT = wWukvT(p.ws, l); w.K = KVR; w.N = KVW; NT = KVW; }
    else if ((t -= WT_UKV) < WT_OUT) { which = 3; w.W = p.w_out + (long)l * D * D; w.WT = wWoutT(p.ws, l); w.K = D; w.N = D; NT = D; }
    else if ((t -= WT_OUT) < WT_UP) { which = 4; w.W = p.w_up + (long)l * D * FF2; w.WT = wWupT(p.ws, l); w.K = D; w.N = FF2; NT = FF2; }
    else { t -= WT_UP; which = 5; w.W = p.w_down + (long)l * FF * D; w.WT = wWdownT(p.ws, l); w.K = FF; w.N = D; NT = D; }
    const int ntn = NT / 64, kb = t / ntn, nb = t % ntn; w.k0 = kb * 32; w.n0 = nb * 64;
    w.s0 = w.n0;
    if (which == 2) { const int hd = (w.n0 % AW) / 64; w.s0 = hd * (NOPE + AV) + (w.n0 < AW ? 0 : NOPE); }
#ifndef HOST_EMU
    if (which == 4) { const int tile = w.n0 / 256, within = w.n0 % 256; w.s0 = within < 128 ? tile * 128 + within : FF + tile * 128 + (within - 128); }
#endif
    return w;
}
constexpr int DOWN_BUSY = (R / 256 * (D / 256)) % NBLOCKS, NFILL = NBLOCKS - DOWN_BUSY;
constexpr int WT_PER = 4, WT_ITEMS = (WT_ALL + WT_PER - 1) / WT_PER, WT_SPLIT = (WT_IN + WT_UQ + WT_UKV + WT_OUT + WT_PER - 1) / WT_PER;
template <> DEV void bphase<BPH_WCVT>(PRef p, int l, int blk, LdsPtr lds) {
#ifdef HOST_EMU
    float* sm = (float*)lds;
#else
    __attribute__((address_space(3))) float* sm = (__attribute__((address_space(3))) float*)lds;
#endif
    BLOCK_FOR(tid) {
        for (int sub = 0; sub < WT_PER; ++sub) { const int t = blk * WT_PER + sub; if (t >= WT_ALL) break; const WTile w = wtile_decode(p, l, t);
            for (int idx = tid; idx < 32 * 64; idx += NTHREADS) { const int kk = idx >> 6, nn = idx & 63;
                float v = 0.f; if (w.s0 + nn < w.N) v = w.W[(long)(w.k0 + kk) * w.N + w.s0 + nn];
                if (w.gain) v *= w.gain[w.k0 + kk];
                sm[sub * 64 * 33 + nn * 33 + kk] = v; } }
    }
    BLOCK_SYNC();
    BLOCK_FOR(tid) {
        for (int sub = 0; sub < WT_PER; ++sub) { const int t = blk * WT_PER + sub; if (t >= WT_ALL) break; const WTile w = wtile_decode(p, l, t);
            for (int idx = tid; idx < 64 * 4; idx += NTHREADS) { const int nn = idx >> 2, ch = idx & 3; const int so = sub * 64 * 33 + nn * 33 + ch * 8;
                U4 o;
                o.x = f2bf(sm[so + 0]) | ((unsigned)f2bf(sm[so + 1]) << 16); o.y = f2bf(sm[so + 2]) | ((unsigned)f2bf(sm[so + 3]) << 16);
                o.z = f2bf(sm[so + 4]) | ((unsigned)f2bf(sm[so + 5]) << 16); o.w = f2bf(sm[so + 6]) | ((unsigned)f2bf(sm[so + 7]) << 16);
                *(U4*)(w.WT + (long)(w.n0 + nn) * w.K + w.k0 + ch * 8) = o; } }
    }
    BLOCK_SYNC();
}
template <> DEV void bphase<BPH_HFFT>(PRef p, int l, int blk, LdsPtr lds) {
    LdsC2 buf = (LdsC2)lds; const int c = blk;
    BLOCK_FOR(tid) {
        const float inv = 1.0f / filt_l1(p, 0, c), bias = p.hy_bias_d[l * HW + c];
        const float* fw = wFT(p.ws) + (long)c * SEQ; const float* bw = wFT(p.ws) + (long)(HW + c) * SEQ;
        for (int i = tid; i < SEQ; i += NTHREADS) {
            const float t0 = fw[i] * inv + (i == 0 ? bias : 0.f), t1 = (i == 0) ? 0.f : bw[SEQ - i] * inv;
            C2 e; e.x = t0 + t1; e.y = 0.f; stc(buf, PI(i), e);
            const C2 w = twid((float)i / (float)NF); const float d = t0 - t1; C2 o; o.x = d * w.x; o.y = d * w.y; stc(buf, PI(i + SEQ), o); }
    }
    BLOCK_SYNC();
    fft_fwd_passes(buf);
    BLOCK_FOR(tid) {
        C2* hs = wHSPEC(p.ws) + (long)c * NF; const float sc = 1.0f / (float)NF;
        for (int q = tid; q < NBF; q += NTHREADS) { C2 a[8];
#pragma unroll
            for (int k = 0; k < 8; ++k) a[k] = ldc(buf, 9 * q + k);
            dft8(a);
#pragma unroll
            for (int k = 0; k < 8; ++k) { C2 o; o.x = a[k].x * sc; o.y = a[k].y * sc; hs[8 * q + k] = o; } }
    }
    BLOCK_SYNC();
}
template <> DEV void bphase<BPH_HYFFT>(PRef p, int lflag, int blk, LdsPtr lds) {
    const int c = blk;
    constexpr int NPB = (B >= 4 && B % 4 == 0) ? 2 : 1;
    LdsC2 bufs[2] = {(LdsC2)lds, (LdsC2)(lds + (NPB == 2 ? (NF + NF / 8) * 8 : 0))};
    for (int pr = 0; pr < B / 2; pr += NPB) {
        BLOCK_FOR(tid) {
#pragma unroll
            for (int k = 0; k < NPB; ++k) { LdsC2 buf = bufs[k]; const bf16* z1 = wZT(p.ws) + ((long)(2 * (pr + k)) * HW + c) * SEQ; const bf16* z2 = z1 + (long)HW * SEQ;
                for (int i = tid; i < SEQ; i += NTHREADS) { C2 e; e.x = bf2f(z1[i]); e.y = bf2f(z2[i]); stc(buf, PI(i), e); stc(buf, PI(i + SEQ), cmul(e, twid((float)i / (float)NF))); } }
        }
        BLOCK_SYNC();
        fft_fwd_passes(bufs[0], NPB == 2 ? bufs[1] : nullptr);
        BLOCK_FOR(tid) {
            const C2* hs = wHSPEC(p.ws) + (long)c * NF;
            for (int q = tid; q < NBF; q += NTHREADS) { C2 hv[8];
#pragma unroll
                for (int k = 0; k < 8; ++k) hv[k] = hs[8 * q + k];
#pragma unroll
                for (int kb = 0; kb < NPB; ++kb) { LdsC2 buf = bufs[kb]; C2 a[8];
#pragma unroll
                    for (int k = 0; k < 8; ++k) a[k] = ldc(buf, 9 * q + k);
                    dft8(a);
#pragma unroll
                    for (int k = 0; k < 8; ++k) a[k] = cmul(a[k], hv[k]);
                    idft8(a);
#pragma unroll
                    for (int k = 0; k < 8; ++k) stc(buf, 9 * q + k, a[k]); } }
        }
        BLOCK_SYNC();
        fft_inv_passes(bufs[0], NPB == 2 ? bufs[1] : nullptr);
        BLOCK_FOR(tid) {
#pragma unroll
            for (int k = 0; k < NPB; ++k) { LdsC2 buf = bufs[k]; bf16* z1 = wZT(p.ws) + ((long)(2 * (pr + k)) * HW + c) * SEQ; bf16* z2 = z1 + (long)HW * SEQ;
                for (int i = tid; i < SEQ; i += NTHREADS) { const C2 a = ldc(buf, PI(i)), bb = ldc(buf, PI(i + SEQ)); const C2 y = cmulc(bb, twid((float)i / (float)NF));
                    if (!(lflag & 256)) { z1[i] = f2bf(a.x + y.x); z2[i] = f2bf(a.y + y.y); } } }
        }
        BLOCK_SYNC();
    }
}
template <> DEV void bphase<BPH_HYCTX>(PRef p, int l, int blk, LdsPtr lds) {
#ifdef HOST_EMU
    float* sm = (float*)lds;
#else
    __attribute__((address_space(3))) float* sm = (__attribute__((address_space(3))) float*)lds;
#endif
    const int b = blk / (HW / 8), c0 = (blk % (HW / 8)) * 8;
    BLOCK_FOR(tid) {
        for (int idx = tid; idx < CTX * 8; idx += NTHREADS) { const int t = idx >> 3, c = idx & 7;
            sm[idx] = wZ(p.ws)[((long)b * CTX + t) * HW + c0 + c];
            sm[CTX * 8 + idx] = wFT1(p.ws)[(long)t * 2 * HW + c0 + c]; sm[2 * CTX * 8 + idx] = wFT1(p.ws)[(long)t * 2 * HW + HW + c0 + c]; }
    }
    BLOCK_SYNC();
    BLOCK_FOR(tid) {
        for (int idx = tid; idx < CTX * 8; idx += NTHREADS) { const int t = idx >> 3, c = idx & 7;
            float y = 0.f;
            for (int s2 = 0; s2 <= t; ++s2) y += sm[CTX * 8 + (t - s2) * 8 + c] * sm[s2 * 8 + c];
            for (int s2 = t + 1; s2 < CTX; ++s2) y += sm[2 * CTX * 8 + (s2 - t) * 8 + c] * sm[s2 * 8 + c];
            const long r = (long)b * RPB + t; const RowI ri = rowinfo((int)r);
            y = y / filt_l1(p, 1, c0 + c) + sm[t * 8 + c] * p.hy_bias_d[l * HW + c0 + c];
            wH(p.ws)[r * D + AW + MW + c0 + c] = f2bf(hy_conv(p, l, r, ri, c0 + c) * y); }
    }
    BLOCK_SYNC();
}
constexpr int HZP = 72;
template <> DEV void bphase<BPH_HYZ>(PRef p, int l, int blk, LdsPtr lds) {
    LdsBf sm = (LdsBf)lds; const int b = blk / (SEQ / 64), tt = blk % (SEQ / 64); const long r0 = (long)b * RPB + CTX + (long)tt * 64;
    BLOCK_FOR(tid) { for (int it = tid; it < (HW / 8) * 16; it += NTHREADS) {
        const int cg = it % (HW / 8), rs = it / (HW / 8); const int t0 = tt * 64 + rs * 4; const long r = r0 + rs * 4;
        float a[4][8], v[4][8];
        conv4x8(wP(p.ws) + r * NP + HY_LO + HW + cg * 8, NP, p.hy_conv_w + (long)l * 3 * N_HY + HW + cg * 8, N_HY, p.hy_conv_b + l * N_HY + HW + cg * 8, t0 > 0, t0 + 4 < SEQ, a);
        conv4x8(wP(p.ws) + r * NP + HY_LO + 2 * HW + cg * 8, NP, p.hy_conv_w + (long)l * 3 * N_HY + 2 * HW + cg * 8, N_HY, p.hy_conv_b + l * N_HY + 2 * HW + cg * 8, t0 > 0, t0 + 4 < SEQ, v);
#pragma unroll
        for (int e = 0; e < 8; ++e)
#pragma unroll
            for (int k = 0; k < 4; ++k) sm[(cg * 8 + e) * HZP + rs * 4 + k] = f2bf(a[k][e] * v[k][e]);
    } }
    BLOCK_SYNC();
    BLOCK_FOR(tid) {
        for (int idx = tid; idx < HW * 8; idx += NTHREADS) { const int c = idx >> 3, ch = idx & 7;
            U4 v; const LdsBf q = sm + c * HZP + ch * 8;
            v.x = q[0] | ((unsigned)q[1] << 16); v.y = q[2] | ((unsigned)q[3] << 16); v.z = q[4] | ((unsigned)q[5] << 16); v.w = q[6] | ((unsigned)q[7] << 16);
            *(U4*)(wZT(p.ws) + ((long)b * HW + c) * SEQ + tt * 64 + ch * 8) = v; }
    }
    BLOCK_SYNC();
}
template <> DEV void bphase<BPH_HYOUT>(PRef p, int l, int blk, LdsPtr lds) {
    LdsBf sm = (LdsBf)lds; const int b = blk / (SEQ / 64), tt = blk % (SEQ / 64); const long r0 = (long)b * RPB + CTX + (long)tt * 64;
    BLOCK_FOR(tid) {
        for (int idx = tid; idx < HW * 8; idx += NTHREADS) { const int c = idx >> 3, ch = idx & 7;
            const U4 v = *(const U4*)(wZT(p.ws) + ((long)b * HW + c) * SEQ + tt * 64 + ch * 8); LdsBf q = sm + c * HZP + ch * 8;
            q[0] = (bf16)v.x; q[1] = (bf16)(v.x >> 16); q[2] = (bf16)v.y; q[3] = (bf16)(v.y >> 16); q[4] = (bf16)v.z; q[5] = (bf16)(v.z >> 16); q[6] = (bf16)v.w; q[7] = (bf16)(v.w >> 16); }
    }
    BLOCK_SYNC();
    BLOCK_FOR(tid) { for (int it = tid; it < (HW / 8) * 16; it += NTHREADS) {
        const int cg = it % (HW / 8), rs = it / (HW / 8); const int t0 = tt * 64 + rs * 4; const long r = r0 + rs * 4;
        float x0[4][8];
        conv4x8(wP(p.ws) + r * NP + HY_LO + cg * 8, NP, p.hy_conv_w + (long)l * 3 * N_HY + cg * 8, N_HY, p.hy_conv_b + l * N_HY + cg * 8, t0 > 0, t0 + 4 < SEQ, x0);
#pragma unroll
        for (int k = 0; k < 4; ++k) {
#pragma unroll
            for (int e = 0; e < 8; ++e) x0[k][e] *= bf2f(sm[(cg * 8 + e) * HZP + rs * 4 + k]);
            *(U4*)(wH(p.ws) + (r + k) * D + AW + MW + cg * 8) = pack8(x0[k]); }
    } }
    BLOCK_SYNC();
}
template <> DEV void phase<PH_GEMM_OUT>(PRef p, int l, int, long gtid, long gth) {
    for (long i = gtid; i < (long)R * D; i += gth) { const int n = (int)(i % D); const long r = i / D; const RowI ri = rowinfo((int)r);
        const float g1 = wMOD(p.ws)[((long)l * (B + 1) + ri.bi) * 6 * D + 2 * D + n];
        wX(p.ws)[i] = f2bf(bf2f(wX(p.ws)[i]) + g1 * dot_bf16(wH(p.ws) + r * D, wWoutT(p.ws, l) + (long)n * D, D)); }
}
template <> DEV void phase<PH_NORM2>(PRef p, int l, int, long gtid, long gth) {
    for (long r = gtid; r < R; r += gth) { const RowI ri = rowinfo((int)r); const bf16* xr = wX(p.ws) + r * D;
        float ss = 0.f; for (int k = 0; k < D; ++k) ss += bf2f(xr[k]) * bf2f(xr[k]);
        const float rstd = 1.0f / sqrtf(ss / (float)D + EPS);
        const float* mod = wMOD(p.ws) + ((long)l * (B + 1) + ri.bi) * 6 * D; const float* g = p.norm2_g + l * D;
        for (int k = 0; k < D; ++k) wH(p.ws)[r * D + k] = f2bf(bf2f(xr[k]) * rstd * g[k] * (1.0f + mod[4 * D + k]) + mod[3 * D + k]); }
}
template <> DEV void phase<PH_FFN_UP>(PRef p, int l, int fc, long gtid, long gth) {
    for (long i = gtid; i < (long)FCR * FF2; i += gth) { const int n = (int)(i % FF2); const long rr = i / FF2; const long r = (long)fc * FCR + rr;
        wUF(p.ws)[i] = f2bf(dot_bf16(wH(p.ws) + r * D, wWupT(p.ws, l) + (long)n * D, D)); }
}
template <> DEV void phase<PH_FFN_CG>(PRef p, int l, int fc, long gtid, long gth) {
    for (long i = gtid; i < (long)FCR * FF; i += gth) { const int j = (int)(i % FF); const long rr = i / FF; const long r = (long)fc * FCR + rr; const RowI ri = rowinfo((int)r);
        const float* w = p.ffn_conv_w + (long)l * 3 * FF2; const float* cb = p.ffn_conv_b + (long)l * FF2; const bf16* u = wUF(p.ws) + rr * FF2;
        float a = cb[j] + w[FF2 + j] * bf2f(u[j]), g = cb[FF + j] + w[FF2 + FF + j] * bf2f(u[FF + j]);
        if (has_prev(ri)) { a += w[j] * bf2f(u[j - FF2]); g += w[FF + j] * bf2f(u[FF + j - FF2]); }
        if (has_next(ri)) { a += w[2 * FF2 + j] * bf2f(u[j + FF2]); g += w[2 * FF2 + FF + j] * bf2f(u[FF + j + FF2]); }
        wGF(p.ws)[i] = f2bf(silu_f(a) * g); }
}
template <> DEV void phase<PH_FFN_DOWN>(PRef p, int l, int fc, long gtid, long gth) {
    for (long i = gtid; i < (long)FCR * D; i += gth) { const int n = (int)(i % D); const long rr = i / D; const long r = (long)fc * FCR + rr; const RowI ri = rowinfo((int)r);
        const float g2 = wMOD(p.ws)[((long)l * (B + 1) + ri.bi) * 6 * D + 5 * D + n];
        const float xn = bf2f(wX(p.ws)[r * D + n]) + g2 * dot_bf16(wGF(p.ws) + rr * FF, wWdownT(p.ws, l) + (long)n * FF, FF);
        wX(p.ws)[r * D + n] = f2bf(xn); }
}
template <> DEV void phase<PH_FINAL>(PRef p, int, int, long gtid, long gth) {
    for (long q = gtid; q < (long)B * SEQ; q += gth) { const bf16* xr = wX(p.ws) + ((q / SEQ) * RPB + CTX + q % SEQ) * D;
        float ss = 0.f; for (int k = 0; k < D; ++k) ss += bf2f(xr[k]) * bf2f(xr[k]);
        const float rstd = 1.0f / sqrtf(ss / (float)D + EPS);
        for (int k = 0; k < D; ++k) p.out[q * D + k] = bf2f(xr[k]) * rstd * p.final_g[k]; }
}


#ifndef HOST_EMU
namespace wv {
typedef float f32x4 __attribute__((ext_vector_type(4)));
typedef unsigned u32x2 __attribute__((ext_vector_type(2)));
__device__ __forceinline__ float wsum(float v, int lane) {
#pragma unroll
    for (int o = 32; o; o >>= 1) v += __int_as_float(__builtin_amdgcn_ds_bpermute((lane ^ o) << 2, __float_as_int(v)));
    return v;
}
typedef __bf16 bf2_t __attribute__((ext_vector_type(2)));
typedef float f32x2_t __attribute__((ext_vector_type(2)));
__device__ __forceinline__ unsigned pk(float lo, float hi) { f32x2_t v = {lo, hi}; return __builtin_bit_cast(unsigned, __builtin_convertvector(v, bf2_t)); }
constexpr int NW = NBLOCKS * (NTHREADS / 64), NV = D / 256;
template <int MODE> __device__ __forceinline__ void norm_rows(PRef p, int l) {
    int t_ = threadIdx.x; asm volatile("" : "+v"(t_)); const int lane = t_ & 63, gw = (int)blockIdx.x * (NTHREADS / 64) + (t_ >> 6);
    const int nrows = MODE == 2 ? B * SEQ : R;
    for (int q0 = gw; q0 < nrows; q0 += 2 * NW) {
        const bool two = q0 + NW < nrows;
        long r[2]; int bi[2]; const float* src[2] = {nullptr, nullptr}; bf16* xdst[2] = {nullptr, nullptr};
        f32x4 v[2][NV];
#pragma unroll
        for (int u = 0; u < 2; ++u) if (u == 0 || two) {
            const int q = q0 + u * NW;
            if (MODE == 2) { r[u] = (long)(q / SEQ) * RPB + CTX + (q % SEQ); bi[u] = 0; }
            else { r[u] = q; const RowI ri = rowinfo(q); bi[u] = ri.bi;
                if (MODE == 0 && l == 0) { src[u] = ri.ctx ? p.ctx + ((long)ri.b * CTX + ri.t) * D : p.x + ((long)ri.b * SEQ + ri.t) * D; xdst[u] = wX(p.ws) + r[u] * D; } }
#pragma unroll
            for (int j = 0; j < NV; ++j) {
                if (src[u]) v[u][j] = *(const f32x4*)(src[u] + 4 * lane + 256 * j);
                else { const u32x2 xw = *(const u32x2*)(wX(p.ws) + r[u] * D + 4 * lane + 256 * j); v[u][j][0] = __uint_as_float(xw.x << 16); v[u][j][1] = __uint_as_float(xw.x & 0xFFFF0000u); v[u][j][2] = __uint_as_float(xw.y << 16); v[u][j][3] = __uint_as_float(xw.y & 0xFFFF0000u); } }
        }
#pragma unroll
        for (int u = 0; u < 2; ++u) if (u == 0 || two) {
            const int q = q0 + u * NW;
            float ss = 0.f;
#pragma unroll
            for (int j = 0; j < NV; ++j) ss += (v[u][j][0] * v[u][j][0] + v[u][j][1] * v[u][j][1]) + (v[u][j][2] * v[u][j][2] + v[u][j][3] * v[u][j][3]);
            if (xdst[u]) {
#pragma unroll
                for (int j = 0; j < NV; ++j) { u32x2 w; w.x = pk(v[u][j][0], v[u][j][1]); w.y = pk(v[u][j][2], v[u][j][3]); *(u32x2*)(xdst[u] + 4 * lane + 256 * j) = w; } }
            const float rstd = 1.0f / sqrtf(wsum(ss, lane) / (float)D + EPS);
            if (MODE == 2) {
#pragma unroll
                for (int j = 0; j < NV; ++j) { const f32x4 g = *(const f32x4*)(p.final_g + 4 * lane + 256 * j); *(f32x4*)(p.out + (long)q * D + 4 * lane + 256 * j) = v[u][j] * rstd * g; }
            } else {
                const float* mod = wMOD(p.ws) + ((long)l * (B + 1) + bi[u]) * 6 * D + (MODE == 0 ? 0 : 3 * D); const float* g = (MODE == 0 ? p.norm1_g : p.norm2_g) + l * D;
#pragma unroll
                for (int j = 0; j < NV; ++j) { const int k = 4 * lane + 256 * j; const f32x4 gg = *(const f32x4*)(g + k), sh = *(const f32x4*)(mod + k), sc = *(const f32x4*)(mod + D + k);
                    const f32x4 o = v[u][j] * rstd * gg * (sc + 1.0f) + sh; u32x2 w; w.x = pk(o[0], o[1]); w.y = pk(o[2], o[3]); *(u32x2*)(wH(p.ws) + r[u] * D + k) = w; }
            }
        }
    }
}
__device__ __forceinline__ float rsum16(float v) {
    v += __int_as_float(__builtin_amdgcn_update_dpp(0, __float_as_int(v), 0x128, 0xf, 0xf, false));
    v += __int_as_float(__builtin_amdgcn_update_dpp(0, __float_as_int(v), 0x124, 0xf, 0xf, false));
    v += __int_as_float(__builtin_amdgcn_update_dpp(0, __float_as_int(v), 0x122, 0xf, 0xf, false));
    v += __int_as_float(__builtin_amdgcn_update_dpp(0, __float_as_int(v), 0x121, 0xf, 0xf, false));
    return v;
}
__device__ __forceinline__ void mla_a_rows(PRef p) {
    int t_ = threadIdx.x; asm volatile("" : "+v"(t_)); const int lane = t_ & 63, i = lane & 15, g = lane >> 4, gw = (int)blockIdx.x * (NTHREADS / 64) + (t_ >> 6);
    static_assert(QR == 3 * 128 && KVR == 2 * 128 && ROPE == 32 && R % 4 == 0, "mla_a lane map");
    for (int q0 = gw * 4; q0 < R; q0 += 8 * NW) {
        U4 uq[2][3], uk[2][2]; float x1[2], x2[2], cs[2], sn[2]; bool ok[2], cx[2] = {false, false};
#pragma unroll
        for (int u = 0; u < 2; ++u) {
            const int r = q0 + u * 4 * NW + g; ok[u] = r < R;
            if (ok[u]) { const RowI ri = rowinfo(r); const bf16* pr = wP(p.ws) + (long)r * NP;
#pragma unroll
                for (int c = 0; c < 3; ++c) uq[u][c] = *(const U4*)(pr + (i + 16 * c) * 8);
#pragma unroll
                for (int c = 0; c < 2; ++c) uk[u][c] = *(const U4*)(pr + QR + (i + 16 * c) * 8);
                x1[u] = bf2f(pr[QR + KVR + i]); x2[u] = bf2f(pr[QR + KVR + 16 + i]);
                const int tt = ri.ctx ? 0 : ri.t; cx[u] = ri.ctx; cs[u] = wROPET(p.ws)[((long)tt * 16 + i) * 2]; sn[u] = wROPET(p.ws)[((long)tt * 16 + i) * 2 + 1]; }
        }
#pragma unroll
        for (int u = 0; u < 2; ++u) {
            const int r = q0 + u * 4 * NW + g;
            float sq = 0.f, sk = 0.f;
            if (ok[u]) { sq = dot8(uq[u][0], uq[u][0]) + dot8(uq[u][1], uq[u][1]) + dot8(uq[u][2], uq[u][2]); sk = dot8(uk[u][0], uk[u][0]) + dot8(uk[u][1], uk[u][1]); }
            sq = rsum16(sq); sk = rsum16(sk);
            if (ok[u]) {
                if (i == 0) { wRS(p.ws)[r] = 1.0f / sqrtf(sq / (float)QR + EPS); wRS(p.ws)[R + r] = 1.0f / sqrtf(sk / (float)KVR + EPS); }
                const float c_ = cx[u] ? 1.0f : cs[u], s_ = cx[u] ? 0.0f : sn[u];
                wKR(p.ws)[(long)r * ROPE + i] = f2bf(x1[u] * c_ - x2[u] * s_); wKR(p.ws)[(long)r * ROPE + 16 + i] = f2bf(x1[u] * s_ + x2[u] * c_); }
        }
    }
}
__device__ __forceinline__ void ml_f_rows(PRef p, int l) {
    int t_ = threadIdx.x; asm volatile("" : "+v"(t_)); const int lane = t_ & 63, gw = (int)blockIdx.x * (NTHREADS / 64) + (t_ >> 6);
    static_assert(SCS == 256, "ml_f_rows: 64 lanes x 4 positions");
    for (int u = NW - 1 - gw; u < B * SCN * MH * 2; u += NW) {
        const int dir = u % 2, h = (u / 2) % MH, sc = (u / (2 * MH)) % SCN, b = u / (2 * MH * SCN);
        const float bi_ = p.ml_gate_b[(l * 4 + 2 * dir) * MH + h], bf_ = p.ml_gate_b[(l * 4 + 2 * dir + 1) * MH + h];
        const long rb = (long)b * RPB + (long)sc * SCS;
        float li[4], c[4]; float run = 0.f;
#pragma unroll
        for (int i = 0; i < 4; ++i) { const int pos = 4 * lane + i; const long r = rb + (dir == 0 ? pos : SCS - 1 - pos);
            const bf16* g = wP(p.ws) + r * NP + ML_LO + 3 * MW;
            li[i] = bf2f(g[(2 * dir) * MH + h]) + bi_; run += logsigmoid_f(bf2f(g[(2 * dir + 1) * MH + h]) + bf_); c[i] = run; }
        float inc = run;
#pragma unroll
        for (int o = 1; o < 64; o <<= 1) { const float t = __int_as_float(__builtin_amdgcn_ds_bpermute(((lane - o) & 63) << 2, __float_as_int(inc))); if (lane >= o) inc += t; }
        const float excl = inc - run;
#pragma unroll
        for (int i = 0; i < 4; ++i) { const int pos = 4 * lane + i; const long r = rb + (dir == 0 ? pos : SCS - 1 - pos); const float F = excl + c[i];
            float* fg = wFG(p.ws) + ((r * 2 + dir) * MH + h) * 2; fg[0] = F; fg[1] = F - li[i]; }
    }
}

constexpr int FROWS = (SEQ + CTX) / NBLOCKS;
static_assert((SEQ + CTX) % NBLOCKS == 0 && HH == 64 && 2 * HW == NTHREADS && FROWS * HH * 4 <= 65536, "filter block phases");
__device__ __forceinline__ void filt_b_block(PRef p, int l, __attribute__((address_space(3))) unsigned char* lds) {
    int t_ = threadIdx.x; asm volatile("" : "+v"(t_)); const int t = t_, j = t & 63, wv_ = t >> 6;
    __attribute__((address_space(3))) float* hs = (__attribute__((address_space(3))) float*)lds;
    const long g0 = (long)blockIdx.x * FROWS;
    __syncthreads();
    for (int idx = t; idx < FROWS * HH; idx += NTHREADS) hs[idx] = wHD1(p.ws)[g0 * HH + idx];
    const float* w2 = p.hy_w2 + (long)l * HH * HH;
    float w[HH];
#pragma unroll
    for (int e = 0; e < HH; ++e) w[e] = w2[e * HH + j];
    const float bj = p.hy_b2[l * HH + j], fj = p.hy_freq[l * HH + j];
    __syncthreads();
    for (int k = wv_; k < FROWS; k += NTHREADS / 64) {
        float acc = bj;
#pragma unroll
        for (int e4 = 0; e4 < HH / 4; ++e4) { const f32x4 h = *(const __attribute__((address_space(3))) f32x4*)(hs + k * HH + e4 * 4);
            acc += h[0] * w[4 * e4]; acc += h[1] * w[4 * e4 + 1]; acc += h[2] * w[4 * e4 + 2]; acc += h[3] * w[4 * e4 + 3]; }
        wHD2(p.ws)[(g0 + k) * HH + j] = sin_f(fj * acc);
    }
    __syncthreads();
}
__device__ __forceinline__ void filt_c_block(PRef p, int l, __attribute__((address_space(3))) unsigned char* lds) {
    int t_ = threadIdx.x; asm volatile("" : "+v"(t_)); const int c2 = t_;
    __attribute__((address_space(3))) float* hs = (__attribute__((address_space(3))) float*)lds;
    const long g0 = (long)blockIdx.x * FROWS;
    __syncthreads();
    for (int idx = c2; idx < FROWS * HH; idx += NTHREADS) hs[idx] = wHD2(p.ws)[g0 * HH + idx];
    const float* w3 = p.hy_w3 + (long)l * HH * 2 * HW;
    float w[HH];
#pragma unroll
    for (int e = 0; e < HH; ++e) w[e] = w3[e * 2 * HW + c2];
    const int c = c2 % HW;
    const float a0 = -4.605170185988091f / 1.5f, a1 = -4.605170185988091f / 0.3f;
    const float delta = fabsf(a0 + (a1 - a0) * (float)c / (float)(HW - 1));
    __syncthreads();
    for (int k = 0; k < FROWS; ++k) {
        float acc = 0.f;
#pragma unroll
        for (int e4 = 0; e4 < HH / 4; ++e4) { const f32x4 h = *(const __attribute__((address_space(3))) f32x4*)(hs + k * HH + e4 * 4);
            acc += h[0] * w[4 * e4]; acc += h[1] * w[4 * e4 + 1]; acc += h[2] * w[4 * e4 + 2]; acc += h[3] * w[4 * e4 + 3]; }
        const long g = g0 + k; const int set = g >= SEQ, pos = (int)(set ? g - SEQ : g), L = set ? CTX : SEQ;
        const float tl = (float)pos / (float)(L - 1); const float v = acc * (exp_f(-tl * delta) + 0.05f);
        if (set == 0) wFT(p.ws)[(long)c2 * SEQ + pos] = v; else wFT1(p.ws)[(long)pos * 2 * HW + c2] = v;
    }
    __syncthreads();
}

constexpr int MOD_KC = D / 8, MOD_BLOCKS = 8 * DEPTH * 6 * D / NTHREADS;
static_assert((DEPTH * 6 * D) % NTHREADS == 0 && MOD_KC % 4 == 0 && MOD_BLOCKS <= NBLOCKS, "mod block phase");
__device__ __forceinline__ void mod_block(PRef p, __attribute__((address_space(3))) unsigned char* lds) {
    if ((int)blockIdx.x >= MOD_BLOCKS) return;
    int t_ = threadIdx.x; asm volatile("" : "+v"(t_)); const int t = t_;
    __attribute__((address_space(3))) float* sm = (__attribute__((address_space(3))) float*)lds;
    const long i = (long)blockIdx.x * NTHREADS + t;
    const int j = (int)(i % (6 * D)), l = (int)((i / (6 * D)) % DEPTH), kc = (int)(i / ((long)6 * D * DEPTH));
    for (int idx = t; idx < (B + 1) * MOD_KC; idx += NTHREADS) { const int bi = idx / MOD_KC, k = kc * MOD_KC + idx % MOD_KC; sm[idx] = silu_f(bi < B ? p.c[(long)bi * D + k] : p.c_ctx[k]); }
    __syncthreads();
    const float* w = p.ada_w + (long)l * D * 6 * D + (long)kc * MOD_KC * 6 * D + j;
    float acc[B + 1];
#pragma unroll
    for (int bi = 0; bi <= B; ++bi) acc[bi] = 0.f;
#pragma unroll 2
    for (int k4 = 0; k4 < MOD_KC / 4; ++k4) {
        float wq[4];
#pragma unroll
        for (int q = 0; q < 4; ++q) wq[q] = w[(long)(4 * k4 + q) * 6 * D];
#pragma unroll
        for (int bi = 0; bi <= B; ++bi) { const f32x4 sv = *(const __attribute__((address_space(3))) f32x4*)(sm + bi * MOD_KC + 4 * k4);
            acc[bi] += sv[0] * wq[0]; acc[bi] += sv[1] * wq[1]; acc[bi] += sv[2] * wq[2]; acc[bi] += sv[3] * wq[3]; }
    }
#pragma unroll
    for (int bi = 0; bi <= B; ++bi) wMODP(p.ws)[(((long)kc * DEPTH + l) * (B + 1) + bi) * 6 * D + j] = acc[bi];
    __syncthreads();
}

__device__ __forceinline__ void filt_d_rows(PRef p) {
    int t_ = threadIdx.x; asm volatile("" : "+v"(t_)); const int lane = t_ & 63, gw = (int)blockIdx.x * (NTHREADS / 64) + (t_ >> 6);
    static_assert(2 * HW * 4 <= NBLOCKS * (NTHREADS / 64) && SEQ % 64 == 0 && CTX % 64 == 0, "filt_d tasks");
    if ((gw & 3) != 0 || (gw >> 2) >= 2 * HW) return;
    const int task = gw >> 2, set = task / HW, c = task % HW;
    float s = 0.f;
    if (set == 0) {
        const float* fw = wFT(p.ws) + (long)c * SEQ; const float* bw = wFT(p.ws) + (long)(HW + c) * SEQ;
#pragma unroll 8
        for (int k = 0; k < SEQ / 64; ++k) { const int pos = lane + 64 * k; s += fabsf(fw[pos]); const float b = fabsf(bw[pos]); s += pos >= 1 ? b : 0.f; }
    } else {
#pragma unroll
        for (int k = 0; k < CTX / 64; ++k) { const int pos = lane + 64 * k; s += fabsf(wFT1(p.ws)[(long)pos * 2 * HW + c]); const float b = fabsf(wFT1(p.ws)[(long)pos * 2 * HW + HW + c]); s += pos >= 1 ? b : 0.f; }
    }
    wFL1(p.ws)[((long)set * HW + c) * 64 + lane] = s;
}
__device__ __forceinline__ void ml_s_scan(PRef p) {
    int t_ = threadIdx.x; asm volatile("" : "+v"(t_)); const long gtid = (long)blockIdx.x * NTHREADS + t_;
    for (long i = gtid; i < (long)B * MH * 2 * (MD + 1) * MD; i += (long)NBLOCKS * NTHREADS) {
        const int el = (int)(i % ((MD + 1) * MD)); long t = i / ((MD + 1) * MD); const int dir = (int)(t % 2); t /= 2; const int h = (int)(t % MH); const int b = (int)(t / MH);
        float* base = wMS(p.ws) + ((((long)b * MH + h) * 2 + dir) * SCN) * (MD + 1) * MD + el;
        float Bk[SCN], Fk[SCN];
#pragma unroll
        for (int k = 0; k < SCN; ++k) { const int sc = ml_scan_sc(dir, k);
            const long r0 = (long)b * RPB + (long)sc * SCS; const long rend = dir == 0 ? r0 + SCS - 1 : r0;
            Fk[k] = wFG(p.ws)[((rend * 2 + dir) * MH + h) * 2]; Bk[k] = base[(long)sc * (MD + 1) * MD]; }
        float C = 0.f;
#pragma unroll
        for (int k = 0; k < SCN; ++k) { const int sc = ml_scan_sc(dir, k); base[(long)sc * (MD + 1) * MD] = C; C = exp_f(Fk[k]) * C + Bk[k]; }
    }
}
}
#endif
#ifndef HOST_EMU
#define LAS __attribute__((address_space(3)))
#endif

#ifndef HOST_EMU
namespace att {
typedef short bf16x8 __attribute__((ext_vector_type(8)));
typedef float f32x4 __attribute__((ext_vector_type(4)));
typedef unsigned u32x4 __attribute__((ext_vector_type(4)));
typedef unsigned u32x2 __attribute__((ext_vector_type(2)));
constexpr int TK = 128;
constexpr int KROW = 224, VROW = TK * 2 + 32, KT_BYTES = TK * KROW, VT_BYTES = 64 * VROW;
constexpr int QBLK = 256, NQB = SEQ / QBLK, NLAT = B * AH * NQB, NCQ = CTX / QBLK;
static_assert(SEQ % QBLK == 0 && RPB % TK == 0 && CTX % TK == 0 && CTX % QBLK == 0, "attention tiling");
__device__ __forceinline__ float bfl(unsigned w) { return __uint_as_float(w << 16); }
__device__ __forceinline__ float bfh(unsigned w) { return __uint_as_float(w & 0xFFFF0000u); }
typedef __bf16 bf2_t __attribute__((ext_vector_type(2)));
typedef float f32x2_t __attribute__((ext_vector_type(2)));
__device__ __forceinline__ unsigned pk(float lo, float hi) { f32x2_t v = {lo, hi}; return __builtin_bit_cast(unsigned, __builtin_convertvector(v, bf2_t)); }
__device__ __forceinline__ float xl(float v, int lane, int m) { return __int_as_float(__builtin_amdgcn_ds_bpermute((lane ^ m) << 2, __float_as_int(v))); }
__device__ __forceinline__ void attn_phase(PRef p, int l, LAS unsigned char* lds) {
    const int wave = __builtin_amdgcn_readfirstlane((int)threadIdx.x >> 6);
    const bool last = (l == DEPTH - 1);
    const int vcu = ((int)blockIdx.x % 8) * (NBLOCKS / 8) + (int)blockIdx.x / 8;
    const int nunits = NLAT + (last ? 0 : B * AH * NCQ);
    const float qscale = 0.14724420716f;
    const bf16* Qg = wQ(p.out); const bf16* KNg = wKN(p.out); const bf16* KRg = wKR(p.ws); const bf16* VTg = wVT(p.out); const float* ROPEg = wROPET(p.ws); bf16* Og = wH(p.ws);
    for (int u = vcu; u < nunits; u += NBLOCKS) {
        int tid_ = threadIdx.x; asm volatile("" : "+v"(tid_));
        const int tid = tid_, lane = tid & 63, i16 = lane & 15, g = lane >> 4;
        const bool isctx = u >= NLAT;
        int b, hd, nkeys; long q0;
        if (!isctx) { b = u / (AH * NQB); hd = (u / NQB) % AH; q0 = (long)b * RPB + CTX + (long)(u % NQB) * QBLK; nkeys = RPB; }
        else { const int uu = u - NLAT; b = uu / (AH * NCQ); hd = (uu / NCQ) % AH; q0 = (long)b * RPB + (long)(uu % NCQ) * QBLK; nkeys = CTX; }
        const long k0 = (long)b * RPB;
        const long qw = q0 + wave * 32;
        bf16x8 qf[2][3];
#pragma unroll
        for (int qb = 0; qb < 2; ++qb) {
            const bf16* qp = (Qg + qw * QW + hd * (NOPE + ROPE)) + (unsigned)((qb * 16 + i16) * QW + g * 8);
            u32x4 raw[3];
#pragma unroll
            for (int ks = 0; ks < 3; ++ks) raw[ks] = *(const u32x4*)(qp + ks * 32);
#pragma unroll
            for (int ks = 0; ks < 2; ++ks) { u32x4 w;
#pragma unroll
                for (int e = 0; e < 4; ++e) w[e] = pk(bfl(raw[ks][e]) * qscale, bfh(raw[ks][e]) * qscale);
                qf[qb][ks] = __builtin_bit_cast(bf16x8, w); }
            u32x4 w2;
            if (!isctx) {
                u32x4 pr;
#pragma unroll
                for (int e = 0; e < 4; ++e) pr[e] = (unsigned)__builtin_amdgcn_ds_bpermute((lane ^ 32) << 2, (int)raw[2][e]);
                const float* tb = (ROPEg + (qw - k0 - CTX) * 32) + (unsigned)((qb * 16 + i16) * 32 + 16 * (g & 1));
                const float sg = g < 2 ? -1.0f : 1.0f;
#pragma unroll
                for (int e = 0; e < 4; ++e) { const f32x4 cs = *(const f32x4*)(tb + 4 * e);
                    const float m0 = bfl(raw[2][e]), m1 = bfh(raw[2][e]), o0 = bfl(pr[e]), o1 = bfh(pr[e]);
                    w2[e] = pk((m0 * cs[0] + sg * o0 * cs[1]) * qscale, (m1 * cs[2] + sg * o1 * cs[3]) * qscale); }
            } else {
#pragma unroll
                for (int e = 0; e < 4; ++e) w2[e] = pk(bfl(raw[2][e]) * qscale, bfh(raw[2][e]) * qscale);
            }
            qf[qb][2] = __builtin_bit_cast(bf16x8, w2);
        }
        const bf16* knb = KNg + k0 * AW + hd * NOPE; const bf16* krb = KRg + k0 * ROPE; const bf16* vb = VTg + (long)hd * AV * R + k0;
        const unsigned kn_off0 = (unsigned)((tid >> 3) * AW + (tid & 7) * 8), kn_off1 = kn_off0 + 64u * AW, kr_off = (unsigned)((tid >> 2) * ROPE + (tid & 3) * 8);
        const unsigned v_off0 = (unsigned)((tid >> 4) * R + (tid & 15) * 8), v_off1 = v_off0 + 32u * R;
        const int kn_dst0 = (tid >> 3) * KROW + (tid & 7) * 16, kn_dst1 = kn_dst0 + 64 * KROW, kr_dst = (tid >> 2) * KROW + 128 + (tid & 3) * 16;
        const int v_dst0 = 2 * KT_BYTES + (tid >> 4) * VROW + (tid & 15) * 16, v_dst1 = v_dst0 + 32 * VROW;
        const int nt = nkeys / TK;
        f32x4 O[2][4];
#pragma unroll
        for (int qb = 0; qb < 2; ++qb)
#pragma unroll
            for (int dvt = 0; dvt < 4; ++dvt) O[qb][dvt] = (f32x4){0.f, 0.f, 0.f, 0.f};
        float mrun[2] = {0.f, 0.f}, lsum[2] = {0.f, 0.f};
        f32x4 negm[2] = {(f32x4){0.f, 0.f, 0.f, 0.f}, (f32x4){0.f, 0.f, 0.f, 0.f}};
        const int kfo = i16 * KROW + g * 16, vfo = 2 * KT_BYTES + i16 * VROW + g * 16;
        u32x4 s1, s2, s3, s4, s5;
        auto load_stage = [&](int tt) { s1 = *(const u32x4*)(knb + (long)tt * TK * AW + kn_off0); s2 = *(const u32x4*)(knb + (long)tt * TK * AW + kn_off1); s3 = *(const u32x4*)(krb + (long)tt * TK * ROPE + kr_off);
            s4 = *(const u32x4*)(vb + (long)tt * TK + v_off0); s5 = *(const u32x4*)(vb + (long)tt * TK + v_off1); };
        auto store_stage = [&](int buf) { const int nk = buf * KT_BYTES, nv = buf * VT_BYTES;
            *(LAS u32x4*)(lds + nk + kn_dst0) = s1; *(LAS u32x4*)(lds + nk + kn_dst1) = s2; *(LAS u32x4*)(lds + nk + kr_dst) = s3; *(LAS u32x4*)(lds + nv + v_dst0) = s4; *(LAS u32x4*)(lds + nv + v_dst1) = s5; };
        auto subtile = [&](int kb_off, int vb_off, bool first) {
            bf16x8 kf[12];
#pragma unroll
            for (int kb = 0; kb < 4; ++kb)
#pragma unroll
                for (int ks = 0; ks < 3; ++ks) kf[kb * 3 + ks] = *(const LAS bf16x8*)(lds + kb_off + kb * 16 * KROW + ks * 64);
            asm volatile("s_waitcnt lgkmcnt(0)" : "+v"(kf[0]), "+v"(kf[1]), "+v"(kf[2]), "+v"(kf[3]), "+v"(kf[4]), "+v"(kf[5]), "+v"(kf[6]), "+v"(kf[7]), "+v"(kf[8]), "+v"(kf[9]), "+v"(kf[10]), "+v"(kf[11]) :: "memory");
            f32x4 S[2][4];
#pragma unroll
            for (int kb = 0; kb < 4; ++kb)
#pragma unroll
                for (int ks = 0; ks < 3; ++ks) {
                    S[0][kb] = __builtin_amdgcn_mfma_f32_16x16x32_bf16(kf[kb * 3 + ks], qf[0][ks], ks == 0 ? negm[0] : S[0][kb], 0, 0, 0);
                    S[1][kb] = __builtin_amdgcn_mfma_f32_16x16x32_bf16(kf[kb * 3 + ks], qf[1][ks], ks == 0 ? negm[1] : S[1][kb], 0, 0, 0); }
            bf16x8 vf[8];
#pragma unroll
            for (int dvt = 0; dvt < 4; ++dvt)
#pragma unroll
                for (int kp = 0; kp < 2; ++kp) vf[dvt * 2 + kp] = *(const LAS bf16x8*)(lds + vb_off + dvt * 16 * VROW + kp * 64);
            asm volatile("" ::: "memory");
            bf16x8 pf[2][2];
#pragma unroll
            for (int qb = 0; qb < 2; ++qb) {
                float mx = S[qb][0][0];
#pragma unroll
                for (int kb = 0; kb < 4; ++kb)
#pragma unroll
                    for (int e = 0; e < 4; ++e) mx = fmaxf(mx, S[qb][kb][e]);
                if (first || __builtin_amdgcn_ballot_w64(mx > 8.0f) != 0ull) {
                    mx = fmaxf(mx, xl(mx, lane, 16)); mx = fmaxf(mx, xl(mx, lane, 32));
                    const float d = first ? mx : fmaxf(mx, 0.0f), corr = first ? 1.0f : __builtin_amdgcn_exp2f(-d);
                    mrun[qb] += d; lsum[qb] *= corr; negm[qb] = (f32x4){-mrun[qb], -mrun[qb], -mrun[qb], -mrun[qb]};
#pragma unroll
                    for (int dvt = 0; dvt < 4; ++dvt) O[qb][dvt] = O[qb][dvt] * corr;
#pragma unroll
                    for (int kb = 0; kb < 4; ++kb) S[qb][kb] = S[qb][kb] - d;
                }
                float ps = 0.f;
#pragma unroll
                for (int kb = 0; kb < 4; ++kb)
#pragma unroll
                    for (int e = 0; e < 4; ++e) { const float ex = __builtin_amdgcn_exp2f(S[qb][kb][e]); S[qb][kb][e] = ex; ps += ex; }
                lsum[qb] += ps;
#pragma unroll
                for (int kp = 0; kp < 2; ++kp) { u32x4 w; w[0] = pk(S[qb][2 * kp][0], S[qb][2 * kp][1]); w[1] = pk(S[qb][2 * kp][2], S[qb][2 * kp][3]); w[2] = pk(S[qb][2 * kp + 1][0], S[qb][2 * kp + 1][1]); w[3] = pk(S[qb][2 * kp + 1][2], S[qb][2 * kp + 1][3]);
                    pf[qb][kp] = __builtin_bit_cast(bf16x8, w); }
            }
            asm volatile("s_waitcnt lgkmcnt(0)" : "+v"(vf[0]), "+v"(vf[1]), "+v"(vf[2]), "+v"(vf[3]), "+v"(vf[4]), "+v"(vf[5]), "+v"(vf[6]), "+v"(vf[7]) :: "memory");
#pragma unroll
            for (int dvt = 0; dvt < 4; ++dvt)
#pragma unroll
                for (int kp = 0; kp < 2; ++kp) {
                    O[0][dvt] = __builtin_amdgcn_mfma_f32_16x16x32_bf16(vf[dvt * 2 + kp], pf[0][kp], O[0][dvt], 0, 0, 0);
                    O[1][dvt] = __builtin_amdgcn_mfma_f32_16x16x32_bf16(vf[dvt * 2 + kp], pf[1][kp], O[1][dvt], 0, 0, 0); }
        };
        load_stage(0); store_stage(0);
        __syncthreads();
        for (int t = 0; t < nt; ++t) {
            const int buf = t & 1;
            if (t + 1 < nt) load_stage(t + 1);
#pragma unroll
            for (int sub = 0; sub < TK / 64; ++sub) subtile(buf * KT_BYTES + sub * 64 * KROW + kfo, buf * VT_BYTES + sub * 128 + vfo, sub == 0 && t == 0);
            if (t + 1 < nt) store_stage(buf ^ 1);
            __syncthreads();
        }
#pragma unroll
        for (int qb = 0; qb < 2; ++qb) {
            float lt = lsum[qb]; lt += xl(lt, lane, 16); lt += xl(lt, lane, 32); const float inv = 1.0f / lt;
            bf16* op = (Og + qw * D + hd * AV) + (unsigned)((qb * 16 + i16) * D + 4 * g);
#pragma unroll
            for (int dvt = 0; dvt < 4; ++dvt) { u32x2 w; w.x = pk(O[qb][dvt][0] * inv, O[qb][dvt][1] * inv); w.y = pk(O[qb][dvt][2] * inv, O[qb][dvt][3] * inv); *(u32x2*)(op + dvt * 16) = w; }
        }
    }
}
}
#endif

#ifndef HOST_EMU
namespace mlk {
typedef short bf16x8 __attribute__((ext_vector_type(8)));
typedef float f32x16 __attribute__((ext_vector_type(16)));
typedef float f32x4 __attribute__((ext_vector_type(4)));
typedef unsigned u32x4 __attribute__((ext_vector_type(4)));
typedef unsigned u32x2 __attribute__((ext_vector_type(2)));
static_assert(SCS == 256 && MD == 64, "mlstm MFMA phases: 256-row super-chunks, head dim 64");
constexpr int KP = 144, TP = 528;
constexpr int O_KL = 0, O_VT = 256 * KP, O_CT = O_VT + 64 * TP, O_FG = O_CT + 2 * 64 * KP, O_NL = O_FG + 2 * 2 * 256 * 4, O_END = O_NL + 2 * 64 * 4;
constexpr int B_KT = 0, B_VT = 64 * TP, B_WL = 2 * 64 * TP, B_END = B_WL + 2 * 256 * 4;
constexpr float LOG2E = 1.4426950408889634f;
__device__ __forceinline__ float bfl(unsigned w) { return __uint_as_float(w << 16); }
__device__ __forceinline__ float bfh(unsigned w) { return __uint_as_float(w & 0xFFFF0000u); }
__device__ __forceinline__ unsigned pk(float lo, float hi) { unsigned r; asm volatile("v_cvt_pk_bf16_f32 %0, %1, %2" : "=v"(r) : "v"(lo), "v"(hi)); return r; }
__device__ __forceinline__ float xl32(float v, int lane) { return __int_as_float(__builtin_amdgcn_ds_bpermute((lane ^ 32) << 2, __float_as_int(v))); }
__device__ __forceinline__ int kpos(int key) { return (key & ~15) | swap23(key & 15); }
__device__ __forceinline__ void stage_t(LAS unsigned char* img, const u32x4 v, int dim0, int key) {
    const int kb = kpos(key) * 2;
#pragma unroll
    for (int e = 0; e < 4; ++e) { *(LAS unsigned short*)(img + (dim0 + 2 * e) * TP + kb) = (unsigned short)(v[e] & 0xFFFFu); *(LAS unsigned short*)(img + (dim0 + 2 * e + 1) * TP + kb) = (unsigned short)(v[e] >> 16); }
}
__device__ __forceinline__ void ml_b_phase(PRef p, LAS unsigned char* lds) {
    const int wave = __builtin_amdgcn_readfirstlane((int)threadIdx.x >> 6);
    for (int u = ((((int)blockIdx.x % 8) + 6) % 8) * (NBLOCKS / 8) + (int)blockIdx.x / 8; u < B * MH * SCN; u += NBLOCKS) {
        int tid_ = threadIdx.x; asm volatile("" : "+v"(tid_)); const int tid = tid_, lane = tid & 63, r = lane & 31, hh = lane >> 5;
        const int sc = u % SCN, h = (u / SCN) % MH, b = u / (SCN * MH); const long r0 = (long)b * RPB + (long)sc * SCS;
        const bf16* kg = wMQK(p.ws) + r0 * 2 * MW + MW + h * MD; const bf16* vg = wP(p.ws) + r0 * NP + ML_LO + MW + h * MD; const float* fg = wFG(p.ws);
#pragma unroll
        for (int i = 0; i < 4; ++i) { const int ci = tid + 512 * i, key = ci >> 3, part = ci & 7;
            stage_t(lds + B_KT, *(const u32x4*)(kg + (unsigned)(key * 2 * MW + part * 8)), part * 8, key);
            stage_t(lds + B_VT, *(const u32x4*)(vg + (unsigned)(key * NP + part * 8)), part * 8, key); }
        { const int dir = tid >> 8, key = tid & 255; const long rend = dir == 0 ? r0 + SCS - 1 : r0;
          const float Fend = fg[((rend * 2 + dir) * MH + h) * 2], G = fg[(((r0 + key) * 2 + dir) * MH + h) * 2 + 1];
          *(LAS float*)(lds + B_WL + (dir * 256 + kpos(key)) * 4) = __builtin_amdgcn_exp2f((Fend - G) * LOG2E); }
        __syncthreads();
        const int dir = wave >> 2, dvb = (wave >> 1) & 1, kb = wave & 1;
        f32x16 acc;
#pragma unroll
        for (int i = 0; i < 16; ++i) acc[i] = 0.f;
        float nacc = 0.f;
#pragma unroll 4
        for (int ks = 0; ks < 16; ++ks) {
            const bf16x8 vf = *(const LAS bf16x8*)(lds + B_VT + (dvb * 32 + r) * TP + ks * 32 + hh * 16);
            const u32x4 kr = *(const LAS u32x4*)(lds + B_KT + (kb * 32 + r) * TP + ks * 32 + hh * 16);
            const f32x4 w0 = *(const LAS f32x4*)(lds + B_WL + (dir * 256 + ks * 16 + hh * 8) * 4), w1 = *(const LAS f32x4*)(lds + B_WL + (dir * 256 + ks * 16 + hh * 8 + 4) * 4);
            const float k0 = bfl(kr[0]) * w0[0], k1 = bfh(kr[0]) * w0[1], k2 = bfl(kr[1]) * w0[2], k3 = bfh(kr[1]) * w0[3], k4 = bfl(kr[2]) * w1[0], k5 = bfh(kr[2]) * w1[1], k6 = bfl(kr[3]) * w1[2], k7 = bfh(kr[3]) * w1[3];
            nacc += ((k0 + k1) + (k2 + k3)) + ((k4 + k5) + (k6 + k7));
            u32x4 kw; kw[0] = pk(k0, k1); kw[1] = pk(k2, k3); kw[2] = pk(k4, k5); kw[3] = pk(k6, k7);
            acc = __builtin_amdgcn_mfma_f32_32x32x16_bf16(vf, __builtin_bit_cast(bf16x8, kw), acc, 0, 0, 0);
        }
        float* ms = wMS(p.ws) + ((((long)b * MH + h) * 2 + dir) * SCN + sc) * (MD + 1) * MD;
#pragma unroll
        for (int g = 0; g < 4; ++g) { f32x4 o; o[0] = acc[4 * g]; o[1] = acc[4 * g + 1]; o[2] = acc[4 * g + 2]; o[3] = acc[4 * g + 3];
            *(f32x4*)(ms + (unsigned)((kb * 32 + r) * MD + dvb * 32 + 8 * g + 4 * hh)) = o; }
        const float nt = nacc + xl32(nacc, lane);
        if (dvb == 0 && hh == 0) ms[MD * MD + kb * 32 + r] = nt;
        __syncthreads();
    }
}
__device__ __forceinline__ void ml_o_phase(PRef p, int l, LAS unsigned char* lds) {
    const int wave = __builtin_amdgcn_readfirstlane((int)threadIdx.x >> 6);
    const bool last = (l == DEPTH - 1);
    for (int u = blockIdx.x; u < B * MH * SCN; u += NBLOCKS) {
        const int sc = u % SCN, h = (u / SCN) % MH, b = u / (SCN * MH);
        if (last && sc < NCS) continue;
        int tid_ = threadIdx.x; asm volatile("" : "+v"(tid_)); const int tid = tid_, lane = tid & 63, r = lane & 31, hh = lane >> 5;
        const long r0 = (long)b * RPB + (long)sc * SCS;
        const bf16* qg = wMQK(p.ws) + r0 * 2 * MW + h * MD; const bf16* kg = qg + MW; const bf16* pg = wP(p.ws) + r0 * NP + ML_LO + h * MD; const float* fg = wFG(p.ws);
        const float* msb = wMS(p.ws) + (((long)b * MH + h) * 2 * SCN + sc) * (MD + 1) * MD;
#pragma unroll
        for (int i = 0; i < 4; ++i) { const int ci = tid + 512 * i, key = ci >> 3, part = ci & 7;
            *(LAS u32x4*)(lds + O_KL + key * KP + part * 16) = *(const u32x4*)(kg + (unsigned)(key * 2 * MW + part * 8));
            stage_t(lds + O_VT, *(const u32x4*)(pg + (unsigned)(key * NP + MW + part * 8)), part * 8, key); }
#pragma unroll
        for (int i = 0; i < 4; ++i) { const int ci = tid + 512 * i, dir = ci >> 10, kdim = (ci >> 4) & 63, d4 = ci & 15;
            const f32x4 c = *(const f32x4*)(msb + (unsigned)(dir * SCN * (MD + 1) * MD + kdim * MD + d4 * 4));
#pragma unroll
            for (int e = 0; e < 4; ++e) *(LAS unsigned short*)(lds + O_CT + (dir * 64 + d4 * 4 + e) * KP + kdim * 2) = (unsigned short)f2bf(c[e]); }
        if (tid < 128) { const int dir = tid >> 6, kdim = tid & 63; *(LAS float*)(lds + O_NL + tid * 4) = msb[(unsigned)(dir * SCN * (MD + 1) * MD + MD * MD + kdim)]; }
        { const int dir = tid >> 8, key = tid & 255; const float F = fg[(((r0 + key) * 2 + dir) * MH + h) * 2], G = fg[(((r0 + key) * 2 + dir) * MH + h) * 2 + 1];
          *(LAS float*)(lds + O_FG + ((dir * 2 + 0) * 256 + key) * 4) = F * LOG2E; *(LAS float*)(lds + O_FG + ((dir * 2 + 1) * 256 + key) * 4) = G * LOG2E; }
        bf16x8 qf[4];
#pragma unroll
        for (int ks = 0; ks < 4; ++ks) qf[ks] = *(const bf16x8*)(qg + (unsigned)((wave * 32 + r) * 2 * MW + ks * 16 + hh * 8));
        __syncthreads();
        f32x16 hs[2];
#pragma unroll
        for (int dvb = 0; dvb < 2; ++dvb)
#pragma unroll
            for (int i = 0; i < 16; ++i) hs[dvb][i] = 0.f;
#pragma unroll 1
        for (int dir = 0; dir < 2; ++dir) {
            const float Ft = *(const LAS float*)(lds + O_FG + ((dir * 2 + 0) * 256 + wave * 32 + r) * 4);
            f32x16 O[2];
#pragma unroll
            for (int dvb = 0; dvb < 2; ++dvb)
#pragma unroll
                for (int i = 0; i < 16; ++i) O[dvb][i] = 0.f;
            float den = 0.f;
            const int kt0 = dir == 0 ? 0 : wave, kt1 = dir == 0 ? wave : 7;
            for (int kt = kt0; kt <= kt1; ++kt) {
                f32x16 S;
#pragma unroll
                for (int i = 0; i < 16; ++i) S[i] = 0.f;
#pragma unroll
                for (int ks = 0; ks < 4; ++ks) {
                    const bf16x8 kf = *(const LAS bf16x8*)(lds + O_KL + (kt * 32 + r) * KP + ks * 32 + hh * 16);
                    S = __builtin_amdgcn_mfma_f32_32x32x16_bf16(kf, qf[ks], S, 0, 0, 0); }
                const bool diag = (kt == wave);
#pragma unroll
                for (int g = 0; g < 4; ++g) { const f32x4 gv = *(const LAS f32x4*)(lds + O_FG + ((dir * 2 + 1) * 256 + kt * 32 + 8 * g + 4 * hh) * 4);
#pragma unroll
                    for (int e = 0; e < 4; ++e) { const int krow = 8 * g + 4 * hh + e; const bool keep = !diag || (dir == 0 ? krow <= r : krow >= r);
                        const float wgt = __builtin_amdgcn_exp2f(keep ? Ft - gv[e] : -1.0e30f); const float sw = S[4 * g + e] * wgt; S[4 * g + e] = sw; den += sw; } }
                bf16x8 pf[2];
#pragma unroll
                for (int s2 = 0; s2 < 2; ++s2) { u32x4 w;
#pragma unroll
                    for (int e = 0; e < 4; ++e) w[e] = pk(S[8 * s2 + 2 * e], S[8 * s2 + 2 * e + 1]);
                    pf[s2] = __builtin_bit_cast(bf16x8, w); }
#pragma unroll
                for (int dvb = 0; dvb < 2; ++dvb)
#pragma unroll
                    for (int s2 = 0; s2 < 2; ++s2) {
                        const bf16x8 vf = *(const LAS bf16x8*)(lds + O_VT + (dvb * 32 + r) * TP + (kt * 32 + s2 * 16) * 2 + hh * 16);
                        O[dvb] = __builtin_amdgcn_mfma_f32_32x32x16_bf16(vf, pf[s2], O[dvb], 0, 0, 0); }
            }
            f32x16 I[2];
#pragma unroll
            for (int dvb = 0; dvb < 2; ++dvb)
#pragma unroll
                for (int i = 0; i < 16; ++i) I[dvb][i] = 0.f;
            float dint = 0.f;
#pragma unroll
            for (int ks = 0; ks < 4; ++ks) {
#pragma unroll
                for (int dvb = 0; dvb < 2; ++dvb) { const bf16x8 cf = *(const LAS bf16x8*)(lds + O_CT + (dir * 64 + dvb * 32 + r) * KP + ks * 32 + hh * 16);
                    I[dvb] = __builtin_amdgcn_mfma_f32_32x32x16_bf16(cf, qf[ks], I[dvb], 0, 0, 0); }
                const u32x4 qr = __builtin_bit_cast(u32x4, qf[ks]);
                const f32x4 n0 = *(const LAS f32x4*)(lds + O_NL + (dir * 64 + ks * 16 + hh * 8) * 4), n1 = *(const LAS f32x4*)(lds + O_NL + (dir * 64 + ks * 16 + hh * 8 + 4) * 4);
                dint += (bfl(qr[0]) * n0[0] + bfh(qr[0]) * n0[1]) + (bfl(qr[1]) * n0[2] + bfh(qr[1]) * n0[3]) + (bfl(qr[2]) * n1[0] + bfh(qr[2]) * n1[1]) + (bfl(qr[3]) * n1[2] + bfh(qr[3]) * n1[3]);
            }
            const float a = __builtin_amdgcn_exp2f(Ft);
            const float dtot = (den + xl32(den, lane)) + a * (dint + xl32(dint, lane));
            const float scl = 1.0f / fmaxf(fabsf(dtot), 1.0f);
#pragma unroll
            for (int dvb = 0; dvb < 2; ++dvb)
#pragma unroll
                for (int i = 0; i < 16; ++i) hs[dvb][i] += (O[dvb][i] + a * I[dvb][i]) * scl;
        }
        const bf16* og = pg + (unsigned)((wave * 32 + r) * NP + 2 * MW + 4 * hh);
        float ss = 0.f;
#pragma unroll
        for (int dvb = 0; dvb < 2; ++dvb)
#pragma unroll
            for (int g = 0; g < 4; ++g) { const u32x2 ov = *(const u32x2*)(og + dvb * 32 + 8 * g);
                const float o0 = bfl(ov[0]), o1 = bfh(ov[0]), o2 = bfl(ov[1]), o3 = bfh(ov[1]);
                float v0 = hs[dvb][4 * g] * rcp_f(1.0f + exp_f(-o0)), v1 = hs[dvb][4 * g + 1] * rcp_f(1.0f + exp_f(-o1)), v2 = hs[dvb][4 * g + 2] * rcp_f(1.0f + exp_f(-o2)), v3 = hs[dvb][4 * g + 3] * rcp_f(1.0f + exp_f(-o3));
                hs[dvb][4 * g] = v0; hs[dvb][4 * g + 1] = v1; hs[dvb][4 * g + 2] = v2; hs[dvb][4 * g + 3] = v3; ss += (v0 * v0 + v1 * v1) + (v2 * v2 + v3 * v3); }
        ss += xl32(ss, lane);
        const float rstd = 1.0f / sqrtf(ss / (float)MD + EPS);
        const float* ng = p.ml_norm_g + l * MW + h * MD + 4 * hh; bf16* op = wH(p.ws) + (r0 + wave * 32 + r) * D + AW + h * MD + 4 * hh;
#pragma unroll
        for (int dvb = 0; dvb < 2; ++dvb)
#pragma unroll
            for (int g = 0; g < 4; ++g) { const f32x4 gg = *(const f32x4*)(ng + dvb * 32 + 8 * g); u32x2 w;
                w[0] = pk(hs[dvb][4 * g] * rstd * gg[0], hs[dvb][4 * g + 1] * rstd * gg[1]); w[1] = pk(hs[dvb][4 * g + 2] * rstd * gg[2], hs[dvb][4 * g + 3] * rstd * gg[3]);
                *(u32x2*)(op + dvb * 32 + 8 * g) = w; }
        __syncthreads();
    }
}
}
#endif
#ifndef HOST_EMU
#define XB_TMO      128
#define XB_XCNT(j)  (256  + 64 * (j))
#define XB_XSUB(j)  (1280 + 64 * (j))
#define XB_XGEN(j)  (2304 + 64 * (j))
#define XB_TOP      3328
#define XB_TOPGEN   3392
#define XCD_BAR_WORDS 3456
#define XB_SPIN_CAP (1u << 18)

__device__ __forceinline__ unsigned xb_ld(unsigned* p)              { return __hip_atomic_load(p, __ATOMIC_RELAXED, __HIP_MEMORY_SCOPE_AGENT); }
__device__ __forceinline__ unsigned xb_add(unsigned* p, unsigned v) { return __hip_atomic_fetch_add(p, v, __ATOMIC_RELAXED, __HIP_MEMORY_SCOPE_AGENT); }
__device__ __forceinline__ unsigned xb_xcc_id() { return (unsigned)__builtin_amdgcn_s_getreg((3 << 11) | 20) & 0xFu; }
#define XB_SPIN(cond, bar) do { unsigned _sp = 0; while (cond) { __builtin_amdgcn_s_sleep(1); \
    if ((++_sp & 255u) == 0u) { if (xb_ld(&(bar)[XB_TMO])) break; if (_sp > XB_SPIN_CAP) { atomicAdd(&(bar)[XB_TMO], 1u); break; } } } } while (0)

struct XcdBarrier { unsigned* bar; unsigned x; volatile LAS unsigned* st; };

__device__ __forceinline__ XcdBarrier xcd_barrier_post(unsigned* bar, volatile LAS unsigned* st) {
    XcdBarrier b; b.bar = bar; b.x = xb_xcc_id(); b.st = st;
    if (threadIdx.x == 0) (void)xb_add(&bar[XB_XCNT(b.x)], 1u);
    return b;
}
__device__ __forceinline__ void xcd_barrier_complete(unsigned* bar, unsigned x, unsigned& nloc, unsigned& nx) {
    const unsigned G = gridDim.x * gridDim.y * gridDim.z;
    unsigned sum, cnt, mine, sp = 0u;
    for (;;) {
        sum = 0u; cnt = 0u; mine = 0u;
#pragma unroll
        for (unsigned j = 0; j < 16; ++j) { const unsigned c = xb_ld(&bar[XB_XCNT(j)]); sum += c; cnt += (c > 0u) ? 1u : 0u; mine = (j == x) ? c : mine; }
        if (sum == G) break;
        __builtin_amdgcn_s_sleep(1);
        if ((++sp & 255u) == 0u) { if (xb_ld(&bar[XB_TMO])) break; if (sp > XB_SPIN_CAP) { atomicAdd(&bar[XB_TMO], 1u); break; } }
    }
    nloc = mine > 0u ? mine : 1u; nx = cnt > 0u ? cnt : 1u;
}
__device__ __forceinline__ void xcd_barrier(const XcdBarrier& b) {
    asm volatile("s_waitcnt vmcnt(0)" ::: "memory");
    __syncthreads();
    if (threadIdx.x == 0) {
        unsigned* bar = b.bar;
        __builtin_amdgcn_s_waitcnt(0);
        unsigned nloc = b.st[0], nx = b.st[1];
        if (nloc == 0u) { xcd_barrier_complete(bar, b.x, nloc, nx); b.st[0] = nloc; b.st[1] = nx; }
        const unsigned old = xb_add(&bar[XB_XSUB(b.x)], 1u);
        const unsigned gen = old / nloc;
        if (old + 1u == (gen + 1u) * nloc) {
            __builtin_amdgcn_fence(__ATOMIC_RELEASE, "agent");
            asm volatile("s_waitcnt vmcnt(0)" ::: "memory");
            const unsigned og = xb_add(&bar[XB_TOP], 1u);
            const unsigned tg = og / nx;
            if (og + 1u == (tg + 1u) * nx) xb_add(&bar[XB_TOPGEN], 1u);
            else XB_SPIN(xb_ld(&bar[XB_TOPGEN]) == tg, bar);
            __builtin_amdgcn_fence(__ATOMIC_ACQUIRE, "agent");
            xb_add(&bar[XB_XGEN(b.x)], 1u);
            asm volatile("s_waitcnt vmcnt(0)" ::: "memory");
        } else {
            XB_SPIN(xb_ld(&bar[XB_XGEN(b.x)]) == gen, bar);
            __builtin_amdgcn_fence(__ATOMIC_ACQUIRE, "agent");
            asm volatile("s_waitcnt vmcnt(0)" ::: "memory");
        }
    }
    __syncthreads();
}
#endif

constexpr int UPT = (R + 253) / 254;
constexpr int LDS_BYTES = 163840;

#ifdef HOST_EMU
#define ATT_PHASE(l) RUN(PH_ATT, l, 0)
#define NORM1_PHASE(l) RUN(PH_NORM1, l, 0)
#define MOD_PHASE() RUN(PH_MOD, 0, 0)
#define FILT_B_PHASE(l) RUN(PH_FILT_B, l, 0)
#define FILT_C_PHASE(l) RUN(PH_FILT_C, l, 0)
#define ML_B_PHASE(l) RUN(PH_ML_B, l, 0)
#define ML_O_PHASE(l) RUN(PH_ML_O, l, 0)
#define NORM2_PHASE(l) RUN(PH_NORM2, l, 0)
#define FINAL_PHASE() RUN(PH_FINAL, 0, 0)
#define MLA_A_PHASE(l) RUN(PH_MLA_A, l, 0)
#define ML_F_PHASE(l) RUN(PH_ML_F, l, 0)
#define FILT_D_PHASE(l) RUN(PH_FILT_D, l, 0)
#define ML_S_PHASE(l) RUN(PH_ML_S, l, 0)
#define GEMM_GEMM1(l) RUN(PH_GEMM1, l, 0)
#define GEMM_Q(l) RUN(PH_MLA_Q, l, 0)
#define GEMM_KV(l) RUN(PH_MLA_KV, l, 0)
#define GEMM_MLQK(l) RUN(PH_ML_QK, l, 0)
#define GEMM_OUT(l) RUN(PH_GEMM_OUT, l, 0)
#else
#define KARG() const Params __attribute__((address_space(4)))* kp_ = (const Params __attribute__((address_space(4)))*)__builtin_amdgcn_kernarg_segment_ptr(); asm volatile("" : "+s"(kp_)); PRef p = *kp_
#define LAT_ 0
#define GEMM_LAT(l, EPI, A_, lda_, Bt_, ldb_, N_, K_, rot, ...) do { KARG(); const int lat_ = ((l) == DEPTH - 1) && (SEQ % 256 == 0) && (CTX % 256 == 0); pg8::Gemm g_{(const bf16*)(A_), (const bf16*)(Bt_), lda_, ldb_, lat_ ? B * SEQ : R, N_, K_, 256}; \
    pg8::StaticOrder S_; S_.init(lat_ ? B * SEQ : R, N_, NBLOCKS, ((int)blockIdx.x + (rot)) % NBLOCKS, lat_); pg8::EPI E_{__VA_ARGS__}; pg8::gemm_phase<pg8::EPI, pg8::StaticOrder, true, true>((LAS unsigned char*)lds, g_, S_, E_); } while (0)
#define GEMM_CALL(EPI, A_, lda_, Bt_, ldb_, M_, N_, K_, rot, ...) GEMM_CALLX(true, EPI, A_, lda_, Bt_, ldb_, M_, N_, K_, rot, __VA_ARGS__)
#define GEMM_CALLX(SP2_, EPI, A_, lda_, Bt_, ldb_, M_, N_, K_, rot, ...) do { KARG(); pg8::Gemm g_{(const bf16*)(A_), (const bf16*)(Bt_), lda_, ldb_, M_, N_, K_, 256}; pg8::StaticOrder S_; S_.init(M_, N_, NBLOCKS, ((int)blockIdx.x + (rot)) % NBLOCKS, LAT_); \
    pg8::EPI E_{__VA_ARGS__}; pg8::gemm_phase<pg8::EPI, pg8::StaticOrder, true, SP2_>((LAS unsigned char*)lds, g_, S_, E_); } while (0)
#define ATT_PHASE(l) do { KARG(); att::attn_phase(p, l, (LAS unsigned char*)lds); } while (0)
#define NORM1_PHASE(l) do { KARG(); wv::norm_rows<0>(p, l); } while (0)
#define MOD_PHASE() do { KARG(); wv::mod_block(p, (LAS unsigned char*)lds); } while (0)
#define FILT_B_PHASE(l) do { KARG(); wv::filt_b_block(p, l, (LAS unsigned char*)lds); } while (0)
#define FILT_C_PHASE(l) do { KARG(); wv::filt_c_block(p, l, (LAS unsigned char*)lds); } while (0)
#define ML_B_PHASE(l) do { KARG(); mlk::ml_b_phase(p, (LAS unsigned char*)lds); } while (0)
#define ML_O_PHASE(l) do { KARG(); mlk::ml_o_phase(p, l, (LAS unsigned char*)lds); } while (0)
#define NORM2_PHASE(l) do { KARG(); wv::norm_rows<1>(p, l); } while (0)
#define FINAL_PHASE() do { KARG(); wv::norm_rows<2>(p, 0); } while (0)
#define MLA_A_PHASE(l) do { KARG(); wv::mla_a_rows(p); } while (0)
#define ML_F_PHASE(l) do { KARG(); wv::ml_f_rows(p, l); } while (0)
#define FILT_D_PHASE(l) do { KARG(); wv::filt_d_rows(p); } while (0)
#define ML_S_PHASE(l) do { KARG(); wv::ml_s_scan(p); } while (0)
#define GEMM_GEMM1(l) GEMM_CALL(EpiBf16, wH(p.ws), D, wWinT(p.ws, l), D, R, NP, D, 0, wP(p.ws), NP, nullptr, 0)
#define GEMM_Q(l) GEMM_CALL(EpiBf16, wP(p.ws), NP, wWuqT(p.ws, l), QR, R, QW, QR, 0, wQ(p.out), QW, wRS(p.ws), 1)
#define GEMM_KV(l) do { GEMM_CALL(EpiBf16, wP(p.ws) + QR, NP, wWukvT(p.ws, l), KVR, R, AW, KVR, (R / 256 * (QW / 256)) % NBLOCKS, wKN(p.out), AW, wRS(p.ws) + R, 1); \
    GEMM_CALLX(false, EpiVT, wWukvT(p.ws, l) + (size_t)AW * KVR, KVR, wP(p.ws) + QR, NP, AW, R, KVR, (R / 256 * ((QW + AW) / 256)) % NBLOCKS, wVT(p.out), wRS(p.ws) + R); } while (0)
#define GEMM_MLQK(l) GEMM_CALL(EpiBf16, wMU(p.ws), MW, wWML(p.ws), MW, R, 2 * MW, MW, (R / 256 * ((QW + 2 * AW) / 256)) % NBLOCKS, wMQK(p.ws), 2 * MW, nullptr, 0)
#define GEMM_OUT(l) GEMM_LAT(l, EpiResid, wH(p.ws), D, wWoutT(p.ws, l), D, D, D, 0, wX(p.ws), wMOD(p.ws) + (size_t)(l) * (B + 1) * 6 * D + 2 * D, nullptr, DRY_)
#define GEMM_UP(l) do { KARG(); pg8::Gemm g_{(const bf16*)(wH(p.ws) - D), (const bf16*)wWupT(p.ws, l), D, D, UPT * 256, FF2, D, 254}; pg8::StaticOrder S_; S_.init(UPT * 256, FF2, NBLOCKS, (int)blockIdx.x); \
    pg8::EpiConvGate E_{wGF(p.ws), p.ffn_conv_w + (size_t)(l) * 3 * FF2, p.ffn_conv_b + (size_t)(l) * FF2, (LAS unsigned char*)lds + pg8::STAGE_BYTES}; pg8::gemm_phase<pg8::EpiConvGate, pg8::StaticOrder, true, true>((LAS unsigned char*)lds, g_, S_, E_); } while (0)
#define GEMM_DOWN(l) GEMM_LAT(l, EpiResid, wGF(p.ws), FF, wWdownT(p.ws, l), FF, D, FF, 0, wX(p.ws), wMOD(p.ws) + (size_t)(l) * (B + 1) * 6 * D + 5 * D, nullptr, DRY_)
#endif
#ifdef HOST_EMU
#define GRID_BAR() do {} while (0)
#define FILL_W(ln, busy, i0, i1, filt) do { const int i0_ = (i0), i1_ = (i1); emu_block_launch(i1_ - i0_, [&](int blk, unsigned char* smem) { bphase<BPH_WCVT>(p, ln, i0_ + blk, smem); }); if (filt) RUN(PH_FILT_A, ln, 0); } while (0)
#define RUN(PH, l, arg) emu_launch([&](long gtid, long gth) { phase<PH>(p, l, arg, gtid, gth); })
#define BRUN(BPH, l, nblk) emu_block_launch(nblk, [&](int blk, unsigned char* smem) { bphase<BPH>(p, l, blk, smem); })
#define BRUN_OFF(BPH, l, nblk, busy) BRUN(BPH, l, nblk)
static void fwd(const Params& p) {
#else
#define GRID_BAR() xcd_barrier(bar)
#define DRY_ 0
#define BRUN(BPH, l, nblk) do { KARG(); for (int blk_ = blockIdx.x; blk_ < (nblk); blk_ += NBLOCKS) bphase<BPH>(p, l, blk_, (LdsPtr)lds); } while (0)
#define BRUN_OFF(BPH, l, nblk, busy) do { KARG(); const int busy_ = (busy); if ((int)blockIdx.x >= busy_) for (int blk_ = (int)blockIdx.x - busy_; blk_ < (nblk); blk_ += NBLOCKS - busy_) bphase<BPH>(p, l, blk_, (LdsPtr)lds); } while (0)
#define FILL_W(ln, busy, i0, i1, filt) do { KARG(); const int busy_ = (busy), nf_ = NBLOCKS - busy_, i1_ = (i1); __syncthreads(); if ((int)blockIdx.x >= busy_) { for (int blk_ = (i0) + (int)blockIdx.x - busy_; blk_ < i1_; blk_ += nf_) bphase<BPH_WCVT>(p, ln, blk_, (LdsPtr)lds); \
    if (filt) { int t_ = threadIdx.x; asm volatile("" : "+v"(t_)); phase<PH_FILT_A>(p, ln, 0, (long)((int)blockIdx.x - busy_) * NTHREADS + t_, (long)nf_ * NTHREADS); } } } while (0)
#define RUN(PH, l, arg) do { KARG(); int t_ = threadIdx.x; asm volatile("" : "+v"(t_)); const int g_ = blockIdx.x * NTHREADS + t_; phase<PH>(p, l, arg, (long)g_, gth); } while (0)
__global__ void __launch_bounds__(NTHREADS, 2) fwd(Params p_unused) {
    extern __shared__ __attribute__((aligned(16))) unsigned char lds[];
    if (threadIdx.x < 4) ((LAS unsigned*)lds)[(LDS_BYTES - 16) / 4 + threadIdx.x] = 0u;
    __syncthreads();
    XcdBarrier bar; { KARG(); bar = xcd_barrier_post(wctl(p.ws) + 1024, (volatile LAS unsigned*)(lds + LDS_BYTES - 16)); }
    constexpr long gth = (long)NBLOCKS * NTHREADS;
#endif
    MOD_PHASE(); RUN(PH_ROPE, 0, 0);
    GRID_BAR();
    RUN(PH_MOD2, 0, 0);
    for (int hs = 0; hs <= 2 * DEPTH; ++hs) {
        const int l = (hs - 1) >> 1;
        if (hs >= 1 && (hs & 1)) {
            NORM1_PHASE(l); FILT_B_PHASE(l);
            GRID_BAR();
            GEMM_GEMM1(l); FILT_C_PHASE(l);
            GRID_BAR();
            MLA_A_PHASE(l); if (l < DEPTH - 1) RUN(PH_HY_Z, l, 0); BRUN(BPH_HYZ, l, B * (SEQ / 64)); FILT_D_PHASE(l); RUN(PH_ML_U, l, 0); ML_F_PHASE(l);
            GRID_BAR();
            GEMM_Q(l); GEMM_KV(l); GEMM_MLQK(l); BRUN(BPH_HFFT, l, HW); if (l < DEPTH - 1) BRUN(BPH_HYCTX, l, B * (HW / 8));
            GRID_BAR();
            ATT_PHASE(l); ML_B_PHASE(l);
            GRID_BAR();
            ML_S_PHASE(l); BRUN(BPH_HYFFT, l, HW);
            GRID_BAR();
            ML_O_PHASE(l); BRUN_OFF(BPH_HYOUT, l, B * (SEQ / 64), l < DEPTH - 1 ? (B * MH * SCN) % NBLOCKS : 0);
            GRID_BAR();
            GEMM_OUT(l);
        }
        if (hs >= 2 && !(hs & 1)) {
            NORM2_PHASE(l);
            GRID_BAR();
#ifdef HOST_EMU
            for (int fcI = 0; fcI < NFC; ++fcI) { RUN(PH_FFN_UP, l, fcI); RUN(PH_FFN_CG, l, fcI); RUN(PH_FFN_DOWN, l, fcI); }
#else
            GEMM_UP(l);
            GRID_BAR();
            GEMM_DOWN(l);
#endif
        }
        {
            int fl = 0, busy = 0, i0 = 0, i1 = 0, filt = 0;
            if (hs == 0) { i1 = WT_SPLIT; filt = 1; }
            else if (hs == 1) { busy = DOWN_BUSY; i0 = WT_SPLIT; i1 = WT_ITEMS; }
            else if (!(hs & 1) && (hs >> 1) < DEPTH) { fl = hs >> 1; busy = DOWN_BUSY; i1 = WT_ITEMS; filt = 1; }
            else if ((hs & 1) && hs > 1) {   }
            FILL_W(fl, busy, i0, i1, filt);
        }
        GRID_BAR();
    }
    FINAL_PHASE();
}

extern "C" void kernel_launch(void* const* d_in, const int* in_sizes, int n_in, void* d_out, int out_size, void* d_ws, size_t ws_size, hipStream_t stream) {
    (void)in_sizes; (void)n_in; (void)out_size; (void)ws_size;
    Params p{};
    const float* const* in = (const float* const*)d_in;
    p.x = in[0]; p.c = in[1]; p.ctx = in[2]; p.c_ctx = in[3]; p.ada_w = in[4]; p.ada_b = in[5]; p.norm1_g = in[6]; p.norm2_g = in[7]; p.w_in = in[8];
    p.q_norm_g = in[9]; p.kv_norm_g = in[10]; p.w_uq = in[11]; p.w_ukv = in[12]; p.ml_conv_w = in[13]; p.ml_conv_b = in[14]; p.ml_wq = in[15]; p.ml_wk = in[16];
    p.ml_gate_b = in[17]; p.ml_norm_g = in[18]; p.hy_conv_w = in[19]; p.hy_conv_b = in[20]; p.hy_w1 = in[21]; p.hy_b1 = in[22]; p.hy_w2 = in[23]; p.hy_b2 = in[24];
    p.hy_w3 = in[25]; p.hy_freq = in[26]; p.hy_bias_d = in[27]; p.w_out = in[28]; p.w_up = in[29]; p.ffn_conv_w = in[30]; p.ffn_conv_b = in[31]; p.w_down = in[32]; p.final_g = in[33];
    p.out = (float*)d_out;
    p.ws = (char*)d_ws;
#ifdef HOST_EMU
    fwd(p);
#else
    static int grid = 0;
    if (grid == 0) {
        int dev = 0, cus = 0;
        if (hipGetDevice(&dev) != hipSuccess || hipDeviceGetAttribute(&cus, hipDeviceAttributeMultiprocessorCount, dev) != hipSuccess) { grid = -1; return; }
        if (hipFuncSetAttribute((const void*)fwd, hipFuncAttributeMaxDynamicSharedMemorySize, LDS_BYTES) != hipSuccess) { grid = -1; return; }
        int per_cu = 0;
        (void)hipOccupancyMaxActiveBlocksPerMultiprocessor(&per_cu, (const void*)fwd, NTHREADS, LDS_BYTES);
        (void)hipGetLastError();
        grid = (cus >= NBLOCKS) ? NBLOCKS : -1;
    }
    if (grid < 0) return;
    (void)hipMemsetAsync(d_ws, 0, CTL_BYTES, stream);
    hipLaunchKernelGGL(fwd, dim3(grid), dim3(NTHREADS), LDS_BYTES, stream, p);
#endif
}
```

```cpp
#ifndef HOST_EMU
#include <hip/hip_runtime.h>
#endif
#include <stdint.h>
#include <math.h>

#ifndef CFG_D_MODEL
#define CFG_D_MODEL 1024
#define CFG_BATCH 8
#define CFG_SEQ 4096
#define CFG_CTX 256
#define CFG_SCS 256
#define CFG_NFC 4
#endif

#define DEV __device__ __forceinline__

namespace cfg {
constexpr int D = CFG_D_MODEL, B = CFG_BATCH, SEQ = CFG_SEQ, CTX = CFG_CTX, DEPTH = 2, GRID_W = 64;
constexpr int RPB = CTX + SEQ;
constexpr int R = B * RPB;
constexpr float EPS = 1e-6f;
constexpr int AH = D / 128, NOPE = 64, ROPE = 32, AV = 64, QR = 3 * D / 8, KVR = D / 4, AW = AH * AV;
constexpr int QW = AH * (NOPE + ROPE);
constexpr int KVW = AH * (NOPE + AV);
constexpr int MH = 4, MD = D / 16, MW = MH * MD;
constexpr int HW = D / 4, HB = 16, HE = 33, HH = 64;
constexpr int N_MLA = QR + KVR + ROPE, N_ML = 3 * MW + 4 * MH, N_HY = 3 * HW, N_IN = N_MLA + N_ML + N_HY;
constexpr int ML_LO = N_MLA, HY_LO = N_MLA + N_ML;
constexpr int NP = (N_IN + 255) / 256 * 256;
constexpr int FF = ((8 * D / 3 + 255) / 256) * 256, FF2 = 2 * FF;
constexpr int SCS = CFG_SCS;
constexpr int SCN = RPB / SCS, NCS = CTX / SCS;
constexpr int NFC = CFG_NFC;
constexpr int FCR = (B / NFC) * RPB;
static_assert(CTX % SCS == 0 && SEQ % SCS == 0, "super-chunk must divide ctx and seq");
static_assert(B % NFC == 0, "ffn chunks");
static_assert(MD == 64 || MD == 16, "mlstm head dim");
}
using namespace cfg;
constexpr int NTHREADS = 512, NBLOCKS = 256;

typedef unsigned short bf16;
struct alignas(16) U4 { unsigned x, y, z, w; };
struct alignas(8) U2 { unsigned x, y; };

DEV float u2f(unsigned u) { union { unsigned u; float f; } c; c.u = u; return c.f; }
DEV unsigned f2u(float f) { union { unsigned u; float f; } c; c.f = f; return c.u; }
DEV float bf2f(bf16 v) { return u2f(((unsigned)v) << 16); }
DEV bf16 f2bf(float f) { unsigned u = f2u(f); u += 0x7FFFu + ((u >> 16) & 1u); return (bf16)(u >> 16); }
DEV float bflo(unsigned w) { return u2f(w << 16); }
DEV float bfhi(unsigned w) { return u2f(w & 0xFFFF0000u); }
#ifdef HOST_EMU
DEV float sin_f(float x) { return sinf(x); }
DEV float cos_t(float turns) { return cosf(6.283185307179586f * turns); }
DEV float sin_t(float turns) { return sinf(6.283185307179586f * turns); }
#else
DEV float sin_f(float x) { return __builtin_amdgcn_sinf(__builtin_amdgcn_fractf(x * 0.15915494309189535f)); }
DEV float cos_t(float turns) { return __builtin_amdgcn_cosf(turns); }
DEV float sin_t(float turns) { return __builtin_amdgcn_sinf(turns); }
#endif
#ifdef HOST_EMU
DEV float exp_f(float x) { return expf(x); }
DEV float log1p_f(float y) { return log1pf(y); }
#else
DEV float exp_f(float x) { return __builtin_amdgcn_exp2f(x * 1.4426950408889634f); }
DEV float log1p_f(float y) { return __builtin_amdgcn_logf(1.0f + y) * 0.6931471805599453f; }
#endif
#ifdef HOST_EMU
DEV float rcp_f(float x) { return 1.0f / x; }
#else
DEV float rcp_f(float x) { return __builtin_amdgcn_rcpf(x); }
#endif
DEV float silu_f(float x) { return x * rcp_f(1.0f + exp_f(-x)); }
DEV float sigmoid_f(float x) { return rcp_f(1.0f + exp_f(-x)); }
DEV float logsigmoid_f(float x) { return x >= 0.f ? -log1p_f(exp_f(-x)) : x - log1p_f(exp_f(x)); }
DEV float dot8(const U4& a, const U4& b) {
    return bflo(a.x) * bflo(b.x) + bfhi(a.x) * bfhi(b.x) + bflo(a.y) * bflo(b.y) + bfhi(a.y) * bfhi(b.y) +
           bflo(a.z) * bflo(b.z) + bfhi(a.z) * bfhi(b.z) + bflo(a.w) * bflo(b.w) + bfhi(a.w) * bfhi(b.w);
}

constexpr size_t CTL_BYTES = 65536;
constexpr size_t al256(size_t x) { return (x + 255) & ~(size_t)255; }
constexpr size_t OFF_ctl = 0, SZ_ctl = al256(CTL_BYTES);
constexpr size_t OFF_X = OFF_ctl + SZ_ctl, SZ_X = al256((size_t)R * D * 2);
constexpr size_t OFF_H = OFF_X + SZ_X, SZ_H = al256((size_t)R * D * 2);
constexpr size_t OFF_MOD = OFF_H + SZ_H, SZ_MOD = al256((size_t)DEPTH * (B + 1) * 6 * D * 4);
constexpr size_t OFF_MODP = OFF_MOD + SZ_MOD, SZ_MODP = al256((size_t)8 * DEPTH * (B + 1) * 6 * D * 4);
constexpr size_t OFF_ROPET = OFF_MODP + SZ_MODP, SZ_ROPET = al256((size_t)SEQ * 16 * 2 * 4);
constexpr size_t OFF_WinT = OFF_ROPET + SZ_ROPET, SZ_WinT = al256((size_t)NP * D * 2);
constexpr size_t OFF_WuqT = OFF_WinT + SZ_WinT, SZ_WuqT = al256((size_t)QW * QR * 2);
constexpr size_t OFF_WukvT = OFF_WuqT + SZ_WuqT, SZ_WukvT = al256((size_t)KVW * KVR * 2);
constexpr size_t OFF_WoutT = OFF_WukvT + SZ_WukvT, SZ_WoutT = al256((size_t)D * D * 2);
constexpr size_t OFF_WupT = OFF_WoutT + SZ_WoutT, SZ_WupT = al256((size_t)FF2 * D * 2);
constexpr size_t OFF_WdownT = OFF_WupT + SZ_WupT, SZ_WdownT = al256((size_t)D * FF * 2);
constexpr size_t OFF_HD1 = OFF_WdownT + SZ_WdownT, SZ_HD1 = al256((size_t)2 * SEQ * HH * 4);
constexpr size_t OFF_HD2 = OFF_HD1 + SZ_HD1, SZ_HD2 = al256((size_t)2 * SEQ * HH * 4);
constexpr size_t OFF_FT = OFF_HD2 + SZ_HD2, SZ_FT = al256((size_t)2 * HW * SEQ * 4);
constexpr size_t OFF_FT1 = OFF_FT + SZ_FT, SZ_FT1 = al256((size_t)CTX * 2 * HW * 4);
constexpr size_t OFF_FL1 = OFF_FT1 + SZ_FT1, SZ_FL1 = al256((size_t)2 * HW * 64 * 4);
constexpr size_t OFF_HSPEC = OFF_FL1 + SZ_FL1, SZ_HSPEC = al256((size_t)HW * 2 * SEQ * 8);
constexpr size_t OFF_P = OFF_HSPEC + SZ_HSPEC, SZ_P = al256((size_t)R * NP * 2);
constexpr size_t OFF_KR = OFF_P + SZ_P, SZ_KR = al256((size_t)R * ROPE * 2);
constexpr size_t OFF_RS = OFF_KR + SZ_KR, SZ_RS = al256((size_t)R * 2 * 4);
constexpr size_t OFF_MQK = OFF_RS + SZ_RS, SZ_MQK = al256((size_t)R * 2 * MW * 2);
constexpr size_t OFF_WML = OFF_MQK + SZ_MQK, SZ_WML = al256((size_t)2 * MW * MW * 2);
constexpr size_t OFF_FG = OFF_WML + SZ_WML, SZ_FG = al256((size_t)R * 2 * MH * 2 * 4);
constexpr size_t OFF_MS = OFF_FG + SZ_FG, SZ_MS = al256((size_t)B * MH * 2 * SCN * (MD + 1) * MD * 4);
constexpr size_t OFF_Z = OFF_MS + SZ_MS, SZ_Z = al256((size_t)B * CTX * HW * 4);
constexpr size_t OFF_ZT = OFF_Z + SZ_Z, SZ_ZT = al256((size_t)B * HW * SEQ * 2);
#ifdef HOST_EMU
constexpr size_t OFF_UF = OFF_P, SZ_UF = al256((size_t)FCR * FF2 * 2), OFF_GF = OFF_UF + SZ_UF, SZ_GF = al256((size_t)FCR * FF * 2);
#else
constexpr size_t OFF_UF = OFF_P, SZ_UF = 0, OFF_GF = OFF_P, SZ_GF = al256((size_t)R * FF * 2);
#endif
constexpr size_t WS_BASE = (OFF_ZT + SZ_ZT) > (OFF_GF + SZ_GF) ? (OFF_ZT + SZ_ZT) : (OFF_GF + SZ_GF);
constexpr size_t OFF_WSET1 = WS_BASE, SZ_WSET = OFF_HD1 - OFF_WinT, WSET_STRIDE = OFF_WSET1 - OFF_WinT;
constexpr size_t WS_NEED = OFF_WSET1 + SZ_WSET;
static_assert(WS_NEED <= (size_t)536870912 || D != 1024, "workspace");
constexpr size_t OFF_Q = 0, OFF_KN = al256((size_t)R * QW * 2), OFF_VT = OFF_KN + al256((size_t)R * AW * 2);
static_assert(OFF_VT + (size_t)R * AW * 2 <= (size_t)B * SEQ * D * 4 || D != 1024, "d_out scratch");
struct Params {
    const float *x, *c, *ctx, *c_ctx, *ada_w, *ada_b, *norm1_g, *norm2_g, *w_in, *q_norm_g, *kv_norm_g, *w_uq, *w_ukv;
    const float *ml_conv_w, *ml_conv_b, *ml_wq, *ml_wk, *ml_gate_b, *ml_norm_g;
    const float *hy_conv_w, *hy_conv_b, *hy_w1, *hy_b1, *hy_w2, *hy_b2, *hy_w3, *hy_freq, *hy_bias_d;
    const float *w_out, *w_up, *ffn_conv_w, *ffn_conv_b, *w_down, *final_g;
    float* out;
    char* ws;
};

DEV unsigned* wctl(char* ws) { return (unsigned*)(ws + OFF_ctl); }
DEV bf16* wX(char* ws) { return (bf16*)(ws + OFF_X); }
DEV bf16* wH(char* ws) { return (bf16*)(ws + OFF_H); }
DEV float* wMOD(char* ws) { return (float*)(ws + OFF_MOD); }
DEV float* wROPET(char* ws) { return (float*)(ws + OFF_ROPET); }
DEV bf16* wWinT(char* ws, int l) { return (bf16*)(ws + OFF_WinT + (size_t)(l & 1) * WSET_STRIDE); }
DEV bf16* wWuqT(char* ws, int l) { return (bf16*)(ws + OFF_WuqT + (size_t)(l & 1) * WSET_STRIDE); }
DEV bf16* wWukvT(char* ws, int l) { return (bf16*)(ws + OFF_WukvT + (size_t)(l & 1) * WSET_STRIDE); }
DEV bf16* wWoutT(char* ws, int l) { return (bf16*)(ws + OFF_WoutT + (size_t)(l & 1) * WSET_STRIDE); }
DEV bf16* wWupT(char* ws, int l) { return (bf16*)(ws + OFF_WupT + (size_t)(l & 1) * WSET_STRIDE); }
DEV bf16* wWdownT(char* ws, int l) { return (bf16*)(ws + OFF_WdownT + (size_t)(l & 1) * WSET_STRIDE); }
DEV float* wHD1(char* ws) { return (float*)(ws + OFF_HD1); }
DEV float* wHD2(char* ws) { return (float*)(ws + OFF_HD2); }
DEV float* wFT(char* ws) { return (float*)(ws + OFF_FT); }
DEV float* wFL1(char* ws) { return (float*)(ws + OFF_FL1); }
DEV float* wMODP(char* ws) { return (float*)(ws + OFF_MODP); }
DEV float* wFT1(char* ws) { return (float*)(ws + OFF_FT1); }
DEV bf16* wZT(char* ws) { return (bf16*)(ws + OFF_ZT); }
struct alignas(8) C2 { float x, y; };
DEV C2* wHSPEC(char* ws) { return (C2*)(ws + OFF_HSPEC); }
DEV bf16* wP(char* ws) { return (bf16*)(ws + OFF_P); }
DEV bf16* wKR(char* ws) { return (bf16*)(ws + OFF_KR); }
DEV float* wRS(char* ws) { return (float*)(ws + OFF_RS); }
DEV bf16* wMQK(char* ws) { return (bf16*)(ws + OFF_MQK); }
DEV bf16* wWML(char* ws) { return (bf16*)(ws + OFF_WML); }
DEV bf16* wMU(char* ws) { return (bf16*)(ws + OFF_MS); }
static_assert((size_t)R * MW * 2 <= SZ_MS, "MU aliases MS");
DEV float* wFG(char* ws) { return (float*)(ws + OFF_FG); }
DEV float* wMS(char* ws) { return (float*)(ws + OFF_MS); }
DEV float* wZ(char* ws) { return (float*)(ws + OFF_Z); }
DEV bf16* wUF(char* ws) { return (bf16*)(ws + OFF_UF); }
DEV bf16* wGF(char* ws) { return (bf16*)(ws + OFF_GF); }
DEV bf16* wQ(float* out) { return (bf16*)((char*)out + OFF_Q); }
DEV bf16* wKN(float* out) { return (bf16*)((char*)out + OFF_KN); }
DEV bf16* wVT(float* out) { return (bf16*)((char*)out + OFF_VT); }

#ifdef HOST_EMU
typedef const Params& PRef;
#else
typedef const Params __attribute__((address_space(4)))& PRef;
#endif

struct RowI { int b, o, t, bi; bool ctx; };
DEV RowI rowinfo(int r) { RowI i; i.b = r / RPB; i.o = r % RPB; i.ctx = i.o < CTX; i.t = i.ctx ? i.o : i.o - CTX; i.bi = i.ctx ? B : i.b; return i; }
DEV int swap23(int o) { return (o & 3) | ((o & 4) << 1) | ((o & 8) >> 1); }
DEV int vperm32(int o) { return (o & 3) | (((o >> 4) & 1) << 2) | (((o >> 2) & 3) << 3); }
DEV bool has_prev(const RowI& i) { return i.t > 0; }
DEV bool has_next(const RowI& i) { return i.t + 1 < (i.ctx ? CTX : SEQ); }

enum { PH_MOD, PH_MOD2, PH_ROPE, PH_FILT_A, PH_FILT_B, PH_FILT_C, PH_FILT_D, PH_NORM1, PH_GEMM1, PH_MLA_A, PH_MLA_Q, PH_MLA_KV, PH_ATT,
       PH_ML_U, PH_ML_QK, PH_ML_F, PH_ML_B, PH_ML_S, PH_ML_O, PH_HY_Z, PH_HY_O, PH_GEMM_OUT, PH_NORM2, PH_FFN_UP, PH_FFN_CG, PH_FFN_DOWN, PH_FINAL };

DEV float dot_bf16(const bf16* a, const bf16* b, int K) {
    float acc = 0.f;
    for (int k = 0; k < K; k += 8) { const U4 av = *(const U4*)(a + k), bv = *(const U4*)(b + k); acc += dot8(av, bv); }
    return acc;
}


#ifndef HOST_EMU
namespace pg8 {
#define PG8_LAS __attribute__((address_space(3)))
typedef unsigned short bf16_t;
typedef short bf16x8 __attribute__((ext_vector_type(8)));
typedef float f32x4 __attribute__((ext_vector_type(4)));
typedef unsigned u32x4 __attribute__((ext_vector_type(4)));
constexpr int BM = 256, BK = 64, HALF = 128, HTB = HALF * BK * 2  , STAGE_BYTES = 8 * HTB, NXCD = 8, WGM = 8;

__host__ __device__ __forceinline__ int lds_byte(int r, int c) { const int st = (r >> 4) * 2 + (c >> 5), rr = r & 15, cc = c & 31, ob = rr * 64 + cc * 2; return st * 1024 + (ob ^ (((ob >> 9) & 1) << 5)); }
__host__ __device__ __forceinline__ void stage_rc(int b, int& R, int& C) { const int st = b / 1024, sb = b % 1024, swz = sb ^ (((sb >> 9) & 1) << 5); R = (st >> 1) * 16 + swz / 64; C = (st & 1) * 32 + (swz % 64) / 2; }
__host__ __device__ __forceinline__ int perm32(int rho) { const int n = rho >> 4, i = rho & 15; return 8 * (i >> 2) + 4 * n + (i & 3); }

struct Unit { int pm, pn; };
struct Gemm { const bf16_t* A; const bf16_t* Bt; int lda, ldb, M, N, K, mstep; };

struct StaticOrder {
    int nM, nN, nwg, G, c, lat;
    __host__ __device__ void init(int M, int N, int G_, int c_, int lat_ = 0) { nM = M / BM; nN = N / BM; nwg = nM * nN; G = G_; c = c_; lat = lat_; }
    __host__ __device__ bool next(int i, Unit& u) const {
        const long L = (long)i * G + c; if (L >= nwg) return false;
        int wgid = (int)L; { const int q = nwg / NXCD, r = nwg % NXCD, xcd = wgid % NXCD, off = wgid / NXCD; wgid = (xcd < r ? xcd * (q + 1) : r * (q + 1) + (xcd - r) * q) + off; }
        const int nig = WGM * nN, gid = wgid / nig, fm = gid * WGM, gsz = (nM - fm) < WGM ? (nM - fm) : WGM;
        u.pm = fm + ((wgid % nig) % gsz); u.pn = (wgid % nig) / gsz;
        if (lat) u.pm = u.pm + (u.pm / (SEQ / BM) + 1) * (CTX / BM);
        return true;
    }
    __device__ __forceinline__ void a_ready(const Unit&) const {}
    __device__ __forceinline__ void done(const Unit&) const {}
};
__device__ __forceinline__ unsigned cvt_pk_bf16(float lo, float hi) { unsigned r; asm volatile("v_cvt_pk_bf16_f32 %0, %1, %2" : "=v"(r) : "v"(lo), "v"(hi)); return r; }

template <class Epi, class Sched, bool ALIGN_EPI = false, bool SP2 = false>
__device__ __forceinline__ void gemm_phase(PG8_LAS unsigned char* lds, const Gemm g, const Sched& S, const Epi& E) {
    int tid_ = threadIdx.x; asm volatile("" : "+v"(tid_));
    const int tid = tid_, wid = __builtin_amdgcn_readfirstlane(tid >> 6), lane = tid & 63, wr = wid >> 2, wc = wid & 3, fr = lane & 15, fq = lane >> 4;
    const int K = g.K, nt = K / BK;
    unsigned vvoffA, vvoffB;
    { int R_, C_; stage_rc(tid * 16, R_, C_); const int Rb = Epi::PERM ? ((R_ & ~31) + perm32(R_ & 31)) : R_;
      vvoffA = (unsigned)(R_ * g.lda + C_) * 2u; vvoffB = (unsigned)(Rb * g.ldb + C_) * 2u; }
    const size_t pvoffA = (size_t)64 * g.lda * 2, pvoffB = (size_t)64 * g.ldb * 2;
    const size_t kstep = (size_t)(BK * 2);
    const size_t hstepA = (size_t)HALF * g.lda * 2, hstepB = (size_t)HALF * g.ldb * 2;
    const size_t tstepA = (size_t)g.mstep * g.lda * 2, tstepB = 2 * hstepB;
    const unsigned ldsw = (unsigned)wid * 1024u;
    const int aoff = lds_byte(wr * 64 + fr, fq * 8), boff = lds_byte(wc * 32 + fr, fq * 8);
#define PG8_SA(b, h) (((b) * 2 + (h)) * HTB)
#define PG8_SB(b, h) ((4 + (b) * 2 + (h)) * HTB)
#define PG8_STAGE(bufoff, gbase, voff) do { _Pragma("unroll") for (int _i = 0; _i < 2; ++_i) \
        __builtin_amdgcn_global_load_lds((const unsigned*)((const char*)(gbase) + (size_t)_i * p##voff + (v##voff)), (PG8_LAS unsigned*)(lds + (bufoff) + ldsw + _i * 8192), 16, 0, 0); } while (0)
#define PG8_LDA(dst, b, h) do { _Pragma("unroll") for (int m = 0; m < 4; ++m) _Pragma("unroll") for (int k = 0; k < 2; ++k) dst[m][k] = *(const PG8_LAS bf16x8*)(lds + PG8_SA(b, h) + aoff + m * 2048 + k * 1024); } while (0)
#define PG8_LDB(dst, b, h) do { _Pragma("unroll") for (int n = 0; n < 2; ++n) _Pragma("unroll") for (int k = 0; k < 2; ++k) dst[n][k] = *(const PG8_LAS bf16x8*)(lds + PG8_SB(b, h) + boff + n * 2048 + k * 1024); } while (0)
#define PG8_MMA(ai, bj, At, Bt) do { __builtin_amdgcn_s_setprio(1); _Pragma("unroll") for (int m = 0; m < 4; ++m) _Pragma("unroll") for (int n = 0; n < 2; ++n) _Pragma("unroll") for (int k = 0; k < 2; ++k) \
        acc[ai][bj][m][n] = __builtin_amdgcn_mfma_f32_16x16x32_bf16(Bt[n][k], At[m][k], acc[ai][bj][m][n], 0, 0, 0); __builtin_amdgcn_s_setprio(0); } while (0)
#define PG8_WAIT_V(n) asm volatile("s_waitcnt vmcnt(" #n ")" ::: "memory")
#define PG8_WAIT_L(n) asm volatile("s_waitcnt lgkmcnt(" #n ")" ::: "memory")
#define PG8_BAR __builtin_amdgcn_s_barrier()
#define PG8_SCHED __builtin_amdgcn_sched_barrier(0)
    Unit cur, nxt; int ui = 0;
    if (!S.next(0, cur)) return;
    f32x4 acc[2][2][4][2];
#pragma unroll
    for (int a = 0; a < 2; ++a)
#pragma unroll
        for (int b = 0; b < 2; ++b)
#pragma unroll
            for (int m = 0; m < 4; ++m)
#pragma unroll
                for (int n = 0; n < 2; ++n) acc[a][b][m][n] = (f32x4){0.f, 0.f, 0.f, 0.f};
    bf16x8 At[4][2], B0[2][2], B1[2][2];
    const char* cA = (const char*)g.A + (size_t)cur.pm * tstepA; const char* cB = (const char*)g.Bt + (size_t)cur.pn * tstepB;
    S.a_ready(cur);
    if constexpr (SP2) {
        PG8_STAGE(PG8_SB(0, 0), cB, voffB); PG8_STAGE(PG8_SB(0, 1), cB + hstepB, voffB); PG8_STAGE(PG8_SA(0, 0), cA, voffA); PG8_STAGE(PG8_SA(0, 1), cA + hstepA, voffA);
        if (wr == 1) PG8_BAR;
        PG8_WAIT_V(2); PG8_BAR;
        PG8_STAGE(PG8_SB(1, 0), cB + kstep, voffB); PG8_STAGE(PG8_SA(1, 0), cA + kstep, voffA); PG8_STAGE(PG8_SB(1, 1), cB + hstepB + kstep, voffB);
        PG8_WAIT_V(6); PG8_BAR;
    } else {
        PG8_STAGE(PG8_SB(0, 0), cB, voffB); PG8_STAGE(PG8_SA(0, 0), cA, voffA); PG8_STAGE(PG8_SB(0, 1), cB + hstepB, voffB); PG8_STAGE(PG8_SA(0, 1), cA + hstepA, voffA);
        if (wr == 1) PG8_BAR;
        PG8_WAIT_V(4); PG8_BAR;
        PG8_STAGE(PG8_SB(1, 0), cB + kstep, voffB); PG8_STAGE(PG8_SA(1, 0), cA + kstep, voffA); PG8_STAGE(PG8_SB(1, 1), cB + hstepB + kstep, voffB);
        PG8_WAIT_V(6); PG8_BAR;
    }
    for (;;) {
        const bool has_next = S.next(ui + 1, nxt);
        const char* nA = has_next ? (const char*)g.A + (size_t)nxt.pm * tstepA : cA; const char* nB = has_next ? (const char*)g.Bt + (size_t)nxt.pn * tstepB : cB;
        for (int t = 0; t < nt; t += 2) {
            const bool last = (t == nt - 2);
            const char* a1 = cA + (size_t)(t + 1) * kstep;
            const char* a2 = last ? nA : cA + (size_t)(t + 2) * kstep; const char* b2 = last ? nB : cB + (size_t)(t + 2) * kstep;
            const char* a3 = a2 + kstep; const char* b3 = b2 + kstep;
            if (last && has_next) S.a_ready(nxt);
            if constexpr (SP2) {
            PG8_LDB(B0, 0, 0); PG8_LDB(B1, 0, 1); PG8_SCHED; PG8_LDA(At, 0, 0); PG8_STAGE(PG8_SA(1, 1), a1 + hstepA, voffA);
            PG8_WAIT_V(8); PG8_WAIT_L(0); PG8_BAR; PG8_MMA(0, 0, At, B0); PG8_MMA(0, 1, At, B1); PG8_BAR; PG8_SCHED;
            PG8_LDA(At, 0, 1); PG8_STAGE(PG8_SB(0, 0), b2, voffB); PG8_STAGE(PG8_SB(0, 1), b2 + hstepB, voffB); PG8_STAGE(PG8_SA(0, 0), a2, voffA);
            PG8_WAIT_V(8); PG8_WAIT_L(0); PG8_BAR; PG8_MMA(1, 0, At, B0); PG8_MMA(1, 1, At, B1); PG8_BAR; PG8_SCHED;
            PG8_LDB(B0, 1, 0); PG8_LDB(B1, 1, 1); PG8_SCHED; PG8_LDA(At, 1, 0); PG8_STAGE(PG8_SA(0, 1), a2 + hstepA, voffA);
            PG8_WAIT_V(8); PG8_WAIT_L(0); PG8_BAR; PG8_MMA(0, 0, At, B0); PG8_MMA(0, 1, At, B1); PG8_BAR; PG8_SCHED;
            PG8_LDA(At, 1, 1); PG8_STAGE(PG8_SB(1, 0), b3, voffB); PG8_STAGE(PG8_SB(1, 1), b3 + hstepB, voffB); PG8_STAGE(PG8_SA(1, 0), a3, voffA);
            PG8_WAIT_V(8); PG8_WAIT_L(0); PG8_BAR; PG8_MMA(1, 0, At, B0); PG8_MMA(1, 1, At, B1); PG8_BAR; PG8_SCHED;
            } else {
            PG8_LDB(B0, 0, 0); PG8_SCHED; PG8_LDA(At, 0, 0); PG8_STAGE(PG8_SA(1, 1), a1 + hstepA, voffA);
            PG8_WAIT_L(8); PG8_BAR; PG8_WAIT_L(0); PG8_MMA(0, 0, At, B0); PG8_BAR; PG8_SCHED;
            PG8_LDB(B1, 0, 1); PG8_STAGE(PG8_SB(0, 0), b2, voffB);
            PG8_BAR; PG8_WAIT_L(0); PG8_MMA(0, 1, At, B1); PG8_BAR;
            PG8_LDA(At, 0, 1); PG8_STAGE(PG8_SA(0, 0), a2, voffA);
            PG8_BAR; PG8_WAIT_L(0); PG8_MMA(1, 0, At, B0); PG8_BAR; PG8_SCHED;
            PG8_STAGE(PG8_SB(0, 1), b2 + hstepB, voffB);
            PG8_WAIT_V(6); PG8_BAR; PG8_MMA(1, 1, At, B1); PG8_BAR;
            PG8_LDB(B0, 1, 0); PG8_SCHED; PG8_LDA(At, 1, 0); PG8_STAGE(PG8_SA(0, 1), a2 + hstepA, voffA);
            PG8_WAIT_L(8); PG8_BAR; PG8_WAIT_L(0); PG8_MMA(0, 0, At, B0); PG8_BAR; PG8_SCHED;
            PG8_LDB(B1, 1, 1); PG8_STAGE(PG8_SB(1, 0), b3, voffB);
            PG8_BAR; PG8_WAIT_L(0); PG8_MMA(0, 1, At, B1); PG8_BAR;
            PG8_LDA(At, 1, 1); PG8_STAGE(PG8_SA(1, 0), a3, voffA);
            PG8_BAR; PG8_WAIT_L(0); PG8_MMA(1, 0, At, B0); PG8_BAR; PG8_SCHED;
            PG8_STAGE(PG8_SB(1, 1), b3 + hstepB, voffB);
            PG8_WAIT_V(6); PG8_BAR; PG8_MMA(1, 1, At, B1); PG8_BAR;
            }
        }
        if constexpr (ALIGN_EPI) { if (wr == 0) PG8_BAR; }
        E(acc, cur, wr, wc, fr, fq); S.done(cur);
        if (!has_next) break;
#pragma unroll
        for (int a = 0; a < 2; ++a)
#pragma unroll
            for (int b = 0; b < 2; ++b)
#pragma unroll
                for (int m = 0; m < 4; ++m)
#pragma unroll
                    for (int n = 0; n < 2; ++n) acc[a][b][m][n] = (f32x4){0.f, 0.f, 0.f, 0.f};
        cur = nxt; cA = nA; cB = nB; ++ui;
        if constexpr (ALIGN_EPI) { if (wr == 1) PG8_BAR; }
    }
    PG8_WAIT_V(0);
    if constexpr (!ALIGN_EPI) { if (wr == 0) PG8_BAR; }
    PG8_BAR;
#undef PG8_SA
#undef PG8_SB
#undef PG8_STAGE
#undef PG8_LDA
#undef PG8_LDB
#undef PG8_MMA
#undef PG8_WAIT_V
#undef PG8_WAIT_L
#undef PG8_BAR
#undef PG8_SCHED
}

struct EpiBf16 {
    static constexpr bool PERM = true;
    bf16_t* O; int ldc; const float* rs; int rs_stride;
    __device__ __forceinline__ void operator()(const f32x4 (&acc)[2][2][4][2], const Unit& u, int wr, int wc, int, int) const {
        __builtin_amdgcn_sched_barrier(0);
        int t_ = threadIdx.x; asm volatile("" : "+v"(t_)); const int fr = t_ & 15, fq = (t_ >> 4) & 3;
        const int row0 = u.pm * BM + wr * 64 + fr, col0 = u.pn * BM + wc * 32 + 8 * fq;
#pragma unroll
        for (int ai = 0; ai < 2; ++ai)
#pragma unroll
            for (int m = 0; m < 4; ++m) { const int row = row0 + ai * HALF + m * 16; bf16_t* rowp = O + (size_t)row * ldc + col0;
                const float sc = rs ? rs[(size_t)row * rs_stride] : 1.0f;
#pragma unroll
                for (int bj = 0; bj < 2; ++bj) { const f32x4 v0 = acc[ai][bj][m][0] * sc, v1 = acc[ai][bj][m][1] * sc;
                    u32x4 w; w.x = cvt_pk_bf16(v0[0], v0[1]); w.y = cvt_pk_bf16(v0[2], v0[3]); w.z = cvt_pk_bf16(v1[0], v1[1]); w.w = cvt_pk_bf16(v1[2], v1[3]);
                    *(u32x4*)(rowp + bj * HALF) = w; } }
    }
};
struct EpiVT {
    static constexpr bool PERM = true;
    bf16_t* O; const float* rs;
    __device__ __forceinline__ void operator()(const f32x4 (&acc)[2][2][4][2], const Unit& u, int wr, int wc, int, int) const {
        __builtin_amdgcn_sched_barrier(0);
        int t_ = threadIdx.x; asm volatile("" : "+v"(t_)); const int fr = t_ & 15, fq = (t_ >> 4) & 3;
        const int row0 = u.pm * BM + wr * 64 + fr, col0 = u.pn * BM + wc * 32;
        typedef unsigned u32x2 __attribute__((ext_vector_type(2)));
#pragma unroll
        for (int bj = 0; bj < 2; ++bj) { const int cb = col0 + bj * HALF;
            const float* rsp = rs + cb + 8 * fq;
            typedef bf16_t __attribute__((address_space(1))) gbf16;
            gbf16* rowp = (gbf16*)(O + (size_t)row0 * R + cb + 4 * (fq >> 1) + 16 * (fq & 1));
#pragma unroll
            for (int ai = 0; ai < 2; ++ai)
#pragma unroll
                for (int m = 0; m < 4; ++m) {
                    const f32x4 v0 = acc[ai][bj][m][0] * *(const f32x4*)(rsp), v1 = acc[ai][bj][m][1] * *(const f32x4*)(rsp + 4);
                    u32x2 w0, w1; w0.x = cvt_pk_bf16(v0[0], v0[1]); w0.y = cvt_pk_bf16(v0[2], v0[3]); w1.x = cvt_pk_bf16(v1[0], v1[1]); w1.y = cvt_pk_bf16(v1[2], v1[3]);
                    *(__attribute__((address_space(1))) u32x2*)(rowp) = w0; *(__attribute__((address_space(1))) u32x2*)(rowp + 8) = w1;
                    rowp += (size_t)(m == 3 ? HALF - 48 : 16) * R; asm volatile("" : "+v"(rowp)); } }
    }
};
struct EpiConvGate {
    static constexpr bool PERM = true;
    bf16_t* O; const float* cw; const float* cb; PG8_LAS unsigned char* xl;
    __device__ __forceinline__ void operator()(f32x4 (&acc)[2][2][4][2], const Unit& u, int wr, int wc, int, int) const {
        __builtin_amdgcn_sched_barrier(0);
        int t_ = threadIdx.x; asm volatile("" : "+v"(t_)); const int lane = t_ & 63, fr = t_ & 15, fq = (t_ >> 4) & 3, wave = wr * 4 + wc;
        PG8_LAS f32x4* myx = (PG8_LAS f32x4*)(xl + wave * 1024);
#pragma unroll
        for (int ai = 0; ai < 2; ++ai)
#pragma unroll
            for (int bj = 0; bj < 2; ++bj)
#pragma unroll
                for (int n = 0; n < 2; ++n) { if (fr == 0) myx[(((ai * 2 + 0) * 2 + bj) * 2 + n) * 4 + fq] = acc[ai][bj][0][n]; if (fr == 15) myx[(((ai * 2 + 1) * 2 + bj) * 2 + n) * 4 + fq] = acc[ai][bj][3][n]; }
        asm volatile("s_waitcnt lgkmcnt(0)" ::: "memory"); __builtin_amdgcn_s_barrier(); asm volatile("" ::: "memory");
        const int rg0 = u.pm * 254 - 1 + wr * 64 + fr;
        unsigned hpm = 0u, hnm = 0u;
#pragma unroll
        for (int ai = 0; ai < 2; ++ai)
#pragma unroll
            for (int m = 0; m < 4; ++m) { const int rg = rg0 + ai * HALF + m * 16; const int o = ((rg % RPB) + RPB) % RPB;
                if (o != 0 && o != CTX) hpm |= 1u << (ai * 4 + m); if (o != CTX - 1 && o != RPB - 1) hnm |= 1u << (ai * 4 + m); }
        typedef float f32x2 __attribute__((ext_vector_type(2)));
        {
#pragma unroll
            for (int bj = 0; bj < 2; ++bj)
#pragma unroll
                for (int n = 0; n < 2; ++n) {
                    const int jj = bj * FF + u.pn * HALF + wc * 32 + 8 * fq + 4 * n;
                    const f32x4 w0 = *(const f32x4*)(cw + jj), w1 = *(const f32x4*)(cw + FF2 + jj), w2 = *(const f32x4*)(cw + 2 * FF2 + jj), bb = *(const f32x4*)(cb + jj);
#pragma unroll
                    for (int ai = 0; ai < 2; ++ai) {
                        const int blk = 2 * ai + wr;
                        f32x4 prow = (f32x4){0.f, 0.f, 0.f, 0.f}, nrow = prow;
                        if (blk > 0) prow = *(const PG8_LAS f32x4*)(xl + (((blk - 1) & 1) * 4 + wc) * 1024 + ((((((blk - 1) >> 1) * 2 + 1) * 2 + bj) * 2 + n) * 4 + fq) * 16);
                        if (blk < 3) nrow = *(const PG8_LAS f32x4*)(xl + (((blk + 1) & 1) * 4 + wc) * 1024 + ((((((blk + 1) >> 1) * 2 + 0) * 2 + bj) * 2 + n) * 4 + fq) * 16);
#pragma unroll
                        for (int ep = 0; ep < 2; ++ep) {
                            f32x2 ru[4], rd[4], res[4];
#pragma unroll
                            for (int m = 0; m < 4; ++m)
#pragma unroll
                                for (int k = 0; k < 2; ++k) { int vi = __float_as_int(acc[ai][bj][m][n][2 * ep + k]); asm volatile("" : "+v"(vi));
                                    ru[m][k] = __int_as_float(__builtin_amdgcn_update_dpp(0, vi, 0x121, 0xf, 0xf, false));
                                    rd[m][k] = __int_as_float(__builtin_amdgcn_update_dpp(0, vi, 0x12F, 0xf, 0xf, false)); }
                            const f32x2 w0p = {w0[2 * ep], w0[2 * ep + 1]}, w1p = {w1[2 * ep], w1[2 * ep + 1]}, w2p = {w2[2 * ep], w2[2 * ep + 1]}, bbp = {bb[2 * ep], bb[2 * ep + 1]};
                            const f32x2 pr2 = {prow[2 * ep], prow[2 * ep + 1]}, nr2 = {nrow[2 * ep], nrow[2 * ep + 1]};
#pragma unroll
                            for (int m = 0; m < 4; ++m) {
                                const f32x2 xv = {acc[ai][bj][m][n][2 * ep], acc[ai][bj][m][n][2 * ep + 1]};
                                const f32x2 upv = fr == 0 ? (m == 0 ? pr2 : ru[m == 0 ? 0 : m - 1]) : ru[m];
                                const f32x2 dnv = fr == 15 ? (m == 3 ? nr2 : rd[m == 3 ? 3 : m + 1]) : rd[m];
                                const bool hp = (hpm >> (ai * 4 + m)) & 1u, hn = (hnm >> (ai * 4 + m)) & 1u;
                                const f32x2 z = {0.f, 0.f};
                                res[m] = bbp + w1p * xv + (hp ? w0p * upv : z) + (hn ? w2p * dnv : z); }
                            asm volatile("" : "+v"(res[0]), "+v"(res[1]), "+v"(res[2]), "+v"(res[3]));
#pragma unroll
                            for (int m = 0; m < 4; ++m) { acc[ai][bj][m][n][2 * ep] = res[m][0]; acc[ai][bj][m][n][2 * ep + 1] = res[m][1]; }
                        }
                    }
                }
        }
#pragma unroll
        for (int ai = 0; ai < 2; ++ai)
#pragma unroll
            for (int m = 0; m < 4; ++m) { const int tr = ai * HALF + wr * 64 + m * 16 + fr, rg = u.pm * 254 - 1 + tr;
                if (tr == 0 || tr == 255 || rg >= R) continue;
                const f32x4 a0 = acc[ai][0][m][0], a1 = acc[ai][0][m][1], g0 = acc[ai][1][m][0], g1 = acc[ai][1][m][1];
                float o[8];
#pragma unroll
                for (int e = 0; e < 4; ++e) { o[e] = a0[e] * __builtin_amdgcn_rcpf(1.0f + __builtin_amdgcn_exp2f(-1.4426950408889634f * a0[e])) * g0[e]; o[4 + e] = a1[e] * __builtin_amdgcn_rcpf(1.0f + __builtin_amdgcn_exp2f(-1.4426950408889634f * a1[e])) * g1[e]; }
                u32x4 w; w.x = cvt_pk_bf16(o[0], o[1]); w.y = cvt_pk_bf16(o[2], o[3]); w.z = cvt_pk_bf16(o[4], o[5]); w.w = cvt_pk_bf16(o[6], o[7]);
                *(u32x4*)(O + (size_t)rg * FF + u.pn * HALF + wc * 32 + 8 * fq) = w; }
    }
};
struct EpiResid {
    static constexpr bool PERM = true;
    bf16_t* X; const float* gate; float* outf; int dry;
    __device__ __forceinline__ void operator()(const f32x4 (&acc)[2][2][4][2], const Unit& u, int wr, int wc, int, int) const {
        __builtin_amdgcn_sched_barrier(0);
        int t_ = threadIdx.x; asm volatile("" : "+v"(t_)); const int fr = t_ & 15, fq = (t_ >> 4) & 3;
        const int row0 = u.pm * BM + wr * 64 + fr, col0 = u.pn * BM + wc * 32 + 8 * fq;
#pragma unroll
        for (int ai = 0; ai < 2; ++ai)
#pragma unroll
            for (int m = 0; m < 4; ++m) { const int row = row0 + ai * HALF + m * 16; const RowI ri = rowinfo(row);
                bf16_t* rowp = X + (size_t)row * D + col0; const float* gp = gate + (size_t)ri.bi * 6 * D + col0;
                float* op = outf ? outf + ((size_t)ri.b * SEQ + ri.t) * D + col0 : nullptr;
#pragma unroll
                for (int bj = 0; bj < 2; ++bj) { const int co = bj * HALF;
                    const u32x4 xw = *(const u32x4*)(rowp + co); const f32x4 g0 = *(const f32x4*)(gp + co), g1 = *(const f32x4*)(gp + co + 4);
                    f32x4 n0, n1;
                    n0[0] = __uint_as_float(xw.x << 16); n0[1] = __uint_as_float(xw.x & 0xFFFF0000u); n0[2] = __uint_as_float(xw.y << 16); n0[3] = __uint_as_float(xw.y & 0xFFFF0000u);
                    n1[0] = __uint_as_float(xw.z << 16); n1[1] = __uint_as_float(xw.z & 0xFFFF0000u); n1[2] = __uint_as_float(xw.w << 16); n1[3] = __uint_as_float(xw.w & 0xFFFF0000u);
                    n0 = n0 + g0 * acc[ai][bj][m][0]; n1 = n1 + g1 * acc[ai][bj][m][1];
                    if (dry) continue;
                    if (outf) { *(f32x4*)(op + co) = n0; *(f32x4*)(op + co + 4) = n1; }
                    else { u32x4 w; w.x = cvt_pk_bf16(n0[0], n0[1]); w.y = cvt_pk_bf16(n0[2], n0[3]); w.z = cvt_pk_bf16(n1[0], n1[1]); w.w = cvt_pk_bf16(n1[2], n1[3]); *(u32x4*)(rowp + co) = w; } } }
    }
};
}
#endif


DEV void ld8(const bf16* q, float (&f)[8]) { const U4 u = *(const U4*)q; f[0] = bflo(u.x); f[1] = bfhi(u.x); f[2] = bflo(u.y); f[3] = bfhi(u.y); f[4] = bflo(u.z); f[5] = bfhi(u.z); f[6] = bflo(u.w); f[7] = bfhi(u.w); }
DEV void ldf8(const float* q, float (&f)[8]) {
#pragma unroll
    for (int e = 0; e < 8; ++e) f[e] = q[e]; }
DEV U4 pack8(const float (&f)[8]) { U4 u; u.x = f2bf(f[0]) | ((unsigned)f2bf(f[1]) << 16); u.y = f2bf(f[2]) | ((unsigned)f2bf(f[3]) << 16); u.z = f2bf(f[4]) | ((unsigned)f2bf(f[5]) << 16); u.w = f2bf(f[6]) | ((unsigned)f2bf(f[7]) << 16); return u; }
DEV void conv4x8(const bf16* src, int ld, const float* w  , int wn, const float* bias, bool hp0, bool hn3, float (&out)[4][8]) {
    float w0[8], w1[8], w2[8], bb[8], x[6][8];
    ldf8(w, w0); ldf8(w + wn, w1); ldf8(w + 2 * wn, w2); ldf8(bias, bb);
#pragma unroll
    for (int i = 0; i < 6; ++i) { if ((i == 0 && !hp0) || (i == 5 && !hn3)) {
#pragma unroll
            for (int e = 0; e < 8; ++e) x[i][e] = 0.f; } else ld8(src + (long)(i - 1) * ld, x[i]); }
#pragma unroll
    for (int i = 0; i < 4; ++i)
#pragma unroll
        for (int e = 0; e < 8; ++e) out[i][e] = bb[e] + w0[e] * x[i][e] + w1[e] * x[i + 1][e] + w2[e] * x[i + 2][e];
}

template <int PH> DEV void phase(PRef p, int l, int arg, long gtid, long gth);


template <> DEV void phase<PH_MOD>(PRef p, int, int, long gtid, long gth) {
    constexpr int KC = D / 8;
    for (long i = gtid; i < (long)8 * DEPTH * 6 * D; i += gth) {
        const int j = (int)(i % (6 * D)), l = (int)((i / (6 * D)) % DEPTH), kc = (int)(i / ((long)6 * D * DEPTH));
        const float* w = p.ada_w + (long)l * D * 6 * D + j;
        float acc[B + 1];
#pragma unroll
        for (int bi = 0; bi <= B; ++bi) acc[bi] = 0.f;
        for (int k = kc * KC; k < (kc + 1) * KC; ++k) { const float wv = w[(long)k * 6 * D];
#pragma unroll
            for (int bi = 0; bi <= B; ++bi) acc[bi] += silu_f(bi < B ? p.c[(long)bi * D + k] : p.c_ctx[k]) * wv; }
#pragma unroll
        for (int bi = 0; bi <= B; ++bi) wMODP(p.ws)[(((long)kc * DEPTH + l) * (B + 1) + bi) * 6 * D + j] = acc[bi];
    }
}
template <> DEV void phase<PH_MOD2>(PRef p, int, int, long gtid, long gth) {
    for (long i = gtid; i < (long)DEPTH * (B + 1) * 6 * D; i += gth) {
        const int j = (int)(i % (6 * D)), l = (int)(i / ((long)6 * D * (B + 1)));
        float acc = p.ada_b[(long)l * 6 * D + j];
        for (int kc = 0; kc < 8; ++kc) acc += wMODP(p.ws)[(long)kc * DEPTH * (B + 1) * 6 * D + i];
        wMOD(p.ws)[i] = acc;
    }
}
template <> DEV void phase<PH_ROPE>(PRef p, int, int, long gtid, long gth) {
    for (long i = gtid; i < (long)SEQ * 16; i += gth) {
        const int j = (int)(i % 16), t = (int)(i / 16);
        const int jj = j & 7;
        const float inv = (jj & 1 ? 0.31622776601683794f : 1.0f) * (jj >> 1 == 0 ? 1.0f : jj >> 1 == 1 ? 0.1f : jj >> 1 == 2 ? 0.01f : 0.001f);
        const float pos = j < 8 ? (float)(t / GRID_W) : (float)(t % GRID_W);
        const float a = pos * inv;
        wROPET(p.ws)[i * 2] = cosf(a); wROPET(p.ws)[i * 2 + 1] = sinf(a);
    }
}
template <> DEV void phase<PH_FILT_A>(PRef p, int l, int, long gtid, long gth) {
    for (long i = gtid; i < (long)2 * SEQ * HH; i += gth) {
        const int j = (int)(i % HH), pos = (int)((i / HH) % SEQ), set = (int)(i / ((long)HH * SEQ));
        const int L = set ? CTX : SEQ; if (pos >= L) continue;
        const float* w1 = p.hy_w1 + (long)l * HE * HH;
        const float tl = (float)pos / (float)(L - 1);
        float acc = p.hy_b1[l * HH + j] + tl * w1[j];
        for (int e = 0; e < HB; ++e) {
            const float band = 1e-4f + (float)e * (((float)(HB - 1) - 1e-4f) / (float)(HB - 1));
            float turns = (float)pos * band / (float)L; turns -= floorf(turns);
            acc += cos_t(turns) * w1[(1 + e) * HH + j] - sin_t(turns) * w1[(1 + HB + e) * HH + j];
        }
        wHD1(p.ws)[i] = sin_f(p.hy_freq[l * HH + j] * acc);
    }
}
template <> DEV void phase<PH_FILT_B>(PRef p, int l, int, long gtid, long gth) {
    for (long i = gtid; i < (long)2 * SEQ * HH; i += gth) {
        const int j = (int)(i % HH), pos = (int)((i / HH) % SEQ), set = (int)(i / ((long)HH * SEQ));
        const int L = set ? CTX : SEQ; if (pos >= L) continue;
        const float* w2 = p.hy_w2 + (long)l * HH * HH;
        const float* h1 = wHD1(p.ws) + (i - j);
        float acc = p.hy_b2[l * HH + j];
        for (int e = 0; e < HH; ++e) acc += h1[e] * w2[e * HH + j];
        wHD2(p.ws)[i] = sin_f(p.hy_freq[l * HH + j] * acc);
    }
}
template <> DEV void phase<PH_FILT_C>(PRef p, int l, int, long gtid, long gth) {
    const float* w3 = p.hy_w3 + (long)l * HH * 2 * HW;
    for (long i = gtid; i < (long)2 * (SEQ / 4) * 2 * HW; i += gth) {
        const int c2 = (int)(i % (2 * HW)), pq = (int)((i / (2 * HW)) % (SEQ / 4)), set = (int)(i / ((long)2 * HW * (SEQ / 4)));
        const int L = set ? CTX : SEQ, pos0 = pq * 4; if (pos0 >= L) continue;
        const float* h2 = wHD2(p.ws) + ((long)set * SEQ + pos0) * HH;
        float acc[4] = {0.f, 0.f, 0.f, 0.f};
        for (int e = 0; e < HH; ++e) { const float w = w3[e * 2 * HW + c2];
#pragma unroll
            for (int k = 0; k < 4; ++k) acc[k] += h2[k * HH + e] * w; }
        const int c = c2 % HW;
        const float a0 = -4.605170185988091f / 1.5f, a1 = -4.605170185988091f / 0.3f;
        const float delta = fabsf(a0 + (a1 - a0) * (float)c / (float)(HW - 1));
#pragma unroll
        for (int k = 0; k < 4; ++k) { const int pos = pos0 + k; const float tl = (float)pos / (float)(L - 1); const float v = acc[k] * (exp_f(-tl * delta) + 0.05f);
            if (set == 0) wFT(p.ws)[(long)c2 * SEQ + pos] = v; else wFT1(p.ws)[(long)pos * 2 * HW + c2] = v; }
    }
}
DEV float filt_tap(PRef p, int set, int c2, int pos) { return set == 0 ? wFT(p.ws)[(long)c2 * SEQ + pos] : wFT1(p.ws)[(long)pos * 2 * HW + c2]; }
template <> DEV void phase<PH_FILT_D>(PRef p, int, int, long gtid, long gth) {
    for (long i = gtid; i < (long)2 * HW * 64; i += gth) {
        const int part = (int)(i % 64), c = (int)((i / 64) % HW), set = (int)(i / (64 * HW)); const int L = set ? CTX : SEQ, per = L / 64;
        float s = 0.f;
        for (int pos = part * per; pos < (part + 1) * per; ++pos) { s += fabsf(filt_tap(p, set, c, pos)); if (pos >= 1) s += fabsf(filt_tap(p, set, HW + c, pos)); }
        wFL1(p.ws)[i] = s;
    }
}
DEV float filt_l1(PRef p, int set, int c) { const float* q = wFL1(p.ws) + ((long)set * HW + c) * 64; float s = 0.f; for (int i = 0; i < 64; ++i) s += q[i]; return s; }
template <> DEV void phase<PH_NORM1>(PRef p, int l, int, long gtid, long gth) {
    for (long r = gtid; r < R; r += gth) {
        const RowI ri = rowinfo((int)r);
        bf16* xr = wX(p.ws) + r * D; const float* src = ri.ctx ? p.ctx + ((long)ri.b * CTX + ri.t) * D : p.x + ((long)ri.b * SEQ + ri.t) * D;
        if (l == 0) for (int k = 0; k < D; ++k) xr[k] = f2bf(src[k]);
        float ss = 0.f; for (int k = 0; k < D; ++k) { const float v = l == 0 ? src[k] : bf2f(xr[k]); ss += v * v; }
        const float rstd = 1.0f / sqrtf(ss / (float)D + EPS);
        const float* mod = wMOD(p.ws) + ((long)l * (B + 1) + ri.bi) * 6 * D;
        const float* g = p.norm1_g + l * D;
        for (int k = 0; k < D; ++k) { const float v = l == 0 ? src[k] : bf2f(xr[k]); wH(p.ws)[r * D + k] = f2bf(v * rstd * g[k] * (1.0f + mod[D + k]) + mod[k]); }
    }
}
template <> DEV void phase<PH_GEMM1>(PRef p, int l, int, long gtid, long gth) {
    for (long i = gtid; i < (long)R * NP; i += gth) { const int n = (int)(i % NP); const long r = i / NP;
        wP(p.ws)[i] = f2bf(dot_bf16(wH(p.ws) + r * D, wWinT(p.ws, l) + (long)n * D, D)); }
}
template <> DEV void phase<PH_MLA_A>(PRef p, int, int, long gtid, long gth) {
    for (long r = gtid; r < R; r += gth) {
        const RowI ri = rowinfo((int)r); const bf16* pr = wP(p.ws) + r * NP;
        float s = 0.f; for (int k = 0; k < QR; ++k) { const float v = bf2f(pr[k]); s += v * v; }
        wRS(p.ws)[r] = 1.0f / sqrtf(s / (float)QR + EPS);
        s = 0.f; for (int k = 0; k < KVR; ++k) { const float v = bf2f(pr[QR + k]); s += v * v; }
        wRS(p.ws)[R + r] = 1.0f / sqrtf(s / (float)KVR + EPS);
        for (int j = 0; j < 16; ++j) {
            const float x1 = bf2f(pr[QR + KVR + j]), x2 = bf2f(pr[QR + KVR + 16 + j]);
            float cs = 1.f, sn = 0.f; if (!ri.ctx) { cs = wROPET(p.ws)[((long)ri.t * 16 + j) * 2]; sn = wROPET(p.ws)[((long)ri.t * 16 + j) * 2 + 1]; }
            wKR(p.ws)[r * ROPE + j] = f2bf(x1 * cs - x2 * sn); wKR(p.ws)[r * ROPE + 16 + j] = f2bf(x1 * sn + x2 * cs);
        }
    }
}
template <> DEV void phase<PH_MLA_Q>(PRef p, int l, int, long gtid, long gth) {
    for (long i = gtid; i < (long)R * QW; i += gth) { const int n = (int)(i % QW); const long r = i / QW;
        const RowI ri = rowinfo((int)r);
        const float rs = wRS(p.ws)[r]; const bf16* a = wP(p.ws) + r * NP;
        float v = rs * dot_bf16(a, wWuqT(p.ws, l) + (long)n * QR, QR);
        wQ(p.out)[i] = f2bf(v);
    }
}
template <> DEV void phase<PH_MLA_KV>(PRef p, int l, int, long gtid, long gth) {
    for (long i = gtid; i < (long)R * KVW; i += gth) { const int n = (int)(i % KVW); const long r = i / KVW;
        const bf16 v = f2bf(wRS(p.ws)[R + r] * dot_bf16(wP(p.ws) + r * NP + QR, wWukvT(p.ws, l) + (long)n * KVR, KVR));
        if (n < AW) wKN(p.out)[r * AW + n] = v; else wVT(p.out)[(long)(n - AW) * R + (r & ~31L) + vperm32((int)(r & 31))] = v; }
}
template <> DEV void phase<PH_ATT>(PRef p, int l, int, long gtid, long gth) {
    const bool last = (l == DEPTH - 1);
    const float scale = 1.0f / sqrtf((float)(NOPE + ROPE));
    for (long i = gtid; i < (long)AH * R; i += gth) {
        const int h = (int)(i / R); const long r = i % R; const RowI ri = rowinfo((int)r);
        if (ri.ctx && last) continue;
        const bf16* qp = wQ(p.out) + r * QW + h * (NOPE + ROPE);
        float qr[ROPE];
#pragma unroll
        for (int j = 0; j < 16; ++j) { const float x1 = bf2f(qp[NOPE + j]), x2 = bf2f(qp[NOPE + 16 + j]);
            float cs = 1.f, sn = 0.f; if (!ri.ctx) { cs = wROPET(p.ws)[((long)ri.t * 16 + j) * 2]; sn = wROPET(p.ws)[((long)ri.t * 16 + j) * 2 + 1]; }
            qr[j] = x1 * cs - x2 * sn; qr[16 + j] = x1 * sn + x2 * cs; }
        float o[AV];
#pragma unroll
        for (int d = 0; d < AV; ++d) o[d] = 0.f;
        float m = -1e30f, ssum = 0.f;
        const long k0 = (long)ri.b * RPB; const int nk = ri.ctx ? CTX : RPB;
        for (int kk = 0; kk < nk; ++kk) {
            const bf16* kv = wKN(p.out) + (k0 + kk) * AW + h * NOPE; const bf16* kr = wKR(p.ws) + (k0 + kk) * ROPE;
            const bf16* vt = wVT(p.out) + (long)h * AV * R + ((k0 + kk) & ~31L) + vperm32((int)((k0 + kk) & 31));
            float s = 0.f;
#pragma unroll
            for (int d = 0; d < NOPE; d += 8) s += dot8(*(const U4*)(qp + d), *(const U4*)(kv + d));
#pragma unroll
            for (int d = 0; d < ROPE; ++d) s += qr[d] * bf2f(kr[d]);
            s *= scale;
            const float mn = fmaxf(m, s); const float corr = exp_f(m - mn), pw = exp_f(s - mn);
            ssum = ssum * corr + pw; m = mn;
#pragma unroll
            for (int d = 0; d < AV; ++d) o[d] = o[d] * corr + pw * bf2f(vt[(long)d * R]);
        }
        const float inv = 1.0f / ssum;
#pragma unroll
        for (int d = 0; d < AV; ++d) wH(p.ws)[r * D + h * AV + d] = f2bf(o[d] * inv);
    }
}
template <> DEV void phase<PH_ML_U>(PRef p, int l, int, long gtid, long gth) {
    for (long i = gtid; i < (long)(R / 4) * (MW / 8); i += gth) { const int cg = (int)(i % (MW / 8)); const long r = (i / (MW / 8)) * 4; const RowI ri = rowinfo((int)r);
        const int L = ri.ctx ? CTX : SEQ; float o[4][8];
        conv4x8(wP(p.ws) + r * NP + ML_LO + cg * 8, NP, p.ml_conv_w + (long)l * 3 * MW + cg * 8, MW, p.ml_conv_b + l * MW + cg * 8, ri.t > 0, ri.t + 4 < L, o);
#pragma unroll
        for (int k = 0; k < 4; ++k) {
#pragma unroll
            for (int e = 0; e < 8; ++e) o[k][e] = silu_f(o[k][e]);
            *(U4*)(wMU(p.ws) + (r + k) * MW + cg * 8) = pack8(o[k]); } }
    const float ksc = 1.0f / sqrtf((float)MD);
    for (long i = gtid; i < (long)2 * MW * MW; i += gth) { const int k = (int)(i % MW), n = (int)(i / MW); const int isk = n >= MW, nn = n % MW, h = nn / MD, e = nn % MD;
        float v = 0.f; if (k / MD == h) v = isk ? p.ml_wk[(((long)l * MH + h) * MD + k % MD) * MD + e] * ksc : p.ml_wq[(((long)l * MH + h) * MD + k % MD) * MD + e];
        wWML(p.ws)[i] = f2bf(v); }
}
template <> DEV void phase<PH_ML_QK>(PRef p, int, int, long gtid, long gth) {
    for (long i = gtid; i < (long)R * 2 * MW; i += gth) { const int n = (int)(i % (2 * MW)); const long r = i / (2 * MW);
        wMQK(p.ws)[i] = f2bf(dot_bf16(wMU(p.ws) + r * MW, wWML(p.ws) + (long)n * MW, MW)); }
}
DEV int ml_scan_sc(int dir, int k) { return dir == 0 ? k : (k < NCS ? NCS - 1 - k : SCN - 1 - (k - NCS)); }
DEV int ml_sc_rank(int dir, int sc) { return dir == 0 ? sc : (sc < NCS ? NCS - 1 - sc : NCS + (SCN - 1 - sc)); }
template <> DEV void phase<PH_ML_F>(PRef p, int l, int, long gtid, long gth) {
    for (long i = gtid; i < (long)B * SCN * MH * 2; i += gth) { const int dir = (int)(i % 2), h = (int)((i / 2) % MH), sc = (int)((i / (2 * MH)) % SCN), b = (int)(i / (2 * MH * SCN));
        const float bi_ = p.ml_gate_b[(l * 4 + 2 * dir) * MH + h], bf_ = p.ml_gate_b[(l * 4 + 2 * dir + 1) * MH + h];
        float F = 0.f;
        for (int pos = 0; pos < SCS; ++pos) { const long r = (long)b * RPB + (long)sc * SCS + (dir == 0 ? pos : SCS - 1 - pos);
            const bf16* g = wP(p.ws) + r * NP + ML_LO + 3 * MW;
            const float li = bf2f(g[(2 * dir) * MH + h]) + bi_, lf = logsigmoid_f(bf2f(g[(2 * dir + 1) * MH + h]) + bf_);
            F += lf; float* fg = wFG(p.ws) + ((r * 2 + dir) * MH + h) * 2; fg[0] = F; fg[1] = F - li; }
    }
}
template <> DEV void phase<PH_ML_B>(PRef p, int, int, long gtid, long gth) {
    for (long i = gtid; i < (long)B * MH * 2 * SCN * (MD + 1) * MD; i += gth) {
        const int e = (int)(i % MD), jrow = (int)((i / MD) % (MD + 1)); long t = i / ((long)MD * (MD + 1));
        const int sc = (int)(t % SCN); t /= SCN; const int dir = (int)(t % 2); t /= 2; const int h = (int)(t % MH); const int b = (int)(t / MH);
        const long r0 = (long)b * RPB + (long)sc * SCS; const long rend = dir == 0 ? r0 + SCS - 1 : r0;
        const float Fend = wFG(p.ws)[((rend * 2 + dir) * MH + h) * 2];
        float acc = 0.f;
        for (int s = 0; s < SCS; ++s) { const long r = r0 + s; const float w = exp_f(Fend - wFG(p.ws)[((r * 2 + dir) * MH + h) * 2 + 1]);
            if (jrow < MD) acc += w * bf2f(wMQK(p.ws)[r * 2 * MW + MW + h * MD + jrow]) * bf2f(wP(p.ws)[r * NP + ML_LO + MW + h * MD + e]);
            else acc += w * bf2f(wMQK(p.ws)[r * 2 * MW + MW + h * MD + e]); }
        wMS(p.ws)[i] = acc;
    }
}
template <> DEV void phase<PH_ML_S>(PRef p, int, int dry, long gtid, long gth) {
    for (long i = gtid; i < (long)B * MH * 2 * (MD + 1) * MD; i += gth) {
        const int el = (int)(i % ((MD + 1) * MD)); long t = i / ((MD + 1) * MD); const int dir = (int)(t % 2); t /= 2; const int h = (int)(t % MH); const int b = (int)(t / MH);
        float* base = wMS(p.ws) + ((((long)b * MH + h) * 2 + dir) * SCN) * (MD + 1) * MD + el;
        float C = 0.f;
        for (int k = 0; k < SCN; ++k) { const int sc = ml_scan_sc(dir, k);
            const long r0 = (long)b * RPB + (long)sc * SCS; const long rend = dir == 0 ? r0 + SCS - 1 : r0;
            const float Ftot = wFG(p.ws)[((rend * 2 + dir) * MH + h) * 2];
            float* slot = base + (long)sc * (MD + 1) * MD; const float Bk = *slot; if (!dry) *slot = C;
            C = exp_f(Ftot) * C + Bk; }
    }
}
template <> DEV void phase<PH_ML_O>(PRef p, int l, int, long gtid, long gth) {
    const bool last = (l == DEPTH - 1);
    constexpr int HV = MD / 2;
    for (long i = gtid; i < (long)MH * R; i += gth) {
        const int h = (int)(i / R); const long r = i % R; const RowI ri = rowinfo((int)r);
        if (ri.ctx && last) continue;
        const bf16* qp = wMQK(p.ws) + r * 2 * MW + h * MD;
        const int sc = ri.o / SCS; const long r0 = (long)ri.b * RPB + (long)sc * SCS;
        float ss = 0.f;
        for (int half = 0; half < 2; ++half) {
            float hs[HV], num[HV];
#pragma unroll
            for (int d = 0; d < HV; ++d) hs[d] = 0.f;
            for (int dir = 0; dir < 2; ++dir) {
#pragma unroll
                for (int d = 0; d < HV; ++d) num[d] = 0.f;
                float den = 0.f;
                const float Ft = wFG(p.ws)[((r * 2 + dir) * MH + h) * 2];
                const long sa = dir == 0 ? r0 : r, sb = dir == 0 ? r : r0 + SCS - 1;
                for (long s = sa; s <= sb; ++s) {
                    const float w = exp_f(Ft - wFG(p.ws)[((s * 2 + dir) * MH + h) * 2 + 1]);
                    float dt = 0.f;
#pragma unroll
                    for (int d = 0; d < MD; d += 8) dt += dot8(*(const U4*)(qp + d), *(const U4*)(wMQK(p.ws) + s * 2 * MW + MW + h * MD + d));
                    dt *= w; den += dt;
#pragma unroll
                    for (int d = 0; d < HV; ++d) num[d] += dt * bf2f(wP(p.ws)[s * NP + ML_LO + MW + h * MD + half * HV + d]);
                }
                if (ml_sc_rank(dir, sc) > 0) {
                    const float a = exp_f(Ft);
                    const float* Cin = wMS(p.ws) + (((((long)ri.b * MH + h) * 2 + dir) * SCN) + sc) * (MD + 1) * MD;
#pragma unroll 1
                    for (int d = 0; d < MD; ++d) { const float qa = bf2f(qp[d]) * a; den += qa * Cin[MD * MD + d];
#pragma unroll
                        for (int e = 0; e < HV; ++e) num[e] += qa * Cin[d * MD + half * HV + e]; }
                }
                const float dn = 1.0f / fmaxf(fabsf(den), 1.0f);
#pragma unroll
                for (int d = 0; d < HV; ++d) hs[d] += num[d] * dn;
            }
#pragma unroll
            for (int d = 0; d < HV; ++d) { const float v = hs[d] * sigmoid_f(bf2f(wP(p.ws)[r * NP + ML_LO + 2 * MW + h * MD + half * HV + d])); ss += v * v;
                wH(p.ws)[r * D + AW + h * MD + half * HV + d] = f2bf(v); }
        }
        const float rstd = 1.0f / sqrtf(ss / (float)MD + EPS);
        for (int d = 0; d < MD; ++d) { bf16* o = wH(p.ws) + r * D + AW + h * MD + d; *o = f2bf(bf2f(*o) * rstd * p.ml_norm_g[l * MW + h * MD + d]); }
    }
}

DEV float hy_conv(PRef p, int l, long r, const RowI& ri, int ch) {
    const float* w = p.hy_conv_w + (long)l * 3 * N_HY; const bf16* pr = wP(p.ws) + r * NP + HY_LO + ch;
    float y = p.hy_conv_b[l * N_HY + ch] + w[N_HY + ch] * bf2f(pr[0]);
    if (has_prev(ri)) y += w[ch] * bf2f(pr[-NP]);
    if (has_next(ri)) y += w[2 * N_HY + ch] * bf2f(pr[NP]);
    return y;
}
template <> DEV void phase<PH_HY_Z>(PRef p, int l, int, long gtid, long gth) {
    for (long i = gtid; i < (long)B * CTX * HW; i += gth) { const int c = (int)(i % HW); const long q = i / HW; const long r = (q / CTX) * RPB + (q % CTX); const RowI ri = rowinfo((int)r);
        wZ(p.ws)[i] = hy_conv(p, l, r, ri, HW + c) * hy_conv(p, l, r, ri, 2 * HW + c); }
}
template <> DEV void phase<PH_HY_O>(PRef p, int l, int, long gtid, long gth) {
    if (l == DEPTH - 1) return;
    for (long i = gtid; i < (long)B * CTX * HW; i += gth) { const int c = (int)(i % HW); const long q = i / HW; const int b = (int)(q / CTX), t = (int)(q % CTX); const long r = (long)b * RPB + t; const RowI ri = rowinfo((int)r);
        const float* z = wZ(p.ws) + (long)b * CTX * HW + c;
        float y = 0.f;
        for (int s2 = 0; s2 <= t; ++s2) y += filt_tap(p, 1, c, t - s2) * z[(long)s2 * HW];
        for (int s2 = t + 1; s2 < CTX; ++s2) y += filt_tap(p, 1, HW + c, s2 - t) * z[(long)s2 * HW];
        y = y / filt_l1(p, 1, c) + z[(long)t * HW] * p.hy_bias_d[l * HW + c];
        wH(p.ws)[r * D + AW + MW + c] = f2bf(hy_conv(p, l, r, ri, c) * y); }
}
#ifdef HOST_EMU
#define BLOCK_FOR(tid) for (int tid = 0; tid < NTHREADS; ++tid)
#define BLOCK_SYNC() do {} while (0)
typedef unsigned char* LdsPtr;
DEV C2 twid(float turns) { C2 w; w.x = cosf(6.283185307179586f * turns); w.y = -sinf(6.283185307179586f * turns); return w; }
#else
DEV int opaque_tid() { int t = threadIdx.x; asm volatile("" : "+v"(t)); return t; }
#define BLOCK_FOR(tid) for (int tid = opaque_tid(), once_ = 1; once_; once_ = 0)
#define BLOCK_SYNC() __syncthreads()
typedef __attribute__((address_space(3))) unsigned char* LdsPtr;
DEV C2 twid(float turns) { C2 w; w.x = __builtin_amdgcn_cosf(turns); w.y = -__builtin_amdgcn_sinf(turns); return w; }
#endif
#ifdef HOST_EMU
typedef float* LdsC2; typedef bf16* LdsBf;
#else
typedef __attribute__((address_space(3))) float* LdsC2; typedef __attribute__((address_space(3))) bf16* LdsBf;
#endif
constexpr int NF = 2 * SEQ, NBF = NF / 8;
static_assert(SEQ == 4096 || SEQ == 512, "FFT passes: one radix-2 step then radix-8 steps (SEQ a power of 8)");
DEV int PI(int i) { return i + (i >> 3); }
DEV C2 ldc(LdsC2 buf, int i) { C2 r; r.x = buf[2 * i]; r.y = buf[2 * i + 1]; return r; }
DEV void stc(LdsC2 buf, int i, C2 v) { buf[2 * i] = v.x; buf[2 * i + 1] = v.y; }
DEV C2 cmul(C2 a, C2 b) { C2 r; r.x = a.x * b.x - a.y * b.y; r.y = a.x * b.y + a.y * b.x; return r; }
DEV C2 cmulc(C2 a, C2 b) { C2 r; r.x = a.x * b.x + a.y * b.y; r.y = a.y * b.x - a.x * b.y; return r; }
DEV void dft4(C2& u0, C2& u1, C2& u2, C2& u3) {
    const C2 t0 = {u0.x + u2.x, u0.y + u2.y}, t1 = {u0.x - u2.x, u0.y - u2.y}, t2 = {u1.x + u3.x, u1.y + u3.y}, d = {u1.x - u3.x, u1.y - u3.y};
    const C2 t3 = {d.y, -d.x};
    u0.x = t0.x + t2.x; u0.y = t0.y + t2.y; u2.x = t0.x - t2.x; u2.y = t0.y - t2.y; u1.x = t1.x + t3.x; u1.y = t1.y + t3.y; u3.x = t1.x - t3.x; u3.y = t1.y - t3.y;
}
DEV void dft8(C2 (&a)[8]) {
    const float c = 0.70710678118654752f;
    C2 b0 = {a[0].x + a[4].x, a[0].y + a[4].y}, b4 = {a[0].x - a[4].x, a[0].y - a[4].y};
    C2 b1 = {a[1].x + a[5].x, a[1].y + a[5].y}, d5 = {a[1].x - a[5].x, a[1].y - a[5].y};
    C2 b2 = {a[2].x + a[6].x, a[2].y + a[6].y}, d6 = {a[2].x - a[6].x, a[2].y - a[6].y};
    C2 b3 = {a[3].x + a[7].x, a[3].y + a[7].y}, d7 = {a[3].x - a[7].x, a[3].y - a[7].y};
    C2 b5 = {c * (d5.x + d5.y), c * (d5.y - d5.x)};
    C2 b6 = {d6.y, -d6.x};
    C2 b7 = {c * (d7.y - d7.x), -c * (d7.x + d7.y)};
    dft4(b0, b1, b2, b3); dft4(b4, b5, b6, b7);
    a[0] = b0; a[2] = b1; a[4] = b2; a[6] = b3; a[1] = b4; a[3] = b5; a[5] = b6; a[7] = b7;
}
DEV void idft8(C2 (&a)[8]) {
#pragma unroll
    for (int k = 0; k < 8; ++k) a[k].y = -a[k].y;
    dft8(a);
#pragma unroll
    for (int k = 0; k < 8; ++k) a[k].y = -a[k].y;
}
DEV void twpow(C2 w1, C2 (&w)[8]) { w[0].x = 1.f; w[0].y = 0.f; w[1] = w1; w[2] = cmul(w1, w1); w[3] = cmul(w[2], w1); w[4] = cmul(w[2], w[2]); w[5] = cmul(w[4], w1); w[6] = cmul(w[3], w[3]); w[7] = cmul(w[4], w[3]); }
template <bool INV> DEV void fft_pass8(LdsC2 buf, int s, int ls, int tid) {
    for (int q = tid; q < NBF; q += NTHREADS) {
        const int blk = q >> ls, j = q & (s - 1), base = (blk << (ls + 3)) + j;
        C2 a[8], w[8];
#pragma unroll
        for (int k = 0; k < 8; ++k) a[k] = ldc(buf, PI(base + (k << ls)));
        twpow(twid((float)j / (float)(8 * s)), w);
        if (!INV) { dft8(a);
#pragma unroll
            for (int m = 1; m < 8; ++m) a[m] = cmul(a[m], w[m]);
        } else {
#pragma unroll
            for (int m = 1; m < 8; ++m) a[m] = cmulc(a[m], w[m]);
            idft8(a); }
#pragma unroll
        for (int k = 0; k < 8; ++k) stc(buf, PI(base + (k << ls)), a[k]);
    }
}
DEV void fft_fwd_passes(LdsC2 buf, LdsC2 buf2 = nullptr) {
    int ls = (SEQ == 4096 ? 9 : 6);
    for (int s = SEQ / 8; s >= 8; s >>= 3, ls -= 3) { BLOCK_FOR(tid) { fft_pass8<false>(buf, s, ls, tid); if (buf2) fft_pass8<false>(buf2, s, ls, tid); } BLOCK_SYNC(); }
}
DEV void fft_inv_passes(LdsC2 buf, LdsC2 buf2 = nullptr) {
    int ls = 3;
    for (int s = 8; s <= SEQ / 8; s <<= 3, ls += 3) { BLOCK_FOR(tid) { fft_pass8<true>(buf, s, ls, tid); if (buf2) fft_pass8<true>(buf2, s, ls, tid); } BLOCK_SYNC(); }
}
enum { BPH_HFFT, BPH_HYFFT, BPH_HYZ, BPH_HYOUT, BPH_WCVT, BPH_HYCTX };
template <int BPH> DEV void bphase(PRef p, int l, int blk, LdsPtr lds);
constexpr int WT_UP = (D / 32) * (FF2 / 64), WT_DOWN = (FF / 32) * (D / 64), WT_IN = (D / 32) * (NP / 64), WT_UQ = (QR / 32) * (QW / 64), WT_UKV = (KVR / 32) * (KVW / 64), WT_OUT = (D / 32) * (D / 64);
constexpr int WT_ALL = WT_IN + WT_UQ + WT_UKV + WT_OUT + WT_UP + WT_DOWN;
static_assert(QR % 32 == 0 && KVR % 32 == 0 && QW % 64 == 0 && FF % 64 == 0 && NP % 64 == 0, "weight tiles");
struct WTile { const float* W; const float* gain; bf16* WT; int K, N, k0, n0, s0; };
DEV WTile wtile_decode(PRef p, int l, int t) {
    WTile w; w.gain = nullptr; int NT, which;
    if (t < WT_IN) { which = 0; w.W = p.w_in + (long)l * D * N_IN; w.WT = wWinT(p.ws, l); w.K = D; w.N = N_IN; NT = NP; }
    else if ((t -= WT_IN) < WT_UQ) { which = 1; w.W = p.w_uq + (long)l * QR * QW; w.gain = p.q_norm_g + l * QR; w.WT = wWuqT(p.ws, l); w.K = QR; w.N = QW; NT = QW; }
    else if ((t -= WT_UQ) < WT_UKV) { which = 2; w.W = p.w_ukv + (long)l * KVR * KVW; w.gain = p.kv_norm_g + l * KVR; w.WT = wWukvT(p.ws, l); w.K = KVR; w.N = KVW; NT = KVW; }
    else if ((t -= WT_UKV) < WT_OUT) { which = 3; w.W = p.w_out + (long)l * D * D; w.WT = wWoutT(p.ws, l); w.K = D; w.N = D; NT = D; }
    else if ((t -= WT_OUT) < WT_UP) { which = 4; w.W = p.w_up + (long)l * D * FF2; w.WT = wWupT(p.ws, l); w.K = D; w.N = FF2; NT = FF2; }
    else { t -= WT_UP; which = 5; w.W = p.w_down + (long)l * FF * D; w.WT = wWdownT(p.ws, l); w.K = FF; w.N = D; NT = D; }
    const int ntn = NT / 64, kb = t / ntn, nb = t % ntn; w.k0 = kb * 32; w.n0 = nb * 64;
    w.s0 = w.n0;
    if (which == 2) { const int hd = (w.n0 % AW) / 64; w.s0 = hd * (NOPE + AV) + (w.n0 < AW ? 0 : NOPE); }
#ifndef HOST_EMU
    if (which == 4) { const int tile = w.n0 / 256, within = w.n0 % 256; w.s0 = within < 128 ? tile * 128 + within : FF + tile * 128 + (within - 128); }
#endif
    return w;
}
constexpr int DOWN_BUSY = (R / 256 * (D / 256)) % NBLOCKS, NFILL = NBLOCKS - DOWN_BUSY;
constexpr int WT_PER = 4, WT_ITEMS = (WT_ALL + WT_PER - 1) / WT_PER, WT_SPLIT = (WT_IN + WT_UQ + WT_UKV + WT_OUT + WT_PER - 1) / WT_PER;
template <> DEV void bphase<BPH_WCVT>(PRef p, int l, int blk, LdsPtr lds) {
#ifdef HOST_EMU
    float* sm = (float*)lds;
#else
    __attribute__((address_space(3))) float* sm = (__attribute__((address_space(3))) float*)lds;
#endif
    BLOCK_FOR(tid) {
        for (int sub = 0; sub < WT_PER; ++sub) { const int t = blk * WT_PER + sub; if (t >= WT_ALL) break; const WTile w = wtile_decode(p, l, t);
            for (int idx = tid; idx < 32 * 64; idx += NTHREADS) { const int kk = idx >> 6, nn = idx & 63;
                float v = 0.f; if (w.s0 + nn < w.N) v = w.W[(long)(w.k0 + kk) * w.N + w.s0 + nn];
                if (w.gain) v *= w.gain[w.k0 + kk];
                sm[sub * 64 * 33 + nn * 33 + kk] = v; } }
    }
    BLOCK_SYNC();
    BLOCK_FOR(tid) {
        for (int sub = 0; sub < WT_PER; ++sub) { const int t = blk * WT_PER + sub; if (t >= WT_ALL) break; const WTile w = wtile_decode(p, l, t);
            for (int idx = tid; idx < 64 * 4; idx += NTHREADS) { const int nn = idx >> 2, ch = idx & 3; const int so = sub * 64 * 33 + nn * 33 + ch * 8;
                U4 o;
                o.x = f2bf(sm[so + 0]) | ((unsigned)f2bf(sm[so + 1]) << 16); o.y = f2bf(sm[so + 2]) | ((unsigned)f2bf(sm[so + 3]) << 16);
                o.z = f2bf(sm[so + 4]) | ((unsigned)f2bf(sm[so + 5]) << 16); o.w = f2bf(sm[so + 6]) | ((unsigned)f2bf(sm[so + 7]) << 16);
                *(U4*)(w.WT + (long)(w.n0 + nn) * w.K + w.k0 + ch * 8) = o; } }
    }
    BLOCK_SYNC();
}
template <> DEV void bphase<BPH_HFFT>(PRef p, int l, int blk, LdsPtr lds) {
    LdsC2 buf = (LdsC2)lds; const int c = blk;
    BLOCK_FOR(tid) {
        const float inv = 1.0f / filt_l1(p, 0, c), bias = p.hy_bias_d[l * HW + c];
        const float* fw = wFT(p.ws) + (long)c * SEQ; const float* bw = wFT(p.ws) + (long)(HW + c) * SEQ;
        for (int i = tid; i < SEQ; i += NTHREADS) {
            const float t0 = fw[i] * inv + (i == 0 ? bias : 0.f), t1 = (i == 0) ? 0.f : bw[SEQ - i] * inv;
            C2 e; e.x = t0 + t1; e.y = 0.f; stc(buf, PI(i), e);
            const C2 w = twid((float)i / (float)NF); const float d = t0 - t1; C2 o; o.x = d * w.x; o.y = d * w.y; stc(buf, PI(i + SEQ), o); }
    }
    BLOCK_SYNC();
    fft_fwd_passes(buf);
    BLOCK_FOR(tid) {
        C2* hs = wHSPEC(p.ws) + (long)c * NF; const float sc = 1.0f / (float)NF;
        for (int q = tid; q < NBF; q += NTHREADS) { C2 a[8];
#pragma unroll
            for (int k = 0; k < 8; ++k) a[k] = ldc(buf, 9 * q + k);
            dft8(a);
#pragma unroll
            for (int k = 0; k < 8; ++k) { C2 o; o.x = a[k].x * sc; o.y = a[k].y * sc; hs[8 * q + k] = o; } }
    }
    BLOCK_SYNC();
}
template <> DEV void bphase<BPH_HYFFT>(PRef p, int lflag, int blk, LdsPtr lds) {
    const int c = blk;
    constexpr int NPB = (B >= 4 && B % 4 == 0) ? 2 : 1;
    LdsC2 bufs[2] = {(LdsC2)lds, (LdsC2)(lds + (NPB == 2 ? (NF + NF / 8) * 8 : 0))};
    for (int pr = 0; pr < B / 2; pr += NPB) {
        BLOCK_FOR(tid) {
#pragma unroll
            for (int k = 0; k < NPB; ++k) { LdsC2 buf = bufs[k]; const bf16* z1 = wZT(p.ws) + ((long)(2 * (pr + k)) * HW + c) * SEQ; const bf16* z2 = z1 + (long)HW * SEQ;
                for (int i = tid; i < SEQ; i += NTHREADS) { C2 e; e.x = bf2f(z1[i]); e.y = bf2f(z2[i]); stc(buf, PI(i), e); stc(buf, PI(i + SEQ), cmul(e, twid((float)i / (float)NF))); } }
        }
        BLOCK_SYNC();
        fft_fwd_passes(bufs[0], NPB == 2 ? bufs[1] : nullptr);
        BLOCK_FOR(tid) {
            const C2* hs = wHSPEC(p.ws) + (long)c * NF;
            for (int q = tid; q < NBF; q += NTHREADS) { C2 hv[8];
#pragma unroll
                for (int k = 0; k < 8; ++k) hv[k] = hs[8 * q + k];
#pragma unroll
                for (int kb = 0; kb < NPB; ++kb) { LdsC2 buf = bufs[kb]; C2 a[8];
#pragma unroll
                    for (int k = 0; k < 8; ++k) a[k] = ldc(buf, 9 * q + k);
                    dft8(a);
#pragma unroll
                    for (int k = 0; k < 8; ++k) a[k] = cmul(a[k], hv[k]);
                    idft8(a);
#pragma unroll
                    for (int k = 0; k < 8; ++k) stc(buf, 9 * q + k, a[k]); } }
        }
        BLOCK_SYNC();
        fft_inv_passes(bufs[0], NPB == 2 ? bufs[1] : nullptr);
        BLOCK_FOR(tid) {
#pragma unroll
            for (int k = 0; k < NPB; ++k) { LdsC2 buf = bufs[k]; bf16* z1 = wZT(p.ws) + ((long)(2 * (pr + k)) * HW + c) * SEQ; bf16* z2 = z1 + (long)HW * SEQ;
                for (int i = tid; i < SEQ; i += NTHREADS) { const C2 a = ldc(buf, PI(i)), bb = ldc(buf, PI(i + SEQ)); const C2 y = cmulc(bb, twid((float)i / (float)NF));
                    if (!(lflag & 256)) { z1[i] = f2bf(a.x + y.x); z2[i] = f2bf(a.y + y.y); } } }
        }
        BLOCK_SYNC();
    }
}
template <> DEV void bphase<BPH_HYCTX>(PRef p, int l, int blk, LdsPtr lds) {
#ifdef HOST_EMU
    typedef float* SmF; struct F4 { float v[4]; };
#define HYC_LD4(ptr) (*(const F4*)(ptr))
#else
    typedef __attribute__((address_space(3))) float* SmF; struct F4 { float v[4]; };
    typedef float hyc_f4 __attribute__((ext_vector_type(4)));
#define HYC_LD4(ptr) hyc_ld4(ptr)
    auto hyc_ld4 = [](SmF q) { const hyc_f4 t = *(const __attribute__((address_space(3))) hyc_f4*)q; F4 r; r.v[0] = t[0]; r.v[1] = t[1]; r.v[2] = t[2]; r.v[3] = t[3]; return r; };
#endif
    SmF sm = (SmF)lds;
    const int b = blk / (HW / 8), c0 = (blk % (HW / 8)) * 8;
    constexpr int ZO = 0, GO = 8 * CTX, IO = GO + 16 * CTX, YO = IO + 8;
    static_assert(CTX % 4 == 0 && (YO + 8 * CTX) * 4 <= 160 * 1024, "ctx hyena LDS");
    BLOCK_FOR(tid) {
        for (int idx = tid; idx < CTX * 8; idx += NTHREADS) { const int t = idx >> 3, c = idx & 7;
            sm[ZO + c * CTX + t] = wZ(p.ws)[((long)b * CTX + t) * HW + c0 + c];
            sm[GO + c * 2 * CTX + CTX + t] = wFT1(p.ws)[(long)t * 2 * HW + c0 + c];
            sm[GO + c * 2 * CTX + CTX - t - (t == 0 ? CTX : 0)] = t == 0 ? 0.f : wFT1(p.ws)[(long)t * 2 * HW + HW + c0 + c]; }
        if (tid < 8) sm[IO + tid] = 1.0f / filt_l1(p, 1, c0 + tid);
    }
    BLOCK_SYNC();
    BLOCK_FOR(tid) {
        for (int idx = tid; idx < 8 * (CTX / 4); idx += NTHREADS) { const int c = idx / (CTX / 4), t0 = (idx % (CTX / 4)) * 4;
            SmF z = sm + ZO + c * CTX; SmF g = sm + GO + c * 2 * CTX;
            float y[4] = {0.f, 0.f, 0.f, 0.f};
            for (int s2 = 0; s2 < CTX; s2 += 4) { const int base = t0 + CTX - s2;
                const F4 zv = HYC_LD4(z + s2), glo = HYC_LD4(g + base - 4), ghi = HYC_LD4(g + base);
                const float w[7] = {glo.v[1], glo.v[2], glo.v[3], ghi.v[0], ghi.v[1], ghi.v[2], ghi.v[3]};
#pragma unroll
                for (int i = 0; i < 4; ++i)
#pragma unroll
                    for (int j = 0; j < 4; ++j) y[i] += w[i - j + 3] * zv.v[j]; }
            const float inv = sm[IO + c], bias = p.hy_bias_d[l * HW + c0 + c];
#pragma unroll
            for (int i = 0; i < 4; ++i) { const int t = t0 + i; const long r = (long)b * RPB + t; const RowI ri = rowinfo((int)r);
                sm[YO + t * 8 + c] = hy_conv(p, l, r, ri, c0 + c) * (y[i] * inv + z[t] * bias); } }
    }
    BLOCK_SYNC();
    BLOCK_FOR(tid) {
        for (int t = tid; t < CTX; t += NTHREADS) { float o[8];
#pragma unroll
            for (int e = 0; e < 8; ++e) o[e] = sm[YO + t * 8 + e];
            *(U4*)(wH(p.ws) + ((long)b * RPB + t) * D + AW + MW + c0) = pack8(o); }
    }
    BLOCK_SYNC();
#undef HYC_LD4
}
constexpr int HZP = 72;
static_assert(HZP % 8 == 0, "hyena LDS rows keep 16-byte alignment");
#ifdef HOST_EMU
DEV void lds_st8(LdsBf q, U2 v) { *(U2*)q = v; }
DEV U2 lds_ld8(LdsBf q) { return *(const U2*)q; }
DEV void lds_st16(LdsBf q, U4 v) { *(U4*)q = v; }
DEV U4 lds_ld16(LdsBf q) { return *(const U4*)q; }
#else
typedef unsigned lds_u2v __attribute__((ext_vector_type(2))); typedef unsigned lds_u4v __attribute__((ext_vector_type(4)));
DEV void lds_st8(LdsBf q, U2 v) { lds_u2v t; t.x = v.x; t.y = v.y; *(__attribute__((address_space(3))) lds_u2v*)q = t; }
DEV U2 lds_ld8(LdsBf q) { const lds_u2v t = *(const __attribute__((address_space(3))) lds_u2v*)q; U2 v; v.x = t.x; v.y = t.y; return v; }
DEV void lds_st16(LdsBf q, U4 v) { lds_u4v t; t.x = v.x; t.y = v.y; t.z = v.z; t.w = v.w; *(__attribute__((address_space(3))) lds_u4v*)q = t; }
DEV U4 lds_ld16(LdsBf q) { const lds_u4v t = *(const __attribute__((address_space(3))) lds_u4v*)q; U4 v; v.x = t.x; v.y = t.y; v.z = t.z; v.w = t.w; return v; }
#endif
template <> DEV void bphase<BPH_HYZ>(PRef p, int l, int blk, LdsPtr lds) {
    LdsBf sm = (LdsBf)lds; const int b = blk / (SEQ / 64), tt = blk % (SEQ / 64); const long r0 = (long)b * RPB + CTX + (long)tt * 64;
    BLOCK_FOR(tid) { for (int it = tid; it < (HW / 8) * 16; it += NTHREADS) {
        const int cg = it % (HW / 8), rs = it / (HW / 8); const int t0 = tt * 64 + rs * 4; const long r = r0 + rs * 4;
        float a[4][8], v[4][8];
        conv4x8(wP(p.ws) + r * NP + HY_LO + HW + cg * 8, NP, p.hy_conv_w + (long)l * 3 * N_HY + HW + cg * 8, N_HY, p.hy_conv_b + l * N_HY + HW + cg * 8, t0 > 0, t0 + 4 < SEQ, a);
        conv4x8(wP(p.ws) + r * NP + HY_LO + 2 * HW + cg * 8, NP, p.hy_conv_w + (long)l * 3 * N_HY + 2 * HW + cg * 8, N_HY, p.hy_conv_b + l * N_HY + 2 * HW + cg * 8, t0 > 0, t0 + 4 < SEQ, v);
#pragma unroll
        for (int e = 0; e < 8; ++e) { U2 w; w.x = f2bf(a[0][e] * v[0][e]) | ((unsigned)f2bf(a[1][e] * v[1][e]) << 16); w.y = f2bf(a[2][e] * v[2][e]) | ((unsigned)f2bf(a[3][e] * v[3][e]) << 16);
            lds_st8(sm + (cg * 8 + e) * HZP + rs * 4, w); }
    } }
    BLOCK_SYNC();
    BLOCK_FOR(tid) {
        for (int idx = tid; idx < HW * 8; idx += NTHREADS) { const int c = idx >> 3, ch = idx & 7;
            const U4 v = lds_ld16(sm + c * HZP + ch * 8);
            *(U4*)(wZT(p.ws) + ((long)b * HW + c) * SEQ + tt * 64 + ch * 8) = v; }
    }
    BLOCK_SYNC();
}
template <> DEV void bphase<BPH_HYOUT>(PRef p, int l, int blk, LdsPtr lds) {
    LdsBf sm = (LdsBf)lds; const int b = blk / (SEQ / 64), tt = blk % (SEQ / 64); const long r0 = (long)b * RPB + CTX + (long)tt * 64;
    BLOCK_FOR(tid) {
        for (int idx = tid; idx < HW * 8; idx += NTHREADS) { const int c = idx >> 3, ch = idx & 7;
            lds_st16(sm + c * HZP + ch * 8, *(const U4*)(wZT(p.ws) + ((long)b * HW + c) * SEQ + tt * 64 + ch * 8)); }
    }
    BLOCK_SYNC();
    BLOCK_FOR(tid) { for (int it = tid; it < (HW / 8) * 16; it += NTHREADS) {
        const int cg = it % (HW / 8), rs = it / (HW / 8); const int t0 = tt * 64 + rs * 4; const long r = r0 + rs * 4;
        float x0[4][8];
        conv4x8(wP(p.ws) + r * NP + HY_LO + cg * 8, NP, p.hy_conv_w + (long)l * 3 * N_HY + cg * 8, N_HY, p.hy_conv_b + l * N_HY + cg * 8, t0 > 0, t0 + 4 < SEQ, x0);
#pragma unroll
        for (int e = 0; e < 8; ++e) { const U2 y = lds_ld8(sm + (cg * 8 + e) * HZP + rs * 4);
            x0[0][e] *= bflo(y.x); x0[1][e] *= bfhi(y.x); x0[2][e] *= bflo(y.y); x0[3][e] *= bfhi(y.y); }
#pragma unroll
        for (int k = 0; k < 4; ++k) *(U4*)(wH(p.ws) + (r + k) * D + AW + MW + cg * 8) = pack8(x0[k]);
    } }
    BLOCK_SYNC();
}
template <> DEV void phase<PH_GEMM_OUT>(PRef p, int l, int, long gtid, long gth) {
    for (long i = gtid; i < (long)R * D; i += gth) { const int n = (int)(i % D); const long r = i / D; const RowI ri = rowinfo((int)r);
        const float g1 = wMOD(p.ws)[((long)l * (B + 1) + ri.bi) * 6 * D + 2 * D + n];
        wX(p.ws)[i] = f2bf(bf2f(wX(p.ws)[i]) + g1 * dot_bf16(wH(p.ws) + r * D, wWoutT(p.ws, l) + (long)n * D, D)); }
}
template <> DEV void phase<PH_NORM2>(PRef p, int l, int, long gtid, long gth) {
    for (long r = gtid; r < R; r += gth) { const RowI ri = rowinfo((int)r); const bf16* xr = wX(p.ws) + r * D;
        float ss = 0.f; for (int k = 0; k < D; ++k) ss += bf2f(xr[k]) * bf2f(xr[k]);
        const float rstd = 1.0f / sqrtf(ss / (float)D + EPS);
        const float* mod = wMOD(p.ws) + ((long)l * (B + 1) + ri.bi) * 6 * D; const float* g = p.norm2_g + l * D;
        for (int k = 0; k < D; ++k) wH(p.ws)[r * D + k] = f2bf(bf2f(xr[k]) * rstd * g[k] * (1.0f + mod[4 * D + k]) + mod[3 * D + k]); }
}
template <> DEV void phase<PH_FFN_UP>(PRef p, int l, int fc, long gtid, long gth) {
    for (long i = gtid; i < (long)FCR * FF2; i += gth) { const int n = (int)(i % FF2); const long rr = i / FF2; const long r = (long)fc * FCR + rr;
        wUF(p.ws)[i] = f2bf(dot_bf16(wH(p.ws) + r * D, wWupT(p.ws, l) + (long)n * D, D)); }
}
template <> DEV void phase<PH_FFN_CG>(PRef p, int l, int fc, long gtid, long gth) {
    for (long i = gtid; i < (long)FCR * FF; i += gth) { const int j = (int)(i % FF); const long rr = i / FF; const long r = (long)fc * FCR + rr; const RowI ri = rowinfo((int)r);
        const float* w = p.ffn_conv_w + (long)l * 3 * FF2; const float* cb = p.ffn_conv_b + (long)l * FF2; const bf16* u = wUF(p.ws) + rr * FF2;
        float a = cb[j] + w[FF2 + j] * bf2f(u[j]), g = cb[FF + j] + w[FF2 + FF + j] * bf2f(u[FF + j]);
        if (has_prev(ri)) { a += w[j] * bf2f(u[j - FF2]); g += w[FF + j] * bf2f(u[FF + j - FF2]); }
        if (has_next(ri)) { a += w[2 * FF2 + j] * bf2f(u[j + FF2]); g += w[2 * FF2 + FF + j] * bf2f(u[FF + j + FF2]); }
        wGF(p.ws)[i] = f2bf(silu_f(a) * g); }
}
template <> DEV void phase<PH_FFN_DOWN>(PRef p, int l, int fc, long gtid, long gth) {
    for (long i = gtid; i < (long)FCR * D; i += gth) { const int n = (int)(i % D); const long rr = i / D; const long r = (long)fc * FCR + rr; const RowI ri = rowinfo((int)r);
        const float g2 = wMOD(p.ws)[((long)l * (B + 1) + ri.bi) * 6 * D + 5 * D + n];
        const float xn = bf2f(wX(p.ws)[r * D + n]) + g2 * dot_bf16(wGF(p.ws) + rr * FF, wWdownT(p.ws, l) + (long)n * FF, FF);
        wX(p.ws)[r * D + n] = f2bf(xn); }
}
template <> DEV void phase<PH_FINAL>(PRef p, int, int, long gtid, long gth) {
    for (long q = gtid; q < (long)B * SEQ; q += gth) { const bf16* xr = wX(p.ws) + ((q / SEQ) * RPB + CTX + q % SEQ) * D;
        float ss = 0.f; for (int k = 0; k < D; ++k) ss += bf2f(xr[k]) * bf2f(xr[k]);
        const float rstd = 1.0f / sqrtf(ss / (float)D + EPS);
        for (int k = 0; k < D; ++k) p.out[q * D + k] = bf2f(xr[k]) * rstd * p.final_g[k]; }
}


#ifndef HOST_EMU
namespace wv {
typedef float f32x4 __attribute__((ext_vector_type(4)));
typedef unsigned u32x2 __attribute__((ext_vector_type(2)));
__device__ __forceinline__ float wsum(float v, int lane) {
#pragma unroll
    for (int o = 32; o; o >>= 1) v += __int_as_float(__builtin_amdgcn_ds_bpermute((lane ^ o) << 2, __float_as_int(v)));
    return v;
}
typedef __bf16 bf2_t __attribute__((ext_vector_type(2)));
typedef float f32x2_t __attribute__((ext_vector_type(2)));
__device__ __forceinline__ unsigned pk(float lo, float hi) { f32x2_t v = {lo, hi}; return __builtin_bit_cast(unsigned, __builtin_convertvector(v, bf2_t)); }
constexpr int NW = NBLOCKS * (NTHREADS / 64), NV = D / 256;
template <int MODE> __device__ __forceinline__ void norm_rows(PRef p, int l) {
    int t_ = threadIdx.x; asm volatile("" : "+v"(t_)); const int lane = t_ & 63, gw = (int)blockIdx.x * (NTHREADS / 64) + (t_ >> 6);
    const int nrows = MODE == 2 ? B * SEQ : R;
    for (int q0 = gw; q0 < nrows; q0 += 2 * NW) {
        const bool two = q0 + NW < nrows;
        long r[2]; int bi[2]; const float* src[2] = {nullptr, nullptr}; bf16* xdst[2] = {nullptr, nullptr};
        f32x4 v[2][NV];
#pragma unroll
        for (int u = 0; u < 2; ++u) if (u == 0 || two) {
            const int q = q0 + u * NW;
            if (MODE == 2) { r[u] = (long)(q / SEQ) * RPB + CTX + (q % SEQ); bi[u] = 0; }
            else { r[u] = q; const RowI ri = rowinfo(q); bi[u] = ri.bi;
                if (MODE == 0 && l == 0) { src[u] = ri.ctx ? p.ctx + ((long)ri.b * CTX + ri.t) * D : p.x + ((long)ri.b * SEQ + ri.t) * D; xdst[u] = wX(p.ws) + r[u] * D; } }
#pragma unroll
            for (int j = 0; j < NV; ++j) {
                if (src[u]) v[u][j] = *(const f32x4*)(src[u] + 4 * lane + 256 * j);
                else { const u32x2 xw = *(const u32x2*)(wX(p.ws) + r[u] * D + 4 * lane + 256 * j); v[u][j][0] = __uint_as_float(xw.x << 16); v[u][j][1] = __uint_as_float(xw.x & 0xFFFF0000u); v[u][j][2] = __uint_as_float(xw.y << 16); v[u][j][3] = __uint_as_float(xw.y & 0xFFFF0000u); } }
        }
#pragma unroll
        for (int u = 0; u < 2; ++u) if (u == 0 || two) {
            const int q = q0 + u * NW;
            float ss = 0.f;
#pragma unroll
            for (int j = 0; j < NV; ++j) ss += (v[u][j][0] * v[u][j][0] + v[u][j][1] * v[u][j][1]) + (v[u][j][2] * v[u][j][2] + v[u][j][3] * v[u][j][3]);
            if (xdst[u]) {
#pragma unroll
                for (int j = 0; j < NV; ++j) { u32x2 w; w.x = pk(v[u][j][0], v[u][j][1]); w.y = pk(v[u][j][2], v[u][j][3]); *(u32x2*)(xdst[u] + 4 * lane + 256 * j) = w; } }
            const float rstd = 1.0f / sqrtf(wsum(ss, lane) / (float)D + EPS);
            if (MODE == 2) {
#pragma unroll
                for (int j = 0; j < NV; ++j) { const f32x4 g = *(const f32x4*)(p.final_g + 4 * lane + 256 * j); *(f32x4*)(p.out + (long)q * D + 4 * lane + 256 * j) = v[u][j] * rstd * g; }
            } else {
                const float* mod = wMOD(p.ws) + ((long)l * (B + 1) + bi[u]) * 6 * D + (MODE == 0 ? 0 : 3 * D); const float* g = (MODE == 0 ? p.norm1_g : p.norm2_g) + l * D;
#pragma unroll
                for (int j = 0; j < NV; ++j) { const int k = 4 * lane + 256 * j; const f32x4 gg = *(const f32x4*)(g + k), sh = *(const f32x4*)(mod + k), sc = *(const f32x4*)(mod + D + k);
                    const f32x4 o = v[u][j] * rstd * gg * (sc + 1.0f) + sh; u32x2 w; w.x = pk(o[0], o[1]); w.y = pk(o[2], o[3]); *(u32x2*)(wH(p.ws) + r[u] * D + k) = w; }
            }
        }
    }
}
__device__ __forceinline__ float rsum16(float v) {
    v += __int_as_float(__builtin_amdgcn_update_dpp(0, __float_as_int(v), 0x128, 0xf, 0xf, false));
    v += __int_as_float(__builtin_amdgcn_update_dpp(0, __float_as_int(v), 0x124, 0xf, 0xf, false));
    v += __int_as_float(__builtin_amdgcn_update_dpp(0, __float_as_int(v), 0x122, 0xf, 0xf, false));
    v += __int_as_float(__builtin_amdgcn_update_dpp(0, __float_as_int(v), 0x121, 0xf, 0xf, false));
    return v;
}
__device__ __forceinline__ void mla_a_rows(PRef p) {
    int t_ = threadIdx.x; asm volatile("" : "+v"(t_)); const int lane = t_ & 63, i = lane & 15, g = lane >> 4, gw = (int)blockIdx.x * (NTHREADS / 64) + (t_ >> 6);
    static_assert(QR == 3 * 128 && KVR == 2 * 128 && ROPE == 32 && R % 4 == 0, "mla_a lane map");
    for (int q0 = gw * 4; q0 < R; q0 += 8 * NW) {
        U4 uq[2][3], uk[2][2]; float x1[2], x2[2], cs[2], sn[2]; bool ok[2], cx[2] = {false, false};
#pragma unroll
        for (int u = 0; u < 2; ++u) {
            const int r = q0 + u * 4 * NW + g; ok[u] = r < R;
            if (ok[u]) { const RowI ri = rowinfo(r); const bf16* pr = wP(p.ws) + (long)r * NP;
#pragma unroll
                for (int c = 0; c < 3; ++c) uq[u][c] = *(const U4*)(pr + (i + 16 * c) * 8);
#pragma unroll
                for (int c = 0; c < 2; ++c) uk[u][c] = *(const U4*)(pr + QR + (i + 16 * c) * 8);
                x1[u] = bf2f(pr[QR + KVR + i]); x2[u] = bf2f(pr[QR + KVR + 16 + i]);
                const int tt = ri.ctx ? 0 : ri.t; cx[u] = ri.ctx; cs[u] = wROPET(p.ws)[((long)tt * 16 + i) * 2]; sn[u] = wROPET(p.ws)[((long)tt * 16 + i) * 2 + 1]; }
        }
#pragma unroll
        for (int u = 0; u < 2; ++u) {
            const int r = q0 + u * 4 * NW + g;
            float sq = 0.f, sk = 0.f;
            if (ok[u]) { sq = dot8(uq[u][0], uq[u][0]) + dot8(uq[u][1], uq[u][1]) + dot8(uq[u][2], uq[u][2]); sk = dot8(uk[u][0], uk[u][0]) + dot8(uk[u][1], uk[u][1]); }
            sq = rsum16(sq); sk = rsum16(sk);
            if (ok[u]) {
                if (i == 0) { wRS(p.ws)[r] = 1.0f / sqrtf(sq / (float)QR + EPS); wRS(p.ws)[R + r] = 1.0f / sqrtf(sk / (float)KVR + EPS); }
                const float c_ = cx[u] ? 1.0f : cs[u], s_ = cx[u] ? 0.0f : sn[u];
                wKR(p.ws)[(long)r * ROPE + i] = f2bf(x1[u] * c_ - x2[u] * s_); wKR(p.ws)[(long)r * ROPE + 16 + i] = f2bf(x1[u] * s_ + x2[u] * c_); }
        }
    }
}
__device__ __forceinline__ void ml_f_rows(PRef p, int l) {
    int t_ = threadIdx.x; asm volatile("" : "+v"(t_)); const int lane = t_ & 63, gw = (int)blockIdx.x * (NTHREADS / 64) + (t_ >> 6);
    static_assert(SCS == 256, "ml_f_rows: 64 lanes x 4 positions");
    for (int u = NW - 1 - gw; u < B * SCN * MH * 2; u += NW) {
        const int dir = u % 2, h = (u / 2) % MH, sc = (u / (2 * MH)) % SCN, b = u / (2 * MH * SCN);
        const float bi_ = p.ml_gate_b[(l * 4 + 2 * dir) * MH + h], bf_ = p.ml_gate_b[(l * 4 + 2 * dir + 1) * MH + h];
        const long rb = (long)b * RPB + (long)sc * SCS;
        float li[4], c[4]; float run = 0.f;
#pragma unroll
        for (int i = 0; i < 4; ++i) { const int pos = 4 * lane + i; const long r = rb + (dir == 0 ? pos : SCS - 1 - pos);
            const bf16* g = wP(p.ws) + r * NP + ML_LO + 3 * MW;
            li[i] = bf2f(g[(2 * dir) * MH + h]) + bi_; run += logsigmoid_f(bf2f(g[(2 * dir + 1) * MH + h]) + bf_); c[i] = run; }
        float inc = run;
#pragma unroll
        for (int o = 1; o < 64; o <<= 1) { const float t = __int_as_float(__builtin_amdgcn_ds_bpermute(((lane - o) & 63) << 2, __float_as_int(inc))); if (lane >= o) inc += t; }
        const float excl = inc - run;
#pragma unroll
        for (int i = 0; i < 4; ++i) { const int pos = 4 * lane + i; const long r = rb + (dir == 0 ? pos : SCS - 1 - pos); const float F = excl + c[i];
            float* fg = wFG(p.ws) + ((r * 2 + dir) * MH + h) * 2; fg[0] = F; fg[1] = F - li[i]; }
    }
}

constexpr int FROWS = (SEQ + CTX) / NBLOCKS;
static_assert((SEQ + CTX) % NBLOCKS == 0 && HH == 64 && 2 * HW == NTHREADS && FROWS * HH * 4 <= 65536, "filter block phases");
__device__ __forceinline__ void filt_b_block(PRef p, int l, __attribute__((address_space(3))) unsigned char* lds) {
    int t_ = threadIdx.x; asm volatile("" : "+v"(t_)); const int t = t_, j = t & 63, wv_ = t >> 6;
    __attribute__((address_space(3))) float* hs = (__attribute__((address_space(3))) float*)lds;
    const long g0 = (long)blockIdx.x * FROWS;
    __syncthreads();
    for (int idx = t; idx < FROWS * HH; idx += NTHREADS) hs[idx] = wHD1(p.ws)[g0 * HH + idx];
    const float* w2 = p.hy_w2 + (long)l * HH * HH;
    float w[HH];
#pragma unroll
    for (int e = 0; e < HH; ++e) w[e] = w2[e * HH + j];
    const float bj = p.hy_b2[l * HH + j], fj = p.hy_freq[l * HH + j];
    __syncthreads();
    for (int k = wv_; k < FROWS; k += NTHREADS / 64) {
        float acc = bj;
#pragma unroll
        for (int e4 = 0; e4 < HH / 4; ++e4) { const f32x4 h = *(const __attribute__((address_space(3))) f32x4*)(hs + k * HH + e4 * 4);
            acc += h[0] * w[4 * e4]; acc += h[1] * w[4 * e4 + 1]; acc += h[2] * w[4 * e4 + 2]; acc += h[3] * w[4 * e4 + 3]; }
        wHD2(p.ws)[(g0 + k) * HH + j] = sin_f(fj * acc);
    }
    __syncthreads();
}
__device__ __forceinline__ void filt_c_block(PRef p, int l, __attribute__((address_space(3))) unsigned char* lds) {
    int t_ = threadIdx.x; asm volatile("" : "+v"(t_)); const int c2 = t_;
    __attribute__((address_space(3))) float* hs = (__attribute__((address_space(3))) float*)lds;
    const long g0 = (long)blockIdx.x * FROWS;
    __syncthreads();
    for (int idx = c2; idx < FROWS * HH; idx += NTHREADS) hs[idx] = wHD2(p.ws)[g0 * HH + idx];
    const float* w3 = p.hy_w3 + (long)l * HH * 2 * HW;
    float w[HH];
#pragma unroll
    for (int e = 0; e < HH; ++e) w[e] = w3[e * 2 * HW + c2];
    const int c = c2 % HW;
    const float a0 = -4.605170185988091f / 1.5f, a1 = -4.605170185988091f / 0.3f;
    const float delta = fabsf(a0 + (a1 - a0) * (float)c / (float)(HW - 1));
    __syncthreads();
    for (int k = 0; k < FROWS; ++k) {
        float acc = 0.f;
#pragma unroll
        for (int e4 = 0; e4 < HH / 4; ++e4) { const f32x4 h = *(const __attribute__((address_space(3))) f32x4*)(hs + k * HH + e4 * 4);
            acc += h[0] * w[4 * e4]; acc += h[1] * w[4 * e4 + 1]; acc += h[2] * w[4 * e4 + 2]; acc += h[3] * w[4 * e4 + 3]; }
        const long g = g0 + k; const int set = g >= SEQ, pos = (int)(set ? g - SEQ : g), L = set ? CTX : SEQ;
        const float tl = (float)pos / (float)(L - 1); const float v = acc * (exp_f(-tl * delta) + 0.05f);
        if (set == 0) wFT(p.ws)[(long)c2 * SEQ + pos] = v; else wFT1(p.ws)[(long)pos * 2 * HW + c2] = v;
    }
    __syncthreads();
}

constexpr int MOD_KC = D / 8, MOD_BLOCKS = 8 * DEPTH * 6 * D / NTHREADS;
static_assert((DEPTH * 6 * D) % NTHREADS == 0 && MOD_KC % 4 == 0 && MOD_BLOCKS <= NBLOCKS, "mod block phase");
__device__ __forceinline__ void mod_block(PRef p, __attribute__((address_space(3))) unsigned char* lds) {
    if ((int)blockIdx.x >= MOD_BLOCKS) return;
    int t_ = threadIdx.x; asm volatile("" : "+v"(t_)); const int t = t_;
    __attribute__((address_space(3))) float* sm = (__attribute__((address_space(3))) float*)lds;
    const long i = (long)blockIdx.x * NTHREADS + t;
    const int j = (int)(i % (6 * D)), l = (int)((i / (6 * D)) % DEPTH), kc = (int)(i / ((long)6 * D * DEPTH));
    for (int idx = t; idx < (B + 1) * MOD_KC; idx += NTHREADS) { const int bi = idx / MOD_KC, k = kc * MOD_KC + idx % MOD_KC; sm[idx] = silu_f(bi < B ? p.c[(long)bi * D + k] : p.c_ctx[k]); }
    __syncthreads();
    const float* w = p.ada_w + (long)l * D * 6 * D + (long)kc * MOD_KC * 6 * D + j;
    float acc[B + 1];
#pragma unroll
    for (int bi = 0; bi <= B; ++bi) acc[bi] = 0.f;
#pragma unroll 2
    for (int k4 = 0; k4 < MOD_KC / 4; ++k4) {
        float wq[4];
#pragma unroll
        for (int q = 0; q < 4; ++q) wq[q] = w[(long)(4 * k4 + q) * 6 * D];
#pragma unroll
        for (int bi = 0; bi <= B; ++bi) { const f32x4 sv = *(const __attribute__((address_space(3))) f32x4*)(sm + bi * MOD_KC + 4 * k4);
            acc[bi] += sv[0] * wq[0]; acc[bi] += sv[1] * wq[1]; acc[bi] += sv[2] * wq[2]; acc[bi] += sv[3] * wq[3]; }
    }
#pragma unroll
    for (int bi = 0; bi <= B; ++bi) wMODP(p.ws)[(((long)kc * DEPTH + l) * (B + 1) + bi) * 6 * D + j] = acc[bi];
    __syncthreads();
}

__device__ __forceinline__ void filt_d_rows(PRef p) {
    int t_ = threadIdx.x; asm volatile("" : "+v"(t_)); const int lane = t_ & 63, gw = (int)blockIdx.x * (NTHREADS / 64) + (t_ >> 6);
    static_assert(2 * HW * 4 <= NBLOCKS * (NTHREADS / 64) && SEQ % 64 == 0 && CTX % 64 == 0, "filt_d tasks");
    if ((gw & 3) != 0 || (gw >> 2) >= 2 * HW) return;
    const int task = gw >> 2, set = task / HW, c = task % HW;
    float s = 0.f;
    if (set == 0) {
        const float* fw = wFT(p.ws) + (long)c * SEQ; const float* bw = wFT(p.ws) + (long)(HW + c) * SEQ;
#pragma unroll 8
        for (int k = 0; k < SEQ / 64; ++k) { const int pos = lane + 64 * k; s += fabsf(fw[pos]); const float b = fabsf(bw[pos]); s += pos >= 1 ? b : 0.f; }
    } else {
#pragma unroll
        for (int k = 0; k < CTX / 64; ++k) { const int pos = lane + 64 * k; s += fabsf(wFT1(p.ws)[(long)pos * 2 * HW + c]); const float b = fabsf(wFT1(p.ws)[(long)pos * 2 * HW + HW + c]); s += pos >= 1 ? b : 0.f; }
    }
    wFL1(p.ws)[((long)set * HW + c) * 64 + lane] = s;
}
__device__ __forceinline__ void ml_s_scan(PRef p) {
    int t_ = threadIdx.x; asm volatile("" : "+v"(t_)); const long gtid = (long)blockIdx.x * NTHREADS + t_;
    for (long i = gtid; i < (long)B * MH * 2 * (MD + 1) * MD; i += (long)NBLOCKS * NTHREADS) {
        const int el = (int)(i % ((MD + 1) * MD)); long t = i / ((MD + 1) * MD); const int dir = (int)(t % 2); t /= 2; const int h = (int)(t % MH); const int b = (int)(t / MH);
        float* base = wMS(p.ws) + ((((long)b * MH + h) * 2 + dir) * SCN) * (MD + 1) * MD + el;
        float Bk[SCN], Fk[SCN];
#pragma unroll
        for (int k = 0; k < SCN; ++k) { const int sc = ml_scan_sc(dir, k);
            const long r0 = (long)b * RPB + (long)sc * SCS; const long rend = dir == 0 ? r0 + SCS - 1 : r0;
            Fk[k] = wFG(p.ws)[((rend * 2 + dir) * MH + h) * 2]; Bk[k] = base[(long)sc * (MD + 1) * MD]; }
        float C = 0.f;
#pragma unroll
        for (int k = 0; k < SCN; ++k) { const int sc = ml_scan_sc(dir, k); base[(long)sc * (MD + 1) * MD] = C; C = exp_f(Fk[k]) * C + Bk[k]; }
    }
}
}
#endif
#ifndef HOST_EMU
#define LAS __attribute__((address_space(3)))
#endif

#ifndef HOST_EMU
namespace att {
typedef short bf16x8 __attribute__((ext_vector_type(8)));
typedef float f32x4 __attribute__((ext_vector_type(4)));
typedef unsigned u32x4 __attribute__((ext_vector_type(4)));
typedef unsigned u32x2 __attribute__((ext_vector_type(2)));
constexpr int TK = 128;
constexpr int KROW = 224, VROW = TK * 2 + 32, KT_BYTES = TK * KROW, VT_BYTES = 64 * VROW;
constexpr int QBLK = 256, NQB = SEQ / QBLK, NLAT = B * AH * NQB, NCQ = CTX / QBLK;
static_assert(SEQ % QBLK == 0 && RPB % TK == 0 && CTX % TK == 0 && CTX % QBLK == 0, "attention tiling");
__device__ __forceinline__ float bfl(unsigned w) { return __uint_as_float(w << 16); }
__device__ __forceinline__ float bfh(unsigned w) { return __uint_as_float(w & 0xFFFF0000u); }
typedef __bf16 bf2_t __attribute__((ext_vector_type(2)));
typedef float f32x2_t __attribute__((ext_vector_type(2)));
__device__ __forceinline__ unsigned pk(float lo, float hi) { f32x2_t v = {lo, hi}; return __builtin_bit_cast(unsigned, __builtin_convertvector(v, bf2_t)); }
__device__ __forceinline__ float xl(float v, int lane, int m) { return __int_as_float(__builtin_amdgcn_ds_bpermute((lane ^ m) << 2, __float_as_int(v))); }
__device__ __forceinline__ void attn_phase(PRef p, int l, LAS unsigned char* lds) {
    const int wave = __builtin_amdgcn_readfirstlane((int)threadIdx.x >> 6);
    const bool last = (l == DEPTH - 1);
    const int vcu = ((int)blockIdx.x % 8) * (NBLOCKS / 8) + (int)blockIdx.x / 8;
    const int nunits = NLAT + (last ? 0 : B * AH * NCQ);
    const float qscale = 0.14724420716f;
    const bf16* Qg = wQ(p.out); const bf16* KNg = wKN(p.out); const bf16* KRg = wKR(p.ws); const bf16* VTg = wVT(p.out); const float* ROPEg = wROPET(p.ws); bf16* Og = wH(p.ws);
    for (int u = vcu; u < nunits; u += NBLOCKS) {
        int tid_ = threadIdx.x; asm volatile("" : "+v"(tid_));
        const int tid = tid_, lane = tid & 63, i16 = lane & 15, g = lane >> 4;
        const bool isctx = u >= NLAT;
        int b, hd, nkeys; long q0;
        if (!isctx) { b = u / (AH * NQB); hd = (u / NQB) % AH; q0 = (long)b * RPB + CTX + (long)(u % NQB) * QBLK; nkeys = RPB; }
        else { const int uu = u - NLAT; b = uu / (AH * NCQ); hd = (uu / NCQ) % AH; q0 = (long)b * RPB + (long)(uu % NCQ) * QBLK; nkeys = CTX; }
        const long k0 = (long)b * RPB;
        const long qw = q0 + wave * 32;
        bf16x8 qf[2][3];
#pragma unroll
        for (int qb = 0; qb < 2; ++qb) {
            const bf16* qp = (Qg + qw * QW + hd * (NOPE + ROPE)) + (unsigned)((qb * 16 + i16) * QW + g * 8);
            u32x4 raw[3];
#pragma unroll
            for (int ks = 0; ks < 3; ++ks) raw[ks] = *(const u32x4*)(qp + ks * 32);
#pragma unroll
            for (int ks = 0; ks < 2; ++ks) { u32x4 w;
#pragma unroll
                for (int e = 0; e < 4; ++e) w[e] = pk(bfl(raw[ks][e]) * qscale, bfh(raw[ks][e]) * qscale);
                qf[qb][ks] = __builtin_bit_cast(bf16x8, w); }
            u32x4 w2;
            if (!isctx) {
                u32x4 pr;
#pragma unroll
                for (int e = 0; e < 4; ++e) pr[e] = (unsigned)__builtin_amdgcn_ds_bpermute((lane ^ 32) << 2, (int)raw[2][e]);
                const float* tb = (ROPEg + (qw - k0 - CTX) * 32) + (unsigned)((qb * 16 + i16) * 32 + 16 * (g & 1));
                const float sg = g < 2 ? -1.0f : 1.0f;
#pragma unroll
                for (int e = 0; e < 4; ++e) { const f32x4 cs = *(const f32x4*)(tb + 4 * e);
                    const float m0 = bfl(raw[2][e]), m1 = bfh(raw[2][e]), o0 = bfl(pr[e]), o1 = bfh(pr[e]);
                    w2[e] = pk((m0 * cs[0] + sg * o0 * cs[1]) * qscale, (m1 * cs[2] + sg * o1 * cs[3]) * qscale); }
            } else {
#pragma unroll
                for (int e = 0; e < 4; ++e) w2[e] = pk(bfl(raw[2][e]) * qscale, bfh(raw[2][e]) * qscale);
            }
            qf[qb][2] = __builtin_bit_cast(bf16x8, w2);
        }
        const bf16* knb = KNg + k0 * AW + hd * NOPE; const bf16* krb = KRg + k0 * ROPE; const bf16* vb = VTg + (long)hd * AV * R + k0;
        const unsigned kn_off0 = (unsigned)((tid >> 3) * AW + (tid & 7) * 8), kn_off1 = kn_off0 + 64u * AW, kr_off = (unsigned)((tid >> 2) * ROPE + (tid & 3) * 8);
        const unsigned v_off0 = (unsigned)((tid >> 4) * R + (tid & 15) * 8), v_off1 = v_off0 + 32u * R;
        const int kn_dst0 = (tid >> 3) * KROW + (tid & 7) * 16, kn_dst1 = kn_dst0 + 64 * KROW, kr_dst = (tid >> 2) * KROW + 128 + (tid & 3) * 16;
        const int v_dst0 = 2 * KT_BYTES + (tid >> 4) * VROW + (tid & 15) * 16, v_dst1 = v_dst0 + 32 * VROW;
        const int nt = nkeys / TK;
        f32x4 O[2][4];
#pragma unroll
        for (int qb = 0; qb < 2; ++qb)
#pragma unroll
            for (int dvt = 0; dvt < 4; ++dvt) O[qb][dvt] = (f32x4){0.f, 0.f, 0.f, 0.f};
        float mrun[2] = {0.f, 0.f}, lsum[2] = {0.f, 0.f};
        f32x4 negm[2] = {(f32x4){0.f, 0.f, 0.f, 0.f}, (f32x4){0.f, 0.f, 0.f, 0.f}};
        const int kfo = i16 * KROW + g * 16, vfo = 2 * KT_BYTES + i16 * VROW + g * 16;
        u32x4 s1, s2, s3, s4, s5;
        auto load_stage = [&](int tt) { s1 = *(const u32x4*)(knb + (long)tt * TK * AW + kn_off0); s2 = *(const u32x4*)(knb + (long)tt * TK * AW + kn_off1); s3 = *(const u32x4*)(krb + (long)tt * TK * ROPE + kr_off);
            s4 = *(const u32x4*)(vb + (long)tt * TK + v_off0); s5 = *(const u32x4*)(vb + (long)tt * TK + v_off1); };
        auto store_stage = [&](int buf) { const int nk = buf * KT_BYTES, nv = buf * VT_BYTES;
            *(LAS u32x4*)(lds + nk + kn_dst0) = s1; *(LAS u32x4*)(lds + nk + kn_dst1) = s2; *(LAS u32x4*)(lds + nk + kr_dst) = s3; *(LAS u32x4*)(lds + nv + v_dst0) = s4; *(LAS u32x4*)(lds + nv + v_dst1) = s5; };
        auto subtile = [&](int kb_off, int vb_off, bool first) {
            bf16x8 kf[12];
#pragma unroll
            for (int kb = 0; kb < 4; ++kb)
#pragma unroll
                for (int ks = 0; ks < 3; ++ks) kf[kb * 3 + ks] = *(const LAS bf16x8*)(lds + kb_off + kb * 16 * KROW + ks * 64);
            asm volatile("s_waitcnt lgkmcnt(0)" : "+v"(kf[0]), "+v"(kf[1]), "+v"(kf[2]), "+v"(kf[3]), "+v"(kf[4]), "+v"(kf[5]), "+v"(kf[6]), "+v"(kf[7]), "+v"(kf[8]), "+v"(kf[9]), "+v"(kf[10]), "+v"(kf[11]) :: "memory");
            f32x4 S[2][4];
#pragma unroll
            for (int kb = 0; kb < 4; ++kb)
#pragma unroll
                for (int ks = 0; ks < 3; ++ks) {
                    S[0][kb] = __builtin_amdgcn_mfma_f32_16x16x32_bf16(kf[kb * 3 + ks], qf[0][ks], ks == 0 ? negm[0] : S[0][kb], 0, 0, 0);
                    S[1][kb] = __builtin_amdgcn_mfma_f32_16x16x32_bf16(kf[kb * 3 + ks], qf[1][ks], ks == 0 ? negm[1] : S[1][kb], 0, 0, 0); }
            bf16x8 vf[8];
#pragma unroll
            for (int dvt = 0; dvt < 4; ++dvt)
#pragma unroll
                for (int kp = 0; kp < 2; ++kp) vf[dvt * 2 + kp] = *(const LAS bf16x8*)(lds + vb_off + dvt * 16 * VROW + kp * 64);
            asm volatile("" ::: "memory");
            bf16x8 pf[2][2];
#pragma unroll
            for (int qb = 0; qb < 2; ++qb) {
                float mx = S[qb][0][0];
#pragma unroll
                for (int kb = 0; kb < 4; ++kb)
#pragma unroll
                    for (int e = 0; e < 4; ++e) mx = fmaxf(mx, S[qb][kb][e]);
                if (first || __builtin_amdgcn_ballot_w64(mx > 8.0f) != 0ull) {
                    mx = fmaxf(mx, xl(mx, lane, 16)); mx = fmaxf(mx, xl(mx, lane, 32));
                    const float d = first ? mx : fmaxf(mx, 0.0f), corr = first ? 1.0f : __builtin_amdgcn_exp2f(-d);
                    mrun[qb] += d; lsum[qb] *= corr; negm[qb] = (f32x4){-mrun[qb], -mrun[qb], -mrun[qb], -mrun[qb]};
#pragma unroll
                    for (int dvt = 0; dvt < 4; ++dvt) O[qb][dvt] = O[qb][dvt] * corr;
#pragma unroll
                    for (int kb = 0; kb < 4; ++kb) S[qb][kb] = S[qb][kb] - d;
                }
                float ps = 0.f;
#pragma unroll
                for (int kb = 0; kb < 4; ++kb)
#pragma unroll
                    for (int e = 0; e < 4; ++e) { const float ex = __builtin_amdgcn_exp2f(S[qb][kb][e]); S[qb][kb][e] = ex; ps += ex; }
                lsum[qb] += ps;
#pragma unroll
                for (int kp = 0; kp < 2; ++kp) { u32x4 w; w[0] = pk(S[qb][2 * kp][0], S[qb][2 * kp][1]); w[1] = pk(S[qb][2 * kp][2], S[qb][2 * kp][3]); w[2] = pk(S[qb][2 * kp + 1][0], S[qb][2 * kp + 1][1]); w[3] = pk(S[qb][2 * kp + 1][2], S[qb][2 * kp + 1][3]);
                    pf[qb][kp] = __builtin_bit_cast(bf16x8, w); }
            }
            asm volatile("s_waitcnt lgkmcnt(0)" : "+v"(vf[0]), "+v"(vf[1]), "+v"(vf[2]), "+v"(vf[3]), "+v"(vf[4]), "+v"(vf[5]), "+v"(vf[6]), "+v"(vf[7]) :: "memory");
#pragma unroll
            for (int dvt = 0; dvt < 4; ++dvt)
#pragma unroll
                for (int kp = 0; kp < 2; ++kp) {
                    O[0][dvt] = __builtin_amdgcn_mfma_f32_16x16x32_bf16(vf[dvt * 2 + kp], pf[0][kp], O[0][dvt], 0, 0, 0);
                    O[1][dvt] = __builtin_amdgcn_mfma_f32_16x16x32_bf16(vf[dvt * 2 + kp], pf[1][kp], O[1][dvt], 0, 0, 0); }
        };
        load_stage(0); store_stage(0);
        __syncthreads();
        for (int t = 0; t < nt; ++t) {
            const int buf = t & 1;
            if (t + 1 < nt) load_stage(t + 1);
#pragma unroll
            for (int sub = 0; sub < TK / 64; ++sub) subtile(buf * KT_BYTES + sub * 64 * KROW + kfo, buf * VT_BYTES + sub * 128 + vfo, sub == 0 && t == 0);
            if (t + 1 < nt) store_stage(buf ^ 1);
            __syncthreads();
        }
#pragma unroll
        for (int qb = 0; qb < 2; ++qb) {
            float lt = lsum[qb]; lt += xl(lt, lane, 16); lt += xl(lt, lane, 32); const float inv = 1.0f / lt;
            bf16* op = (Og + qw * D + hd * AV) + (unsigned)((qb * 16 + i16) * D + 4 * g);
#pragma unroll
            for (int dvt = 0; dvt < 4; ++dvt) { u32x2 w; w.x = pk(O[qb][dvt][0] * inv, O[qb][dvt][1] * inv); w.y = pk(O[qb][dvt][2] * inv, O[qb][dvt][3] * inv); *(u32x2*)(op + dvt * 16) = w; }
        }
    }
}
}
#endif

#ifndef HOST_EMU
namespace mlk {
typedef short bf16x8 __attribute__((ext_vector_type(8)));
typedef float f32x16 __attribute__((ext_vector_type(16)));
typedef float f32x4 __attribute__((ext_vector_type(4)));
typedef unsigned u32x4 __attribute__((ext_vector_type(4)));
typedef unsigned u32x2 __attribute__((ext_vector_type(2)));
static_assert(SCS == 256 && MD == 64, "mlstm MFMA phases: 256-row super-chunks, head dim 64");
constexpr int KP = 144, TP = 528;
constexpr int O_KL = 0, O_VT = 256 * KP, O_CT = O_VT + 64 * TP, O_FG = O_CT + 2 * 64 * KP, O_NL = O_FG + 2 * 2 * 256 * 4, O_END = O_NL + 2 * 64 * 4;
constexpr int B_KT = 0, B_VT = 64 * TP, B_WL = 2 * 64 * TP, B_END = B_WL + 2 * 256 * 4;
constexpr float LOG2E = 1.4426950408889634f;
__device__ __forceinline__ float bfl(unsigned w) { return __uint_as_float(w << 16); }
__device__ __forceinline__ float bfh(unsigned w) { return __uint_as_float(w & 0xFFFF0000u); }
__device__ __forceinline__ unsigned pk(float lo, float hi) { unsigned r; asm volatile("v_cvt_pk_bf16_f32 %0, %1, %2" : "=v"(r) : "v"(lo), "v"(hi)); return r; }
__device__ __forceinline__ float xl32(float v, int lane) { return __int_as_float(__builtin_amdgcn_ds_bpermute((lane ^ 32) << 2, __float_as_int(v))); }
__device__ __forceinline__ int kpos(int key) { return (key & ~15) | swap23(key & 15); }
__device__ __forceinline__ void stage_t(LAS unsigned char* img, const u32x4 v, int dim0, int key) {
    const int kb = kpos(key) * 2;
#pragma unroll
    for (int e = 0; e < 4; ++e) { *(LAS unsigned short*)(img + (dim0 + 2 * e) * TP + kb) = (unsigned short)(v[e] & 0xFFFFu); *(LAS unsigned short*)(img + (dim0 + 2 * e + 1) * TP + kb) = (unsigned short)(v[e] >> 16); }
}
__device__ __forceinline__ void ml_b_phase(PRef p, LAS unsigned char* lds) {
    const int wave = __builtin_amdgcn_readfirstlane((int)threadIdx.x >> 6);
    for (int u = ((((int)blockIdx.x % 8) + 6) % 8) * (NBLOCKS / 8) + (int)blockIdx.x / 8; u < B * MH * SCN; u += NBLOCKS) {
        int tid_ = threadIdx.x; asm volatile("" : "+v"(tid_)); const int tid = tid_, lane = tid & 63, r = lane & 31, hh = lane >> 5;
        const int sc = u % SCN, h = (u / SCN) % MH, b = u / (SCN * MH); const long r0 = (long)b * RPB + (long)sc * SCS;
        const bf16* kg = wMQK(p.ws) + r0 * 2 * MW + MW + h * MD; const bf16* vg = wP(p.ws) + r0 * NP + ML_LO + MW + h * MD; const float* fg = wFG(p.ws);
#pragma unroll
        for (int i = 0; i < 4; ++i) { const int ci = tid + 512 * i, key = ci >> 3, part = ci & 7;
            stage_t(lds + B_KT, *(const u32x4*)(kg + (unsigned)(key * 2 * MW + part * 8)), part * 8, key);
            stage_t(lds + B_VT, *(const u32x4*)(vg + (unsigned)(key * NP + part * 8)), part * 8, key); }
        { const int dir = tid >> 8, key = tid & 255; const long rend = dir == 0 ? r0 + SCS - 1 : r0;
          const float Fend = fg[((rend * 2 + dir) * MH + h) * 2], G = fg[(((r0 + key) * 2 + dir) * MH + h) * 2 + 1];
          *(LAS float*)(lds + B_WL + (dir * 256 + kpos(key)) * 4) = __builtin_amdgcn_exp2f((Fend - G) * LOG2E); }
        __syncthreads();
        const int dir = wave >> 2, dvb = (wave >> 1) & 1, kb = wave & 1;
        f32x16 acc;
#pragma unroll
        for (int i = 0; i < 16; ++i) acc[i] = 0.f;
        float nacc = 0.f;
#pragma unroll 4
        for (int ks = 0; ks < 16; ++ks) {
            const bf16x8 vf = *(const LAS bf16x8*)(lds + B_VT + (dvb * 32 + r) * TP + ks * 32 + hh * 16);
            const u32x4 kr = *(const LAS u32x4*)(lds + B_KT + (kb * 32 + r) * TP + ks * 32 + hh * 16);
            const f32x4 w0 = *(const LAS f32x4*)(lds + B_WL + (dir * 256 + ks * 16 + hh * 8) * 4), w1 = *(const LAS f32x4*)(lds + B_WL + (dir * 256 + ks * 16 + hh * 8 + 4) * 4);
            const float k0 = bfl(kr[0]) * w0[0], k1 = bfh(kr[0]) * w0[1], k2 = bfl(kr[1]) * w0[2], k3 = bfh(kr[1]) * w0[3], k4 = bfl(kr[2]) * w1[0], k5 = bfh(kr[2]) * w1[1], k6 = bfl(kr[3]) * w1[2], k7 = bfh(kr[3]) * w1[3];
            nacc += ((k0 + k1) + (k2 + k3)) + ((k4 + k5) + (k6 + k7));
            u32x4 kw; kw[0] = pk(k0, k1); kw[1] = pk(k2, k3); kw[2] = pk(k4, k5); kw[3] = pk(k6, k7);
            acc = __builtin_amdgcn_mfma_f32_32x32x16_bf16(vf, __builtin_bit_cast(bf16x8, kw), acc, 0, 0, 0);
        }
        float* ms = wMS(p.ws) + ((((long)b * MH + h) * 2 + dir) * SCN + sc) * (MD + 1) * MD;
#pragma unroll
        for (int g = 0; g < 4; ++g) { f32x4 o; o[0] = acc[4 * g]; o[1] = acc[4 * g + 1]; o[2] = acc[4 * g + 2]; o[3] = acc[4 * g + 3];
            *(f32x4*)(ms + (unsigned)((kb * 32 + r) * MD + dvb * 32 + 8 * g + 4 * hh)) = o; }
        const float nt = nacc + xl32(nacc, lane);
        if (dvb == 0 && hh == 0) ms[MD * MD + kb * 32 + r] = nt;
        __syncthreads();
    }
}
__device__ __forceinline__ void ml_o_phase(PRef p, int l, LAS unsigned char* lds) {
    const int wave = __builtin_amdgcn_readfirstlane((int)threadIdx.x >> 6);
    const bool last = (l == DEPTH - 1);
    for (int u = blockIdx.x; u < B * MH * SCN; u += NBLOCKS) {
        const int sc = u % SCN, h = (u / SCN) % MH, b = u / (SCN * MH);
        if (last && sc < NCS) continue;
        int tid_ = threadIdx.x; asm volatile("" : "+v"(tid_)); const int tid = tid_, lane = tid & 63, r = lane & 31, hh = lane >> 5;
        const long r0 = (long)b * RPB + (long)sc * SCS;
        const bf16* qg = wMQK(p.ws) + r0 * 2 * MW + h * MD; const bf16* kg = qg + MW; const bf16* pg = wP(p.ws) + r0 * NP + ML_LO + h * MD; const float* fg = wFG(p.ws);
        const float* msb = wMS(p.ws) + (((long)b * MH + h) * 2 * SCN + sc) * (MD + 1) * MD;
#pragma unroll
        for (int i = 0; i < 4; ++i) { const int ci = tid + 512 * i, key = ci >> 3, part = ci & 7;
            *(LAS u32x4*)(lds + O_KL + key * KP + part * 16) = *(const u32x4*)(kg + (unsigned)(key * 2 * MW + part * 8));
            stage_t(lds + O_VT, *(const u32x4*)(pg + (unsigned)(key * NP + MW + part * 8)), part * 8, key); }
#pragma unroll
        for (int i = 0; i < 4; ++i) { const int ci = tid + 512 * i, dir = ci >> 10, kdim = (ci >> 4) & 63, d4 = ci & 15;
            const f32x4 c = *(const f32x4*)(msb + (unsigned)(dir * SCN * (MD + 1) * MD + kdim * MD + d4 * 4));
#pragma unroll
            for (int e = 0; e < 4; ++e) *(LAS unsigned short*)(lds + O_CT + (dir * 64 + d4 * 4 + e) * KP + kdim * 2) = (unsigned short)f2bf(c[e]); }
        if (tid < 128) { const int dir = tid >> 6, kdim = tid & 63; *(LAS float*)(lds + O_NL + tid * 4) = msb[(unsigned)(dir * SCN * (MD + 1) * MD + MD * MD + kdim)]; }
        { const int dir = tid >> 8, key = tid & 255; const float F = fg[(((r0 + key) * 2 + dir) * MH + h) * 2], G = fg[(((r0 + key) * 2 + dir) * MH + h) * 2 + 1];
          *(LAS float*)(lds + O_FG + ((dir * 2 + 0) * 256 + key) * 4) = F * LOG2E; *(LAS float*)(lds + O_FG + ((dir * 2 + 1) * 256 + key) * 4) = G * LOG2E; }
        bf16x8 qf[4];
#pragma unroll
        for (int ks = 0; ks < 4; ++ks) qf[ks] = *(const bf16x8*)(qg + (unsigned)((wave * 32 + r) * 2 * MW + ks * 16 + hh * 8));
        __syncthreads();
        f32x16 hs[2];
#pragma unroll
        for (int dvb = 0; dvb < 2; ++dvb)
#pragma unroll
            for (int i = 0; i < 16; ++i) hs[dvb][i] = 0.f;
#pragma unroll 1
        for (int dir = 0; dir < 2; ++dir) {
            const float Ft = *(const LAS float*)(lds + O_FG + ((dir * 2 + 0) * 256 + wave * 32 + r) * 4);
            f32x16 O[2];
#pragma unroll
            for (int dvb = 0; dvb < 2; ++dvb)
#pragma unroll
                for (int i = 0; i < 16; ++i) O[dvb][i] = 0.f;
            float den = 0.f;
            const int kt0 = dir == 0 ? 0 : wave, kt1 = dir == 0 ? wave : 7;
            for (int kt = kt0; kt <= kt1; ++kt) {
                f32x16 S;
#pragma unroll
                for (int i = 0; i < 16; ++i) S[i] = 0.f;
#pragma unroll
                for (int ks = 0; ks < 4; ++ks) {
                    const bf16x8 kf = *(const LAS bf16x8*)(lds + O_KL + (kt * 32 + r) * KP + ks * 32 + hh * 16);
                    S = __builtin_amdgcn_mfma_f32_32x32x16_bf16(kf, qf[ks], S, 0, 0, 0); }
                const bool diag = (kt == wave);
#pragma unroll
                for (int g = 0; g < 4; ++g) { const f32x4 gv = *(const LAS f32x4*)(lds + O_FG + ((dir * 2 + 1) * 256 + kt * 32 + 8 * g + 4 * hh) * 4);
#pragma unroll
                    for (int e = 0; e < 4; ++e) { const int krow = 8 * g + 4 * hh + e; const bool keep = !diag || (dir == 0 ? krow <= r : krow >= r);
                        const float wgt = __builtin_amdgcn_exp2f(keep ? Ft - gv[e] : -1.0e30f); const float sw = S[4 * g + e] * wgt; S[4 * g + e] = sw; den += sw; } }
                bf16x8 pf[2];
#pragma unroll
                for (int s2 = 0; s2 < 2; ++s2) { u32x4 w;
#pragma unroll
                    for (int e = 0; e < 4; ++e) w[e] = pk(S[8 * s2 + 2 * e], S[8 * s2 + 2 * e + 1]);
                    pf[s2] = __builtin_bit_cast(bf16x8, w); }
#pragma unroll
                for (int dvb = 0; dvb < 2; ++dvb)
#pragma unroll
                    for (int s2 = 0; s2 < 2; ++s2) {
                        const bf16x8 vf = *(const LAS bf16x8*)(lds + O_VT + (dvb * 32 + r) * TP + (kt * 32 + s2 * 16) * 2 + hh * 16);
                        O[dvb] = __builtin_amdgcn_mfma_f32_32x32x16_bf16(vf, pf[s2], O[dvb], 0, 0, 0); }
            }
            f32x16 I[2];
#pragma unroll
            for (int dvb = 0; dvb < 2; ++dvb)
#pragma unroll
                for (int i = 0; i < 16; ++i) I[dvb][i] = 0.f;
            float dint = 0.f;
#pragma unroll
            for (int ks = 0; ks < 4; ++ks) {
#pragma unroll
                for (int dvb = 0; dvb < 2; ++dvb) { const bf16x8 cf = *(const LAS bf16x8*)(lds + O_CT + (dir * 64 + dvb * 32 + r) * KP + ks * 32 + hh * 16);
                    I[dvb] = __builtin_amdgcn_mfma_f32_32x32x16_bf16(cf, qf[ks], I[dvb], 0, 0, 0); }
                const u32x4 qr = __builtin_bit_cast(u32x4, qf[ks]);
                const f32x4 n0 = *(const LAS f32x4*)(lds + O_NL + (dir * 64 + ks * 16 + hh * 8) * 4), n1 = *(const LAS f32x4*)(lds + O_NL + (dir * 64 + ks * 16 + hh * 8 + 4) * 4);
                dint += (bfl(qr[0]) * n0[0] + bfh(qr[0]) * n0[1]) + (bfl(qr[1]) * n0[2] + bfh(qr[1]) * n0[3]) + (bfl(qr[2]) * n1[0] + bfh(qr[2]) * n1[1]) + (bfl(qr[3]) * n1[2] + bfh(qr[3]) * n1[3]);
            }
            const float a = __builtin_amdgcn_exp2f(Ft);
            const float dtot = (den + xl32(den, lane)) + a * (dint + xl32(dint, lane));
            const float scl = 1.0f / fmaxf(fabsf(dtot), 1.0f);
#pragma unroll
            for (int dvb = 0; dvb < 2; ++dvb)
#pragma unroll
                for (int i = 0; i < 16; ++i) hs[dvb][i] += (O[dvb][i] + a * I[dvb][i]) * scl;
        }
        const bf16* og = pg + (unsigned)((wave * 32 + r) * NP + 2 * MW + 4 * hh);
        float ss = 0.f;
#pragma unroll
        for (int dvb = 0; dvb < 2; ++dvb)
#pragma unroll
            for (int g = 0; g < 4; ++g) { const u32x2 ov = *(const u32x2*)(og + dvb * 32 + 8 * g);
                const float o0 = bfl(ov[0]), o1 = bfh(ov[0]), o2 = bfl(ov[1]), o3 = bfh(ov[1]);
                float v0 = hs[dvb][4 * g] * rcp_f(1.0f + exp_f(-o0)), v1 = hs[dvb][4 * g + 1] * rcp_f(1.0f + exp_f(-o1)), v2 = hs[dvb][4 * g + 2] * rcp_f(1.0f + exp_f(-o2)), v3 = hs[dvb][4 * g + 3] * rcp_f(1.0f + exp_f(-o3));
                hs[dvb][4 * g] = v0; hs[dvb][4 * g + 1] = v1; hs[dvb][4 * g + 2] = v2; hs[dvb][4 * g + 3] = v3; ss += (v0 * v0 + v1 * v1) + (v2 * v2 + v3 * v3); }
        ss += xl32(ss, lane);
        const float rstd = 1.0f / sqrtf(ss / (float)MD + EPS);
        const float* ng = p.ml_norm_g + l * MW + h * MD + 4 * hh; bf16* op = wH(p.ws) + (r0 + wave * 32 + r) * D + AW + h * MD + 4 * hh;
#pragma unroll
        for (int dvb = 0; dvb < 2; ++dvb)
#pragma unroll
            for (int g = 0; g < 4; ++g) { const f32x4 gg = *(const f32x4*)(ng + dvb * 32 + 8 * g); u32x2 w;
                w[0] = pk(hs[dvb][4 * g] * rstd * gg[0], hs[dvb][4 * g + 1] * rstd * gg[1]); w[1] = pk(hs[dvb][4 * g + 2] * rstd * gg[2], hs[dvb][4 * g + 3] * rstd * gg[3]);
                *(u32x2*)(op + dvb * 32 + 8 * g) = w; }
        __syncthreads();
    }
}
}
#endif
#ifndef HOST_EMU
#define XB_TMO      128
#define XB_XCNT(j)  (256  + 64 * (j))
#define XB_XSUB(j)  (1280 + 64 * (j))
#define XB_XGEN(j)  (2304 + 64 * (j))
#define XB_TOP      3328
#define XB_TOPGEN   3392
#define XCD_BAR_WORDS 3456
#define XB_SPIN_CAP (1u << 18)

__device__ __forceinline__ unsigned xb_ld(unsigned* p)              { return __hip_atomic_load(p, __ATOMIC_RELAXED, __HIP_MEMORY_SCOPE_AGENT); }
__device__ __forceinline__ unsigned xb_add(unsigned* p, unsigned v) { return __hip_atomic_fetch_add(p, v, __ATOMIC_RELAXED, __HIP_MEMORY_SCOPE_AGENT); }
__device__ __forceinline__ unsigned xb_xcc_id() { return (unsigned)__builtin_amdgcn_s_getreg((3 << 11) | 20) & 0xFu; }
#define XB_SPIN(cond, bar) do { unsigned _sp = 0; while (cond) { __builtin_amdgcn_s_sleep(1); \
    if ((++_sp & 255u) == 0u) { if (xb_ld(&(bar)[XB_TMO])) break; if (_sp > XB_SPIN_CAP) { atomicAdd(&(bar)[XB_TMO], 1u); break; } } } } while (0)

struct XcdBarrier { unsigned* bar; unsigned x; volatile LAS unsigned* st; };

__device__ __forceinline__ XcdBarrier xcd_barrier_post(unsigned* bar, volatile LAS unsigned* st) {
    XcdBarrier b; b.bar = bar; b.x = xb_xcc_id(); b.st = st;
    if (threadIdx.x == 0) (void)xb_add(&bar[XB_XCNT(b.x)], 1u);
    return b;
}
__device__ __forceinline__ void xcd_barrier_complete(unsigned* bar, unsigned x, unsigned& nloc, unsigned& nx) {
    const unsigned G = gridDim.x * gridDim.y * gridDim.z;
    unsigned sum, cnt, mine, sp = 0u;
    for (;;) {
        sum = 0u; cnt = 0u; mine = 0u;
#pragma unroll
        for (unsigned j = 0; j < 16; ++j) { const unsigned c = xb_ld(&bar[XB_XCNT(j)]); sum += c; cnt += (c > 0u) ? 1u : 0u; mine = (j == x) ? c : mine; }
        if (sum == G) break;
        __builtin_amdgcn_s_sleep(1);
        if ((++sp & 255u) == 0u) { if (xb_ld(&bar[XB_TMO])) break; if (sp > XB_SPIN_CAP) { atomicAdd(&bar[XB_TMO], 1u); break; } }
    }
    nloc = mine > 0u ? mine : 1u; nx = cnt > 0u ? cnt : 1u;
}
__device__ __forceinline__ void xcd_barrier(const XcdBarrier& b) {
    asm volatile("s_waitcnt vmcnt(0)" ::: "memory");
    __syncthreads();
    if (threadIdx.x == 0) {
        unsigned* bar = b.bar;
        __builtin_amdgcn_s_waitcnt(0);
        unsigned nloc = b.st[0], nx = b.st[1];
        if (nloc == 0u) { xcd_barrier_complete(bar, b.x, nloc, nx); b.st[0] = nloc; b.st[1] = nx; }
        const unsigned old = xb_add(&bar[XB_XSUB(b.x)], 1u);
        const unsigned gen = old / nloc;
        if (old + 1u == (gen + 1u) * nloc) {
            __builtin_amdgcn_fence(__ATOMIC_RELEASE, "agent");
            asm volatile("s_waitcnt vmcnt(0)" ::: "memory");
            const unsigned og = xb_add(&bar[XB_TOP], 1u);
            const unsigned tg = og / nx;
            if (og + 1u == (tg + 1u) * nx) xb_add(&bar[XB_TOPGEN], 1u);
            else XB_SPIN(xb_ld(&bar[XB_TOPGEN]) == tg, bar);
            __builtin_amdgcn_fence(__ATOMIC_ACQUIRE, "agent");
            xb_add(&bar[XB_XGEN(b.x)], 1u);
            asm volatile("s_waitcnt vmcnt(0)" ::: "memory");
        } else {
            XB_SPIN(xb_ld(&bar[XB_XGEN(b.x)]) == gen, bar);
            __builtin_amdgcn_fence(__ATOMIC_ACQUIRE, "agent");
            asm volatile("s_waitcnt vmcnt(0)" ::: "memory");
        }
    }
    __syncthreads();
}
#endif

constexpr int UPT = (R + 253) / 254;
constexpr int LDS_BYTES = 163840;

#ifdef HOST_EMU
#define ATT_PHASE(l) RUN(PH_ATT, l, 0)
#define NORM1_PHASE(l) RUN(PH_NORM1, l, 0)
#define MOD_PHASE() RUN(PH_MOD, 0, 0)
#define FILT_B_PHASE(l) RUN(PH_FILT_B, l, 0)
#define FILT_C_PHASE(l) RUN(PH_FILT_C, l, 0)
#define ML_B_PHASE(l) RUN(PH_ML_B, l, 0)
#define ML_O_PHASE(l) RUN(PH_ML_O, l, 0)
#define NORM2_PHASE(l) RUN(PH_NORM2, l, 0)
#define FINAL_PHASE() RUN(PH_FINAL, 0, 0)
#define MLA_A_PHASE(l) RUN(PH_MLA_A, l, 0)
#define ML_F_PHASE(l) RUN(PH_ML_F, l, 0)
#define FILT_D_PHASE(l) RUN(PH_FILT_D, l, 0)
#define ML_S_PHASE(l) RUN(PH_ML_S, l, 0)
#define GEMM_GEMM1(l) RUN(PH_GEMM1, l, 0)
#define GEMM_Q(l) RUN(PH_MLA_Q, l, 0)
#define GEMM_KV(l) RUN(PH_MLA_KV, l, 0)
#define GEMM_MLQK(l) RUN(PH_ML_QK, l, 0)
#define GEMM_OUT(l) RUN(PH_GEMM_OUT, l, 0)
#else
#define KARG() const Params __attribute__((address_space(4)))* kp_ = (const Params __attribute__((address_space(4)))*)__builtin_amdgcn_kernarg_segment_ptr(); asm volatile("" : "+s"(kp_)); PRef p = *kp_
#define LAT_ 0
#define GEMM_LAT(l, EPI, A_, lda_, Bt_, ldb_, N_, K_, rot, ...) do { KARG(); const int lat_ = ((l) == DEPTH - 1) && (SEQ % 256 == 0) && (CTX % 256 == 0); pg8::Gemm g_{(const bf16*)(A_), (const bf16*)(Bt_), lda_, ldb_, lat_ ? B * SEQ : R, N_, K_, 256}; \
    pg8::StaticOrder S_; S_.init(lat_ ? B * SEQ : R, N_, NBLOCKS, ((int)blockIdx.x + (rot)) % NBLOCKS, lat_); pg8::EPI E_{__VA_ARGS__}; pg8::gemm_phase<pg8::EPI, pg8::StaticOrder, true, true>((LAS unsigned char*)lds, g_, S_, E_); } while (0)
#define GEMM_CALL(EPI, A_, lda_, Bt_, ldb_, M_, N_, K_, rot, ...) GEMM_CALLX(true, EPI, A_, lda_, Bt_, ldb_, M_, N_, K_, rot, __VA_ARGS__)
#define GEMM_CALLX(SP2_, EPI, A_, lda_, Bt_, ldb_, M_, N_, K_, rot, ...) do { KARG(); pg8::Gemm g_{(const bf16*)(A_), (const bf16*)(Bt_), lda_, ldb_, M_, N_, K_, 256}; pg8::StaticOrder S_; S_.init(M_, N_, NBLOCKS, ((int)blockIdx.x + (rot)) % NBLOCKS, LAT_); \
    pg8::EPI E_{__VA_ARGS__}; pg8::gemm_phase<pg8::EPI, pg8::StaticOrder, true, SP2_>((LAS unsigned char*)lds, g_, S_, E_); } while (0)
#define ATT_PHASE(l) do { KARG(); att::attn_phase(p, l, (LAS unsigned char*)lds); } while (0)
#define NORM1_PHASE(l) do { KARG(); wv::norm_rows<0>(p, l); } while (0)
#define MOD_PHASE() do { KARG(); wv::mod_block(p, (LAS unsigned char*)lds); } while (0)
#define FILT_B_PHASE(l) do { KARG(); wv::filt_b_block(p, l, (LAS unsigned char*)lds); } while (0)
#define FILT_C_PHASE(l) do { KARG(); wv::filt_c_block(p, l, (LAS unsigned char*)lds); } while (0)
#define ML_B_PHASE(l) do { KARG(); mlk::ml_b_phase(p, (LAS unsigned char*)lds); } while (0)
#define ML_O_PHASE(l) do { KARG(); mlk::ml_o_phase(p, l, (LAS unsigned char*)lds); } while (0)
#define NORM2_PHASE(l) do { KARG(); wv::norm_rows<1>(p, l); } while (0)
#define FINAL_PHASE() do { KARG(); wv::norm_rows<2>(p, 0); } while (0)
#define MLA_A_PHASE(l) do { KARG(); wv::mla_a_rows(p); } while (0)
#define ML_F_PHASE(l) do { KARG(); wv::ml_f_rows(p, l); } while (0)
#define FILT_D_PHASE(l) do { KARG(); wv::filt_d_rows(p); } while (0)
#define ML_S_PHASE(l) do { KARG(); wv::ml_s_scan(p); } while (0)
#define GEMM_GEMM1(l) GEMM_CALL(EpiBf16, wH(p.ws), D, wWinT(p.ws, l), D, R, NP, D, 0, wP(p.ws), NP, nullptr, 0)
#define GEMM_Q(l) GEMM_CALL(EpiBf16, wP(p.ws), NP, wWuqT(p.ws, l), QR, R, QW, QR, 0, wQ(p.out), QW, wRS(p.ws), 1)
#define GEMM_KV(l) do { GEMM_CALL(EpiBf16, wP(p.ws) + QR, NP, wWukvT(p.ws, l), KVR, R, AW, KVR, (R / 256 * (QW / 256)) % NBLOCKS, wKN(p.out), AW, wRS(p.ws) + R, 1); \
    GEMM_CALLX(false, EpiVT, wWukvT(p.ws, l) + (size_t)AW * KVR, KVR, wP(p.ws) + QR, NP, AW, R, KVR, (R / 256 * ((QW + AW) / 256)) % NBLOCKS, wVT(p.out), wRS(p.ws) + R); } while (0)
#define GEMM_MLQK(l) GEMM_CALL(EpiBf16, wMU(p.ws), MW, wWML(p.ws), MW, R, 2 * MW, MW, (R / 256 * ((QW + 2 * AW) / 256)) % NBLOCKS, wMQK(p.ws), 2 * MW, nullptr, 0)
#define GEMM_OUT(l) GEMM_LAT(l, EpiResid, wH(p.ws), D, wWoutT(p.ws, l), D, D, D, 0, wX(p.ws), wMOD(p.ws) + (size_t)(l) * (B + 1) * 6 * D + 2 * D, nullptr, DRY_)
#define GEMM_UP(l) do { KARG(); pg8::Gemm g_{(const bf16*)(wH(p.ws) - D), (const bf16*)wWupT(p.ws, l), D, D, UPT * 256, FF2, D, 254}; pg8::StaticOrder S_; S_.init(UPT * 256, FF2, NBLOCKS, (int)blockIdx.x); \
    pg8::EpiConvGate E_{wGF(p.ws), p.ffn_conv_w + (size_t)(l) * 3 * FF2, p.ffn_conv_b + (size_t)(l) * FF2, (LAS unsigned char*)lds + pg8::STAGE_BYTES}; pg8::gemm_phase<pg8::EpiConvGate, pg8::StaticOrder, true, true>((LAS unsigned char*)lds, g_, S_, E_); } while (0)
#define GEMM_DOWN(l) GEMM_LAT(l, EpiResid, wGF(p.ws), FF, wWdownT(p.ws, l), FF, D, FF, 0, wX(p.ws), wMOD(p.ws) + (size_t)(l) * (B + 1) * 6 * D + 5 * D, nullptr, DRY_)
#endif
#ifdef HOST_EMU
#define GRID_BAR() do {} while (0)
#define FILL_W(ln, busy, i0, i1, filt) do { const int i0_ = (i0), i1_ = (i1); emu_block_launch(i1_ - i0_, [&](int blk, unsigned char* smem) { bphase<BPH_WCVT>(p, ln, i0_ + blk, smem); }); if (filt) RUN(PH_FILT_A, ln, 0); } while (0)
#define RUN(PH, l, arg) emu_launch([&](long gtid, long gth) { phase<PH>(p, l, arg, gtid, gth); })
#define BRUN(BPH, l, nblk) emu_block_launch(nblk, [&](int blk, unsigned char* smem) { bphase<BPH>(p, l, blk, smem); })
#define BRUN_OFF(BPH, l, nblk, busy) BRUN(BPH, l, nblk)
static void fwd(const Params& p) {
#else
#define GRID_BAR() xcd_barrier(bar)
#define DRY_ 0
#define BRUN(BPH, l, nblk) do { KARG(); for (int blk_ = blockIdx.x; blk_ < (nblk); blk_ += NBLOCKS) bphase<BPH>(p, l, blk_, (LdsPtr)lds); } while (0)
#define BRUN_OFF(BPH, l, nblk, busy) do { KARG(); const int busy_ = (busy); if ((int)blockIdx.x >= busy_) for (int blk_ = (int)blockIdx.x - busy_; blk_ < (nblk); blk_ += NBLOCKS - busy_) bphase<BPH>(p, l, blk_, (LdsPtr)lds); } while (0)
#define FILL_W(ln, busy, i0, i1, filt) do { KARG(); const int busy_ = (busy), nf_ = NBLOCKS - busy_, i1_ = (i1); __syncthreads(); if ((int)blockIdx.x >= busy_) { for (int blk_ = (i0) + (int)blockIdx.x - busy_; blk_ < i1_; blk_ += nf_) bphase<BPH_WCVT>(p, ln, blk_, (LdsPtr)lds); \
    if (filt) { int t_ = threadIdx.x; asm volatile("" : "+v"(t_)); phase<PH_FILT_A>(p, ln, 0, (long)((int)blockIdx.x - busy_) * NTHREADS + t_, (long)nf_ * NTHREADS); } } } while (0)
#define RUN(PH, l, arg) do { KARG(); int t_ = threadIdx.x; asm volatile("" : "+v"(t_)); const int g_ = blockIdx.x * NTHREADS + t_; phase<PH>(p, l, arg, (long)g_, gth); } while (0)
__global__ void __launch_bounds__(NTHREADS, 2) fwd(Params p_unused) {
    extern __shared__ __attribute__((aligned(16))) unsigned char lds[];
    if (threadIdx.x < 4) ((LAS unsigned*)lds)[(LDS_BYTES - 16) / 4 + threadIdx.x] = 0u;
    __syncthreads();
    XcdBarrier bar; { KARG(); bar = xcd_barrier_post(wctl(p.ws) + 1024, (volatile LAS unsigned*)(lds + LDS_BYTES - 16)); }
    constexpr long gth = (long)NBLOCKS * NTHREADS;
#endif
    MOD_PHASE(); RUN(PH_ROPE, 0, 0);
    GRID_BAR();
    RUN(PH_MOD2, 0, 0);
    for (int hs = 0; hs <= 2 * DEPTH; ++hs) {
        const int l = (hs - 1) >> 1;
        if (hs >= 1 && (hs & 1)) {
            NORM1_PHASE(l); FILT_B_PHASE(l);
            GRID_BAR();
            GEMM_GEMM1(l); FILT_C_PHASE(l);
            GRID_BAR();
            MLA_A_PHASE(l); if (l < DEPTH - 1) RUN(PH_HY_Z, l, 0); BRUN(BPH_HYZ, l, B * (SEQ / 64)); FILT_D_PHASE(l); RUN(PH_ML_U, l, 0); ML_F_PHASE(l);
            GRID_BAR();
            GEMM_Q(l); GEMM_KV(l); GEMM_MLQK(l); BRUN(BPH_HFFT, l, HW); if (l < DEPTH - 1) BRUN(BPH_HYCTX, l, B * (HW / 8));
            GRID_BAR();
            ATT_PHASE(l); ML_B_PHASE(l);
            GRID_BAR();
            ML_S_PHASE(l); BRUN(BPH_HYFFT, l, HW);
            GRID_BAR();
            ML_O_PHASE(l); BRUN_OFF(BPH_HYOUT, l, B * (SEQ / 64), l < DEPTH - 1 ? (B * MH * SCN) % NBLOCKS : 0);
            GRID_BAR();
            GEMM_OUT(l);
        }
        if (hs >= 2 && !(hs & 1)) {
            NORM2_PHASE(l);
            GRID_BAR();
#ifdef HOST_EMU
            for (int fcI = 0; fcI < NFC; ++fcI) { RUN(PH_FFN_UP, l, fcI); RUN(PH_FFN_CG, l, fcI); RUN(PH_FFN_DOWN, l, fcI); }
#else
            GEMM_UP(l);
            GRID_BAR();
            GEMM_DOWN(l);
#endif
        }
        {
            int fl = 0, busy = 0, i0 = 0, i1 = 0, filt = 0;
            if (hs == 0) { i1 = WT_SPLIT; filt = 1; }
            else if (hs == 1) { busy = DOWN_BUSY; i0 = WT_SPLIT; i1 = WT_ITEMS; }
            else if (!(hs & 1) && (hs >> 1) < DEPTH) { fl = hs >> 1; busy = DOWN_BUSY; i1 = WT_ITEMS; filt = 1; }
            else if ((hs & 1) && hs > 1) {   }
            FILL_W(fl, busy, i0, i1, filt);
        }
        GRID_BAR();
    }
    FINAL_PHASE();
}

extern "C" void kernel_launch(void* const* d_in, const int* in_sizes, int n_in, void* d_out, int out_size, void* d_ws, size_t ws_size, hipStream_t stream) {
    (void)in_sizes; (void)n_in; (void)out_size; (void)ws_size;
    Params p{};
    const float* const* in = (const float* const*)d_in;
    p.x = in[0]; p.c = in[1]; p.ctx = in[2]; p.c_ctx = in[3]; p.ada_w = in[4]; p.ada_b = in[5]; p.norm1_g = in[6]; p.norm2_g = in[7]; p.w_in = in[8];
    p.q_norm_g = in[9]; p.kv_norm_g = in[10]; p.w_uq = in[11]; p.w_ukv = in[12]; p.ml_conv_w = in[13]; p.ml_conv_b = in[14]; p.ml_wq = in[15]; p.ml_wk = in[16];
    p.ml_gate_b = in[17]; p.ml_norm_g = in[18]; p.hy_conv_w = in[19]; p.hy_conv_b = in[20]; p.hy_w1 = in[21]; p.hy_b1 = in[22]; p.hy_w2 = in[23]; p.hy_b2 = in[24];
    p.hy_w3 = in[25]; p.hy_freq = in[26]; p.hy_bias_d = in[27]; p.w_out = in[28]; p.w_up = in[29]; p.ffn_conv_w = in[30]; p.ffn_conv_b = in[31]; p.w_down = in[32]; p.final_g = in[33];
    p.out = (float*)d_out;
    p.ws = (char*)d_ws;
#ifdef HOST_EMU
    fwd(p);
#else
    static int grid = 0;
    if (grid == 0) {
        int dev = 0, cus = 0;
        if (hipGetDevice(&dev) != hipSuccess || hipDeviceGetAttribute(&cus, hipDeviceAttributeMultiprocessorCount, dev) != hipSuccess) { grid = -1; return; }
        if (hipFuncSetAttribute((const void*)fwd, hipFuncAttributeMaxDynamicSharedMemorySize, LDS_BYTES) != hipSuccess) { grid = -1; return; }
        int per_cu = 0;
        (void)hipOccupancyMaxActiveBlocksPerMultiprocessor(&per_cu, (const void*)fwd, NTHREADS, LDS_BYTES);
        (void)hipGetLastError();
        grid = (cus >= NBLOCKS) ? NBLOCKS : -1;
    }
    if (grid < 0) return;
    (void)hipMemsetAsync(d_ws, 0, CTL_BYTES, stream);
    hipLaunchKernelGGL(fwd, dim3(grid), dim3(NTHREADS), LDS_BYTES, stream, p);
#endif
}
```

```cpp
#ifndef HOST_EMU
#include <hip/hip_runtime.h>
#endif
#include <stdint.h>
#include <math.h>

#ifndef CFG_D_MODEL
#define CFG_D_MODEL 1024
#define CFG_BATCH 8
#define CFG_SEQ 4096
#define CFG_CTX 256
#define CFG_SCS 256
#define CFG_NFC 4
#endif

#define DEV __device__ __forceinline__

namespace cfg {
constexpr int D = CFG_D_MODEL, B = CFG_BATCH, SEQ = CFG_SEQ, CTX = CFG_CTX, DEPTH = 2, GRID_W = 64;
constexpr int RPB = CTX + SEQ;
constexpr int R = B * RPB;
constexpr float EPS = 1e-6f;
constexpr int AH = D / 128, NOPE = 64, ROPE = 32, AV = 64, QR = 3 * D / 8, KVR = D / 4, AW = AH * AV;
constexpr int QW = AH * (NOPE + ROPE);
constexpr int KVW = AH * (NOPE + AV);
constexpr int MH = 4, MD = D / 16, MW = MH * MD;
constexpr int HW = D / 4, HB = 16, HE = 33, HH = 64;
constexpr int N_MLA = QR + KVR + ROPE, N_ML = 3 * MW + 4 * MH, N_HY = 3 * HW, N_IN = N_MLA + N_ML + N_HY;
constexpr int ML_LO = N_MLA, HY_LO = N_MLA + N_ML;
constexpr int NP = (N_IN + 255) / 256 * 256;
constexpr int FF = ((8 * D / 3 + 255) / 256) * 256, FF2 = 2 * FF;
constexpr int SCS = CFG_SCS;
constexpr int SCN = RPB / SCS, NCS = CTX / SCS;
constexpr int NFC = CFG_NFC;
constexpr int FCR = (B / NFC) * RPB;
static_assert(CTX % SCS == 0 && SEQ % SCS == 0, "super-chunk must divide ctx and seq");
static_assert(B % NFC == 0, "ffn chunks");
static_assert(MD == 64 || MD == 16, "mlstm head dim");
}
using namespace cfg;
constexpr int NTHREADS = 512, NBLOCKS = 256;

typedef unsigned short bf16;
struct alignas(16) U4 { unsigned x, y, z, w; };
struct alignas(8) U2 { unsigned x, y; };

DEV float u2f(unsigned u) { union { unsigned u; float f; } c; c.u = u; return c.f; }
DEV unsigned f2u(float f) { union { unsigned u; float f; } c; c.f = f; return c.u; }
DEV float bf2f(bf16 v) { return u2f(((unsigned)v) << 16); }
DEV bf16 f2bf(float f) { unsigned u = f2u(f); u += 0x7FFFu + ((u >> 16) & 1u); return (bf16)(u >> 16); }
DEV float bflo(unsigned w) { return u2f(w << 16); }
DEV float bfhi(unsigned w) { return u2f(w & 0xFFFF0000u); }
#ifdef HOST_EMU
DEV float sin_f(float x) { return sinf(x); }
DEV float cos_t(float turns) { return cosf(6.283185307179586f * turns); }
DEV float sin_t(float turns) { return sinf(6.283185307179586f * turns); }
#else
DEV float sin_f(float x) { return __builtin_amdgcn_sinf(__builtin_amdgcn_fractf(x * 0.15915494309189535f)); }
DEV float cos_t(float turns) { return __builtin_amdgcn_cosf(turns); }
DEV float sin_t(float turns) { return __builtin_amdgcn_sinf(turns); }
#endif
#ifdef HOST_EMU
DEV float exp_f(float x) { return expf(x); }
DEV float log1p_f(float y) { return log1pf(y); }
#else
DEV float exp_f(float x) { return __builtin_amdgcn_exp2f(x * 1.4426950408889634f); }
DEV float log1p_f(float y) { return __builtin_amdgcn_logf(1.0f + y) * 0.6931471805599453f; }
#endif
#ifdef HOST_EMU
DEV float rcp_f(float x) { return 1.0f / x; }
#else
DEV float rcp_f(float x) { return __builtin_amdgcn_rcpf(x); }
#endif
DEV float silu_f(float x) { return x * rcp_f(1.0f + exp_f(-x)); }
DEV float sigmoid_f(float x) { return rcp_f(1.0f + exp_f(-x)); }
DEV float logsigmoid_f(float x) { return x >= 0.f ? -log1p_f(exp_f(-x)) : x - log1p_f(exp_f(x)); }
DEV float dot8(const U4& a, const U4& b) {
    return bflo(a.x) * bflo(b.x) + bfhi(a.x) * bfhi(b.x) + bflo(a.y) * bflo(b.y) + bfhi(a.y) * bfhi(b.y) +
           bflo(a.z) * bflo(b.z) + bfhi(a.z) * bfhi(b.z) + bflo(a.w) * bflo(b.w) + bfhi(a.w) * bfhi(b.w);
}

constexpr size_t CTL_BYTES = 65536;
constexpr size_t al256(size_t x) { return (x + 255) & ~(size_t)255; }
constexpr size_t OFF_ctl = 0, SZ_ctl = al256(CTL_BYTES);
constexpr size_t OFF_X = OFF_ctl + SZ_ctl, SZ_X = al256((size_t)R * D * 2);
constexpr size_t OFF_H = OFF_X + SZ_X, SZ_H = al256((size_t)R * D * 2);
constexpr size_t OFF_MOD = OFF_H + SZ_H, SZ_MOD = al256((size_t)DEPTH * (B + 1) * 6 * D * 4);
constexpr size_t OFF_MODP = OFF_MOD + SZ_MOD, SZ_MODP = al256((size_t)8 * DEPTH * (B + 1) * 6 * D * 4);
constexpr size_t OFF_ROPET = OFF_MODP + SZ_MODP, SZ_ROPET = al256((size_t)SEQ * 16 * 2 * 4);
constexpr size_t OFF_WinT = OFF_ROPET + SZ_ROPET, SZ_WinT = al256((size_t)NP * D * 2);
constexpr size_t OFF_WuqT = OFF_WinT + SZ_WinT, SZ_WuqT = al256((size_t)QW * QR * 2);
constexpr size_t OFF_WukvT = OFF_WuqT + SZ_WuqT, SZ_WukvT = al256((size_t)KVW * KVR * 2);
constexpr size_t OFF_WoutT = OFF_WukvT + SZ_WukvT, SZ_WoutT = al256((size_t)D * D * 2);
constexpr size_t OFF_WupT = OFF_WoutT + SZ_WoutT, SZ_WupT = al256((size_t)FF2 * D * 2);
constexpr size_t OFF_WdownT = OFF_WupT + SZ_WupT, SZ_WdownT = al256((size_t)D * FF * 2);
constexpr size_t OFF_HD1 = OFF_WdownT + SZ_WdownT, SZ_HD1 = al256((size_t)2 * SEQ * HH * 4);
constexpr size_t OFF_HD2 = OFF_HD1 + SZ_HD1, SZ_HD2 = al256((size_t)2 * SEQ * HH * 4);
constexpr size_t OFF_FT = OFF_HD2 + SZ_HD2, SZ_FT = al256((size_t)2 * HW * SEQ * 4);
constexpr size_t OFF_FT1 = OFF_FT + SZ_FT, SZ_FT1 = al256((size_t)CTX * 2 * HW * 4);
constexpr size_t OFF_FL1 = OFF_FT1 + SZ_FT1, SZ_FL1 = al256((size_t)2 * HW * 64 * 4);
constexpr size_t OFF_HSPEC = OFF_FL1 + SZ_FL1, SZ_HSPEC = al256((size_t)HW * 2 * SEQ * 8);
constexpr size_t OFF_P = OFF_HSPEC + SZ_HSPEC, SZ_P = al256((size_t)R * NP * 2);
constexpr size_t OFF_KR = OFF_P + SZ_P, SZ_KR = al256((size_t)R * ROPE * 2);
constexpr size_t OFF_RS = OFF_KR + SZ_KR, SZ_RS = al256((size_t)R * 2 * 4);
constexpr size_t OFF_MQK = OFF_RS + SZ_RS, SZ_MQK = al256((size_t)R * 2 * MW * 2);
constexpr size_t OFF_WML = OFF_MQK + SZ_MQK, SZ_WML = al256((size_t)2 * MW * MW * 2);
constexpr size_t OFF_FG = OFF_WML + SZ_WML, SZ_FG = al256((size_t)R * 2 * MH * 2 * 4);
constexpr size_t OFF_MS = OFF_FG + SZ_FG, SZ_MS = al256((size_t)B * MH * 2 * SCN * (MD + 1) * MD * 4);
constexpr size_t OFF_Z = OFF_MS + SZ_MS, SZ_Z = al256((size_t)B * CTX * HW * 4);
constexpr size_t OFF_ZT = OFF_Z + SZ_Z, SZ_ZT = al256((size_t)B * HW * SEQ * 2);
#ifdef HOST_EMU
constexpr size_t OFF_UF = OFF_P, SZ_UF = al256((size_t)FCR * FF2 * 2), OFF_GF = OFF_UF + SZ_UF, SZ_GF = al256((size_t)FCR * FF * 2);
#else
constexpr size_t OFF_UF = OFF_P, SZ_UF = 0, OFF_GF = OFF_P, SZ_GF = al256((size_t)R * FF * 2);
#endif
constexpr size_t WS_BASE = (OFF_ZT + SZ_ZT) > (OFF_GF + SZ_GF) ? (OFF_ZT + SZ_ZT) : (OFF_GF + SZ_GF);
constexpr size_t OFF_WSET1 = WS_BASE, SZ_WSET = OFF_HD1 - OFF_WinT, WSET_STRIDE = OFF_WSET1 - OFF_WinT;
constexpr size_t WS_NEED = OFF_WSET1 + SZ_WSET;
static_assert(WS_NEED <= (size_t)536870912 || D != 1024, "workspace");
constexpr size_t OFF_Q = 0, OFF_KN = al256((size_t)R * QW * 2), OFF_VT = OFF_KN + al256((size_t)R * AW * 2);
static_assert(OFF_VT + (size_t)R * AW * 2 <= (size_t)B * SEQ * D * 4 || D != 1024, "d_out scratch");
struct Params {
    const float *x, *c, *ctx, *c_ctx, *ada_w, *ada_b, *norm1_g, *norm2_g, *w_in, *q_norm_g, *kv_norm_g, *w_uq, *w_ukv;
    const float *ml_conv_w, *ml_conv_b, *ml_wq, *ml_wk, *ml_gate_b, *ml_norm_g;
    const float *hy_conv_w, *hy_conv_b, *hy_w1, *hy_b1, *hy_w2, *hy_b2, *hy_w3, *hy_freq, *hy_bias_d;
    const float *w_out, *w_up, *ffn_conv_w, *ffn_conv_b, *w_down, *final_g;
    float* out;
    char* ws;
};

DEV unsigned* wctl(char* ws) { return (unsigned*)(ws + OFF_ctl); }
DEV bf16* wX(char* ws) { return (bf16*)(ws + OFF_X); }
DEV bf16* wH(char* ws) { return (bf16*)(ws + OFF_H); }
DEV float* wMOD(char* ws) { return (float*)(ws + OFF_MOD); }
DEV float* wROPET(char* ws) { return (float*)(ws + OFF_ROPET); }
DEV bf16* wWinT(char* ws, int l) { return (bf16*)(ws + OFF_WinT + (size_t)(l & 1) * WSET_STRIDE); }
DEV bf16* wWuqT(char* ws, int l) { return (bf16*)(ws + OFF_WuqT + (size_t)(l & 1) * WSET_STRIDE); }
DEV bf16* wWukvT(char* ws, int l) { return (bf16*)(ws + OFF_WukvT + (size_t)(l & 1) * WSET_STRIDE); }
DEV bf16* wWoutT(char* ws, int l) { return (bf16*)(ws + OFF_WoutT + (size_t)(l & 1) * WSET_STRIDE); }
DEV bf16* wWupT(char* ws, int l) { return (bf16*)(ws + OFF_WupT + (size_t)(l & 1) * WSET_STRIDE); }
DEV bf16* wWdownT(char* ws, int l) { return (bf16*)(ws + OFF_WdownT + (size_t)(l & 1) * WSET_STRIDE); }
DEV float* wHD1(char* ws) { return (float*)(ws + OFF_HD1); }
DEV float* wHD2(char* ws) { return (float*)(ws + OFF_HD2); }
DEV float* wFT(char* ws) { return (float*)(ws + OFF_FT); }
DEV float* wFL1(char* ws) { return (float*)(ws + OFF_FL1); }
DEV float* wMODP(char* ws) { return (float*)(ws + OFF_MODP); }
DEV float* wFT1(char* ws) { return (float*)(ws + OFF_FT1); }
DEV bf16* wZT(char* ws) { return (bf16*)(ws + OFF_ZT); }
struct alignas(8) C2 { float x, y; };
DEV C2* wHSPEC(char* ws) { return (C2*)(ws + OFF_HSPEC); }
DEV bf16* wP(char* ws) { return (bf16*)(ws + OFF_P); }
DEV bf16* wKR(char* ws) { return (bf16*)(ws + OFF_KR); }
DEV float* wRS(char* ws) { return (float*)(ws + OFF_RS); }
DEV bf16* wMQK(char* ws) { return (bf16*)(ws + OFF_MQK); }
DEV bf16* wWML(char* ws) { return (bf16*)(ws + OFF_WML); }
DEV bf16* wMU(char* ws) { return (bf16*)(ws + OFF_MS); }
static_assert((size_t)R * MW * 2 <= SZ_MS, "MU aliases MS");
DEV float* wFG(char* ws) { return (float*)(ws + OFF_FG); }
DEV float* wMS(char* ws) { return (float*)(ws + OFF_MS); }
DEV float* wZ(char* ws) { return (float*)(ws + OFF_Z); }
DEV bf16* wUF(char* ws) { return (bf16*)(ws + OFF_UF); }
DEV bf16* wGF(char* ws) { return (bf16*)(ws + OFF_GF); }
DEV bf16* wQ(float* out) { return (bf16*)((char*)out + OFF_Q); }
DEV bf16* wKN(float* out) { return (bf16*)((char*)out + OFF_KN); }
DEV bf16* wVT(float* out) { return (bf16*)((char*)out + OFF_VT); }

#ifdef HOST_EMU
typedef const Params& PRef;
#else
typedef const Params __attribute__((address_space(4)))& PRef;
#endif

struct RowI { int b, o, t, bi; bool ctx; };
DEV RowI rowinfo(int r) { RowI i; i.b = r / RPB; i.o = r % RPB; i.ctx = i.o < CTX; i.t = i.ctx ? i.o : i.o - CTX; i.bi = i.ctx ? B : i.b; return i; }
DEV int swap23(int o) { return (o & 3) | ((o & 4) << 1) | ((o & 8) >> 1); }
DEV int vperm32(int o) { return (o & 3) | (((o >> 4) & 1) << 2) | (((o >> 2) & 3) << 3); }
DEV bool has_prev(const RowI& i) { return i.t > 0; }
DEV bool has_next(const RowI& i) { return i.t + 1 < (i.ctx ? CTX : SEQ); }

enum { PH_MOD, PH_MOD2, PH_ROPE, PH_FILT_A, PH_FILT_B, PH_FILT_C, PH_FILT_D, PH_NORM1, PH_GEMM1, PH_MLA_A, PH_MLA_Q, PH_MLA_KV, PH_ATT,
       PH_ML_U, PH_ML_QK, PH_ML_F, PH_ML_B, PH_ML_S, PH_ML_O, PH_HY_Z, PH_HY_O, PH_GEMM_OUT, PH_NORM2, PH_FFN_UP, PH_FFN_CG, PH_FFN_DOWN, PH_FINAL };

DEV float dot_bf16(const bf16* a, const bf16* b, int K) {
    float acc = 0.f;
    for (int k = 0; k < K; k += 8) { const U4 av = *(const U4*)(a + k), bv = *(const U4*)(b + k); acc += dot8(av, bv); }
    return acc;
}


#ifndef HOST_EMU
namespace pg8 {
#define PG8_LAS __attribute__((address_space(3)))
typedef unsigned short bf16_t;
typedef short bf16x8 __attribute__((ext_vector_type(8)));
typedef float f32x4 __attribute__((ext_vector_type(4)));
typedef unsigned u32x4 __attribute__((ext_vector_type(4)));
constexpr int BM = 256, BK = 64, HALF = 128, HTB = HALF * BK * 2  , STAGE_BYTES = 8 * HTB, NXCD = 8, WGM = 8;

__host__ __device__ __forceinline__ int lds_byte(int r, int c) { const int st = (r >> 4) * 2 + (c >> 5), rr = r & 15, cc = c & 31, ob = rr * 64 + cc * 2; return st * 1024 + (ob ^ (((ob >> 9) & 1) << 5)); }
__host__ __device__ __forceinline__ void stage_rc(int b, int& R, int& C) { const int st = b / 1024, sb = b % 1024, swz = sb ^ (((sb >> 9) & 1) << 5); R = (st >> 1) * 16 + swz / 64; C = (st & 1) * 32 + (swz % 64) / 2; }
__host__ __device__ __forceinline__ int perm32(int rho) { const int n = rho >> 4, i = rho & 15; return 8 * (i >> 2) + 4 * n + (i & 3); }

struct Unit { int pm, pn; };
struct Gemm { const bf16_t* A; const bf16_t* Bt; int lda, ldb, M, N, K, mstep; };

struct StaticOrder {
    int nM, nN, nwg, G, c, lat;
    __host__ __device__ void init(int M, int N, int G_, int c_, int lat_ = 0) { nM = M / BM; nN = N / BM; nwg = nM * nN; G = G_; c = c_; lat = lat_; }
    __host__ __device__ bool next(int i, Unit& u) const {
        const long L = (long)i * G + c; if (L >= nwg) return false;
        int wgid = (int)L; { const int q = nwg / NXCD, r = nwg % NXCD, xcd = wgid % NXCD, off = wgid / NXCD; wgid = (xcd < r ? xcd * (q + 1) : r * (q + 1) + (xcd - r) * q) + off; }
        const int nig = WGM * nN, gid = wgid / nig, fm = gid * WGM, gsz = (nM - fm) < WGM ? (nM - fm) : WGM;
        u.pm = fm + ((wgid % nig) % gsz); u.pn = (wgid % nig) / gsz;
        if (lat) u.pm = u.pm + (u.pm / (SEQ / BM) + 1) * (CTX / BM);
        return true;
    }
    __device__ __forceinline__ void a_ready(const Unit&) const {}
    __device__ __forceinline__ void done(const Unit&) const {}
};
__device__ __forceinline__ unsigned cvt_pk_bf16(float lo, float hi) { unsigned r; asm volatile("v_cvt_pk_bf16_f32 %0, %1, %2" : "=v"(r) : "v"(lo), "v"(hi)); return r; }

template <class Epi, class Sched, bool ALIGN_EPI = false, bool SP2 = false>
__device__ __forceinline__ void gemm_phase(PG8_LAS unsigned char* lds, const Gemm g, const Sched& S, const Epi& E) {
    int tid_ = threadIdx.x; asm volatile("" : "+v"(tid_));
    const int tid = tid_, wid = __builtin_amdgcn_readfirstlane(tid >> 6), lane = tid & 63, wr = wid >> 2, wc = wid & 3, fr = lane & 15, fq = lane >> 4;
    const int K = g.K, nt = K / BK;
    unsigned vvoffA, vvoffB;
    { int R_, C_; stage_rc(tid * 16, R_, C_); const int Rb = Epi::PERM ? ((R_ & ~31) + perm32(R_ & 31)) : R_;
      vvoffA = (unsigned)(R_ * g.lda + C_) * 2u; vvoffB = (unsigned)(Rb * g.ldb + C_) * 2u; }
    const size_t pvoffA = (size_t)64 * g.lda * 2, pvoffB = (size_t)64 * g.ldb * 2;
    const size_t kstep = (size_t)(BK * 2);
    const size_t hstepA = (size_t)HALF * g.lda * 2, hstepB = (size_t)HALF * g.ldb * 2;
    const size_t tstepA = (size_t)g.mstep * g.lda * 2, tstepB = 2 * hstepB;
    const unsigned ldsw = (unsigned)wid * 1024u;
    const int aoff = lds_byte(wr * 64 + fr, fq * 8), boff = lds_byte(wc * 32 + fr, fq * 8);
#define PG8_SA(b, h) (((b) * 2 + (h)) * HTB)
#define PG8_SB(b, h) ((4 + (b) * 2 + (h)) * HTB)
#define PG8_STAGE(bufoff, gbase, voff) do { _Pragma("unroll") for (int _i = 0; _i < 2; ++_i) \
        __builtin_amdgcn_global_load_lds((const unsigned*)((const char*)(gbase) + (size_t)_i * p##voff + (v##voff)), (PG8_LAS unsigned*)(lds + (bufoff) + ldsw + _i * 8192), 16, 0, 0); } while (0)
#define PG8_LDA(dst, b, h) do { _Pragma("unroll") for (int m = 0; m < 4; ++m) _Pragma("unroll") for (int k = 0; k < 2; ++k) dst[m][k] = *(const PG8_LAS bf16x8*)(lds + PG8_SA(b, h) + aoff + m * 2048 + k * 1024); } while (0)
#define PG8_LDB(dst, b, h) do { _Pragma("unroll") for (int n = 0; n < 2; ++n) _Pragma("unroll") for (int k = 0; k < 2; ++k) dst[n][k] = *(const PG8_LAS bf16x8*)(lds + PG8_SB(b, h) + boff + n * 2048 + k * 1024); } while (0)
#define PG8_MMA(ai, bj, At, Bt) do { __builtin_amdgcn_s_setprio(1); _Pragma("unroll") for (int m = 0; m < 4; ++m) _Pragma("unroll") for (int n = 0; n < 2; ++n) _Pragma("unroll") for (int k = 0; k < 2; ++k) \
        acc[ai][bj][m][n] = __builtin_amdgcn_mfma_f32_16x16x32_bf16(Bt[n][k], At[m][k], acc[ai][bj][m][n], 0, 0, 0); __builtin_amdgcn_s_setprio(0); } while (0)
#define PG8_WAIT_V(n) asm volatile("s_waitcnt vmcnt(" #n ")" ::: "memory")
#define PG8_WAIT_L(n) asm volatile("s_waitcnt lgkmcnt(" #n ")" ::: "memory")
#define PG8_BAR __builtin_amdgcn_s_barrier()
#define PG8_SCHED __builtin_amdgcn_sched_barrier(0)
    Unit cur, nxt; int ui = 0;
    if (!S.next(0, cur)) return;
    f32x4 acc[2][2][4][2];
#pragma unroll
    for (int a = 0; a < 2; ++a)
#pragma unroll
        for (int b = 0; b < 2; ++b)
#pragma unroll
            for (int m = 0; m < 4; ++m)
#pragma unroll
                for (int n = 0; n < 2; ++n) acc[a][b][m][n] = (f32x4){0.f, 0.f, 0.f, 0.f};
    bf16x8 At[4][2], B0[2][2], B1[2][2];
    const char* cA = (const char*)g.A + (size_t)cur.pm * tstepA; const char* cB = (const char*)g.Bt + (size_t)cur.pn * tstepB;
    S.a_ready(cur);
    if constexpr (SP2) {
        PG8_STAGE(PG8_SB(0, 0), cB, voffB); PG8_STAGE(PG8_SB(0, 1), cB + hstepB, voffB); PG8_STAGE(PG8_SA(0, 0), cA, voffA); PG8_STAGE(PG8_SA(0, 1), cA + hstepA, voffA);
        if (wr == 1) PG8_BAR;
        PG8_WAIT_V(2); PG8_BAR;
        PG8_STAGE(PG8_SB(1, 0), cB + kstep, voffB); PG8_STAGE(PG8_SA(1, 0), cA + kstep, voffA); PG8_STAGE(PG8_SB(1, 1), cB + hstepB + kstep, voffB);
        PG8_WAIT_V(6); PG8_BAR;
    } else {
        PG8_STAGE(PG8_SB(0, 0), cB, voffB); PG8_STAGE(PG8_SA(0, 0), cA, voffA); PG8_STAGE(PG8_SB(0, 1), cB + hstepB, voffB); PG8_STAGE(PG8_SA(0, 1), cA + hstepA, voffA);
        if (wr == 1) PG8_BAR;
        PG8_WAIT_V(4); PG8_BAR;
        PG8_STAGE(PG8_SB(1, 0), cB + kstep, voffB); PG8_STAGE(PG8_SA(1, 0), cA + kstep, voffA); PG8_STAGE(PG8_SB(1, 1), cB + hstepB + kstep, voffB);
        PG8_WAIT_V(6); PG8_BAR;
    }
    for (;;) {
        const bool has_next = S.next(ui + 1, nxt);
        const char* nA = has_next ? (const char*)g.A + (size_t)nxt.pm * tstepA : cA; const char* nB = has_next ? (const char*)g.Bt + (size_t)nxt.pn * tstepB : cB;
        for (int t = 0; t < nt; t += 2) {
            const bool last = (t == nt - 2);
            const char* a1 = cA + (size_t)(t + 1) * kstep;
            const char* a2 = last ? nA : cA + (size_t)(t + 2) * kstep; const char* b2 = last ? nB : cB + (size_t)(t + 2) * kstep;
            const char* a3 = a2 + kstep; const char* b3 = b2 + kstep;
            if (last && has_next) S.a_ready(nxt);
            if constexpr (SP2) {
            PG8_LDB(B0, 0, 0); PG8_LDB(B1, 0, 1); PG8_SCHED; PG8_LDA(At, 0, 0); PG8_STAGE(PG8_SA(1, 1), a1 + hstepA, voffA);
            PG8_WAIT_V(8); PG8_WAIT_L(0); PG8_BAR; PG8_MMA(0, 0, At, B0); PG8_MMA(0, 1, At, B1); PG8_BAR; PG8_SCHED;
            PG8_LDA(At, 0, 1); PG8_STAGE(PG8_SB(0, 0), b2, voffB); PG8_STAGE(PG8_SB(0, 1), b2 + hstepB, voffB); PG8_STAGE(PG8_SA(0, 0), a2, voffA);
            PG8_WAIT_V(8); PG8_WAIT_L(0); PG8_BAR; PG8_MMA(1, 0, At, B0); PG8_MMA(1, 1, At, B1); PG8_BAR; PG8_SCHED;
            PG8_LDB(B0, 1, 0); PG8_LDB(B1, 1, 1); PG8_SCHED; PG8_LDA(At, 1, 0); PG8_STAGE(PG8_SA(0, 1), a2 + hstepA, voffA);
            PG8_WAIT_V(8); PG8_WAIT_L(0); PG8_BAR; PG8_MMA(0, 0, At, B0); PG8_MMA(0, 1, At, B1); PG8_BAR; PG8_SCHED;
            PG8_LDA(At, 1, 1); PG8_STAGE(PG8_SB(1, 0), b3, voffB); PG8_STAGE(PG8_SB(1, 1), b3 + hstepB, voffB); PG8_STAGE(PG8_SA(1, 0), a3, voffA);
            PG8_WAIT_V(8); PG8_WAIT_L(0); PG8_BAR; PG8_MMA(1, 0, At, B0); PG8_MMA(1, 1, At, B1); PG8_BAR; PG8_SCHED;
            } else {
            PG8_LDB(B0, 0, 0); PG8_SCHED; PG8_LDA(At, 0, 0); PG8_STAGE(PG8_SA(1, 1), a1 + hstepA, voffA);
            PG8_WAIT_L(8); PG8_BAR; PG8_WAIT_L(0); PG8_MMA(0, 0, At, B0); PG8_BAR; PG8_SCHED;
            PG8_LDB(B1, 0, 1); PG8_STAGE(PG8_SB(0, 0), b2, voffB);
            PG8_BAR; PG8_WAIT_L(0); PG8_MMA(0, 1, At, B1); PG8_BAR;
            PG8_LDA(At, 0, 1); PG8_STAGE(PG8_SA(0, 0), a2, voffA);
            PG8_BAR; PG8_WAIT_L(0); PG8_MMA(1, 0, At, B0); PG8_BAR; PG8_SCHED;
            PG8_STAGE(PG8_SB(0, 1), b2 + hstepB, voffB);
            PG8_WAIT_V(6); PG8_BAR; PG8_MMA(1, 1, At, B1); PG8_BAR;
            PG8_LDB(B0, 1, 0); PG8_SCHED; PG8_LDA(At, 1, 0); PG8_STAGE(PG8_SA(0, 1), a2 + hstepA, voffA);
            PG8_WAIT_L(8); PG8_BAR; PG8_WAIT_L(0); PG8_MMA(0, 0, At, B0); PG8_BAR; PG8_SCHED;
            PG8_LDB(B1, 1, 1); PG8_STAGE(PG8_SB(1, 0), b3, voffB);
            PG8_BAR; PG8_WAIT_L(0); PG8_MMA(0, 1, At, B1); PG8_BAR;
            PG8_LDA(At, 1, 1); PG8_STAGE(PG8_SA(1, 0), a3, voffA);
            PG8_BAR; PG8_WAIT_L(0); PG8_MMA(1, 0, At, B0); PG8_BAR; PG8_SCHED;
            PG8_STAGE(PG8_SB(1, 1), b3 + hstepB, voffB);
            PG8_WAIT_V(6); PG8_BAR; PG8_MMA(1, 1, At, B1); PG8_BAR;
            }
        }
        if constexpr (ALIGN_EPI) { if (wr == 0) PG8_BAR; }
        E(acc, cur, wr, wc, fr, fq); S.done(cur);
        if (!has_next) break;
#pragma unroll
        for (int a = 0; a < 2; ++a)
#pragma unroll
            for (int b = 0; b < 2; ++b)
#pragma unroll
                for (int m = 0; m < 4; ++m)
#pragma unroll
                    for (int n = 0; n < 2; ++n) acc[a][b][m][n] = (f32x4){0.f, 0.f, 0.f, 0.f};
        cur = nxt; cA = nA; cB = nB; ++ui;
        if constexpr (ALIGN_EPI) { if (wr == 1) PG8_BAR; }
    }
    PG8_WAIT_V(0);
    if constexpr (!ALIGN_EPI) { if (wr == 0) PG8_BAR; }
    PG8_BAR;
#undef PG8_SA
#undef PG8_SB
#undef PG8_STAGE
#undef PG8_LDA
#undef PG8_LDB
#undef PG8_MMA
#undef PG8_WAIT_V
#undef PG8_WAIT_L
#undef PG8_BAR
#undef PG8_SCHED
}

struct EpiBf16 {
    static constexpr bool PERM = true;
    bf16_t* O; int ldc; const float* rs; int rs_stride;
    __device__ __forceinline__ void operator()(const f32x4 (&acc)[2][2][4][2], const Unit& u, int wr, int wc, int, int) const {
        __builtin_amdgcn_sched_barrier(0);
        int t_ = threadIdx.x; asm volatile("" : "+v"(t_)); const int fr = t_ & 15, fq = (t_ >> 4) & 3;
        const int row0 = u.pm * BM + wr * 64 + fr, col0 = u.pn * BM + wc * 32 + 8 * fq;
#pragma unroll
        for (int ai = 0; ai < 2; ++ai)
#pragma unroll
            for (int m = 0; m < 4; ++m) { const int row = row0 + ai * HALF + m * 16; bf16_t* rowp = O + (size_t)row * ldc + col0;
                const float sc = rs ? rs[(size_t)row * rs_stride] : 1.0f;
#pragma unroll
                for (int bj = 0; bj < 2; ++bj) { const f32x4 v0 = acc[ai][bj][m][0] * sc, v1 = acc[ai][bj][m][1] * sc;
                    u32x4 w; w.x = cvt_pk_bf16(v0[0], v0[1]); w.y = cvt_pk_bf16(v0[2], v0[3]); w.z = cvt_pk_bf16(v1[0], v1[1]); w.w = cvt_pk_bf16(v1[2], v1[3]);
                    *(u32x4*)(rowp + bj * HALF) = w; } }
    }
};
struct EpiVT {
    static constexpr bool PERM = true;
    bf16_t* O; const float* rs;
    __device__ __forceinline__ void operator()(const f32x4 (&acc)[2][2][4][2], const Unit& u, int wr, int wc, int, int) const {
        __builtin_amdgcn_sched_barrier(0);
        int t_ = threadIdx.x; asm volatile("" : "+v"(t_)); const int fr = t_ & 15, fq = (t_ >> 4) & 3;
        const int row0 = u.pm * BM + wr * 64 + fr, col0 = u.pn * BM + wc * 32;
        typedef unsigned u32x2 __attribute__((ext_vector_type(2)));
#pragma unroll
        for (int bj = 0; bj < 2; ++bj) { const int cb = col0 + bj * HALF;
            const float* rsp = rs + cb + 8 * fq;
            typedef bf16_t __attribute__((address_space(1))) gbf16;
            gbf16* rowp = (gbf16*)(O + (size_t)row0 * R + cb + 4 * (fq >> 1) + 16 * (fq & 1));
#pragma unroll
            for (int ai = 0; ai < 2; ++ai)
#pragma unroll
                for (int m = 0; m < 4; ++m) {
                    const f32x4 v0 = acc[ai][bj][m][0] * *(const f32x4*)(rsp), v1 = acc[ai][bj][m][1] * *(const f32x4*)(rsp + 4);
                    u32x2 w0, w1; w0.x = cvt_pk_bf16(v0[0], v0[1]); w0.y = cvt_pk_bf16(v0[2], v0[3]); w1.x = cvt_pk_bf16(v1[0], v1[1]); w1.y = cvt_pk_bf16(v1[2], v1[3]);
                    *(__attribute__((address_space(1))) u32x2*)(rowp) = w0; *(__attribute__((address_space(1))) u32x2*)(rowp + 8) = w1;
                    rowp += (size_t)(m == 3 ? HALF - 48 : 16) * R; asm volatile("" : "+v"(rowp)); } }
    }
};
struct EpiConvGate {
    static constexpr bool PERM = true;
    bf16_t* O; const float* cw; const float* cb; PG8_LAS unsigned char* xl;
    __device__ __forceinline__ void operator()(f32x4 (&acc)[2][2][4][2], const Unit& u, int wr, int wc, int, int) const {
        __builtin_amdgcn_sched_barrier(0);
        int t_ = threadIdx.x; asm volatile("" : "+v"(t_)); const int lane = t_ & 63, fr = t_ & 15, fq = (t_ >> 4) & 3, wave = wr * 4 + wc;
        PG8_LAS f32x4* myx = (PG8_LAS f32x4*)(xl + wave * 1024);
#pragma unroll
        for (int ai = 0; ai < 2; ++ai)
#pragma unroll
            for (int bj = 0; bj < 2; ++bj)
#pragma unroll
                for (int n = 0; n < 2; ++n) { if (fr == 0) myx[(((ai * 2 + 0) * 2 + bj) * 2 + n) * 4 + fq] = acc[ai][bj][0][n]; if (fr == 15) myx[(((ai * 2 + 1) * 2 + bj) * 2 + n) * 4 + fq] = acc[ai][bj][3][n]; }
        asm volatile("s_waitcnt lgkmcnt(0)" ::: "memory"); __builtin_amdgcn_s_barrier(); asm volatile("" ::: "memory");
        const int rg0 = u.pm * 254 - 1 + wr * 64 + fr;
        unsigned hpm = 0u, hnm = 0u;
#pragma unroll
        for (int ai = 0; ai < 2; ++ai)
#pragma unroll
            for (int m = 0; m < 4; ++m) { const int rg = rg0 + ai * HALF + m * 16; const int o = ((rg % RPB) + RPB) % RPB;
                if (o != 0 && o != CTX) hpm |= 1u << (ai * 4 + m); if (o != CTX - 1 && o != RPB - 1) hnm |= 1u << (ai * 4 + m); }
        typedef float f32x2 __attribute__((ext_vector_type(2)));
        {
#pragma unroll
            for (int bj = 0; bj < 2; ++bj)
#pragma unroll
                for (int n = 0; n < 2; ++n) {
                    const int jj = bj * FF + u.pn * HALF + wc * 32 + 8 * fq + 4 * n;
                    const f32x4 w0 = *(const f32x4*)(cw + jj), w1 = *(const f32x4*)(cw + FF2 + jj), w2 = *(const f32x4*)(cw + 2 * FF2 + jj), bb = *(const f32x4*)(cb + jj);
#pragma unroll
                    for (int ai = 0; ai < 2; ++ai) {
                        const int blk = 2 * ai + wr;
                        f32x4 prow = (f32x4){0.f, 0.f, 0.f, 0.f}, nrow = prow;
                        if (blk > 0) prow = *(const PG8_LAS f32x4*)(xl + (((blk - 1) & 1) * 4 + wc) * 1024 + ((((((blk - 1) >> 1) * 2 + 1) * 2 + bj) * 2 + n) * 4 + fq) * 16);
                        if (blk < 3) nrow = *(const PG8_LAS f32x4*)(xl + (((blk + 1) & 1) * 4 + wc) * 1024 + ((((((blk + 1) >> 1) * 2 + 0) * 2 + bj) * 2 + n) * 4 + fq) * 16);
#pragma unroll
                        for (int ep = 0; ep < 2; ++ep) {
                            f32x2 ru[4], rd[4], res[4];
#pragma unroll
                            for (int m = 0; m < 4; ++m)
#pragma unroll
                                for (int k = 0; k < 2; ++k) { int vi = __float_as_int(acc[ai][bj][m][n][2 * ep + k]); asm volatile("" : "+v"(vi));
                                    ru[m][k] = __int_as_float(__builtin_amdgcn_update_dpp(0, vi, 0x121, 0xf, 0xf, false));
                                    rd[m][k] = __int_as_float(__builtin_amdgcn_update_dpp(0, vi, 0x12F, 0xf, 0xf, false)); }
                            const f32x2 w0p = {w0[2 * ep], w0[2 * ep + 1]}, w1p = {w1[2 * ep], w1[2 * ep + 1]}, w2p = {w2[2 * ep], w2[2 * ep + 1]}, bbp = {bb[2 * ep], bb[2 * ep + 1]};
                            const f32x2 pr2 = {prow[2 * ep], prow[2 * ep + 1]}, nr2 = {nrow[2 * ep], nrow[2 * ep + 1]};
#pragma unroll
                            for (int m = 0; m < 4; ++m) {
                                const f32x2 xv = {acc[ai][bj][m][n][2 * ep], acc[ai][bj][m][n][2 * ep + 1]};
                                const f32x2 upv = fr == 0 ? (m == 0 ? pr2 : ru[m == 0 ? 0 : m - 1]) : ru[m];
                                const f32x2 dnv = fr == 15 ? (m == 3 ? nr2 : rd[m == 3 ? 3 : m + 1]) : rd[m];
                                const bool hp = (hpm >> (ai * 4 + m)) & 1u, hn = (hnm >> (ai * 4 + m)) & 1u;
                                const f32x2 z = {0.f, 0.f};
                                res[m] = bbp + w1p * xv + (hp ? w0p * upv : z) + (hn ? w2p * dnv : z); }
                            asm volatile("" : "+v"(res[0]), "+v"(res[1]), "+v"(res[2]), "+v"(res[3]));
#pragma unroll
                            for (int m = 0; m < 4; ++m) { acc[ai][bj][m][n][2 * ep] = res[m][0]; acc[ai][bj][m][n][2 * ep + 1] = res[m][1]; }
                        }
                    }
                }
        }
#pragma unroll
        for (int ai = 0; ai < 2; ++ai)
#pragma unroll
            for (int m = 0; m < 4; ++m) { const int tr = ai * HALF + wr * 64 + m * 16 + fr, rg = u.pm * 254 - 1 + tr;
                if (tr == 0 || tr == 255 || rg >= R) continue;
                const f32x4 a0 = acc[ai][0][m][0], a1 = acc[ai][0][m][1], g0 = acc[ai][1][m][0], g1 = acc[ai][1][m][1];
                float o[8];
#pragma unroll
                for (int e = 0; e < 4; ++e) { o[e] = a0[e] * __builtin_amdgcn_rcpf(1.0f + __builtin_amdgcn_exp2f(-1.4426950408889634f * a0[e])) * g0[e]; o[4 + e] = a1[e] * __builtin_amdgcn_rcpf(1.0f + __builtin_amdgcn_exp2f(-1.4426950408889634f * a1[e])) * g1[e]; }
                u32x4 w; w.x = cvt_pk_bf16(o[0], o[1]); w.y = cvt_pk_bf16(o[2], o[3]); w.z = cvt_pk_bf16(o[4], o[5]); w.w = cvt_pk_bf16(o[6], o[7]);
                *(u32x4*)(O + (size_t)rg * FF + u.pn * HALF + wc * 32 + 8 * fq) = w; }
    }
};
struct EpiResid {
    static constexpr bool PERM = true;
    bf16_t* X; const float* gate; float* outf; int dry;
    __device__ __forceinline__ void operator()(const f32x4 (&acc)[2][2][4][2], const Unit& u, int wr, int wc, int, int) const {
        __builtin_amdgcn_sched_barrier(0);
        int t_ = threadIdx.x; asm volatile("" : "+v"(t_)); const int fr = t_ & 15, fq = (t_ >> 4) & 3;
        const int row0 = u.pm * BM + wr * 64 + fr, col0 = u.pn * BM + wc * 32 + 8 * fq;
#pragma unroll
        for (int ai = 0; ai < 2; ++ai)
#pragma unroll
            for (int m = 0; m < 4; ++m) { const int row = row0 + ai * HALF + m * 16; const RowI ri = rowinfo(row);
                bf16_t* rowp = X + (size_t)row * D + col0; const float* gp = gate + (size_t)ri.bi * 6 * D + col0;
                float* op = outf ? outf + ((size_t)ri.b * SEQ + ri.t) * D + col0 : nullptr;
#pragma unroll
                for (int bj = 0; bj < 2; ++bj) { const int co = bj * HALF;
                    const u32x4 xw = *(const u32x4*)(rowp + co); const f32x4 g0 = *(const f32x4*)(gp + co), g1 = *(const f32x4*)(gp + co + 4);
                    f32x4 n0, n1;
                    n0[0] = __uint_as_float(xw.x << 16); n0[1] = __uint_as_float(xw.x & 0xFFFF0000u); n0[2] = __uint_as_float(xw.y << 16); n0[3] = __uint_as_float(xw.y & 0xFFFF0000u);
                    n1[0] = __uint_as_float(xw.z << 16); n1[1] = __uint_as_float(xw.z & 0xFFFF0000u); n1[2] = __uint_as_float(xw.w << 16); n1[3] = __uint_as_float(xw.w & 0xFFFF0000u);
                    n0 = n0 + g0 * acc[ai][bj][m][0]; n1 = n1 + g1 * acc[ai][bj][m][1];
                    if (dry) continue;
                    if (outf) { *(f32x4*)(op + co) = n0; *(f32x4*)(op + co + 4) = n1; }
                    else { u32x4 w; w.x = cvt_pk_bf16(n0[0], n0[1]); w.y = cvt_pk_bf16(n0[2], n0[3]); w.z = cvt_pk_bf16(n1[0], n1[1]); w.w = cvt_pk_bf16(n1[2], n1[3]); *(u32x4*)(rowp + co) = w; } } }
    }
};
}
#endif


DEV void ld8(const bf16* q, float (&f)[8]) { const U4 u = *(const U4*)q; f[0] = bflo(u.x); f[1] = bfhi(u.x); f[2] = bflo(u.y); f[3] = bfhi(u.y); f[4] = bflo(u.z); f[5] = bfhi(u.z); f[6] = bflo(u.w); f[7] = bfhi(u.w); }
DEV void ldf8(const float* q, float (&f)[8]) {
#pragma unroll
    for (int e = 0; e < 8; ++e) f[e] = q[e]; }
DEV U4 pack8(const float (&f)[8]) { U4 u; u.x = f2bf(f[0]) | ((unsigned)f2bf(f[1]) << 16); u.y = f2bf(f[2]) | ((unsigned)f2bf(f[3]) << 16); u.z = f2bf(f[4]) | ((unsigned)f2bf(f[5]) << 16); u.w = f2bf(f[6]) | ((unsigned)f2bf(f[7]) << 16); return u; }
DEV void conv4x8(const bf16* src, int ld, const float* w  , int wn, const float* bias, bool hp0, bool hn3, float (&out)[4][8]) {
    float w0[8], w1[8], w2[8], bb[8], x[6][8];
    ldf8(w, w0); ldf8(w + wn, w1); ldf8(w + 2 * wn, w2); ldf8(bias, bb);
#pragma unroll
    for (int i = 0; i < 6; ++i) { if ((i == 0 && !hp0) || (i == 5 && !hn3)) {
#pragma unroll
            for (int e = 0; e < 8; ++e) x[i][e] = 0.f; } else ld8(src + (long)(i - 1) * ld, x[i]); }
#pragma unroll
    for (int i = 0; i < 4; ++i)
#pragma unroll
        for (int e = 0; e < 8; ++e) out[i][e] = bb[e] + w0[e] * x[i][e] + w1[e] * x[i + 1][e] + w2[e] * x[i + 2][e];
}

template <int PH> DEV void phase(PRef p, int l, int arg, long gtid, long gth);


template <> DEV void phase<PH_MOD>(PRef p, int, int, long gtid, long gth) {
    constexpr int KC = D / 8;
    for (long i = gtid; i < (long)8 * DEPTH * 6 * D; i += gth) {
        const int j = (int)(i % (6 * D)), l = (int)((i / (6 * D)) % DEPTH), kc = (int)(i / ((long)6 * D * DEPTH));
        const float* w = p.ada_w + (long)l * D * 6 * D + j;
        float acc[B + 1];
#pragma unroll
        for (int bi = 0; bi <= B; ++bi) acc[bi] = 0.f;
        for (int k = kc * KC; k < (kc + 1) * KC; ++k) { const float wv = w[(long)k * 6 * D];
#pragma unroll
            for (int bi = 0; bi <= B; ++bi) acc[bi] += silu_f(bi < B ? p.c[(long)bi * D + k] : p.c_ctx[k]) * wv; }
#pragma unroll
        for (int bi = 0; bi <= B; ++bi) wMODP(p.ws)[(((long)kc * DEPTH + l) * (B + 1) + bi) * 6 * D + j] = acc[bi];
    }
}
template <> DEV void phase<PH_MOD2>(PRef p, int, int, long gtid, long gth) {
    for (long i = gtid; i < (long)DEPTH * (B + 1) * 6 * D; i += gth) {
        const int j = (int)(i % (6 * D)), l = (int)(i / ((long)6 * D * (B + 1)));
        float acc = p.ada_b[(long)l * 6 * D + j];
        for (int kc = 0; kc < 8; ++kc) acc += wMODP(p.ws)[(long)kc * DEPTH * (B + 1) * 6 * D + i];
        wMOD(p.ws)[i] = acc;
    }
}
template <> DEV void phase<PH_ROPE>(PRef p, int, int, long gtid, long gth) {
    for (long i = gtid; i < (long)SEQ * 16; i += gth) {
        const int j = (int)(i % 16), t = (int)(i / 16);
        const int jj = j & 7;
        const float inv = (jj & 1 ? 0.31622776601683794f : 1.0f) * (jj >> 1 == 0 ? 1.0f : jj >> 1 == 1 ? 0.1f : jj >> 1 == 2 ? 0.01f : 0.001f);
        const float pos = j < 8 ? (float)(t / GRID_W) : (float)(t % GRID_W);
        const float a = pos * inv;
        wROPET(p.ws)[i * 2] = cosf(a); wROPET(p.ws)[i * 2 + 1] = sinf(a);
    }
}
template <> DEV void phase<PH_FILT_A>(PRef p, int l, int, long gtid, long gth) {
    for (long i = gtid; i < (long)2 * SEQ * HH; i += gth) {
        const int j = (int)(i % HH), pos = (int)((i / HH) % SEQ), set = (int)(i / ((long)HH * SEQ));
        const int L = set ? CTX : SEQ; if (pos >= L) continue;
        const float* w1 = p.hy_w1 + (long)l * HE * HH;
        const float tl = (float)pos / (float)(L - 1);
        float acc = p.hy_b1[l * HH + j] + tl * w1[j];
        for (int e = 0; e < HB; ++e) {
            const float band = 1e-4f + (float)e * (((float)(HB - 1) - 1e-4f) / (float)(HB - 1));
            float turns = (float)pos * band / (float)L; turns -= floorf(turns);
            acc += cos_t(turns) * w1[(1 + e) * HH + j] - sin_t(turns) * w1[(1 + HB + e) * HH + j];
        }
        wHD1(p.ws)[i] = sin_f(p.hy_freq[l * HH + j] * acc);
    }
}
template <> DEV void phase<PH_FILT_B>(PRef p, int l, int, long gtid, long gth) {
    for (long i = gtid; i < (long)2 * SEQ * HH; i += gth) {
        const int j = (int)(i % HH), pos = (int)((i / HH) % SEQ), set = (int)(i / ((long)HH * SEQ));
        const int L = set ? CTX : SEQ; if (pos >= L) continue;
        const float* w2 = p.hy_w2 + (long)l * HH * HH;
        const float* h1 = wHD1(p.ws) + (i - j);
        float acc = p.hy_b2[l * HH + j];
        for (int e = 0; e < HH; ++e) acc += h1[e] * w2[e * HH + j];
        wHD2(p.ws)[i] = sin_f(p.hy_freq[l * HH + j] * acc);
    }
}
template <> DEV void phase<PH_FILT_C>(PRef p, int l, int, long gtid, long gth) {
    const float* w3 = p.hy_w3 + (long)l * HH * 2 * HW;
    for (long i = gtid; i < (long)2 * (SEQ / 4) * 2 * HW; i += gth) {
        const int c2 = (int)(i % (2 * HW)), pq = (int)((i / (2 * HW)) % (SEQ / 4)), set = (int)(i / ((long)2 * HW * (SEQ / 4)));
        const int L = set ? CTX : SEQ, pos0 = pq * 4; if (pos0 >= L) continue;
        const float* h2 = wHD2(p.ws) + ((long)set * SEQ + pos0) * HH;
        float acc[4] = {0.f, 0.f, 0.f, 0.f};
        for (int e = 0; e < HH; ++e) { const float w = w3[e * 2 * HW + c2];
#pragma unroll
            for (int k = 0; k < 4; ++k) acc[k] += h2[k * HH + e] * w; }
        const int c = c2 % HW;
        const float a0 = -4.605170185988091f / 1.5f, a1 = -4.605170185988091f / 0.3f;
        const float delta = fabsf(a0 + (a1 - a0) * (float)c / (float)(HW - 1));
#pragma unroll
        for (int k = 0; k < 4; ++k) { const int pos = pos0 + k; const float tl = (float)pos / (float)(L - 1); const float v = acc[k] * (exp_f(-tl * delta) + 0.05f);
            if (set == 0) wFT(p.ws)[(long)c2 * SEQ + pos] = v; else wFT1(p.ws)[(long)pos * 2 * HW + c2] = v; }
    }
}
DEV float filt_tap(PRef p, int set, int c2, int pos) { return set == 0 ? wFT(p.ws)[(long)c2 * SEQ + pos] : wFT1(p.ws)[(long)pos * 2 * HW + c2]; }
template <> DEV void phase<PH_FILT_D>(PRef p, int, int, long gtid, long gth) {
    for (long i = gtid; i < (long)2 * HW * 64; i += gth) {
        const int part = (int)(i % 64), c = (int)((i / 64) % HW), set = (int)(i / (64 * HW)); const int L = set ? CTX : SEQ, per = L / 64;
        float s = 0.f;
        for (int pos = part * per; pos < (part + 1) * per; ++pos) { s += fabsf(filt_tap(p, set, c, pos)); if (pos >= 1) s += fabsf(filt_tap(p, set, HW + c, pos)); }
        wFL1(p.ws)[i] = s;
    }
}
DEV float filt_l1(PRef p, int set, int c) { const float* q = wFL1(p.ws) + ((long)set * HW + c) * 64; float s = 0.f; for (int i = 0; i < 64; ++i) s += q[i]; return s; }
template <> DEV void phase<PH_NORM1>(PRef p, int l, int, long gtid, long gth) {
    for (long r = gtid; r < R; r += gth) {
        const RowI ri = rowinfo((int)r);
        bf16* xr = wX(p.ws) + r * D; const float* src = ri.ctx ? p.ctx + ((long)ri.b * CTX + ri.t) * D : p.x + ((long)ri.b * SEQ + ri.t) * D;
        if (l == 0) for (int k = 0; k < D; ++k) xr[k] = f2bf(src[k]);
        float ss = 0.f; for (int k = 0; k < D; ++k) { const float v = l == 0 ? src[k] : bf2f(xr[k]); ss += v * v; }
        const float rstd = 1.0f / sqrtf(ss / (float)D + EPS);
        const float* mod = wMOD(p.ws) + ((long)l * (B + 1) + ri.bi) * 6 * D;
        const float* g = p.norm1_g + l * D;
        for (int k = 0; k < D; ++k) { const float v = l == 0 ? src[k] : bf2f(xr[k]); wH(p.ws)[r * D + k] = f2bf(v * rstd * g[k] * (1.0f + mod[D + k]) + mod[k]); }
    }
}
template <> DEV void phase<PH_GEMM1>(PRef p, int l, int, long gtid, long gth) {
    for (long i = gtid; i < (long)R * NP; i += gth) { const int n = (int)(i % NP); const long r = i / NP;
        wP(p.ws)[i] = f2bf(dot_bf16(wH(p.ws) + r * D, wWinT(p.ws, l) + (long)n * D, D)); }
}
template <> DEV void phase<PH_MLA_A>(PRef p, int, int, long gtid, long gth) {
    for (long r = gtid; r < R; r += gth) {
        const RowI ri = rowinfo((int)r); const bf16* pr = wP(p.ws) + r * NP;
        float s = 0.f; for (int k = 0; k < QR; ++k) { const float v = bf2f(pr[k]); s += v * v; }
        wRS(p.ws)[r] = 1.0f / sqrtf(s / (float)QR + EPS);
        s = 0.f; for (int k = 0; k < KVR; ++k) { const float v = bf2f(pr[QR + k]); s += v * v; }
        wRS(p.ws)[R + r] = 1.0f / sqrtf(s / (float)KVR + EPS);
        for (int j = 0; j < 16; ++j) {
            const float x1 = bf2f(pr[QR + KVR + j]), x2 = bf2f(pr[QR + KVR + 16 + j]);
            float cs = 1.f, sn = 0.f; if (!ri.ctx) { cs = wROPET(p.ws)[((long)ri.t * 16 + j) * 2]; sn = wROPET(p.ws)[((long)ri.t * 16 + j) * 2 + 1]; }
            wKR(p.ws)[r * ROPE + j] = f2bf(x1 * cs - x2 * sn); wKR(p.ws)[r * ROPE + 16 + j] = f2bf(x1 * sn + x2 * cs);
        }
    }
}
template <> DEV void phase<PH_MLA_Q>(PRef p, int l, int, long gtid, long gth) {
    for (long i = gtid; i < (long)R * QW; i += gth) { const int n = (int)(i % QW); const long r = i / QW;
        const RowI ri = rowinfo((int)r);
        const float rs = wRS(p.ws)[r]; const bf16* a = wP(p.ws) + r * NP;
        float v = rs * dot_bf16(a, wWuqT(p.ws, l) + (long)n * QR, QR);
        wQ(p.out)[i] = f2bf(v);
    }
}
template <> DEV void phase<PH_MLA_KV>(PRef p, int l, int, long gtid, long gth) {
    for (long i = gtid; i < (long)R * KVW; i += gth) { const int n = (int)(i % KVW); const long r = i / KVW;
        const bf16 v = f2bf(wRS(p.ws)[R + r] * dot_bf16(wP(p.ws) + r * NP + QR, wWukvT(p.ws, l) + (long)n * KVR, KVR));
        if (n < AW) wKN(p.out)[r * AW + n] = v; else wVT(p.out)[(long)(n - AW) * R + (r & ~31L) + vperm32((int)(r & 31))] = v; }
}
template <> DEV void phase<PH_ATT>(PRef p, int l, int, long gtid, long gth) {
    const bool last = (l == DEPTH - 1);
    const float scale = 1.0f / sqrtf((float)(NOPE + ROPE));
    for (long i = gtid; i < (long)AH * R; i += gth) {
        const int h = (int)(i / R); const long r = i % R; const RowI ri = rowinfo((int)r);
        if (ri.ctx && last) continue;
        const bf16* qp = wQ(p.out) + r * QW + h * (NOPE + ROPE);
        float qr[ROPE];
#pragma unroll
        for (int j = 0; j < 16; ++j) { const float x1 = bf2f(qp[NOPE + j]), x2 = bf2f(qp[NOPE + 16 + j]);
            float cs = 1.f, sn = 0.f; if (!ri.ctx) { cs = wROPET(p.ws)[((long)ri.t * 16 + j) * 2]; sn = wROPET(p.ws)[((long)ri.t * 16 + j) * 2 + 1]; }
            qr[j] = x1 * cs - x2 * sn; qr[16 + j] = x1 * sn + x2 * cs; }
        float o[AV];
#pragma unroll
        for (int d = 0; d < AV; ++d) o[d] = 0.f;
        float m = -1e30f, ssum = 0.f;
        const long k0 = (long)ri.b * RPB; const int nk = ri.ctx ? CTX : RPB;
        for (int kk = 0; kk < nk; ++kk) {
            const bf16* kv = wKN(p.out) + (k0 + kk) * AW + h * NOPE; const bf16* kr = wKR(p.ws) + (k0 + kk) * ROPE;
            const bf16* vt = wVT(p.out) + (long)h * AV * R + ((k0 + kk) & ~31L) + vperm32((int)((k0 + kk) & 31));
            float s = 0.f;
#pragma unroll
            for (int d = 0; d < NOPE; d += 8) s += dot8(*(const U4*)(qp + d), *(const U4*)(kv + d));
#pragma unroll
            for (int d = 0; d < ROPE; ++d) s += qr[d] * bf2f(kr[d]);
            s *= scale;
            const float mn = fmaxf(m, s); const float corr = exp_f(m - mn), pw = exp_f(s - mn);
            ssum = ssum * corr + pw; m = mn;
#pragma unroll
            for (int d = 0; d < AV; ++d) o[d] = o[d] * corr + pw * bf2f(vt[(long)d * R]);
        }
        const float inv = 1.0f / ssum;
#pragma unroll
        for (int d = 0; d < AV; ++d) wH(p.ws)[r * D + h * AV + d] = f2bf(o[d] * inv);
    }
}
template <> DEV void phase<PH_ML_U>(PRef p, int l, int, long gtid, long gth) {
    for (long i = gtid; i < (long)(R / 4) * (MW / 8); i += gth) { const int cg = (int)(i % (MW / 8)); const long r = (i / (MW / 8)) * 4; const RowI ri = rowinfo((int)r);
        const int L = ri.ctx ? CTX : SEQ; float o[4][8];
        conv4x8(wP(p.ws) + r * NP + ML_LO + cg * 8, NP, p.ml_conv_w + (long)l * 3 * MW + cg * 8, MW, p.ml_conv_b + l * MW + cg * 8, ri.t > 0, ri.t + 4 < L, o);
#pragma unroll
        for (int k = 0; k < 4; ++k) {
#pragma unroll
            for (int e = 0; e < 8; ++e) o[k][e] = silu_f(o[k][e]);
            *(U4*)(wMU(p.ws) + (r + k) * MW + cg * 8) = pack8(o[k]); } }
    const float ksc = 1.0f / sqrtf((float)MD);
    for (long i = gtid; i < (long)2 * MW * MW; i += gth) { const int k = (int)(i % MW), n = (int)(i / MW); const int isk = n >= MW, nn = n % MW, h = nn / MD, e = nn % MD;
        float v = 0.f; if (k / MD == h) v = isk ? p.ml_wk[(((long)l * MH + h) * MD + k % MD) * MD + e] * ksc : p.ml_wq[(((long)l * MH + h) * MD + k % MD) * MD + e];
        wWML(p.ws)[i] = f2bf(v); }
}
template <> DEV void phase<PH_ML_QK>(PRef p, int, int, long gtid, long gth) {
    for (long i = gtid; i < (long)R * 2 * MW; i += gth) { const int n = (int)(i % (2 * MW)); const long r = i / (2 * MW);
        wMQK(p.ws)[i] = f2bf(dot_bf16(wMU(p.ws) + r * MW, wWML(p.ws) + (long)n * MW, MW)); }
}
DEV int ml_scan_sc(int dir, int k) { return dir == 0 ? k : (k < NCS ? NCS - 1 - k : SCN - 1 - (k - NCS)); }
DEV int ml_sc_rank(int dir, int sc) { return dir == 0 ? sc : (sc < NCS ? NCS - 1 - sc : NCS + (SCN - 1 - sc)); }
template <> DEV void phase<PH_ML_F>(PRef p, int l, int, long gtid, long gth) {
    for (long i = gtid; i < (long)B * SCN * MH * 2; i += gth) { const int dir = (int)(i % 2), h = (int)((i / 2) % MH), sc = (int)((i / (2 * MH)) % SCN), b = (int)(i / (2 * MH * SCN));
        const float bi_ = p.ml_gate_b[(l * 4 + 2 * dir) * MH + h], bf_ = p.ml_gate_b[(l * 4 + 2 * dir + 1) * MH + h];
        float F = 0.f;
        for (int pos = 0; pos < SCS; ++pos) { const long r = (long)b * RPB + (long)sc * SCS + (dir == 0 ? pos : SCS - 1 - pos);
            const bf16* g = wP(p.ws) + r * NP + ML_LO + 3 * MW;
            const float li = bf2f(g[(2 * dir) * MH + h]) + bi_, lf = logsigmoid_f(bf2f(g[(2 * dir + 1) * MH + h]) + bf_);
            F += lf; float* fg = wFG(p.ws) + ((r * 2 + dir) * MH + h) * 2; fg[0] = F; fg[1] = F - li; }
    }
}
template <> DEV void phase<PH_ML_B>(PRef p, int, int, long gtid, long gth) {
    for (long i = gtid; i < (long)B * MH * 2 * SCN * (MD + 1) * MD; i += gth) {
        const int e = (int)(i % MD), jrow = (int)((i / MD) % (MD + 1)); long t = i / ((long)MD * (MD + 1));
        const int sc = (int)(t % SCN); t /= SCN; const int dir = (int)(t % 2); t /= 2; const int h = (int)(t % MH); const int b = (int)(t / MH);
        const long r0 = (long)b * RPB + (long)sc * SCS; const long rend = dir == 0 ? r0 + SCS - 1 : r0;
        const float Fend = wFG(p.ws)[((rend * 2 + dir) * MH + h) * 2];
        float acc = 0.f;
        for (int s = 0; s < SCS; ++s) { const long r = r0 + s; const float w = exp_f(Fend - wFG(p.ws)[((r * 2 + dir) * MH + h) * 2 + 1]);
            if (jrow < MD) acc += w * bf2f(wMQK(p.ws)[r * 2 * MW + MW + h * MD + jrow]) * bf2f(wP(p.ws)[r * NP + ML_LO + MW + h * MD + e]);
            else acc += w * bf2f(wMQK(p.ws)[r * 2 * MW + MW + h * MD + e]); }
        wMS(p.ws)[i] = acc;
    }
}
template <> DEV void phase<PH_ML_S>(PRef p, int, int dry, long gtid, long gth) {
    for (long i = gtid; i < (long)B * MH * 2 * (MD + 1) * MD; i += gth) {
        const int el = (int)(i % ((MD + 1) * MD)); long t = i / ((MD + 1) * MD); const int dir = (int)(t % 2); t /= 2; const int h = (int)(t % MH); const int b = (int)(t / MH);
        float* base = wMS(p.ws) + ((((long)b * MH + h) * 2 + dir) * SCN) * (MD + 1) * MD + el;
        float C = 0.f;
        for (int k = 0; k < SCN; ++k) { const int sc = ml_scan_sc(dir, k);
            const long r0 = (long)b * RPB + (long)sc * SCS; const long rend = dir == 0 ? r0 + SCS - 1 : r0;
            const float Ftot = wFG(p.ws)[((rend * 2 + dir) * MH + h) * 2];
            float* slot = base + (long)sc * (MD + 1) * MD; const float Bk = *slot; if (!dry) *slot = C;
            C = exp_f(Ftot) * C + Bk; }
    }
}
template <> DEV void phase<PH_ML_O>(PRef p, int l, int, long gtid, long gth) {
    const bool last = (l == DEPTH - 1);
    constexpr int HV = MD / 2;
    for (long i = gtid; i < (long)MH * R; i += gth) {
        const int h = (int)(i / R); const long r = i % R; const RowI ri = rowinfo((int)r);
        if (ri.ctx && last) continue;
        const bf16* qp = wMQK(p.ws) + r * 2 * MW + h * MD;
        const int sc = ri.o / SCS; const long r0 = (long)ri.b * RPB + (long)sc * SCS;
        float ss = 0.f;
        for (int half = 0; half < 2; ++half) {
            float hs[HV], num[HV];
#pragma unroll
            for (int d = 0; d < HV; ++d) hs[d] = 0.f;
            for (int dir = 0; dir < 2; ++dir) {
#pragma unroll
                for (int d = 0; d < HV; ++d) num[d] = 0.f;
                float den = 0.f;
                const float Ft = wFG(p.ws)[((r * 2 + dir) * MH + h) * 2];
                const long sa = dir == 0 ? r0 : r, sb = dir == 0 ? r : r0 + SCS - 1;
                for (long s = sa; s <= sb; ++s) {
                    const float w = exp_f(Ft - wFG(p.ws)[((s * 2 + dir) * MH + h) * 2 + 1]);
                    float dt = 0.f;
#pragma unroll
                    for (int d = 0; d < MD; d += 8) dt += dot8(*(const U4*)(qp + d), *(const U4*)(wMQK(p.ws) + s * 2 * MW + MW + h * MD + d));
                    dt *= w; den += dt;
#pragma unroll
                    for (int d = 0; d < HV; ++d) num[d] += dt * bf2f(wP(p.ws)[s * NP + ML_LO + MW + h * MD + half * HV + d]);
                }
                if (ml_sc_rank(dir, sc) > 0) {
                    const float a = exp_f(Ft);
                    const float* Cin = wMS(p.ws) + (((((long)ri.b * MH + h) * 2 + dir) * SCN) + sc) * (MD + 1) * MD;
#pragma unroll 1
                    for (int d = 0; d < MD; ++d) { const float qa = bf2f(qp[d]) * a; den += qa * Cin[MD * MD + d];
#pragma unroll
                        for (int e = 0; e < HV; ++e) num[e] += qa * Cin[d * MD + half * HV + e]; }
                }
                const float dn = 1.0f / fmaxf(fabsf(den), 1.0f);
#pragma unroll
                for (int d = 0; d < HV; ++d) hs[d] += num[d] * dn;
            }
#pragma unroll
            for (int d = 0; d < HV; ++d) { const float v = hs[d] * sigmoid_f(bf2f(wP(p.ws)[r * NP + ML_LO + 2 * MW + h * MD + half * HV + d])); ss += v * v;
                wH(p.ws)[r * D + AW + h * MD + half * HV + d] = f2bf(v); }
        }
        const float rstd = 1.0f / sqrtf(ss / (float)MD + EPS);
        for (int d = 0; d < MD; ++d) { bf16* o = wH(p.ws) + r * D + AW + h * MD + d; *o = f2bf(bf2f(*o) * rstd * p.ml_norm_g[l * MW + h * MD + d]); }
    }
}

DEV float hy_conv(PRef p, int l, long r, const RowI& ri, int ch) {
    const float* w = p.hy_conv_w + (long)l * 3 * N_HY; const bf16* pr = wP(p.ws) + r * NP + HY_LO + ch;
    float y = p.hy_conv_b[l * N_HY + ch] + w[N_HY + ch] * bf2f(pr[0]);
    if (has_prev(ri)) y += w[ch] * bf2f(pr[-NP]);
    if (has_next(ri)) y += w[2 * N_HY + ch] * bf2f(pr[NP]);
    return y;
}
template <> DEV void phase<PH_HY_Z>(PRef p, int l, int, long gtid, long gth) {
    for (long i = gtid; i < (long)B * CTX * HW; i += gth) { const int c = (int)(i % HW); const long q = i / HW; const long r = (q / CTX) * RPB + (q % CTX); const RowI ri = rowinfo((int)r);
        wZ(p.ws)[i] = hy_conv(p, l, r, ri, HW + c) * hy_conv(p, l, r, ri, 2 * HW + c); }
}
template <> DEV void phase<PH_HY_O>(PRef p, int l, int, long gtid, long gth) {
    if (l == DEPTH - 1) return;
    for (long i = gtid; i < (long)B * CTX * HW; i += gth) { const int c = (int)(i % HW); const long q = i / HW; const int b = (int)(q / CTX), t = (int)(q % CTX); const long r = (long)b * RPB + t; const RowI ri = rowinfo((int)r);
        const float* z = wZ(p.ws) + (long)b * CTX * HW + c;
        float y = 0.f;
        for (int s2 = 0; s2 <= t; ++s2) y += filt_tap(p, 1, c, t - s2) * z[(long)s2 * HW];
        for (int s2 = t + 1; s2 < CTX; ++s2) y += filt_tap(p, 1, HW + c, s2 - t) * z[(long)s2 * HW];
        y = y / filt_l1(p, 1, c) + z[(long)t * HW] * p.hy_bias_d[l * HW + c];
        wH(p.ws)[r * D + AW + MW + c] = f2bf(hy_conv(p, l, r, ri, c) * y); }
}
#ifdef HOST_EMU
#define BLOCK_FOR(tid) for (int tid = 0; tid < NTHREADS; ++tid)
#define BLOCK_SYNC() do {} while (0)
typedef unsigned char* LdsPtr;
DEV C2 twid(float turns) { C2 w; w.x = cosf(6.283185307179586f * turns); w.y = -sinf(6.283185307179586f * turns); return w; }
#else
DEV int opaque_tid() { int t = threadIdx.x; asm volatile("" : "+v"(t)); return t; }
#define BLOCK_FOR(tid) for (int tid = opaque_tid(), once_ = 1; once_; once_ = 0)
#define BLOCK_SYNC() __syncthreads()
typedef __attribute__((address_space(3))) unsigned char* LdsPtr;
DEV C2 twid(float turns) { C2 w; w.x = __builtin_amdgcn_cosf(turns); w.y = -__builtin_amdgcn_sinf(turns); return w; }
#endif
#ifdef HOST_EMU
typedef float* LdsC2; typedef bf16* LdsBf;
#else
typedef __attribute__((address_space(3))) float* LdsC2; typedef __attribute__((address_space(3))) bf16* LdsBf;
#endif
constexpr int NF = 2 * SEQ, NBF = NF / 8;
static_assert(SEQ == 4096 || SEQ == 512, "FFT passes: one radix-2 step then radix-8 steps (SEQ a power of 8)");
DEV int PI(int i) { return i + (i >> 3); }
DEV C2 ldc(LdsC2 buf, int i) { C2 r; r.x = buf[2 * i]; r.y = buf[2 * i + 1]; return r; }
DEV void stc(LdsC2 buf, int i, C2 v) { buf[2 * i] = v.x; buf[2 * i + 1] = v.y; }
DEV C2 cmul(C2 a, C2 b) { C2 r; r.x = a.x * b.x - a.y * b.y; r.y = a.x * b.y + a.y * b.x; return r; }
DEV C2 cmulc(C2 a, C2 b) { C2 r; r.x = a.x * b.x + a.y * b.y; r.y = a.y * b.x - a.x * b.y; return r; }
DEV void dft4(C2& u0, C2& u1, C2& u2, C2& u3) {
    const C2 t0 = {u0.x + u2.x, u0.y + u2.y}, t1 = {u0.x - u2.x, u0.y - u2.y}, t2 = {u1.x + u3.x, u1.y + u3.y}, d = {u1.x - u3.x, u1.y - u3.y};
    const C2 t3 = {d.y, -d.x};
    u0.x = t0.x + t2.x; u0.y = t0.y + t2.y; u2.x = t0.x - t2.x; u2.y = t0.y - t2.y; u1.x = t1.x + t3.x; u1.y = t1.y + t3.y; u3.x = t1.x - t3.x; u3.y = t1.y - t3.y;
}
DEV void dft8(C2 (&a)[8]) {
    const float c = 0.70710678118654752f;
    C2 b0 = {a[0].x + a[4].x, a[0].y + a[4].y}, b4 = {a[0].x - a[4].x, a[0].y - a[4].y};
    C2 b1 = {a[1].x + a[5].x, a[1].y + a[5].y}, d5 = {a[1].x - a[5].x, a[1].y - a[5].y};
    C2 b2 = {a[2].x + a[6].x, a[2].y + a[6].y}, d6 = {a[2].x - a[6].x, a[2].y - a[6].y};
    C2 b3 = {a[3].x + a[7].x, a[3].y + a[7].y}, d7 = {a[3].x - a[7].x, a[3].y - a[7].y};
    C2 b5 = {c * (d5.x + d5.y), c * (d5.y - d5.x)};
    C2 b6 = {d6.y, -d6.x};
    C2 b7 = {c * (d7.y - d7.x), -c * (d7.x + d7.y)};
    dft4(b0, b1, b2, b3); dft4(b4, b5, b6, b7);
    a[0] = b0; a[2] = b1; a[4] = b2; a[6] = b3; a[1] = b4; a[3] = b5; a[5] = b6; a[7] = b7;
}
DEV void idft8(C2 (&a)[8]) {
#pragma unroll
    for (int k = 0; k < 8; ++k) a[k].y = -a[k].y;
    dft8(a);
#pragma unroll
    for (int k = 0; k < 8; ++k) a[k].y = -a[k].y;
}
DEV void twpow(C2 w1, C2 (&w)[8]) { w[0].x = 1.f; w[0].y = 0.f; w[1] = w1; w[2] = cmul(w1, w1); w[3] = cmul(w[2], w1); w[4] = cmul(w[2], w[2]); w[5] = cmul(w[4], w1); w[6] = cmul(w[3], w[3]); w[7] = cmul(w[4], w[3]); }
template <bool INV> DEV void fft_pass8(LdsC2 buf, int s, int ls, int tid) {
    for (int q = tid; q < NBF; q += NTHREADS) {
        const int blk = q >> ls, j = q & (s - 1), base = (blk << (ls + 3)) + j;
        C2 a[8], w[8];
#pragma unroll
        for (int k = 0; k < 8; ++k) a[k] = ldc(buf, PI(base + (k << ls)));
        twpow(twid((float)j / (float)(8 * s)), w);
        if (!INV) { dft8(a);
#pragma unroll
            for (int m = 1; m < 8; ++m) a[m] = cmul(a[m], w[m]);
        } else {
#pragma unroll
            for (int m = 1; m < 8; ++m) a[m] = cmulc(a[m], w[m]);
            idft8(a); }
#pragma unroll
        for (int k = 0; k < 8; ++k) stc(buf, PI(base + (k << ls)), a[k]);
    }
}
DEV void fft_fwd_passes(LdsC2 buf, LdsC2 buf2 = nullptr) {
    int ls = (SEQ == 4096 ? 9 : 6);
    for (int s = SEQ / 8; s >= 8; s >>= 3, ls -= 3) { BLOCK_FOR(tid) { fft_pass8<false>(buf, s, ls, tid); if (buf2) fft_pass8<false>(buf2, s, ls, tid); } BLOCK_SYNC(); }
}
DEV void fft_inv_passes(LdsC2 buf, LdsC2 buf2 = nullptr) {
    int ls = 3;
    for (int s = 8; s <= SEQ / 8; s <<= 3, ls += 3) { BLOCK_FOR(tid) { fft_pass8<true>(buf, s, ls, tid); if (buf2) fft_pass8<true>(buf2, s, ls, tid); } BLOCK_SYNC(); }
}
enum { BPH_HFFT, BPH_HYFFT, BPH_HYZ, BPH_HYOUT, BPH_WCVT, BPH_HYCTX };
template <int BPH> DEV void bphase(PRef p, int l, int blk, LdsPtr lds);
constexpr int WT_UP = (D / 32) * (FF2 / 64), WT_DOWN = (FF / 32) * (D / 64), WT_IN = (D / 32) * (NP / 64), WT_UQ = (QR / 32) * (QW / 64), WT_UKV = (KVR / 32) * (KVW / 64), WT_OUT = (D / 32) * (D / 64);
constexpr int WT_ALL = WT_IN + WT_UQ + WT_UKV + WT_OUT + WT_UP + WT_DOWN;
static_assert(QR % 32 == 0 && KVR % 32 == 0 && QW % 64 == 0 && FF % 64 == 0 && NP % 64 == 0, "weight tiles");
struct WTile { const float* W; const float* gain; bf16* WT; int K, N, k0, n0, s0; };
DEV WTile wtile_decode(PRef p, int l, int t) {
    WTile w; w.gain = nullptr; int NT, which;
    if (t < WT_IN) { which = 0; w.W = p.w_in + (long)l * D * N_IN; w.WT = wWinT(p.ws, l); w.K = D; w.N = N_IN; NT = NP; }
    else if ((t -= WT_IN) < WT_UQ) { which = 1; w.W = p.w_uq + (long)l * QR * QW; w.gain = p.q_norm_g + l * QR; w.WT = wWuqT(p.ws, l); w.K = QR; w.N = QW; NT = QW; }
    else if ((t -= WT_UQ) < WT_UKV) { which = 2; w.W = p.w_ukv + (long)l * KVR * KVW; w.gain = p.kv_norm_g + l * KVR; w.WT = wWukvT(p.ws, l); w.K = KVR; w.N = KVW; NT = KVW; }
    else if ((t -= WT_UKV) < WT_OUT) { which = 3; w.W = p.w_out + (long)l * D * D; w.WT = wWoutT(p.ws, l); w.K = D; w.N = D; NT = D; }
    else if ((t -= WT_OUT) < WT_UP) { which = 4; w.W = p.w_up + (long)l * D * FF2; w.WT = wWupT(p.ws, l); w.K = D; w.N = FF2; NT = FF2; }
    else { t -= WT_UP; which = 5; w.W = p.w_down + (long)l * FF * D; w.WT = wWdownT(p.ws, l); w.K = FF; w.N = D; NT = D; }
    const int ntn = NT / 64, kb = t / ntn, nb = t % ntn; w.k0 = kb * 32; w.n0 = nb * 64;
    w.s0 = w.n0;
    if (which == 2) { const int hd = (w.n0 % AW) / 64; w.s0 = hd * (NOPE + AV) + (w.n0 < AW ? 0 : NOPE); }
#ifndef HOST_EMU
    if (which == 4) { const int tile = w.n0 / 256, within = w.n0 % 256; w.s0 = within < 128 ? tile * 128 + within : FF + tile * 128 + (within - 128); }
#endif
    return w;
}
constexpr int DOWN_BUSY = (R / 256 * (D / 256)) % NBLOCKS, NFILL = NBLOCKS - DOWN_BUSY;
constexpr int WT_PER = 4, WT_ITEMS = (WT_ALL + WT_PER - 1) / WT_PER, WT_SPLIT = (WT_IN + WT_UQ + WT_UKV + WT_OUT + WT_PER - 1) / WT_PER;
template <> DEV void bphase<BPH_WCVT>(PRef p, int l, int blk, LdsPtr lds) {
#ifdef HOST_EMU
    float* sm = (float*)lds;
#else
    __attribute__((address_space(3))) float* sm = (__attribute__((address_space(3))) float*)lds;
#endif
    BLOCK_FOR(tid) {
        for (int sub = 0; sub < WT_PER; ++sub) { const int t = blk * WT_PER + sub; if (t >= WT_ALL) break; const WTile w = wtile_decode(p, l, t);
            for (int idx = tid; idx < 32 * 64; idx += NTHREADS) { const int kk = idx >> 6, nn = idx & 63;
                float v = 0.f; if (w.s0 + nn < w.N) v = w.W[(long)(w.k0 + kk) * w.N + w.s0 + nn];
                if (w.gain) v *= w.gain[w.k0 + kk];
                sm[sub * 64 * 33 + nn * 33 + kk] = v; } }
    }
    BLOCK_SYNC();
    BLOCK_FOR(tid) {
        for (int sub = 0; sub < WT_PER; ++sub) { const int t = blk * WT_PER + sub; if (t >= WT_ALL) break; const WTile w = wtile_decode(p, l, t);
            for (int idx = tid; idx < 64 * 4; idx += NTHREADS) { const int nn = idx >> 2, ch = idx & 3; const int so = sub * 64 * 33 + nn * 33 + ch * 8;
                U4 o;
                o.x = f2bf(sm[so + 0]) | ((unsigned)f2bf(sm[so + 1]) << 16); o.y = f2bf(sm[so + 2]) | ((unsigned)f2bf(sm[so + 3]) << 16);
                o.z = f2bf(sm[so + 4]) | ((unsigned)f2bf(sm[so + 5]) << 16); o.w = f2bf(sm[so + 6]) | ((unsigned)f2bf(sm[so + 7]) << 16);
                *(U4*)(w.WT + (long)(w.n0 + nn) * w.K + w.k0 + ch * 8) = o; } }
    }
    BLOCK_SYNC();
}
template <> DEV void bphase<BPH_HFFT>(PRef p, int l, int blk, LdsPtr lds) {
    LdsC2 buf = (LdsC2)lds; const int c = blk;
    BLOCK_FOR(tid) {
        const float inv = 1.0f / filt_l1(p, 0, c), bias = p.hy_bias_d[l * HW + c];
        const float* fw = wFT(p.ws) + (long)c * SEQ; const float* bw = wFT(p.ws) + (long)(HW + c) * SEQ;
        for (int i = tid; i < SEQ; i += NTHREADS) {
            const float t0 = fw[i] * inv + (i == 0 ? bias : 0.f), t1 = (i == 0) ? 0.f : bw[SEQ - i] * inv;
            C2 e; e.x = t0 + t1; e.y = 0.f; stc(buf, PI(i), e);
            const C2 w = twid((float)i / (float)NF); const float d = t0 - t1; C2 o; o.x = d * w.x; o.y = d * w.y; stc(buf, PI(i + SEQ), o); }
    }
    BLOCK_SYNC();
    fft_fwd_passes(buf);
    BLOCK_FOR(tid) {
        C2* hs = wHSPEC(p.ws) + (long)c * NF; const float sc = 1.0f / (float)NF;
        for (int q = tid; q < NBF; q += NTHREADS) { C2 a[8];
#pragma unroll
            for (int k = 0; k < 8; ++k) a[k] = ldc(buf, 9 * q + k);
            dft8(a);
#pragma unroll
            for (int k = 0; k < 8; ++k) { C2 o; o.x = a[k].x * sc; o.y = a[k].y * sc; hs[8 * q + k] = o; } }
    }
    BLOCK_SYNC();
}
template <> DEV void bphase<BPH_HYFFT>(PRef p, int lflag, int blk, LdsPtr lds) {
    const int c = blk;
    constexpr int NPB = (B >= 4 && B % 4 == 0) ? 2 : 1;
    LdsC2 bufs[2] = {(LdsC2)lds, (LdsC2)(lds + (NPB == 2 ? (NF + NF / 8) * 8 : 0))};
    for (int pr = 0; pr < B / 2; pr += NPB) {
        BLOCK_FOR(tid) {
#pragma unroll
            for (int k = 0; k < NPB; ++k) { LdsC2 buf = bufs[k]; const bf16* z1 = wZT(p.ws) + ((long)(2 * (pr + k)) * HW + c) * SEQ; const bf16* z2 = z1 + (long)HW * SEQ;
                for (int i = tid; i < SEQ; i += NTHREADS) { C2 e; e.x = bf2f(z1[i]); e.y = bf2f(z2[i]); stc(buf, PI(i), e); stc(buf, PI(i + SEQ), cmul(e, twid((float)i / (float)NF))); } }
        }
        BLOCK_SYNC();
        fft_fwd_passes(bufs[0], NPB == 2 ? bufs[1] : nullptr);
        BLOCK_FOR(tid) {
            const C2* hs = wHSPEC(p.ws) + (long)c * NF;
            for (int q = tid; q < NBF; q += NTHREADS) { C2 hv[8];
#pragma unroll
                for (int k = 0; k < 8; ++k) hv[k] = hs[8 * q + k];
#pragma unroll
                for (int kb = 0; kb < NPB; ++kb) { LdsC2 buf = bufs[kb]; C2 a[8];
#pragma unroll
                    for (int k = 0; k < 8; ++k) a[k] = ldc(buf, 9 * q + k);
                    dft8(a);
#pragma unroll
                    for (int k = 0; k < 8; ++k) a[k] = cmul(a[k], hv[k]);
                    idft8(a);
#pragma unroll
                    for (int k = 0; k < 8; ++k) stc(buf, 9 * q + k, a[k]); } }
        }
        BLOCK_SYNC();
        fft_inv_passes(bufs[0], NPB == 2 ? bufs[1] : nullptr);
        BLOCK_FOR(tid) {
#pragma unroll
            for (int k = 0; k < NPB; ++k) { LdsC2 buf = bufs[k]; bf16* z1 = wZT(p.ws) + ((long)(2 * (pr + k)) * HW + c) * SEQ; bf16* z2 = z1 + (long)HW * SEQ;
                for (int i = tid; i < SEQ; i += NTHREADS) { const C2 a = ldc(buf, PI(i)), bb = ldc(buf, PI(i + SEQ)); const C2 y = cmulc(bb, twid((float)i / (float)NF));
                    if (!(lflag & 256)) { z1[i] = f2bf(a.x + y.x); z2[i] = f2bf(a.y + y.y); } } }
        }
        BLOCK_SYNC();
    }
}
template <> DEV void bphase<BPH_HYCTX>(PRef p, int l, int blk, LdsPtr lds) {
#ifdef HOST_EMU
    typedef float* SmF; struct F4 { float v[4]; };
#define HYC_LD4(ptr) (*(const F4*)(ptr))
#else
    typedef __attribute__((address_space(3))) float* SmF; struct F4 { float v[4]; };
    typedef float hyc_f4 __attribute__((ext_vector_type(4)));
#define HYC_LD4(ptr) hyc_ld4(ptr)
    auto hyc_ld4 = [](SmF q) { const hyc_f4 t = *(const __attribute__((address_space(3))) hyc_f4*)q; F4 r; r.v[0] = t[0]; r.v[1] = t[1]; r.v[2] = t[2]; r.v[3] = t[3]; return r; };
#endif
    SmF sm = (SmF)lds;
    const int b = blk / (HW / 8), c0 = (blk % (HW / 8)) * 8;
    constexpr int ZO = 0, GO = 8 * CTX, IO = GO + 16 * CTX, YO = IO + 8;
    static_assert(CTX % 4 == 0 && (YO + 8 * CTX) * 4 <= 160 * 1024, "ctx hyena LDS");
    BLOCK_FOR(tid) {
        for (int idx = tid; idx < CTX * 8; idx += NTHREADS) { const int t = idx >> 3, c = idx & 7;
            sm[ZO + c * CTX + t] = wZ(p.ws)[((long)b * CTX + t) * HW + c0 + c];
            sm[GO + c * 2 * CTX + CTX + t] = wFT1(p.ws)[(long)t * 2 * HW + c0 + c];
            sm[GO + c * 2 * CTX + CTX - t - (t == 0 ? CTX : 0)] = t == 0 ? 0.f : wFT1(p.ws)[(long)t * 2 * HW + HW + c0 + c]; }
        if (tid < 8) sm[IO + tid] = 1.0f / filt_l1(p, 1, c0 + tid);
    }
    BLOCK_SYNC();
    BLOCK_FOR(tid) {
        for (int idx = tid; idx < 8 * (CTX / 4); idx += NTHREADS) { const int c = idx / (CTX / 4), t0 = (idx % (CTX / 4)) * 4;
            SmF z = sm + ZO + c * CTX; SmF g = sm + GO + c * 2 * CTX;
            float y[4] = {0.f, 0.f, 0.f, 0.f};
            for (int s2 = 0; s2 < CTX; s2 += 4) { const int base = t0 + CTX - s2;
                const F4 zv = HYC_LD4(z + s2), glo = HYC_LD4(g + base - 4), ghi = HYC_LD4(g + base);
                const float w[7] = {glo.v[1], glo.v[2], glo.v[3], ghi.v[0], ghi.v[1], ghi.v[2], ghi.v[3]};
#pragma unroll
                for (int i = 0; i < 4; ++i)
#pragma unroll
                    for (int j = 0; j < 4; ++j) y[i] += w[i - j + 3] * zv.v[j]; }
            const float inv = sm[IO + c], bias = p.hy_bias_d[l * HW + c0 + c];
#pragma unroll
            for (int i = 0; i < 4; ++i) { const int t = t0 + i; const long r = (long)b * RPB + t; const RowI ri = rowinfo((int)r);
                sm[YO + t * 8 + c] = hy_conv(p, l, r, ri, c0 + c) * (y[i] * inv + z[t] * bias); } }
    }
    BLOCK_SYNC();
    BLOCK_FOR(tid) {
        for (int t = tid; t < CTX; t += NTHREADS) { float o[8];
#pragma unroll
            for (int e = 0; e < 8; ++e) o[e] = sm[YO + t * 8 + e];
            *(U4*)(wH(p.ws) + ((long)b * RPB + t) * D + AW + MW + c0) = pack8(o); }
    }
    BLOCK_SYNC();
#undef HYC_LD4
}
constexpr int HZP = 72;
static_assert(HZP % 8 == 0, "hyena LDS rows keep 16-byte alignment");
#ifdef HOST_EMU
DEV void lds_st8(LdsBf q, U2 v) { *(U2*)q = v; }
DEV U2 lds_ld8(LdsBf q) { return *(const U2*)q; }
DEV void lds_st16(LdsBf q, U4 v) { *(U4*)q = v; }
DEV U4 lds_ld16(LdsBf q) { return *(const U4*)q; }
#else
typedef unsigned lds_u2v __attribute__((ext_vector_type(2))); typedef unsigned lds_u4v __attribute__((ext_vector_type(4)));
DEV void lds_st8(LdsBf q, U2 v) { lds_u2v t; t.x = v.x; t.y = v.y; *(__attribute__((address_space(3))) lds_u2v*)q = t; }
DEV U2 lds_ld8(LdsBf q) { const lds_u2v t = *(const __attribute__((address_space(3))) lds_u2v*)q; U2 v; v.x = t.x; v.y = t.y; return v; }
DEV void lds_st16(LdsBf q, U4 v) { lds_u4v t; t.x = v.x; t.y = v.y; t.z = v.z; t.w = v.w; *(__attribute__((address_space(3))) lds_u4v*)q = t; }
DEV U4 lds_ld16(LdsBf q) { const lds_u4v t = *(const __attribute__((address_space(3))) lds_u4v*)q; U4 v; v.x = t.x; v.y = t.y; v.z = t.z; v.w = t.w; return v; }
#endif
template <> DEV void bphase<BPH_HYZ>(PRef p, int l, int blk, LdsPtr lds) {
    LdsBf sm = (LdsBf)lds; const int b = blk / (SEQ / 64), tt = blk % (SEQ / 64); const long r0 = (long)b * RPB + CTX + (long)tt * 64;
    BLOCK_FOR(tid) { for (int it = tid; it < (HW / 8) * 16; it += NTHREADS) {
        const int cg = it % (HW / 8), rs = it / (HW / 8); const int t0 = tt * 64 + rs * 4; const long r = r0 + rs * 4;
        float a[4][8], v[4][8];
        conv4x8(wP(p.ws) + r * NP + HY_LO + HW + cg * 8, NP, p.hy_conv_w + (long)l * 3 * N_HY + HW + cg * 8, N_HY, p.hy_conv_b + l * N_HY + HW + cg * 8, t0 > 0, t0 + 4 < SEQ, a);
        conv4x8(wP(p.ws) + r * NP + HY_LO + 2 * HW + cg * 8, NP, p.hy_conv_w + (long)l * 3 * N_HY + 2 * HW + cg * 8, N_HY, p.hy_conv_b + l * N_HY + 2 * HW + cg * 8, t0 > 0, t0 + 4 < SEQ, v);
#pragma unroll
        for (int e = 0; e < 8; ++e) { U2 w; w.x = f2bf(a[0][e] * v[0][e]) | ((unsigned)f2bf(a[1][e] * v[1][e]) << 16); w.y = f2bf(a[2][e] * v[2][e]) | ((unsigned)f2bf(a[3][e] * v[3][e]) << 16);
            lds_st8(sm + (cg * 8 + e) * HZP + rs * 4, w); }
    } }
    BLOCK_SYNC();
    BLOCK_FOR(tid) {
        for (int idx = tid; idx < HW * 8; idx += NTHREADS) { const int c = idx >> 3, ch = idx & 7;
            const U4 v = lds_ld16(sm + c * HZP + ch * 8);
            *(U4*)(wZT(p.ws) + ((long)b * HW + c) * SEQ + tt * 64 + ch * 8) = v; }
    }
    BLOCK_SYNC();
}
template <> DEV void bphase<BPH_HYOUT>(PRef p, int l, int blk, LdsPtr lds) {
    LdsBf sm = (LdsBf)lds; const int b = blk / (SEQ / 64), tt = blk % (SEQ / 64); const long r0 = (long)b * RPB + CTX + (long)tt * 64;
    BLOCK_FOR(tid) {
        for (int idx = tid; idx < HW * 8; idx += NTHREADS) { const int c = idx >> 3, ch = idx & 7;
            lds_st16(sm + c * HZP + ch * 8, *(const U4*)(wZT(p.ws) + ((long)b * HW + c) * SEQ + tt * 64 + ch * 8)); }
    }
    BLOCK_SYNC();
    BLOCK_FOR(tid) { for (int it = tid; it < (HW / 8) * 16; it += NTHREADS) {
        const int cg = it % (HW / 8), rs = it / (HW / 8); const int t0 = tt * 64 + rs * 4; const long r = r0 + rs * 4;
        float x0[4][8];
        conv4x8(wP(p.ws) + r * NP + HY_LO + cg * 8, NP, p.hy_conv_w + (long)l * 3 * N_HY + cg * 8, N_HY, p.hy_conv_b + l * N_HY + cg * 8, t0 > 0, t0 + 4 < SEQ, x0);
#pragma unroll
        for (int e = 0; e < 8; ++e) { const U2 y = lds_ld8(sm + (cg * 8 + e) * HZP + rs * 4);
            x0[0][e] *= bflo(y.x); x0[1][e] *= bfhi(y.x); x0[2][e] *= bflo(y.y); x0[3][e] *= bfhi(y.y); }
#pragma unroll
        for (int k = 0; k < 4; ++k) *(U4*)(wH(p.ws) + (r + k) * D + AW + MW + cg * 8) = pack8(x0[k]);
    } }
    BLOCK_SYNC();
}
template <> DEV void phase<PH_GEMM_OUT>(PRef p, int l, int, long gtid, long gth) {
    for (long i = gtid; i < (long)R * D; i += gth) { const int n = (int)(i % D); const long r = i / D; const RowI ri = rowinfo((int)r);
        const float g1 = wMOD(p.ws)[((long)l * (B + 1) + ri.bi) * 6 * D + 2 * D + n];
        wX(p.ws)[i] = f2bf(bf2f(wX(p.ws)[i]) + g1 * dot_bf16(wH(p.ws) + r * D, wWoutT(p.ws, l) + (long)n * D, D)); }
}
template <> DEV void phase<PH_NORM2>(PRef p, int l, int, long gtid, long gth) {
    for (long r = gtid; r < R; r += gth) { const RowI ri = rowinfo((int)r); const bf16* xr = wX(p.ws) + r * D;
        float ss = 0.f; for (int k = 0; k < D; ++k) ss += bf2f(xr[k]) * bf2f(xr[k]);
        const float rstd = 1.0f / sqrtf(ss / (float)D + EPS);
        const float* mod = wMOD(p.ws) + ((long)l * (B + 1) + ri.bi) * 6 * D; const float* g = p.norm2_g + l * D;
        for (int k = 0; k < D; ++k) wH(p.ws)[r * D + k] = f2bf(bf2f(xr[k]) * rstd * g[k] * (1.0f + mod[4 * D + k]) + mod[3 * D + k]); }
}
template <> DEV void phase<PH_FFN_UP>(PRef p, int l, int fc, long gtid, long gth) {
    for (long i = gtid; i < (long)FCR * FF2; i += gth) { const int n = (int)(i % FF2); const long rr = i / FF2; const long r = (long)fc * FCR + rr;
        wUF(p.ws)[i] = f2bf(dot_bf16(wH(p.ws) + r * D, wWupT(p.ws, l) + (long)n * D, D)); }
}
template <> DEV void phase<PH_FFN_CG>(PRef p, int l, int fc, long gtid, long gth) {
    for (long i = gtid; i < (long)FCR * FF; i += gth) { const int j = (int)(i % FF); const long rr = i / FF; const long r = (long)fc * FCR + rr; const RowI ri = rowinfo((int)r);
        const float* w = p.ffn_conv_w + (long)l * 3 * FF2; const float* cb = p.ffn_conv_b + (long)l * FF2; const bf16* u = wUF(p.ws) + rr * FF2;
        float a = cb[j] + w[FF2 + j] * bf2f(u[j]), g = cb[FF + j] + w[FF2 + FF + j] * bf2f(u[FF + j]);
        if (has_prev(ri)) { a += w[j] * bf2f(u[j - FF2]); g += w[FF + j] * bf2f(u[FF + j - FF2]); }
        if (has_next(ri)) { a += w[2 * FF2 + j] * bf2f(u[j + FF2]); g += w[2 * FF2 + FF + j] * bf2f(u[FF + j + FF2]); }
        wGF(p.ws)[i] = f2bf(silu_f(a) * g); }
}
template <> DEV void phase<PH_FFN_DOWN>(PRef p, int l, int fc, long gtid, long gth) {
    for (long i = gtid; i < (long)FCR * D; i += gth) { const int n = (int)(i % D); const long rr = i / D; const long r = (long)fc * FCR + rr; const RowI ri = rowinfo((int)r);
        const float g2 = wMOD(p.ws)[((long)l * (B + 1) + ri.bi) * 6 * D + 5 * D + n];
        const float xn = bf2f(wX(p.ws)[r * D + n]) + g2 * dot_bf16(wGF(p.ws) + rr * FF, wWdownT(p.ws, l) + (long)n * FF, FF);
        wX(p.ws)[r * D + n] = f2bf(xn); }
}
template <> DEV void phase<PH_FINAL>(PRef p, int, int, long gtid, long gth) {
    for (long q = gtid; q < (long)B * SEQ; q += gth) { const bf16* xr = wX(p.ws) + ((q / SEQ) * RPB + CTX + q % SEQ) * D;
        float ss = 0.f; for (int k = 0; k < D; ++k) ss += bf2f(xr[k]) * bf2f(xr[k]);
        const float rstd = 1.0f / sqrtf(ss / (float)D + EPS);
        for (int k = 0; k < D; ++k) p.out[q * D + k] = bf2f(xr[k]) * rstd * p.final_g[k]; }
}


#ifndef HOST_EMU
namespace wv {
typedef float f32x4 __attribute__((ext_vector_type(4)));
typedef unsigned u32x2 __attribute__((ext_vector_type(2)));
__device__ __forceinline__ float wsum(float v, int lane) {
#pragma unroll
    for (int o = 32; o; o >>= 1) v += __int_as_float(__builtin_amdgcn_ds_bpermute((lane ^ o) << 2, __float_as_int(v)));
    return v;
}
typedef __bf16 bf2_t __attribute__((ext_vector_type(2)));
typedef float f32x2_t __attribute__((ext_vector_type(2)));
__device__ __forceinline__ unsigned pk(float lo, float hi) { f32x2_t v = {lo, hi}; return __builtin_bit_cast(unsigned, __builtin_convertvector(v, bf2_t)); }
constexpr int NW = NBLOCKS * (NTHREADS / 64), NV = D / 256;
template <int MODE> __device__ __forceinline__ void norm_rows(PRef p, int l) {
    int t_ = threadIdx.x; asm volatile("" : "+v"(t_)); const int lane = t_ & 63, gw = (int)blockIdx.x * (NTHREADS / 64) + (t_ >> 6);
    constexpr int nrows = MODE == 2 ? B * SEQ : R, RPW = nrows / NW;
    static_assert(nrows % NW == 0, "norm rows per wave");
    const int qbase = gw * RPW;
    f32x4 A[NV], Sh[NV], G[NV]; int cur = -1;
    const float* g = MODE == 2 ? p.final_g : (MODE == 0 ? p.norm1_g : p.norm2_g) + l * D;
#pragma unroll
    for (int j = 0; j < NV; ++j) { G[j] = *(const f32x4*)(g + 4 * lane + 256 * j); A[j] = G[j]; Sh[j] = (f32x4){0.f, 0.f, 0.f, 0.f}; }
    for (int k = 0; k < RPW; k += 2) {
        const bool two = k + 1 < RPW;
        long r[2]; int bi[2]; const float* src[2] = {nullptr, nullptr}; bf16* xdst[2] = {nullptr, nullptr};
        f32x4 v[2][NV];
#pragma unroll
        for (int u = 0; u < 2; ++u) if (u == 0 || two) {
            const int q = qbase + k + u;
            if (MODE == 2) { r[u] = (long)(q / SEQ) * RPB + CTX + (q % SEQ); bi[u] = 0; }
            else { r[u] = q; const RowI ri = rowinfo(q); bi[u] = ri.bi;
                if (MODE == 0 && l == 0) { src[u] = ri.ctx ? p.ctx + ((long)ri.b * CTX + ri.t) * D : p.x + ((long)ri.b * SEQ + ri.t) * D; xdst[u] = wX(p.ws) + r[u] * D; } }
#pragma unroll
            for (int j = 0; j < NV; ++j) {
                if (src[u]) v[u][j] = *(const f32x4*)(src[u] + 4 * lane + 256 * j);
                else { const u32x2 xw = *(const u32x2*)(wX(p.ws) + r[u] * D + 4 * lane + 256 * j); v[u][j][0] = __uint_as_float(xw.x << 16); v[u][j][1] = __uint_as_float(xw.x & 0xFFFF0000u); v[u][j][2] = __uint_as_float(xw.y << 16); v[u][j][3] = __uint_as_float(xw.y & 0xFFFF0000u); } }
        }
#pragma unroll
        for (int u = 0; u < 2; ++u) if (u == 0 || two) {
            const int q = qbase + k + u;
            if (MODE != 2 && bi[u] != cur) {
                cur = bi[u];
                const float* mod = wMOD(p.ws) + ((long)l * (B + 1) + cur) * 6 * D + (MODE == 0 ? 0 : 3 * D);
#pragma unroll
                for (int j = 0; j < NV; ++j) { const int kk = 4 * lane + 256 * j; Sh[j] = *(const f32x4*)(mod + kk); const f32x4 sc = *(const f32x4*)(mod + D + kk); A[j] = G[j] * (sc + 1.0f); }
            }
            float ss = 0.f;
#pragma unroll
            for (int j = 0; j < NV; ++j) ss += (v[u][j][0] * v[u][j][0] + v[u][j][1] * v[u][j][1]) + (v[u][j][2] * v[u][j][2] + v[u][j][3] * v[u][j][3]);
            if (xdst[u]) {
#pragma unroll
                for (int j = 0; j < NV; ++j) { u32x2 w; w.x = pk(v[u][j][0], v[u][j][1]); w.y = pk(v[u][j][2], v[u][j][3]); *(u32x2*)(xdst[u] + 4 * lane + 256 * j) = w; } }
            const float rstd = 1.0f / sqrtf(wsum(ss, lane) / (float)D + EPS);
            if (MODE == 2) {
#pragma unroll
                for (int j = 0; j < NV; ++j) *(f32x4*)(p.out + (long)q * D + 4 * lane + 256 * j) = v[u][j] * rstd * A[j];
            } else {
#pragma unroll
                for (int j = 0; j < NV; ++j) { const int kk = 4 * lane + 256 * j;
                    const f32x4 o = v[u][j] * rstd * A[j] + Sh[j]; u32x2 w; w.x = pk(o[0], o[1]); w.y = pk(o[2], o[3]); *(u32x2*)(wH(p.ws) + r[u] * D + kk) = w; }
            }
        }
    }
}
__device__ __forceinline__ float rsum16(float v) {
    v += __int_as_float(__builtin_amdgcn_update_dpp(0, __float_as_int(v), 0x128, 0xf, 0xf, false));
    v += __int_as_float(__builtin_amdgcn_update_dpp(0, __float_as_int(v), 0x124, 0xf, 0xf, false));
    v += __int_as_float(__builtin_amdgcn_update_dpp(0, __float_as_int(v), 0x122, 0xf, 0xf, false));
    v += __int_as_float(__builtin_amdgcn_update_dpp(0, __float_as_int(v), 0x121, 0xf, 0xf, false));
    return v;
}
__device__ __forceinline__ void mla_a_rows(PRef p) {
    int t_ = threadIdx.x; asm volatile("" : "+v"(t_)); const int lane = t_ & 63, i = lane & 15, g = lane >> 4, gw = (int)blockIdx.x * (NTHREADS / 64) + (t_ >> 6);
    static_assert(QR == 3 * 128 && KVR == 2 * 128 && ROPE == 32 && R % 4 == 0, "mla_a lane map");
    for (int q0 = gw * 4; q0 < R; q0 += 8 * NW) {
        U4 uq[2][3], uk[2][2]; float x1[2], x2[2], cs[2], sn[2]; bool ok[2], cx[2] = {false, false};
#pragma unroll
        for (int u = 0; u < 2; ++u) {
            const int r = q0 + u * 4 * NW + g; ok[u] = r < R;
            if (ok[u]) { const RowI ri = rowinfo(r); const bf16* pr = wP(p.ws) + (long)r * NP;
#pragma unroll
                for (int c = 0; c < 3; ++c) uq[u][c] = *(const U4*)(pr + (i + 16 * c) * 8);
#pragma unroll
                for (int c = 0; c < 2; ++c) uk[u][c] = *(const U4*)(pr + QR + (i + 16 * c) * 8);
                x1[u] = bf2f(pr[QR + KVR + i]); x2[u] = bf2f(pr[QR + KVR + 16 + i]);
                const int tt = ri.ctx ? 0 : ri.t; cx[u] = ri.ctx; cs[u] = wROPET(p.ws)[((long)tt * 16 + i) * 2]; sn[u] = wROPET(p.ws)[((long)tt * 16 + i) * 2 + 1]; }
        }
#pragma unroll
        for (int u = 0; u < 2; ++u) {
            const int r = q0 + u * 4 * NW + g;
            float sq = 0.f, sk = 0.f;
            if (ok[u]) { sq = dot8(uq[u][0], uq[u][0]) + dot8(uq[u][1], uq[u][1]) + dot8(uq[u][2], uq[u][2]); sk = dot8(uk[u][0], uk[u][0]) + dot8(uk[u][1], uk[u][1]); }
            sq = rsum16(sq); sk = rsum16(sk);
            if (ok[u]) {
                if (i == 0) { wRS(p.ws)[r] = 1.0f / sqrtf(sq / (float)QR + EPS); wRS(p.ws)[R + r] = 1.0f / sqrtf(sk / (float)KVR + EPS); }
                const float c_ = cx[u] ? 1.0f : cs[u], s_ = cx[u] ? 0.0f : sn[u];
                wKR(p.ws)[(long)r * ROPE + i] = f2bf(x1[u] * c_ - x2[u] * s_); wKR(p.ws)[(long)r * ROPE + 16 + i] = f2bf(x1[u] * s_ + x2[u] * c_); }
        }
    }
}
__device__ __forceinline__ void ml_f_rows(PRef p, int l) {
    int t_ = threadIdx.x; asm volatile("" : "+v"(t_)); const int lane = t_ & 63, gw = (int)blockIdx.x * (NTHREADS / 64) + (t_ >> 6);
    static_assert(SCS == 256, "ml_f_rows: 64 lanes x 4 positions");
    for (int u = NW - 1 - gw; u < B * SCN * MH * 2; u += NW) {
        const int dir = u % 2, h = (u / 2) % MH, sc = (u / (2 * MH)) % SCN, b = u / (2 * MH * SCN);
        const float bi_ = p.ml_gate_b[(l * 4 + 2 * dir) * MH + h], bf_ = p.ml_gate_b[(l * 4 + 2 * dir + 1) * MH + h];
        const long rb = (long)b * RPB + (long)sc * SCS;
        float li[4], c[4]; float run = 0.f;
#pragma unroll
        for (int i = 0; i < 4; ++i) { const int pos = 4 * lane + i; const long r = rb + (dir == 0 ? pos : SCS - 1 - pos);
            const bf16* g = wP(p.ws) + r * NP + ML_LO + 3 * MW;
            li[i] = bf2f(g[(2 * dir) * MH + h]) + bi_; run += logsigmoid_f(bf2f(g[(2 * dir + 1) * MH + h]) + bf_); c[i] = run; }
        float inc = run;
#pragma unroll
        for (int o = 1; o < 64; o <<= 1) { const float t = __int_as_float(__builtin_amdgcn_ds_bpermute(((lane - o) & 63) << 2, __float_as_int(inc))); if (lane >= o) inc += t; }
        const float excl = inc - run;
#pragma unroll
        for (int i = 0; i < 4; ++i) { const int pos = 4 * lane + i; const long r = rb + (dir == 0 ? pos : SCS - 1 - pos); const float F = excl + c[i];
            float* fg = wFG(p.ws) + ((r * 2 + dir) * MH + h) * 2; fg[0] = F; fg[1] = F - li[i]; }
    }
}

constexpr int FROWS = (SEQ + CTX) / NBLOCKS;
static_assert((SEQ + CTX) % NBLOCKS == 0 && HH == 64 && 2 * HW == NTHREADS && FROWS * HH * 4 <= 65536, "filter block phases");
__device__ __forceinline__ void filt_b_block(PRef p, int l, __attribute__((address_space(3))) unsigned char* lds) {
    int t_ = threadIdx.x; asm volatile("" : "+v"(t_)); const int t = t_, j = t & 63, wv_ = t >> 6;
    __attribute__((address_space(3))) float* hs = (__attribute__((address_space(3))) float*)lds;
    const long g0 = (long)blockIdx.x * FROWS;
    __syncthreads();
    for (int idx = t; idx < FROWS * HH; idx += NTHREADS) hs[idx] = wHD1(p.ws)[g0 * HH + idx];
    const float* w2 = p.hy_w2 + (long)l * HH * HH;
    float w[HH];
#pragma unroll
    for (int e = 0; e < HH; ++e) w[e] = w2[e * HH + j];
    const float bj = p.hy_b2[l * HH + j], fj = p.hy_freq[l * HH + j];
    __syncthreads();
    for (int k = wv_; k < FROWS; k += NTHREADS / 64) {
        float acc = bj;
#pragma unroll
        for (int e4 = 0; e4 < HH / 4; ++e4) { const f32x4 h = *(const __attribute__((address_space(3))) f32x4*)(hs + k * HH + e4 * 4);
            acc += h[0] * w[4 * e4]; acc += h[1] * w[4 * e4 + 1]; acc += h[2] * w[4 * e4 + 2]; acc += h[3] * w[4 * e4 + 3]; }
        wHD2(p.ws)[(g0 + k) * HH + j] = sin_f(fj * acc);
    }
    __syncthreads();
}
__device__ __forceinline__ void filt_c_block(PRef p, int l, __attribute__((address_space(3))) unsigned char* lds) {
    int t_ = threadIdx.x; asm volatile("" : "+v"(t_)); const int c2 = t_;
    __attribute__((address_space(3))) float* hs = (__attribute__((address_space(3))) float*)lds;
    const long g0 = (long)blockIdx.x * FROWS;
    __syncthreads();
    for (int idx = c2; idx < FROWS * HH; idx += NTHREADS) hs[idx] = wHD2(p.ws)[g0 * HH + idx];
    const float* w3 = p.hy_w3 + (long)l * HH * 2 * HW;
    float w[HH];
#pragma unroll
    for (int e = 0; e < HH; ++e) w[e] = w3[e * 2 * HW + c2];
    const int c = c2 % HW;
    const float a0 = -4.605170185988091f / 1.5f, a1 = -4.605170185988091f / 0.3f;
    const float delta = fabsf(a0 + (a1 - a0) * (float)c / (float)(HW - 1));
    __syncthreads();
    for (int k = 0; k < FROWS; ++k) {
        float acc = 0.f;
#pragma unroll
        for (int e4 = 0; e4 < HH / 4; ++e4) { const f32x4 h = *(const __attribute__((address_space(3))) f32x4*)(hs + k * HH + e4 * 4);
            acc += h[0] * w[4 * e4]; acc += h[1] * w[4 * e4 + 1]; acc += h[2] * w[4 * e4 + 2]; acc += h[3] * w[4 * e4 + 3]; }
        const long g = g0 + k; const int set = g >= SEQ, pos = (int)(set ? g - SEQ : g), L = set ? CTX : SEQ;
        const float tl = (float)pos / (float)(L - 1); const float v = acc * (exp_f(-tl * delta) + 0.05f);
        if (set == 0) wFT(p.ws)[(long)c2 * SEQ + pos] = v; else wFT1(p.ws)[(long)pos * 2 * HW + c2] = v;
    }
    __syncthreads();
}

constexpr int MOD_KC = D / 8, MOD_BLOCKS = 8 * DEPTH * 6 * D / NTHREADS;
static_assert((DEPTH * 6 * D) % NTHREADS == 0 && MOD_KC % 4 == 0 && MOD_BLOCKS <= NBLOCKS, "mod block phase");
__device__ __forceinline__ void mod_block(PRef p, __attribute__((address_space(3))) unsigned char* lds) {
    if ((int)blockIdx.x >= MOD_BLOCKS) return;
    int t_ = threadIdx.x; asm volatile("" : "+v"(t_)); const int t = t_;
    __attribute__((address_space(3))) float* sm = (__attribute__((address_space(3))) float*)lds;
    const long i = (long)blockIdx.x * NTHREADS + t;
    const int j = (int)(i % (6 * D)), l = (int)((i / (6 * D)) % DEPTH), kc = (int)(i / ((long)6 * D * DEPTH));
    for (int idx = t; idx < (B + 1) * MOD_KC; idx += NTHREADS) { const int bi = idx / MOD_KC, k = kc * MOD_KC + idx % MOD_KC; sm[idx] = silu_f(bi < B ? p.c[(long)bi * D + k] : p.c_ctx[k]); }
    __syncthreads();
    const float* w = p.ada_w + (long)l * D * 6 * D + (long)kc * MOD_KC * 6 * D + j;
    float acc[B + 1];
#pragma unroll
    for (int bi = 0; bi <= B; ++bi) acc[bi] = 0.f;
#pragma unroll 2
    for (int k4 = 0; k4 < MOD_KC / 4; ++k4) {
        float wq[4];
#pragma unroll
        for (int q = 0; q < 4; ++q) wq[q] = w[(long)(4 * k4 + q) * 6 * D];
#pragma unroll
        for (int bi = 0; bi <= B; ++bi) { const f32x4 sv = *(const __attribute__((address_space(3))) f32x4*)(sm + bi * MOD_KC + 4 * k4);
            acc[bi] += sv[0] * wq[0]; acc[bi] += sv[1] * wq[1]; acc[bi] += sv[2] * wq[2]; acc[bi] += sv[3] * wq[3]; }
    }
#pragma unroll
    for (int bi = 0; bi <= B; ++bi) wMODP(p.ws)[(((long)kc * DEPTH + l) * (B + 1) + bi) * 6 * D + j] = acc[bi];
    __syncthreads();
}

__device__ __forceinline__ void filt_d_rows(PRef p) {
    int t_ = threadIdx.x; asm volatile("" : "+v"(t_)); const int lane = t_ & 63, gw = (int)blockIdx.x * (NTHREADS / 64) + (t_ >> 6);
    static_assert(2 * HW * 4 <= NBLOCKS * (NTHREADS / 64) && SEQ % 64 == 0 && CTX % 64 == 0, "filt_d tasks");
    if ((gw & 3) != 0 || (gw >> 2) >= 2 * HW) return;
    const int task = gw >> 2, set = task / HW, c = task % HW;
    float s = 0.f;
    if (set == 0) {
        const float* fw = wFT(p.ws) + (long)c * SEQ; const float* bw = wFT(p.ws) + (long)(HW + c) * SEQ;
#pragma unroll 8
        for (int k = 0; k < SEQ / 64; ++k) { const int pos = lane + 64 * k; s += fabsf(fw[pos]); const float b = fabsf(bw[pos]); s += pos >= 1 ? b : 0.f; }
    } else {
#pragma unroll
        for (int k = 0; k < CTX / 64; ++k) { const int pos = lane + 64 * k; s += fabsf(wFT1(p.ws)[(long)pos * 2 * HW + c]); const float b = fabsf(wFT1(p.ws)[(long)pos * 2 * HW + HW + c]); s += pos >= 1 ? b : 0.f; }
    }
    wFL1(p.ws)[((long)set * HW + c) * 64 + lane] = s;
}
__device__ __forceinline__ void ml_s_scan(PRef p) {
    int t_ = threadIdx.x; asm volatile("" : "+v"(t_)); const long gtid = (long)blockIdx.x * NTHREADS + t_;
    for (long i = gtid; i < (long)B * MH * 2 * (MD + 1) * MD; i += (long)NBLOCKS * NTHREADS) {
        const int el = (int)(i % ((MD + 1) * MD)); long t = i / ((MD + 1) * MD); const int dir = (int)(t % 2); t /= 2; const int h = (int)(t % MH); const int b = (int)(t / MH);
        float* base = wMS(p.ws) + ((((long)b * MH + h) * 2 + dir) * SCN) * (MD + 1) * MD + el;
        float Bk[SCN], Fk[SCN];
#pragma unroll
        for (int k = 0; k < SCN; ++k) { const int sc = ml_scan_sc(dir, k);
            const long r0 = (long)b * RPB + (long)sc * SCS; const long rend = dir == 0 ? r0 + SCS - 1 : r0;
            Fk[k] = wFG(p.ws)[((rend * 2 + dir) * MH + h) * 2]; Bk[k] = base[(long)sc * (MD + 1) * MD]; }
        float C = 0.f;
#pragma unroll
        for (int k = 0; k < SCN; ++k) { const int sc = ml_scan_sc(dir, k); base[(long)sc * (MD + 1) * MD] = C; C = exp_f(Fk[k]) * C + Bk[k]; }
    }
}
}
#endif
#ifndef HOST_EMU
#define LAS __attribute__((address_space(3)))
#endif

#ifndef HOST_EMU
namespace att {
typedef short bf16x8 __attribute__((ext_vector_type(8)));
typedef float f32x4 __attribute__((ext_vector_type(4)));
typedef unsigned u32x4 __attribute__((ext_vector_type(4)));
typedef unsigned u32x2 __attribute__((ext_vector_type(2)));
constexpr int TK = 128;
constexpr int KROW = 224, VROW = TK * 2 + 32, KT_BYTES = TK * KROW, VT_BYTES = 64 * VROW;
constexpr int QBLK = 256, NQB = SEQ / QBLK, NLAT = B * AH * NQB, NCQ = CTX / QBLK;
static_assert(SEQ % QBLK == 0 && RPB % TK == 0 && CTX % TK == 0 && CTX % QBLK == 0, "attention tiling");
__device__ __forceinline__ float bfl(unsigned w) { return __uint_as_float(w << 16); }
__device__ __forceinline__ float bfh(unsigned w) { return __uint_as_float(w & 0xFFFF0000u); }
typedef __bf16 bf2_t __attribute__((ext_vector_type(2)));
typedef float f32x2_t __attribute__((ext_vector_type(2)));
__device__ __forceinline__ unsigned pk(float lo, float hi) { f32x2_t v = {lo, hi}; return __builtin_bit_cast(unsigned, __builtin_convertvector(v, bf2_t)); }
__device__ __forceinline__ float xl(float v, int lane, int m) { return __int_as_float(__builtin_amdgcn_ds_bpermute((lane ^ m) << 2, __float_as_int(v))); }
__device__ __forceinline__ void attn_phase(PRef p, int l, LAS unsigned char* lds) {
    const int wave = __builtin_amdgcn_readfirstlane((int)threadIdx.x >> 6);
    const bool last = (l == DEPTH - 1);
    const int vcu = ((int)blockIdx.x % 8) * (NBLOCKS / 8) + (int)blockIdx.x / 8;
    const int nunits = NLAT + (last ? 0 : B * AH * NCQ);
    const float qscale = 0.14724420716f;
    const bf16* Qg = wQ(p.out); const bf16* KNg = wKN(p.out); const bf16* KRg = wKR(p.ws); const bf16* VTg = wVT(p.out); const float* ROPEg = wROPET(p.ws); bf16* Og = wH(p.ws);
    for (int u = vcu; u < nunits; u += NBLOCKS) {
        int tid_ = threadIdx.x; asm volatile("" : "+v"(tid_));
        const int tid = tid_, lane = tid & 63, i16 = lane & 15, g = lane >> 4;
        const bool isctx = u >= NLAT;
        int b, hd, nkeys; long q0;
        if (!isctx) { b = u / (AH * NQB); hd = (u / NQB) % AH; q0 = (long)b * RPB + CTX + (long)(u % NQB) * QBLK; nkeys = RPB; }
        else { const int uu = u - NLAT; b = uu / (AH * NCQ); hd = (uu / NCQ) % AH; q0 = (long)b * RPB + (long)(uu % NCQ) * QBLK; nkeys = CTX; }
        const long k0 = (long)b * RPB;
        const long qw = q0 + wave * 32;
        bf16x8 qf[2][3];
#pragma unroll
        for (int qb = 0; qb < 2; ++qb) {
            const bf16* qp = (Qg + qw * QW + hd * (NOPE + ROPE)) + (unsigned)((qb * 16 + i16) * QW + g * 8);
            u32x4 raw[3];
#pragma unroll
            for (int ks = 0; ks < 3; ++ks) raw[ks] = *(const u32x4*)(qp + ks * 32);
#pragma unroll
            for (int ks = 0; ks < 2; ++ks) { u32x4 w;
#pragma unroll
                for (int e = 0; e < 4; ++e) w[e] = pk(bfl(raw[ks][e]) * qscale, bfh(raw[ks][e]) * qscale);
                qf[qb][ks] = __builtin_bit_cast(bf16x8, w); }
            u32x4 w2;
            if (!isctx) {
                u32x4 pr;
#pragma unroll
                for (int e = 0; e < 4; ++e) pr[e] = (unsigned)__builtin_amdgcn_ds_bpermute((lane ^ 32) << 2, (int)raw[2][e]);
                const float* tb = (ROPEg + (qw - k0 - CTX) * 32) + (unsigned)((qb * 16 + i16) * 32 + 16 * (g & 1));
                const float sg = g < 2 ? -1.0f : 1.0f;
#pragma unroll
                for (int e = 0; e < 4; ++e) { const f32x4 cs = *(const f32x4*)(tb + 4 * e);
                    const float m0 = bfl(raw[2][e]), m1 = bfh(raw[2][e]), o0 = bfl(pr[e]), o1 = bfh(pr[e]);
                    w2[e] = pk((m0 * cs[0] + sg * o0 * cs[1]) * qscale, (m1 * cs[2] + sg * o1 * cs[3]) * qscale); }
            } else {
#pragma unroll
                for (int e = 0; e < 4; ++e) w2[e] = pk(bfl(raw[2][e]) * qscale, bfh(raw[2][e]) * qscale);
            }
            qf[qb][2] = __builtin_bit_cast(bf16x8, w2);
        }
        const bf16* knb = KNg + k0 * AW + hd * NOPE; const bf16* krb = KRg + k0 * ROPE; const bf16* vb = VTg + (long)hd * AV * R + k0;
        const unsigned kn_off0 = (unsigned)((tid >> 3) * AW + (tid & 7) * 8), kn_off1 = kn_off0 + 64u * AW, kr_off = (unsigned)((tid >> 2) * ROPE + (tid & 3) * 8);
        const unsigned v_off0 = (unsigned)((tid >> 4) * R + (tid & 15) * 8), v_off1 = v_off0 + 32u * R;
        const int kn_dst0 = (tid >> 3) * KROW + (tid & 7) * 16, kn_dst1 = kn_dst0 + 64 * KROW, kr_dst = (tid >> 2) * KROW + 128 + (tid & 3) * 16;
        const int v_dst0 = 2 * KT_BYTES + (tid >> 4) * VROW + (tid & 15) * 16, v_dst1 = v_dst0 + 32 * VROW;
        const int nt = nkeys / TK;
        f32x4 O[2][4];
#pragma unroll
        for (int qb = 0; qb < 2; ++qb)
#pragma unroll
            for (int dvt = 0; dvt < 4; ++dvt) O[qb][dvt] = (f32x4){0.f, 0.f, 0.f, 0.f};
        float mrun[2] = {0.f, 0.f}, lsum[2] = {0.f, 0.f};
        f32x4 negm[2] = {(f32x4){0.f, 0.f, 0.f, 0.f}, (f32x4){0.f, 0.f, 0.f, 0.f}};
        const int kfo = i16 * KROW + g * 16, vfo = 2 * KT_BYTES + i16 * VROW + g * 16;
        u32x4 s1, s2, s3, s4, s5;
        auto load_stage = [&](int tt) { s1 = *(const u32x4*)(knb + (long)tt * TK * AW + kn_off0); s2 = *(const u32x4*)(knb + (long)tt * TK * AW + kn_off1); s3 = *(const u32x4*)(krb + (long)tt * TK * ROPE + kr_off);
            s4 = *(const u32x4*)(vb + (long)tt * TK + v_off0); s5 = *(const u32x4*)(vb + (long)tt * TK + v_off1); };
        auto store_stage = [&](int buf) { const int nk = buf * KT_BYTES, nv = buf * VT_BYTES;
            *(LAS u32x4*)(lds + nk + kn_dst0) = s1; *(LAS u32x4*)(lds + nk + kn_dst1) = s2; *(LAS u32x4*)(lds + nk + kr_dst) = s3; *(LAS u32x4*)(lds + nv + v_dst0) = s4; *(LAS u32x4*)(lds + nv + v_dst1) = s5; };
        auto subtile = [&](int kb_off, int vb_off, bool first) {
            bf16x8 kf[12];
#pragma unroll
            for (int kb = 0; kb < 4; ++kb)
#pragma unroll
                for (int ks = 0; ks < 3; ++ks) kf[kb * 3 + ks] = *(const LAS bf16x8*)(lds + kb_off + kb * 16 * KROW + ks * 64);
            asm volatile("s_waitcnt lgkmcnt(0)" : "+v"(kf[0]), "+v"(kf[1]), "+v"(kf[2]), "+v"(kf[3]), "+v"(kf[4]), "+v"(kf[5]), "+v"(kf[6]), "+v"(kf[7]), "+v"(kf[8]), "+v"(kf[9]), "+v"(kf[10]), "+v"(kf[11]) :: "memory");
            f32x4 S[2][4];
#pragma unroll
            for (int kb = 0; kb < 4; ++kb)
#pragma unroll
                for (int ks = 0; ks < 3; ++ks) {
                    S[0][kb] = __builtin_amdgcn_mfma_f32_16x16x32_bf16(kf[kb * 3 + ks], qf[0][ks], ks == 0 ? negm[0] : S[0][kb], 0, 0, 0);
                    S[1][kb] = __builtin_amdgcn_mfma_f32_16x16x32_bf16(kf[kb * 3 + ks], qf[1][ks], ks == 0 ? negm[1] : S[1][kb], 0, 0, 0); }
            bf16x8 vf[8];
#pragma unroll
            for (int dvt = 0; dvt < 4; ++dvt)
#pragma unroll
                for (int kp = 0; kp < 2; ++kp) vf[dvt * 2 + kp] = *(const LAS bf16x8*)(lds + vb_off + dvt * 16 * VROW + kp * 64);
            asm volatile("" ::: "memory");
            bf16x8 pf[2][2];
#pragma unroll
            for (int qb = 0; qb < 2; ++qb) {
                float mx = S[qb][0][0];
#pragma unroll
                for (int kb = 0; kb < 4; ++kb)
#pragma unroll
                    for (int e = 0; e < 4; ++e) mx = fmaxf(mx, S[qb][kb][e]);
                if (first || __builtin_amdgcn_ballot_w64(mx > 8.0f) != 0ull) {
                    mx = fmaxf(mx, xl(mx, lane, 16)); mx = fmaxf(mx, xl(mx, lane, 32));
                    const float d = first ? mx : fmaxf(mx, 0.0f), corr = first ? 1.0f : __builtin_amdgcn_exp2f(-d);
                    mrun[qb] += d; lsum[qb] *= corr; negm[qb] = (f32x4){-mrun[qb], -mrun[qb], -mrun[qb], -mrun[qb]};
#pragma unroll
                    for (int dvt = 0; dvt < 4; ++dvt) O[qb][dvt] = O[qb][dvt] * corr;
#pragma unroll
                    for (int kb = 0; kb < 4; ++kb) S[qb][kb] = S[qb][kb] - d;
                }
                float ps = 0.f;
#pragma unroll
                for (int kb = 0; kb < 4; ++kb)
#pragma unroll
                    for (int e = 0; e < 4; ++e) { const float ex = __builtin_amdgcn_exp2f(S[qb][kb][e]); S[qb][kb][e] = ex; ps += ex; }
                lsum[qb] += ps;
#pragma unroll
                for (int kp = 0; kp < 2; ++kp) { u32x4 w; w[0] = pk(S[qb][2 * kp][0], S[qb][2 * kp][1]); w[1] = pk(S[qb][2 * kp][2], S[qb][2 * kp][3]); w[2] = pk(S[qb][2 * kp + 1][0], S[qb][2 * kp + 1][1]); w[3] = pk(S[qb][2 * kp + 1][2], S[qb][2 * kp + 1][3]);
                    pf[qb][kp] = __builtin_bit_cast(bf16x8, w); }
            }
            asm volatile("s_waitcnt lgkmcnt(0)" : "+v"(vf[0]), "+v"(vf[1]), "+v"(vf[2]), "+v"(vf[3]), "+v"(vf[4]), "+v"(vf[5]), "+v"(vf[6]), "+v"(vf[7]) :: "memory");
#pragma unroll
            for (int dvt = 0; dvt < 4; ++dvt)
#pragma unroll
                for (int kp = 0; kp < 2; ++kp) {
                    O[0][dvt] = __builtin_amdgcn_mfma_f32_16x16x32_bf16(vf[dvt * 2 + kp], pf[0][kp], O[0][dvt], 0, 0, 0);
                    O[1][dvt] = __builtin_amdgcn_mfma_f32_16x16x32_bf16(vf[dvt * 2 + kp], pf[1][kp], O[1][dvt], 0, 0, 0); }
        };
        load_stage(0); store_stage(0);
        __syncthreads();
        for (int t = 0; t < nt; ++t) {
            const int buf = t & 1;
            if (t + 1 < nt) load_stage(t + 1);
#pragma unroll
            for (int sub = 0; sub < TK / 64; ++sub) subtile(buf * KT_BYTES + sub * 64 * KROW + kfo, buf * VT_BYTES + sub * 128 + vfo, sub == 0 && t == 0);
            if (t + 1 < nt) store_stage(buf ^ 1);
            __syncthreads();
        }
#pragma unroll
        for (int qb = 0; qb < 2; ++qb) {
            float lt = lsum[qb]; lt += xl(lt, lane, 16); lt += xl(lt, lane, 32); const float inv = 1.0f / lt;
            bf16* op = (Og + qw * D + hd * AV) + (unsigned)((qb * 16 + i16) * D + 4 * g);
#pragma unroll
            for (int dvt = 0; dvt < 4; ++dvt) { u32x2 w; w.x = pk(O[qb][dvt][0] * inv, O[qb][dvt][1] * inv); w.y = pk(O[qb][dvt][2] * inv, O[qb][dvt][3] * inv); *(u32x2*)(op + dvt * 16) = w; }
        }
    }
}
}
#endif

#ifndef HOST_EMU
namespace mlk {
typedef short bf16x8 __attribute__((ext_vector_type(8)));
typedef float f32x16 __attribute__((ext_vector_type(16)));
typedef float f32x4 __attribute__((ext_vector_type(4)));
typedef unsigned u32x4 __attribute__((ext_vector_type(4)));
typedef unsigned u32x2 __attribute__((ext_vector_type(2)));
static_assert(SCS == 256 && MD == 64, "mlstm MFMA phases: 256-row super-chunks, head dim 64");
constexpr int KP = 144, TP = 528;
constexpr int O_KL = 0, O_VT = 256 * KP, O_CT = O_VT + 64 * TP, O_FG = O_CT + 2 * 64 * KP, O_NL = O_FG + 2 * 2 * 256 * 4, O_END = O_NL + 2 * 64 * 4;
constexpr int B_KT = 0, B_VT = 64 * TP, B_WL = 2 * 64 * TP, B_END = B_WL + 2 * 256 * 4;
constexpr float LOG2E = 1.4426950408889634f;
__device__ __forceinline__ float bfl(unsigned w) { return __uint_as_float(w << 16); }
__device__ __forceinline__ float bfh(unsigned w) { return __uint_as_float(w & 0xFFFF0000u); }
__device__ __forceinline__ unsigned pk(float lo, float hi) { unsigned r; asm volatile("v_cvt_pk_bf16_f32 %0, %1, %2" : "=v"(r) : "v"(lo), "v"(hi)); return r; }
__device__ __forceinline__ float xl32(float v, int lane) { return __int_as_float(__builtin_amdgcn_ds_bpermute((lane ^ 32) << 2, __float_as_int(v))); }
__device__ __forceinline__ int kpos(int key) { return (key & ~15) | swap23(key & 15); }
__device__ __forceinline__ void stage_t(LAS unsigned char* img, const u32x4 v, int dim0, int key) {
    const int kb = kpos(key) * 2;
#pragma unroll
    for (int e = 0; e < 4; ++e) { *(LAS unsigned short*)(img + (dim0 + 2 * e) * TP + kb) = (unsigned short)(v[e] & 0xFFFFu); *(LAS unsigned short*)(img + (dim0 + 2 * e + 1) * TP + kb) = (unsigned short)(v[e] >> 16); }
}
__device__ __forceinline__ void ml_b_phase(PRef p, LAS unsigned char* lds) {
    const int wave = __builtin_amdgcn_readfirstlane((int)threadIdx.x >> 6);
    for (int u = ((((int)blockIdx.x % 8) + 6) % 8) * (NBLOCKS / 8) + (int)blockIdx.x / 8; u < B * MH * SCN; u += NBLOCKS) {
        int tid_ = threadIdx.x; asm volatile("" : "+v"(tid_)); const int tid = tid_, lane = tid & 63, r = lane & 31, hh = lane >> 5;
        const int sc = u % SCN, h = (u / SCN) % MH, b = u / (SCN * MH); const long r0 = (long)b * RPB + (long)sc * SCS;
        const bf16* kg = wMQK(p.ws) + r0 * 2 * MW + MW + h * MD; const bf16* vg = wP(p.ws) + r0 * NP + ML_LO + MW + h * MD; const float* fg = wFG(p.ws);
#pragma unroll
        for (int i = 0; i < 4; ++i) { const int ci = tid + 512 * i, key = ci >> 3, part = ci & 7;
            stage_t(lds + B_KT, *(const u32x4*)(kg + (unsigned)(key * 2 * MW + part * 8)), part * 8, key);
            stage_t(lds + B_VT, *(const u32x4*)(vg + (unsigned)(key * NP + part * 8)), part * 8, key); }
        { const int dir = tid >> 8, key = tid & 255; const long rend = dir == 0 ? r0 + SCS - 1 : r0;
          const float Fend = fg[((rend * 2 + dir) * MH + h) * 2], G = fg[(((r0 + key) * 2 + dir) * MH + h) * 2 + 1];
          *(LAS float*)(lds + B_WL + (dir * 256 + kpos(key)) * 4) = __builtin_amdgcn_exp2f((Fend - G) * LOG2E); }
        __syncthreads();
        const int dir = wave >> 2, dvb = (wave >> 1) & 1, kb = wave & 1;
        f32x16 acc;
#pragma unroll
        for (int i = 0; i < 16; ++i) acc[i] = 0.f;
        float nacc = 0.f;
#pragma unroll 4
        for (int ks = 0; ks < 16; ++ks) {
            const bf16x8 vf = *(const LAS bf16x8*)(lds + B_VT + (dvb * 32 + r) * TP + ks * 32 + hh * 16);
            const u32x4 kr = *(const LAS u32x4*)(lds + B_KT + (kb * 32 + r) * TP + ks * 32 + hh * 16);
            const f32x4 w0 = *(const LAS f32x4*)(lds + B_WL + (dir * 256 + ks * 16 + hh * 8) * 4), w1 = *(const LAS f32x4*)(lds + B_WL + (dir * 256 + ks * 16 + hh * 8 + 4) * 4);
            const float k0 = bfl(kr[0]) * w0[0], k1 = bfh(kr[0]) * w0[1], k2 = bfl(kr[1]) * w0[2], k3 = bfh(kr[1]) * w0[3], k4 = bfl(kr[2]) * w1[0], k5 = bfh(kr[2]) * w1[1], k6 = bfl(kr[3]) * w1[2], k7 = bfh(kr[3]) * w1[3];
            nacc += ((k0 + k1) + (k2 + k3)) + ((k4 + k5) + (k6 + k7));
            u32x4 kw; kw[0] = pk(k0, k1); kw[1] = pk(k2, k3); kw[2] = pk(k4, k5); kw[3] = pk(k6, k7);
            acc = __builtin_amdgcn_mfma_f32_32x32x16_bf16(vf, __builtin_bit_cast(bf16x8, kw), acc, 0, 0, 0);
        }
        float* ms = wMS(p.ws) + ((((long)b * MH + h) * 2 + dir) * SCN + sc) * (MD + 1) * MD;
#pragma unroll
        for (int g = 0; g < 4; ++g) { f32x4 o; o[0] = acc[4 * g]; o[1] = acc[4 * g + 1]; o[2] = acc[4 * g + 2]; o[3] = acc[4 * g + 3];
            *(f32x4*)(ms + (unsigned)((kb * 32 + r) * MD + dvb * 32 + 8 * g + 4 * hh)) = o; }
        const float nt = nacc + xl32(nacc, lane);
        if (dvb == 0 && hh == 0) ms[MD * MD + kb * 32 + r] = nt;
        __syncthreads();
    }
}
__device__ __forceinline__ void ml_o_phase(PRef p, int l, LAS unsigned char* lds) {
    const int wave = __builtin_amdgcn_readfirstlane((int)threadIdx.x >> 6);
    const bool last = (l == DEPTH - 1);
    for (int u = blockIdx.x; u < B * MH * SCN; u += NBLOCKS) {
        const int sc = u % SCN, h = (u / SCN) % MH, b = u / (SCN * MH);
        if (last && sc < NCS) continue;
        int tid_ = threadIdx.x; asm volatile("" : "+v"(tid_)); const int tid = tid_, lane = tid & 63, r = lane & 31, hh = lane >> 5;
        const long r0 = (long)b * RPB + (long)sc * SCS;
        const bf16* qg = wMQK(p.ws) + r0 * 2 * MW + h * MD; const bf16* kg = qg + MW; const bf16* pg = wP(p.ws) + r0 * NP + ML_LO + h * MD; const float* fg = wFG(p.ws);
        const float* msb = wMS(p.ws) + (((long)b * MH + h) * 2 * SCN + sc) * (MD + 1) * MD;
#pragma unroll
        for (int i = 0; i < 4; ++i) { const int ci = tid + 512 * i, key = ci >> 3, part = ci & 7;
            *(LAS u32x4*)(lds + O_KL + key * KP + part * 16) = *(const u32x4*)(kg + (unsigned)(key * 2 * MW + part * 8));
            stage_t(lds + O_VT, *(const u32x4*)(pg + (unsigned)(key * NP + MW + part * 8)), part * 8, key); }
#pragma unroll
        for (int i = 0; i < 4; ++i) { const int ci = tid + 512 * i, dir = ci >> 10, kdim = (ci >> 4) & 63, d4 = ci & 15;
            const f32x4 c = *(const f32x4*)(msb + (unsigned)(dir * SCN * (MD + 1) * MD + kdim * MD + d4 * 4));
#pragma unroll
            for (int e = 0; e < 4; ++e) *(LAS unsigned short*)(lds + O_CT + (dir * 64 + d4 * 4 + e) * KP + kdim * 2) = (unsigned short)f2bf(c[e]); }
        if (tid < 128) { const int dir = tid >> 6, kdim = tid & 63; *(LAS float*)(lds + O_NL + tid * 4) = msb[(unsigned)(dir * SCN * (MD + 1) * MD + MD * MD + kdim)]; }
        { const int dir = tid >> 8, key = tid & 255; const float F = fg[(((r0 + key) * 2 + dir) * MH + h) * 2], G = fg[(((r0 + key) * 2 + dir) * MH + h) * 2 + 1];
          *(LAS float*)(lds + O_FG + ((dir * 2 + 0) * 256 + key) * 4) = F * LOG2E; *(LAS float*)(lds + O_FG + ((dir * 2 + 1) * 256 + key) * 4) = G * LOG2E; }
        bf16x8 qf[4];
#pragma unroll
        for (int ks = 0; ks < 4; ++ks) qf[ks] = *(const bf16x8*)(qg + (unsigned)((wave * 32 + r) * 2 * MW + ks * 16 + hh * 8));
        __syncthreads();
        f32x16 hs[2];
#pragma unroll
        for (int dvb = 0; dvb < 2; ++dvb)
#pragma unroll
            for (int i = 0; i < 16; ++i) hs[dvb][i] = 0.f;
#pragma unroll 1
        for (int dir = 0; dir < 2; ++dir) {
            const float Ft = *(const LAS float*)(lds + O_FG + ((dir * 2 + 0) * 256 + wave * 32 + r) * 4);
            f32x16 O[2];
#pragma unroll
            for (int dvb = 0; dvb < 2; ++dvb)
#pragma unroll
                for (int i = 0; i < 16; ++i) O[dvb][i] = 0.f;
            float den = 0.f;
            const int kt0 = dir == 0 ? 0 : wave, kt1 = dir == 0 ? wave : 7;
            for (int kt = kt0; kt <= kt1; ++kt) {
                f32x16 S;
#pragma unroll
                for (int i = 0; i < 16; ++i) S[i] = 0.f;
#pragma unroll
                for (int ks = 0; ks < 4; ++ks) {
                    const bf16x8 kf = *(const LAS bf16x8*)(lds + O_KL + (kt * 32 + r) * KP + ks * 32 + hh * 16);
                    S = __builtin_amdgcn_mfma_f32_32x32x16_bf16(kf, qf[ks], S, 0, 0, 0); }
                const bool diag = (kt == wave);
#pragma unroll
                for (int g = 0; g < 4; ++g) { const f32x4 gv = *(const LAS f32x4*)(lds + O_FG + ((dir * 2 + 1) * 256 + kt * 32 + 8 * g + 4 * hh) * 4);
#pragma unroll
                    for (int e = 0; e < 4; ++e) { const int krow = 8 * g + 4 * hh + e; const bool keep = !diag || (dir == 0 ? krow <= r : krow >= r);
                        const float wgt = __builtin_amdgcn_exp2f(keep ? Ft - gv[e] : -1.0e30f); const float sw = S[4 * g + e] * wgt; S[4 * g + e] = sw; den += sw; } }
                bf16x8 pf[2];
#pragma unroll
                for (int s2 = 0; s2 < 2; ++s2) { u32x4 w;
#pragma unroll
                    for (int e = 0; e < 4; ++e) w[e] = pk(S[8 * s2 + 2 * e], S[8 * s2 + 2 * e + 1]);
                    pf[s2] = __builtin_bit_cast(bf16x8, w); }
#pragma unroll
                for (int dvb = 0; dvb < 2; ++dvb)
#pragma unroll
                    for (int s2 = 0; s2 < 2; ++s2) {
                        const bf16x8 vf = *(const LAS bf16x8*)(lds + O_VT + (dvb * 32 + r) * TP + (kt * 32 + s2 * 16) * 2 + hh * 16);
                        O[dvb] = __builtin_amdgcn_mfma_f32_32x32x16_bf16(vf, pf[s2], O[dvb], 0, 0, 0); }
            }
            f32x16 I[2];
#pragma unroll
            for (int dvb = 0; dvb < 2; ++dvb)
#pragma unroll
                for (int i = 0; i < 16; ++i) I[dvb][i] = 0.f;
            float dint = 0.f;
#pragma unroll
            for (int ks = 0; ks < 4; ++ks) {
#pragma unroll
                for (int dvb = 0; dvb < 2; ++dvb) { const bf16x8 cf = *(const LAS bf16x8*)(lds + O_CT + (dir * 64 + dvb * 32 + r) * KP + ks * 32 + hh * 16);
                    I[dvb] = __builtin_amdgcn_mfma_f32_32x32x16_bf16(cf, qf[ks], I[dvb], 0, 0, 0); }
                const u32x4 qr = __builtin_bit_cast(u32x4, qf[ks]);
                const f32x4 n0 = *(const LAS f32x4*)(lds + O_NL + (dir * 64 + ks * 16 + hh * 8) * 4), n1 = *(const LAS f32x4*)(lds + O_NL + (dir * 64 + ks * 16 + hh * 8 + 4) * 4);
                dint += (bfl(qr[0]) * n0[0] + bfh(qr[0]) * n0[1]) + (bfl(qr[1]) * n0[2] + bfh(qr[1]) * n0[3]) + (bfl(qr[2]) * n1[0] + bfh(qr[2]) * n1[1]) + (bfl(qr[3]) * n1[2] + bfh(qr[3]) * n1[3]);
            }
            const float a = __builtin_amdgcn_exp2f(Ft);
            const float dtot = (den + xl32(den, lane)) + a * (dint + xl32(dint, lane));
            const float scl = 1.0f / fmaxf(fabsf(dtot), 1.0f);
#pragma unroll
            for (int dvb = 0; dvb < 2; ++dvb)
#pragma unroll
                for (int i = 0; i < 16; ++i) hs[dvb][i] += (O[dvb][i] + a * I[dvb][i]) * scl;
        }
        const bf16* og = pg + (unsigned)((wave * 32 + r) * NP + 2 * MW + 4 * hh);
        float ss = 0.f;
#pragma unroll
        for (int dvb = 0; dvb < 2; ++dvb)
#pragma unroll
            for (int g = 0; g < 4; ++g) { const u32x2 ov = *(const u32x2*)(og + dvb * 32 + 8 * g);
                const float o0 = bfl(ov[0]), o1 = bfh(ov[0]), o2 = bfl(ov[1]), o3 = bfh(ov[1]);
                float v0 = hs[dvb][4 * g] * rcp_f(1.0f + exp_f(-o0)), v1 = hs[dvb][4 * g + 1] * rcp_f(1.0f + exp_f(-o1)), v2 = hs[dvb][4 * g + 2] * rcp_f(1.0f + exp_f(-o2)), v3 = hs[dvb][4 * g + 3] * rcp_f(1.0f + exp_f(-o3));
                hs[dvb][4 * g] = v0; hs[dvb][4 * g + 1] = v1; hs[dvb][4 * g + 2] = v2; hs[dvb][4 * g + 3] = v3; ss += (v0 * v0 + v1 * v1) + (v2 * v2 + v3 * v3); }
        ss += xl32(ss, lane);
        const float rstd = 1.0f / sqrtf(ss / (float)MD + EPS);
        const float* ng = p.ml_norm_g + l * MW + h * MD + 4 * hh; bf16* op = wH(p.ws) + (r0 + wave * 32 + r) * D + AW + h * MD + 4 * hh;
#pragma unroll
        for (int dvb = 0; dvb < 2; ++dvb)
#pragma unroll
            for (int g = 0; g < 4; ++g) { const f32x4 gg = *(const f32x4*)(ng + dvb * 32 + 8 * g); u32x2 w;
                w[0] = pk(hs[dvb][4 * g] * rstd * gg[0], hs[dvb][4 * g + 1] * rstd * gg[1]); w[1] = pk(hs[dvb][4 * g + 2] * rstd * gg[2], hs[dvb][4 * g + 3] * rstd * gg[3]);
                *(u32x2*)(op + dvb * 32 + 8 * g) = w; }
        __syncthreads();
    }
}
}
#endif
#ifndef HOST_EMU
#define XB_TMO      128
#define XB_XCNT(j)  (256  + 64 * (j))
#define XB_XSUB(j)  (1280 + 64 * (j))
#define XB_XGEN(j)  (2304 + 64 * (j))
#define XB_TOP      3328
#define XB_TOPGEN   3392
#define XCD_BAR_WORDS 3456
#define XB_SPIN_CAP (1u << 18)

__device__ __forceinline__ unsigned xb_ld(unsigned* p)              { return __hip_atomic_load(p, __ATOMIC_RELAXED, __HIP_MEMORY_SCOPE_AGENT); }
__device__ __forceinline__ unsigned xb_add(unsigned* p, unsigned v) { return __hip_atomic_fetch_add(p, v, __ATOMIC_RELAXED, __HIP_MEMORY_SCOPE_AGENT); }
__device__ __forceinline__ unsigned xb_xcc_id() { return (unsigned)__builtin_amdgcn_s_getreg((3 << 11) | 20) & 0xFu; }
#define XB_SPIN(cond, bar) do { unsigned _sp = 0; while (cond) { __builtin_amdgcn_s_sleep(1); \
    if ((++_sp & 255u) == 0u) { if (xb_ld(&(bar)[XB_TMO])) break; if (_sp > XB_SPIN_CAP) { atomicAdd(&(bar)[XB_TMO], 1u); break; } } } } while (0)

struct XcdBarrier { unsigned* bar; unsigned x; volatile LAS unsigned* st; };

__device__ __forceinline__ XcdBarrier xcd_barrier_post(unsigned* bar, volatile LAS unsigned* st) {
    XcdBarrier b; b.bar = bar; b.x = xb_xcc_id(); b.st = st;
    if (threadIdx.x == 0) (void)xb_add(&bar[XB_XCNT(b.x)], 1u);
    return b;
}
__device__ __forceinline__ void xcd_barrier_complete(unsigned* bar, unsigned x, unsigned& nloc, unsigned& nx) {
    const unsigned G = gridDim.x * gridDim.y * gridDim.z;
    unsigned sum, cnt, mine, sp = 0u;
    for (;;) {
        sum = 0u; cnt = 0u; mine = 0u;
#pragma unroll
        for (unsigned j = 0; j < 16; ++j) { const unsigned c = xb_ld(&bar[XB_XCNT(j)]); sum += c; cnt += (c > 0u) ? 1u : 0u; mine = (j == x) ? c : mine; }
        if (sum == G) break;
        __builtin_amdgcn_s_sleep(1);
        if ((++sp & 255u) == 0u) { if (xb_ld(&bar[XB_TMO])) break; if (sp > XB_SPIN_CAP) { atomicAdd(&bar[XB_TMO], 1u); break; } }
    }
    nloc = mine > 0u ? mine : 1u; nx = cnt > 0u ? cnt : 1u;
}
__device__ __forceinline__ void xcd_barrier(const XcdBarrier& b) {
    asm volatile("s_waitcnt vmcnt(0)" ::: "memory");
    __syncthreads();
    if (threadIdx.x == 0) {
        unsigned* bar = b.bar;
        __builtin_amdgcn_s_waitcnt(0);
        unsigned nloc = b.st[0], nx = b.st[1];
        if (nloc == 0u) { xcd_barrier_complete(bar, b.x, nloc, nx); b.st[0] = nloc; b.st[1] = nx; }
        const unsigned old = xb_add(&bar[XB_XSUB(b.x)], 1u);
        const unsigned gen = old / nloc;
        if (old + 1u == (gen + 1u) * nloc) {
            __builtin_amdgcn_fence(__ATOMIC_RELEASE, "agent");
            asm volatile("s_waitcnt vmcnt(0)" ::: "memory");
            const unsigned og = xb_add(&bar[XB_TOP], 1u);
            const unsigned tg = og / nx;
            if (og + 1u == (tg + 1u) * nx) xb_add(&bar[XB_TOPGEN], 1u);
            else XB_SPIN(xb_ld(&bar[XB_TOPGEN]) == tg, bar);
            __builtin_amdgcn_fence(__ATOMIC_ACQUIRE, "agent");
            xb_add(&bar[XB_XGEN(b.x)], 1u);
            asm volatile("s_waitcnt vmcnt(0)" ::: "memory");
        } else {
            XB_SPIN(xb_ld(&bar[XB_XGEN(b.x)]) == gen, bar);
            __builtin_amdgcn_fence(__ATOMIC_ACQUIRE, "agent");
            asm volatile("s_waitcnt vmcnt(0)" ::: "memory");
        }
    }
    __syncthreads();
}
#endif

constexpr int UPT = (R + 253) / 254;
constexpr int LDS_BYTES = 163840;

#ifdef HOST_EMU
#define ATT_PHASE(l) RUN(PH_ATT, l, 0)
#define NORM1_PHASE(l) RUN(PH_NORM1, l, 0)
#define MOD_PHASE() RUN(PH_MOD, 0, 0)
#define FILT_B_PHASE(l) RUN(PH_FILT_B, l, 0)
#define FILT_C_PHASE(l) RUN(PH_FILT_C, l, 0)
#define ML_B_PHASE(l) RUN(PH_ML_B, l, 0)
#define ML_O_PHASE(l) RUN(PH_ML_O, l, 0)
#define NORM2_PHASE(l) RUN(PH_NORM2, l, 0)
#define FINAL_PHASE() RUN(PH_FINAL, 0, 0)
#define MLA_A_PHASE(l) RUN(PH_MLA_A, l, 0)
#define ML_F_PHASE(l) RUN(PH_ML_F, l, 0)
#define FILT_D_PHASE(l) RUN(PH_FILT_D, l, 0)
#define ML_S_PHASE(l) RUN(PH_ML_S, l, 0)
#define GEMM_GEMM1(l) RUN(PH_GEMM1, l, 0)
#define GEMM_Q(l) RUN(PH_MLA_Q, l, 0)
#define GEMM_KV(l) RUN(PH_MLA_KV, l, 0)
#define GEMM_MLQK(l) RUN(PH_ML_QK, l, 0)
#define GEMM_OUT(l) RUN(PH_GEMM_OUT, l, 0)
#else
#define KARG() const Params __attribute__((address_space(4)))* kp_ = (const Params __attribute__((address_space(4)))*)__builtin_amdgcn_kernarg_segment_ptr(); asm volatile("" : "+s"(kp_)); PRef p = *kp_
#define LAT_ 0
#define GEMM_LAT(l, EPI, A_, lda_, Bt_, ldb_, N_, K_, rot, ...) do { KARG(); const int lat_ = ((l) == DEPTH - 1) && (SEQ % 256 == 0) && (CTX % 256 == 0); pg8::Gemm g_{(const bf16*)(A_), (const bf16*)(Bt_), lda_, ldb_, lat_ ? B * SEQ : R, N_, K_, 256}; \
    pg8::StaticOrder S_; S_.init(lat_ ? B * SEQ : R, N_, NBLOCKS, ((int)blockIdx.x + (rot)) % NBLOCKS, lat_); pg8::EPI E_{__VA_ARGS__}; pg8::gemm_phase<pg8::EPI, pg8::StaticOrder, true, true>((LAS unsigned char*)lds, g_, S_, E_); } while (0)
#define GEMM_CALL(EPI, A_, lda_, Bt_, ldb_, M_, N_, K_, rot, ...) GEMM_CALLX(true, EPI, A_, lda_, Bt_, ldb_, M_, N_, K_, rot, __VA_ARGS__)
#define GEMM_CALLX(SP2_, EPI, A_, lda_, Bt_, ldb_, M_, N_, K_, rot, ...) do { KARG(); pg8::Gemm g_{(const bf16*)(A_), (const bf16*)(Bt_), lda_, ldb_, M_, N_, K_, 256}; pg8::StaticOrder S_; S_.init(M_, N_, NBLOCKS, ((int)blockIdx.x + (rot)) % NBLOCKS, LAT_); \
    pg8::EPI E_{__VA_ARGS__}; pg8::gemm_phase<pg8::EPI, pg8::StaticOrder, true, SP2_>((LAS unsigned char*)lds, g_, S_, E_); } while (0)
#define ATT_PHASE(l) do { KARG(); att::attn_phase(p, l, (LAS unsigned char*)lds); } while (0)
#define NORM1_PHASE(l) do { KARG(); wv::norm_rows<0>(p, l); } while (0)
#define MOD_PHASE() do { KARG(); wv::mod_block(p, (LAS unsigned char*)lds); } while (0)
#define FILT_B_PHASE(l) do { KARG(); wv::filt_b_block(p, l, (LAS unsigned char*)lds); } while (0)
#define FILT_C_PHASE(l) do { KARG(); wv::filt_c_block(p, l, (LAS unsigned char*)lds); } while (0)
#define ML_B_PHASE(l) do { KARG(); mlk::ml_b_phase(p, (LAS unsigned char*)lds); } while (0)
#define ML_O_PHASE(l) do { KARG(); mlk::ml_o_phase(p, l, (LAS unsigned char*)lds); } while (0)
#define NORM2_PHASE(l) do { KARG(); wv::norm_rows<1>(p, l); } while (0)
#define FINAL_PHASE() do { KARG(); wv::norm_rows<2>(p, 0); } while (0)
#define MLA_A_PHASE(l) do { KARG(); wv::mla_a_rows(p); } while (0)
#define ML_F_PHASE(l) do { KARG(); wv::ml_f_rows(p, l); } while (0)
#define FILT_D_PHASE(l) do { KARG(); wv::filt_d_rows(p); } while (0)
#define ML_S_PHASE(l) do { KARG(); wv::ml_s_scan(p); } while (0)
#define GEMM_GEMM1(l) GEMM_CALL(EpiBf16, wH(p.ws), D, wWinT(p.ws, l), D, R, NP, D, 0, wP(p.ws), NP, nullptr, 0)
#define GEMM_Q(l) GEMM_CALL(EpiBf16, wP(p.ws), NP, wWuqT(p.ws, l), QR, R, QW, QR, 0, wQ(p.out), QW, wRS(p.ws), 1)
#define GEMM_KV(l) do { GEMM_CALL(EpiBf16, wP(p.ws) + QR, NP, wWukvT(p.ws, l), KVR, R, AW, KVR, (R / 256 * (QW / 256)) % NBLOCKS, wKN(p.out), AW, wRS(p.ws) + R, 1); \
    GEMM_CALLX(false, EpiVT, wWukvT(p.ws, l) + (size_t)AW * KVR, KVR, wP(p.ws) + QR, NP, AW, R, KVR, (R / 256 * ((QW + AW) / 256)) % NBLOCKS, wVT(p.out), wRS(p.ws) + R); } while (0)
#define GEMM_MLQK(l) GEMM_CALL(EpiBf16, wMU(p.ws), MW, wWML(p.ws), MW, R, 2 * MW, MW, (R / 256 * ((QW + 2 * AW) / 256)) % NBLOCKS, wMQK(p.ws), 2 * MW, nullptr, 0)
#define GEMM_OUT(l) GEMM_LAT(l, EpiResid, wH(p.ws), D, wWoutT(p.ws, l), D, D, D, 0, wX(p.ws), wMOD(p.ws) + (size_t)(l) * (B + 1) * 6 * D + 2 * D, nullptr, DRY_)
#define GEMM_UP(l) do { KARG(); pg8::Gemm g_{(const bf16*)(wH(p.ws) - D), (const bf16*)wWupT(p.ws, l), D, D, UPT * 256, FF2, D, 254}; pg8::StaticOrder S_; S_.init(UPT * 256, FF2, NBLOCKS, (int)blockIdx.x); \
    pg8::EpiConvGate E_{wGF(p.ws), p.ffn_conv_w + (size_t)(l) * 3 * FF2, p.ffn_conv_b + (size_t)(l) * FF2, (LAS unsigned char*)lds + pg8::STAGE_BYTES}; pg8::gemm_phase<pg8::EpiConvGate, pg8::StaticOrder, true, true>((LAS unsigned char*)lds, g_, S_, E_); } while (0)
#define GEMM_DOWN(l) GEMM_LAT(l, EpiResid, wGF(p.ws), FF, wWdownT(p.ws, l), FF, D, FF, 0, wX(p.ws), wMOD(p.ws) + (size_t)(l) * (B + 1) * 6 * D + 5 * D, nullptr, DRY_)
#endif
#ifdef HOST_EMU
#define GRID_BAR() do {} while (0)
#define FILL_W(ln, busy, i0, i1, filt) do { const int i0_ = (i0), i1_ = (i1); emu_block_launch(i1_ - i0_, [&](int blk, unsigned char* smem) { bphase<BPH_WCVT>(p, ln, i0_ + blk, smem); }); if (filt) RUN(PH_FILT_A, ln, 0); } while (0)
#define RUN(PH, l, arg) emu_launch([&](long gtid, long gth) { phase<PH>(p, l, arg, gtid, gth); })
#define BRUN(BPH, l, nblk) emu_block_launch(nblk, [&](int blk, unsigned char* smem) { bphase<BPH>(p, l, blk, smem); })
#define BRUN_OFF(BPH, l, nblk, busy) BRUN(BPH, l, nblk)
static void fwd(const Params& p) {
#else
#define GRID_BAR() xcd_barrier(bar)
#define DRY_ 0
#define BRUN(BPH, l, nblk) do { KARG(); for (int blk_ = blockIdx.x; blk_ < (nblk); blk_ += NBLOCKS) bphase<BPH>(p, l, blk_, (LdsPtr)lds); } while (0)
#define BRUN_OFF(BPH, l, nblk, busy) do { KARG(); const int busy_ = (busy); if ((int)blockIdx.x >= busy_) for (int blk_ = (int)blockIdx.x - busy_; blk_ < (nblk); blk_ += NBLOCKS - busy_) bphase<BPH>(p, l, blk_, (LdsPtr)lds); } while (0)
#define FILL_W(ln, busy, i0, i1, filt) do { KARG(); const int busy_ = (busy), nf_ = NBLOCKS - busy_, i1_ = (i1); __syncthreads(); if ((int)blockIdx.x >= busy_) { for (int blk_ = (i0) + (int)blockIdx.x - busy_; blk_ < i1_; blk_ += nf_) bphase<BPH_WCVT>(p, ln, blk_, (LdsPtr)lds); \
    if (filt) { int t_ = threadIdx.x; asm volatile("" : "+v"(t_)); phase<PH_FILT_A>(p, ln, 0, (long)((int)blockIdx.x - busy_) * NTHREADS + t_, (long)nf_ * NTHREADS); } } } while (0)
#define RUN(PH, l, arg) do { KARG(); int t_ = threadIdx.x; asm volatile("" : "+v"(t_)); const int g_ = blockIdx.x * NTHREADS + t_; phase<PH>(p, l, arg, (long)g_, gth); } while (0)
__global__ void __launch_bounds__(NTHREADS, 2) fwd(Params p_unused) {
    extern __shared__ __attribute__((aligned(16))) unsigned char lds[];
    if (threadIdx.x < 4) ((LAS unsigned*)lds)[(LDS_BYTES - 16) / 4 + threadIdx.x] = 0u;
    __syncthreads();
    XcdBarrier bar; { KARG(); bar = xcd_barrier_post(wctl(p.ws) + 1024, (volatile LAS unsigned*)(lds + LDS_BYTES - 16)); }
    constexpr long gth = (long)NBLOCKS * NTHREADS;
#endif
    MOD_PHASE(); RUN(PH_ROPE, 0, 0);
    GRID_BAR();
    RUN(PH_MOD2, 0, 0);
    for (int hs = 0; hs <= 2 * DEPTH; ++hs) {
        const int l = (hs - 1) >> 1;
        if (hs >= 1 && (hs & 1)) {
            NORM1_PHASE(l); FILT_B_PHASE(l);
            GRID_BAR();
            GEMM_GEMM1(l); FILT_C_PHASE(l);
            GRID_BAR();
            MLA_A_PHASE(l); if (l < DEPTH - 1) RUN(PH_HY_Z, l, 0); BRUN(BPH_HYZ, l, B * (SEQ / 64)); FILT_D_PHASE(l); RUN(PH_ML_U, l, 0); ML_F_PHASE(l);
            GRID_BAR();
            GEMM_Q(l); GEMM_KV(l); GEMM_MLQK(l); BRUN(BPH_HFFT, l, HW); if (l < DEPTH - 1) BRUN(BPH_HYCTX, l, B * (HW / 8));
            GRID_BAR();
            ATT_PHASE(l); ML_B_PHASE(l);
            GRID_BAR();
            ML_S_PHASE(l); BRUN(BPH_HYFFT, l, HW);
            GRID_BAR();
            ML_O_PHASE(l); BRUN_OFF(BPH_HYOUT, l, B * (SEQ / 64), l < DEPTH - 1 ? (B * MH * SCN) % NBLOCKS : 0);
            GRID_BAR();
            GEMM_OUT(l);
        }
        if (hs >= 2 && !(hs & 1)) {
            NORM2_PHASE(l);
            GRID_BAR();
#ifdef HOST_EMU
            for (int fcI = 0; fcI < NFC; ++fcI) { RUN(PH_FFN_UP, l, fcI); RUN(PH_FFN_CG, l, fcI); RUN(PH_FFN_DOWN, l, fcI); }
#else
            GEMM_UP(l);
            GRID_BAR();
            GEMM_DOWN(l);
#endif
        }
        {
            int fl = 0, busy = 0, i0 = 0, i1 = 0, filt = 0;
            if (hs == 0) { i1 = WT_SPLIT; filt = 1; }
            else if (hs == 1) { busy = DOWN_BUSY; i0 = WT_SPLIT; i1 = WT_ITEMS; }
            else if (!(hs & 1) && (hs >> 1) < DEPTH) { fl = hs >> 1; busy = DOWN_BUSY; i1 = WT_ITEMS; filt = 1; }
            else if ((hs & 1) && hs > 1) {   }
            FILL_W(fl, busy, i0, i1, filt);
        }
        GRID_BAR();
    }
    FINAL_PHASE();
}

extern "C" void kernel_launch(void* const* d_in, const int* in_sizes, int n_in, void* d_out, int out_size, void* d_ws, size_t ws_size, hipStream_t stream) {
    (void)in_sizes; (void)n_in; (void)out_size; (void)ws_size;
    Params p{};
    const float* const* in = (const float* const*)d_in;
    p.x = in[0]; p.c = in[1]; p.ctx = in[2]; p.c_ctx = in[3]; p.ada_w = in[4]; p.ada_b = in[5]; p.norm1_g = in[6]; p.norm2_g = in[7]; p.w_in = in[8];
    p.q_norm_g = in[9]; p.kv_norm_g = in[10]; p.w_uq = in[11]; p.w_ukv = in[12]; p.ml_conv_w = in[13]; p.ml_conv_b = in[14]; p.ml_wq = in[15]; p.ml_wk = in[16];
    p.ml_gate_b = in[17]; p.ml_norm_g = in[18]; p.hy_conv_w = in[19]; p.hy_conv_b = in[20]; p.hy_w1 = in[21]; p.hy_b1 = in[22]; p.hy_w2 = in[23]; p.hy_b2 = in[24];
    p.hy_w3 = in[25]; p.hy_freq = in[26]; p.hy_bias_d = in[27]; p.w_out = in[28]; p.w_up = in[29]; p.ffn_conv_w = in[30]; p.ffn_conv_b = in[31]; p.w_down = in[32]; p.final_g = in[33];
    p.out = (float*)d_out;
    p.ws = (char*)d_ws;
#ifdef HOST_EMU
    fwd(p);
#else
    static int grid = 0;
    if (grid == 0) {
        int dev = 0, cus = 0;
        if (hipGetDevice(&dev) != hipSuccess || hipDeviceGetAttribute(&cus, hipDeviceAttributeMultiprocessorCount, dev) != hipSuccess) { grid = -1; return; }
        if (hipFuncSetAttribute((const void*)fwd, hipFuncAttributeMaxDynamicSharedMemorySize, LDS_BYTES) != hipSuccess) { grid = -1; return; }
        int per_cu = 0;
        (void)hipOccupancyMaxActiveBlocksPerMultiprocessor(&per_cu, (const void*)fwd, NTHREADS, LDS_BYTES);
        (void)hipGetLastError();
        grid = (cus >= NBLOCKS) ? NBLOCKS : -1;
    }
    if (grid < 0) return;
    (void)hipMemsetAsync(d_ws, 0, CTL_BYTES, stream);
    hipLaunchKernelGGL(fwd, dim3(grid), dim3(NTHREADS), LDS_BYTES, stream, p);
#endif
}
```
